# Optimizing an MI355X kernel written in HIP

```python
import jax, jax.numpy as jnp
from jax import lax
import numpy as np

D_MODEL = 2048
BATCH = 2
SEQ = 4096
DEPTH = 4

MIX_WIDTH = D_MODEL
EPS = 1e-6
LRU_WIDTH = MIX_WIDTH // 2
LRU_BLOCKS = 8
LRU_BLOCK_W = LRU_WIDTH // LRU_BLOCKS
CONV_W = 4
LRU_C = 8.0
MLSTM_WIDTH = MIX_WIDTH // 2
MLSTM_HEADS = 4
MLSTM_DV = MLSTM_WIDTH // MLSTM_HEADS
MLSTM_DK = MLSTM_DV // 2
MLSTM_QK = MLSTM_HEADS * MLSTM_DK
MLSTM_CHUNK = 128
AB_IN = 2 * LRU_WIDTH + 2 * MLSTM_QK + 2 * MLSTM_WIDTH + 2 * MLSTM_HEADS
SB_HEADS = 16
SB_HEAD_DIM = MIX_WIDTH // SB_HEADS
SB_BLOCK = 128
FFN_HIDDEN = ((8 * D_MODEL // 3 + 255) // 256) * 256

kernel_name = "hybrid_rglru_mlstm_stickbreaking_adaln"


def rmsnorm(x, g):
    xf = x.astype(jnp.float32)
    y = xf * lax.rsqrt(jnp.mean(xf * xf, axis=-1, keepdims=True) + EPS)
    return (y * g.astype(jnp.float32)).astype(x.dtype)


def causal_depthwise_conv(x, w, b):
    C = x.shape[-1]
    y = lax.conv_general_dilated(x, w[:, None, :], window_strides=(1,), padding=[(CONV_W - 1, 0)],
                                 dimension_numbers=("NWC", "WIO", "NWC"), feature_group_count=C)
    return y + b


def _linear_recurrence_combine(e1, e2):
    a1, b1 = e1
    a2, b2 = e2
    return a1 * a2, a2 * b1 + b2


def rglru(x, gate_w, gate_b, lam):
    B, S, _ = x.shape
    xb = x.reshape(B, S, LRU_BLOCKS, LRU_BLOCK_W)
    g = jnp.einsum("bsnd,gnde->gbsne", xb, gate_w).reshape(2, B, S, LRU_WIDTH) + gate_b[:, None, None, :]
    r = jax.nn.sigmoid(g[0])
    i = jax.nn.sigmoid(g[1])
    log_a = LRU_C * r * jax.nn.log_sigmoid(lam)
    a = jnp.exp(log_a)
    u = jnp.sqrt(-jnp.expm1(2.0 * log_a)) * (i * x)
    _, h = lax.associative_scan(_linear_recurrence_combine, (a, u), axis=1)
    return h


def mlstm_chunkwise(q, k, v, ig, fg):
    B, S, H, _ = q.shape
    L = MLSTM_CHUNK
    NC = S // L

    def chunks(t):
        t = t.reshape((B, NC, L, H) + t.shape[3:])
        return jnp.moveaxis(jnp.moveaxis(t, 1, 0), 3, 2)

    qc = chunks(q)
    kc = chunks(k * (MLSTM_DK ** -0.5))
    vc = chunks(v)
    lic = chunks(ig)
    lfc = chunks(jax.nn.log_sigmoid(fg))
    causal = jnp.tril(jnp.ones((L, L), dtype=bool))

    def step(carry, xs):
        C, n, m = carry
        qb, kb, vb, li, lf = xs
        bcum = jnp.cumsum(lf, axis=-1)
        Dm = jnp.where(causal, bcum[..., :, None] - bcum[..., None, :] + li[..., None, :], -jnp.inf)
        m_inter = bcum + m[..., None]
        m_t = jnp.maximum(m_inter, jnp.max(Dm, axis=-1))
        w_intra = jnp.exp(Dm - m_t[..., None])
        w_inter = jnp.exp(m_inter - m_t)
        s = jnp.einsum("bhtd,bhsd->bhts", qb, kb) * w_intra
        num = jnp.einsum("bhts,bhsv->bhtv", s, vb) + w_inter[..., None] * jnp.einsum("bhvd,bhtd->bhtv", C, qb)
        den = jnp.sum(s, axis=-1) + w_inter * jnp.einsum("bhd,bhtd->bht", n, qb)
        h = num / jnp.maximum(jnp.abs(den), jnp.exp(-m_t))[..., None]
        b_last = bcum[..., -1]
        gk = b_last[..., None] - bcum + li
        m_new = jnp.maximum(b_last + m, jnp.max(gk, axis=-1))
        decay = jnp.exp(b_last + m - m_new)
        wk = jnp.exp(gk - m_new[..., None])
        C_new = decay[..., None, None] * C + jnp.einsum("bhs,bhsv,bhsd->bhvd", wk, vb, kb)
        n_new = decay[..., None] * n + jnp.einsum("bhs,bhsd->bhd", wk, kb)
        return (C_new, n_new, m_new), h

    init = (jnp.zeros((B, H, MLSTM_DV, MLSTM_DK), jnp.float32),
            jnp.zeros((B, H, MLSTM_DK), jnp.float32),
            jnp.zeros((B, H), jnp.float32))
    _, hs = lax.scan(step, init, (qc, kc, vc, lic, lfc))
    return jnp.transpose(hs, (1, 0, 3, 2, 4)).reshape(B, S, H, MLSTM_DV)


def rglru_mlstm_mixer(h, w_in, w_out, conv_w, conv_b, gate_w, gate_b, lam, m_gate_b, m_norm_g):
    B, S, _ = h.shape
    f32 = jnp.float32
    proj = (h @ w_in).astype(f32)
    cuts = np.cumsum([LRU_WIDTH, LRU_WIDTH, MLSTM_QK, MLSTM_QK, MLSTM_WIDTH, MLSTM_WIDTH, MLSTM_HEADS])
    xa, ya, q, k, v, o, ig, fg = jnp.split(proj, cuts, axis=-1)
    xa = causal_depthwise_conv(xa, conv_w.astype(f32), conv_b.astype(f32))
    out_a = rglru(xa, gate_w.astype(f32), gate_b.astype(f32), lam.astype(f32)) * jax.nn.gelu(ya)
    mgb = m_gate_b.astype(f32)
    hb = mlstm_chunkwise(q.reshape(B, S, MLSTM_HEADS, MLSTM_DK), k.reshape(B, S, MLSTM_HEADS, MLSTM_DK),
                         v.reshape(B, S, MLSTM_HEADS, MLSTM_DV), ig + mgb[0], fg + mgb[1])
    hb = hb * lax.rsqrt(jnp.mean(hb * hb, axis=-1, keepdims=True) + EPS)
    hb = hb * m_norm_g.astype(f32).reshape(MLSTM_HEADS, MLSTM_DV)
    out_b = hb.reshape(B, S, MLSTM_WIDTH) * jax.nn.sigmoid(o)
    mix = jnp.concatenate([out_a, out_b], axis=-1).astype(h.dtype)
    return mix @ w_out


def _stick_breaking_block(qb, kp, vp, start):
    z = jnp.einsum("bhtd,bhsd->bhts", qb, kp) * (SB_HEAD_DIM ** -0.5)
    t_idx = start + jnp.arange(qb.shape[2])
    s_idx = jnp.arange(kp.shape[2])
    mask = s_idx[None, :] < t_idx[:, None]
    log_omb = jnp.where(mask, -jax.nn.softplus(z), 0.0)
    rev = lax.cumsum(log_omb, axis=3, reverse=True)
    log_A = jax.nn.log_sigmoid(z) + (rev - log_omb)
    A = jnp.where(mask, jnp.exp(log_A), 0.0)
    return jnp.einsum("bhts,bhsd->bhtd", A, vp)


def stick_breaking_mixer(h, w_qkv, w_out):
    B, S, _ = h.shape
    qkv = (h @ w_qkv).astype(jnp.float32).reshape(B, S, 3, SB_HEADS, SB_HEAD_DIM)
    qkv = jnp.transpose(qkv, (2, 0, 3, 1, 4))
    q, k, v = qkv[0], qkv[1], qkv[2]
    outs = []
    for start in range(0, S, SB_BLOCK):
        end = start + SB_BLOCK
        outs.append(_stick_breaking_block(q[:, :, start:end], k[:, :, :end], v[:, :, :end], start))
    o = jnp.concatenate(outs, axis=2)
    o = jnp.transpose(o, (0, 2, 1, 3)).reshape(B, S, SB_HEADS * SB_HEAD_DIM).astype(h.dtype)
    return o @ w_out


def swiglu(h, w1, w3, w2):
    return (jax.nn.silu(h @ w1) * (h @ w3)) @ w2


def setup_inputs(seed: int = 0) -> dict:
    key = jax.random.key(seed)
    ks = jax.random.split(key, 24)
    f32 = jnp.float32
    ne, no = (DEPTH + 1) // 2, DEPTH // 2

    def nrm(k, shape, scale):
        return jax.random.normal(k, shape, f32) * scale

    u = jax.random.uniform(ks[13], (ne, LRU_WIDTH), f32, 0.9, 0.999)
    mlstm_gate_b = jnp.stack([nrm(ks[14], (ne, MLSTM_HEADS), 0.1),
                              jax.random.uniform(ks[15], (ne, MLSTM_HEADS), f32, 3.0, 6.0)], axis=1)
    return {
        "x": nrm(ks[0], (BATCH, SEQ, D_MODEL), 1.0),
        "c": nrm(ks[1], (BATCH, D_MODEL), 1.0),
        "ada_w": nrm(ks[2], (DEPTH, 2, D_MODEL, 3 * D_MODEL), 0.5 * D_MODEL ** -0.5),
        "ada_b": nrm(ks[3], (DEPTH, 2, 3 * D_MODEL), 0.02),
        "norm_g": 1.0 + nrm(ks[4], (DEPTH, 2, D_MODEL), 0.02),
        "final_g": 1.0 + nrm(ks[5], (D_MODEL,), 0.02),
        "ffn_w1": nrm(ks[6], (DEPTH, D_MODEL, FFN_HIDDEN), D_MODEL ** -0.5),
        "ffn_w3": nrm(ks[7], (DEPTH, D_MODEL, FFN_HIDDEN), D_MODEL ** -0.5),
        "ffn_w2": nrm(ks[8], (DEPTH, FFN_HIDDEN, D_MODEL), FFN_HIDDEN ** -0.5),
        "ab_w_in": nrm(ks[9], (ne, D_MODEL, AB_IN), D_MODEL ** -0.5),
        "ab_w_out": nrm(ks[10], (ne, MIX_WIDTH, D_MODEL), MIX_WIDTH ** -0.5),
        "lru_conv_w": nrm(ks[11], (ne, CONV_W, LRU_WIDTH), CONV_W ** -0.5),
        "lru_conv_b": nrm(ks[12], (ne, LRU_WIDTH), 0.02),
        "lru_gate_w": nrm(ks[16], (ne, 2, LRU_BLOCKS, LRU_BLOCK_W, LRU_BLOCK_W), LRU_BLOCK_W ** -0.5),
        "lru_gate_b": nrm(ks[17], (ne, 2, LRU_WIDTH), 0.02),
        "lru_lambda": jnp.log(u) - jnp.log1p(-u),
        "mlstm_gate_b": mlstm_gate_b,
        "mlstm_norm_g": 1.0 + nrm(ks[18], (ne, MLSTM_WIDTH), 0.02),
        "sb_w_qkv": nrm(ks[19], (no, D_MODEL, 3 * SB_HEADS * SB_HEAD_DIM), D_MODEL ** -0.5),
        "sb_w_out": nrm(ks[20], (no, SB_HEADS * SB_HEAD_DIM, D_MODEL), (SB_HEADS * SB_HEAD_DIM) ** -0.5),
    }


def reference(x, c, ada_w, ada_b, norm_g, final_g, ffn_w1, ffn_w3, ffn_w2,
              ab_w_in, ab_w_out, lru_conv_w, lru_conv_b, lru_gate_w, lru_gate_b, lru_lambda,
              mlstm_gate_b, mlstm_norm_g, sb_w_qkv, sb_w_out):
    c_act = jax.nn.silu(c)
    for layer in range(DEPTH):
        j = layer // 2
        shift, scale, gate = jnp.split(c_act @ ada_w[layer, 0] + ada_b[layer, 0], 3, axis=-1)
        hn = rmsnorm(x, norm_g[layer, 0]) * (1.0 + scale[:, None, :]) + shift[:, None, :]
        if layer % 2 == 0:
            y = rglru_mlstm_mixer(hn, ab_w_in[j], ab_w_out[j], lru_conv_w[j], lru_conv_b[j],
                                  lru_gate_w[j], lru_gate_b[j], lru_lambda[j],
                                  mlstm_gate_b[j], mlstm_norm_g[j])
        else:
            y = stick_breaking_mixer(hn, sb_w_qkv[j], sb_w_out[j])
        x = x + gate[:, None, :] * y
        shift, scale, gate = jnp.split(c_act @ ada_w[layer, 1] + ada_b[layer, 1], 3, axis=-1)
        hn = rmsnorm(x, norm_g[layer, 1]) * (1.0 + scale[:, None, :]) + shift[:, None, :]
        x = x + gate[:, None, :] * swiglu(hn, ffn_w1[layer], ffn_w3[layer], ffn_w2[layer])
    return rmsnorm(x, final_g)
```

```cpp
#include <hip/hip_runtime.h>
#include <cstdio>
#include <cstdint>

constexpr int NWAVES = 8;
constexpr int BATCH = 2, SEQ = 4096, DM = 2048, DEPTH = 4, M = BATCH * SEQ;
constexpr int LRU_W = 1024, NBLK = 8, BW = 128;
constexpr int MLW = 1024, MH = 4, DV = 256, DK = 128, MQK = 512, CH = 128, NCH = SEQ / CH;
constexpr int AB_IN = 5128, AB_IN_PAD = 5376;
constexpr int SBH = 16, SBD = 128;
constexpr int FF = 5632;
constexpr float EPS = 1e-6f;
constexpr float LOG2E = 1.4426950408889634f, LN2 = 0.6931471805599453f;

constexpr size_t MiB = 1u << 20;
constexpr size_t WS_CTL = 0, CTL_ZERO_BYTES = 1 * MiB;
constexpr size_t WS_MOD = 1 * MiB;
constexpr size_t WS_WABIN = 2 * MiB;
constexpr size_t WS_WABOUT = 44 * MiB;
constexpr size_t WS_WQKV = 60 * MiB;
constexpr size_t WS_WSBO = 108 * MiB;
constexpr size_t WS_W13 = 124 * MiB;
constexpr size_t WS_W2 = 300 * MiB;
constexpr size_t WS_HN = 388 * MiB;
constexpr size_t WS_P0 = 420 * MiB;
constexpr size_t WS_IG = 516 * MiB;
constexpr size_t WS_MIX = 517 * MiB;
constexpr size_t WS_ACT = 549 * MiB;
constexpr size_t WS_DC = 637 * MiB;
constexpr size_t WS_CIN = 669 * MiB;
constexpr size_t WS_SMALL = 685 * MiB;
constexpr size_t WS_HLOC = 686 * MiB;
constexpr size_t WS_PCUM = 718 * MiB;
constexpr size_t WS_AGG = 750 * MiB;
constexpr size_t WS_HTMP = 752 * MiB;
constexpr size_t WS_END = 784 * MiB;
constexpr int CW_BAR = 4096;

constexpr int BIG_BYTES = 147456;
constexpr int MISC_OFF = BIG_BYTES;
constexpr int SM_OFF = BIG_BYTES + 1024;
constexpr int LDS_BYTES = 163840;

namespace pg8 {
#define PG8_LAS __attribute__((address_space(3)))
typedef unsigned short bf16_t;
typedef short bf16x8 __attribute__((ext_vector_type(8)));
typedef float f32x4 __attribute__((ext_vector_type(4)));
typedef unsigned u32x4 __attribute__((ext_vector_type(4)));
constexpr int BM = 256, BK = 64, HALF = 128, HTB = HALF * BK * 2  , STAGE_BYTES = 8 * HTB, NXCD = 8, WGM = 8;

__host__ __device__ __forceinline__ int lds_byte(int r, int c) { const int st = (r >> 4) * 2 + (c >> 5), rr = r & 15, cc = c & 31, ob = rr * 64 + cc * 2; return st * 1024 + (ob ^ (((ob >> 9) & 1) << 5)); }
__host__ __device__ __forceinline__ void stage_rc(int b, int& R, int& C) { const int st = b / 1024, sb = b % 1024, swz = sb ^ (((sb >> 9) & 1) << 5); R = (st >> 1) * 16 + swz / 64; C = (st & 1) * 32 + (swz % 64) / 2; }
__host__ __device__ __forceinline__ int perm32(int rho) { const int n = rho >> 4, i = rho & 15; return 8 * (i >> 2) + 4 * n + (i & 3); }

struct Unit { int pm, pn; };
struct Gemm { const bf16_t* A; const bf16_t* Bt; int M, N, K; };

struct StaticOrder {
    int nM, nN, nwg, G, c;
    __host__ __device__ void init(int M, int N, int G_, int c_) { nM = M / BM; nN = N / BM; nwg = nM * nN; G = G_; c = c_; }
    __host__ __device__ bool next(int i, Unit& u) const {
        const long L = (long)i * G + c; if (L >= nwg) return false;
        int wgid = (int)L; { const int q = nwg / NXCD, r = nwg % NXCD, xcd = wgid % NXCD, off = wgid / NXCD; wgid = (xcd < r ? xcd * (q + 1) : r * (q + 1) + (xcd - r) * q) + off; }
        const int nig = WGM * nN, gid = wgid / nig, fm = gid * WGM, gsz = (nM - fm) < WGM ? (nM - fm) : WGM;
        u.pm = fm + ((wgid % nig) % gsz); u.pn = (wgid % nig) / gsz; return true;
    }
    __device__ __forceinline__ void a_ready(const Unit&) const {}
    __device__ __forceinline__ void done(const Unit&) const {}
};

__device__ __forceinline__ unsigned cvt_pk_bf16(float lo, float hi) { unsigned r; asm volatile("v_cvt_pk_bf16_f32 %0, %1, %2" : "=v"(r) : "v"(lo), "v"(hi)); return r; }
typedef float f32x2 __attribute__((ext_vector_type(2)));
__device__ __forceinline__ u32x4 pack8(f32x4 v0, f32x4 v1) { u32x4 w; w.x = cvt_pk_bf16(v0[0], v0[1]); w.y = cvt_pk_bf16(v0[2], v0[3]); w.z = cvt_pk_bf16(v1[0], v1[1]); w.w = cvt_pk_bf16(v1[2], v1[3]); return w; }

struct EpiBf16Split {
    static constexpr bool PERM = true, AFTER_DRAIN = false;
    bf16_t* O; int ldc; int split_cols; size_t split_stride; float scale0;
    __device__ __forceinline__ void operator()(const f32x4 (&acc)[2][2][4][2], const Unit& u, int wr, int wc, int fr, int fq) const {
        const int row0 = u.pm * BM + wr * 64 + fr; int colt = u.pn * BM; bf16_t* base = O;
        float sc = 1.f; { const int t = colt / split_cols; base += (size_t)t * split_stride; colt -= t * split_cols; if (t == 0) sc = scale0; }
        const int col0 = colt + wc * 32 + 8 * fq;
#pragma unroll
        for (int ai = 0; ai < 2; ++ai)
#pragma unroll
            for (int m = 0; m < 4; ++m) { bf16_t* rowp = base + (size_t)(row0 + ai * HALF + m * 16) * ldc + col0;
#pragma unroll
                for (int bj = 0; bj < 2; ++bj) { *(u32x4*)(rowp + bj * HALF) = pack8(acc[ai][bj][m][0] * sc, acc[ai][bj][m][1] * sc); } }
    }
};

struct EpiResid {
    static constexpr bool PERM = true, AFTER_DRAIN = false;
    const float* base; float* out; const float* gate0;
    __device__ __forceinline__ void operator()(const f32x4 (&acc)[2][2][4][2], const Unit& u, int wr, int wc, int fr, int fq) const {
        const int row0 = u.pm * BM + wr * 64 + fr, col0 = u.pn * BM + wc * 32 + 8 * fq;
        const float* gp = gate0 + (u.pm >= 16 ? 6144 : 0) + col0;
        f32x4 gv[2][2];
#pragma unroll
        for (int bj = 0; bj < 2; ++bj)
#pragma unroll
            for (int n = 0; n < 2; ++n) gv[bj][n] = *(const f32x4*)(gp + bj * HALF + 4 * n);
#pragma unroll
        for (int ai = 0; ai < 2; ++ai)
#pragma unroll
            for (int m = 0; m < 4; ++m) { const size_t off = (size_t)(row0 + ai * HALF + m * 16) * 2048 + col0;
#pragma unroll
                for (int bj = 0; bj < 2; ++bj)
#pragma unroll
                    for (int n = 0; n < 2; ++n) { const f32x4 b = *(const f32x4*)(base + off + bj * HALF + 4 * n); *(f32x4*)(out + off + bj * HALF + 4 * n) = b + gv[bj][n] * acc[ai][bj][m][n]; }
                if (m & 1) asm volatile("" ::: "memory"); }
    }
};

struct EpiSwiGLU {
    static constexpr bool PERM = true, AFTER_DRAIN = false;
    bf16_t* O;
    static __device__ __forceinline__ f32x4 silu_mul(f32x4 a, f32x4 b) { f32x4 r;
#pragma unroll
        for (int i = 0; i < 4; ++i) { const float e = __builtin_amdgcn_exp2f(-a[i] * 1.4426950408889634f); r[i] = a[i] * __builtin_amdgcn_rcpf(1.f + e) * b[i]; }
        return r; }
    __device__ __forceinline__ void operator()(const f32x4 (&acc)[2][2][4][2], const Unit& u, int wr, int wc, int fr, int fq) const {
        const int row0 = u.pm * BM + wr * 64 + fr, col0 = u.pn * HALF + wc * 32 + 8 * fq;
#pragma unroll
        for (int ai = 0; ai < 2; ++ai)
#pragma unroll
            for (int m = 0; m < 4; ++m) { bf16_t* rowp = O + (size_t)(row0 + ai * HALF + m * 16) * 5632 + col0;
                *(u32x4*)rowp = pack8(silu_mul(acc[ai][0][m][0], acc[ai][1][m][0]), silu_mul(acc[ai][0][m][1], acc[ai][1][m][1])); }
    }
};

struct EpiInProj {
    static constexpr bool PERM = true, AFTER_DRAIN = false;
    float* XA; bf16_t *YA, *Qm, *Km, *Vm, *Om; float *IG, *FG; float kscale;
    __device__ __forceinline__ void operator()(const f32x4 (&acc)[2][2][4][2], const Unit& u, int wr, int wc, int fr, int fq) const {
        const int pn = u.pn, row0 = u.pm * BM + wr * 64 + fr, cl = wc * 32 + 8 * fq;
        if (pn < 4) {
#pragma unroll
            for (int ai = 0; ai < 2; ++ai)
#pragma unroll
                for (int m = 0; m < 4; ++m) { float* rp = XA + (size_t)(row0 + ai * HALF + m * 16) * 1024 + pn * 256 + cl;
#pragma unroll
                    for (int bj = 0; bj < 2; ++bj)
#pragma unroll
                        for (int n = 0; n < 2; ++n) *(f32x4*)(rp + bj * HALF + 4 * n) = acc[ai][bj][m][n]; }
        } else if (pn < 20) {
            bf16_t* base; int ld, colt; float sc = 1.f;
            if (pn < 8) { base = YA; ld = 1024; colt = (pn - 4) * 256; }
            else if (pn < 10) { base = Qm; ld = 512; colt = (pn - 8) * 256; }
            else if (pn < 12) { base = Km; ld = 512; colt = (pn - 10) * 256; sc = kscale; }
            else if (pn < 16) { base = Vm; ld = 1024; colt = (pn - 12) * 256; }
            else { base = Om; ld = 1024; colt = (pn - 16) * 256; }
#pragma unroll
            for (int ai = 0; ai < 2; ++ai)
#pragma unroll
                for (int m = 0; m < 4; ++m) { bf16_t* rowp = base + (size_t)(row0 + ai * HALF + m * 16) * ld + colt + cl;
#pragma unroll
                    for (int bj = 0; bj < 2; ++bj) *(u32x4*)(rowp + bj * HALF) = pack8(acc[ai][bj][m][0] * sc, acc[ai][bj][m][1] * sc); }
        } else {
            if (wc == 0 && fq == 0) {
#pragma unroll
                for (int ai = 0; ai < 2; ++ai)
#pragma unroll
                    for (int m = 0; m < 4; ++m) { const size_t r = (size_t)(row0 + ai * HALF + m * 16); *(f32x4*)(IG + r * 4) = acc[ai][0][m][0]; *(f32x4*)(FG + r * 4) = acc[ai][0][m][1]; }
            }
        }
    }
};

template <class Epi, class Sched, bool ALIGN_EPI = false, bool SP2 = false>
__device__ __forceinline__ void gemm_phase(PG8_LAS unsigned char* lds, const Gemm g, const Sched& S, const Epi& E) {
    int tid_ = threadIdx.x; asm volatile("" : "+v"(tid_)); const int tid = tid_, wid = __builtin_amdgcn_readfirstlane(tid >> 6), lane = tid & 63, wr = wid >> 2, wc = wid & 3, fr = lane & 15, fq = lane >> 4;
    const int K = g.K, nt = K / BK;
    unsigned voffA[2], voffB[2];
#pragma unroll
    for (int i = 0; i < 2; ++i) { int R, C; stage_rc(tid * 16 + i * 8192, R, C); const int Rb = Epi::PERM ? ((R & ~31) + perm32(R & 31)) : R;
        voffA[i] = (unsigned)(R * K + C) * 2u; voffB[i] = (unsigned)(Rb * K + C) * 2u; }
    const size_t kstep = (size_t)(BK * 2);
    const size_t hstep = (size_t)HALF * K * 2;
    const size_t tstep = 2 * hstep;
    const unsigned ldsw = (unsigned)wid * 1024u;
    const int aoff = lds_byte(wr * 64 + fr, fq * 8), boff = lds_byte(wc * 32 + fr, fq * 8);
#define PG8_SA(b, h) (((b) * 2 + (h)) * HTB)
#define PG8_SB(b, h) ((4 + (b) * 2 + (h)) * HTB)
#define PG8_STAGE(bufoff, gbase, voff) do { _Pragma("unroll") for (int _i = 0; _i < 2; ++_i) \
        __builtin_amdgcn_global_load_lds((const unsigned*)((const char*)(gbase) + (voff)[_i]), (PG8_LAS unsigned*)(lds + (bufoff) + ldsw + _i * 8192), 16, 0, 0); } while (0)
#define PG8_LDA(dst, b, h) do { _Pragma("unroll") for (int m = 0; m < 4; ++m) _Pragma("unroll") for (int k = 0; k < 2; ++k) dst[m][k] = *(const PG8_LAS bf16x8*)(lds + PG8_SA(b, h) + aoff + m * 2048 + k * 1024); } while (0)
#define PG8_LDB(dst, b, h) do { _Pragma("unroll") for (int n = 0; n < 2; ++n) _Pragma("unroll") for (int k = 0; k < 2; ++k) dst[n][k] = *(const PG8_LAS bf16x8*)(lds + PG8_SB(b, h) + boff + n * 2048 + k * 1024); } while (0)
#define PG8_MMA(ai, bj, At, Bt) do { __builtin_amdgcn_s_setprio(1); _Pragma("unroll") for (int m = 0; m < 4; ++m) _Pragma("unroll") for (int n = 0; n < 2; ++n) _Pragma("unroll") for (int k = 0; k < 2; ++k) \
        acc[ai][bj][m][n] = __builtin_amdgcn_mfma_f32_16x16x32_bf16(Bt[n][k], At[m][k], acc[ai][bj][m][n], 0, 0, 0); __builtin_amdgcn_s_setprio(0); } while (0)
#define PG8_WAIT_V(n) asm volatile("s_waitcnt vmcnt(" #n ")" ::: "memory")
#define PG8_WAIT_L(n) asm volatile("s_waitcnt lgkmcnt(" #n ")" ::: "memory")
#define PG8_BAR __builtin_amdgcn_s_barrier()
#define PG8_SCHED __builtin_amdgcn_sched_barrier(0)
    Unit cur, nxt; int ui = 0;
    if (!S.next(0, cur)) return;
    f32x4 acc[2][2][4][2];
#pragma unroll
    for (int a = 0; a < 2; ++a)
#pragma unroll
        for (int b = 0; b < 2; ++b)
#pragma unroll
            for (int m = 0; m < 4; ++m)
#pragma unroll
                for (int n = 0; n < 2; ++n) acc[a][b][m][n] = (f32x4){0.f, 0.f, 0.f, 0.f};
    bf16x8 At[4][2], B0[2][2], B1[2][2];
    const char* cA = (const char*)g.A + (size_t)cur.pm * tstep; const char* cB = (const char*)g.Bt + (size_t)cur.pn * tstep;
    S.a_ready(cur);
    if constexpr (SP2) {
        PG8_STAGE(PG8_SB(0, 0), cB, voffB); PG8_STAGE(PG8_SB(0, 1), cB + hstep, voffB); PG8_STAGE(PG8_SA(0, 0), cA, voffA); PG8_STAGE(PG8_SA(0, 1), cA + hstep, voffA);
        if (wr == 1) PG8_BAR;
        PG8_WAIT_V(2); PG8_BAR;
        PG8_STAGE(PG8_SB(1, 0), cB + kstep, voffB); PG8_STAGE(PG8_SA(1, 0), cA + kstep, voffA); PG8_STAGE(PG8_SB(1, 1), cB + hstep + kstep, voffB);
        PG8_WAIT_V(6); PG8_BAR;
    } else {
        PG8_STAGE(PG8_SB(0, 0), cB, voffB); PG8_STAGE(PG8_SA(0, 0), cA, voffA); PG8_STAGE(PG8_SB(0, 1), cB + hstep, voffB); PG8_STAGE(PG8_SA(0, 1), cA + hstep, voffA);
        if (wr == 1) PG8_BAR;
        PG8_WAIT_V(4); PG8_BAR;
        PG8_STAGE(PG8_SB(1, 0), cB + kstep, voffB); PG8_STAGE(PG8_SA(1, 0), cA + kstep, voffA); PG8_STAGE(PG8_SB(1, 1), cB + hstep + kstep, voffB);
        PG8_WAIT_V(6); PG8_BAR;
    }
    for (;;) {
        const bool has_next = S.next(ui + 1, nxt);
        const char* nA = has_next ? (const char*)g.A + (size_t)nxt.pm * tstep : cA; const char* nB = has_next ? (const char*)g.Bt + (size_t)nxt.pn * tstep : cB;
        for (int t = 0; t < nt; t += 2) {
            const bool last = (t == nt - 2);
            const char* a1 = cA + (size_t)(t + 1) * kstep;
            const char* a2 = last ? nA : cA + (size_t)(t + 2) * kstep; const char* b2 = last ? nB : cB + (size_t)(t + 2) * kstep;
            const char* a3 = a2 + kstep; const char* b3 = b2 + kstep;
            if (last && has_next) S.a_ready(nxt);
            if constexpr (SP2) {
            PG8_LDB(B0, 0, 0); PG8_LDB(B1, 0, 1); PG8_SCHED; PG8_LDA(At, 0, 0); PG8_STAGE(PG8_SA(1, 1), a1 + hstep, voffA);
            PG8_WAIT_V(8); PG8_WAIT_L(0); PG8_BAR; PG8_MMA(0, 0, At, B0); PG8_MMA(0, 1, At, B1); PG8_BAR; PG8_SCHED;
            PG8_LDA(At, 0, 1); PG8_STAGE(PG8_SB(0, 0), b2, voffB); PG8_STAGE(PG8_SB(0, 1), b2 + hstep, voffB); PG8_STAGE(PG8_SA(0, 0), a2, voffA);
            PG8_WAIT_V(8); PG8_WAIT_L(0); PG8_BAR; PG8_MMA(1, 0, At, B0); PG8_MMA(1, 1, At, B1); PG8_BAR; PG8_SCHED;
            PG8_LDB(B0, 1, 0); PG8_LDB(B1, 1, 1); PG8_SCHED; PG8_LDA(At, 1, 0); PG8_STAGE(PG8_SA(0, 1), a2 + hstep, voffA);
            PG8_WAIT_V(8); PG8_WAIT_L(0); PG8_BAR; PG8_MMA(0, 0, At, B0); PG8_MMA(0, 1, At, B1); PG8_BAR; PG8_SCHED;
            PG8_LDA(At, 1, 1); PG8_STAGE(PG8_SB(1, 0), b3, voffB); PG8_STAGE(PG8_SB(1, 1), b3 + hstep, voffB); PG8_STAGE(PG8_SA(1, 0), a3, voffA);
            PG8_WAIT_V(8); PG8_WAIT_L(0); PG8_BAR; PG8_MMA(1, 0, At, B0); PG8_MMA(1, 1, At, B1); PG8_BAR; PG8_SCHED;
            } else {
            PG8_LDB(B0, 0, 0); PG8_SCHED; PG8_LDA(At, 0, 0); PG8_STAGE(PG8_SA(1, 1), a1 + hstep, voffA);
            PG8_WAIT_L(8); PG8_BAR; PG8_WAIT_L(0); PG8_MMA(0, 0, At, B0); PG8_BAR; PG8_SCHED;
            PG8_LDB(B1, 0, 1); PG8_STAGE(PG8_SB(0, 0), b2, voffB);
            PG8_BAR; PG8_WAIT_L(0); PG8_MMA(0, 1, At, B1); PG8_BAR;
            PG8_LDA(At, 0, 1); PG8_STAGE(PG8_SA(0, 0), a2, voffA);
            PG8_BAR; PG8_WAIT_L(0); PG8_MMA(1, 0, At, B0); PG8_BAR; PG8_SCHED;
            PG8_STAGE(PG8_SB(0, 1), b2 + hstep, voffB);
            PG8_WAIT_V(6); PG8_BAR; PG8_MMA(1, 1, At, B1); PG8_BAR;
            PG8_LDB(B0, 1, 0); PG8_SCHED; PG8_LDA(At, 1, 0); PG8_STAGE(PG8_SA(0, 1), a2 + hstep, voffA);
            PG8_WAIT_L(8); PG8_BAR; PG8_WAIT_L(0); PG8_MMA(0, 0, At, B0); PG8_BAR; PG8_SCHED;
            PG8_LDB(B1, 1, 1); PG8_STAGE(PG8_SB(1, 0), b3, voffB);
            PG8_BAR; PG8_WAIT_L(0); PG8_MMA(0, 1, At, B1); PG8_BAR;
            PG8_LDA(At, 1, 1); PG8_STAGE(PG8_SA(1, 0), a3, voffA);
            PG8_BAR; PG8_WAIT_L(0); PG8_MMA(1, 0, At, B0); PG8_BAR; PG8_SCHED;
            PG8_STAGE(PG8_SB(1, 1), b3 + hstep, voffB);
            PG8_WAIT_V(6); PG8_BAR; PG8_MMA(1, 1, At, B1); PG8_BAR;
            }
        }
        if constexpr (ALIGN_EPI) { if (wr == 0) PG8_BAR; }
        if constexpr (!Epi::AFTER_DRAIN) { E(acc, cur, wr, wc, fr, fq); S.done(cur); }
        if (!has_next) break;
#pragma unroll
        for (int a = 0; a < 2; ++a)
#pragma unroll
            for (int b = 0; b < 2; ++b)
#pragma unroll
                for (int m = 0; m < 4; ++m)
#pragma unroll
                    for (int n = 0; n < 2; ++n) acc[a][b][m][n] = (f32x4){0.f, 0.f, 0.f, 0.f};
        cur = nxt; cA = nA; cB = nB; ++ui;
        if constexpr (ALIGN_EPI) { if (wr == 1) PG8_BAR; }
    }
    PG8_WAIT_V(0);
    if constexpr (!ALIGN_EPI) { if (wr == 0) PG8_BAR; }
    PG8_BAR;
    if constexpr (Epi::AFTER_DRAIN) { E.fused(acc, cur, wr, wc, fr, fq, lds, wid, lane); S.done(cur); }
#undef PG8_SA
#undef PG8_SB
#undef PG8_STAGE
#undef PG8_LDA
#undef PG8_LDB
#undef PG8_MMA
#undef PG8_WAIT_V
#undef PG8_WAIT_L
#undef PG8_BAR
#undef PG8_SCHED
}
}
#ifndef PG8_SP2
#define PG8_SP2 true
#endif
#ifndef PG8_ALIGN
#define PG8_ALIGN true
#endif

#define GAS __attribute__((address_space(1)))
#define LAS __attribute__((address_space(3)))
typedef unsigned short bf16;
typedef unsigned v4u __attribute__((ext_vector_type(4)));
typedef unsigned v2u __attribute__((ext_vector_type(2)));
typedef float f32x4 __attribute__((ext_vector_type(4)));
typedef short bf16x8 __attribute__((ext_vector_type(8)));
typedef GAS unsigned gu32;
#define RLX_AGENT __ATOMIC_RELAXED, __HIP_MEMORY_SCOPE_AGENT
#define LDS_WAIT() asm volatile("s_waitcnt lgkmcnt(0)" ::: "memory")
#define VM_WAIT() asm volatile("s_waitcnt vmcnt(0)" ::: "memory")
__device__ __forceinline__ unsigned pk2(float lo, float hi) { return pg8::cvt_pk_bf16(lo, hi); }
__device__ __forceinline__ bf16 f2bf(float x) { return (bf16)(pg8::cvt_pk_bf16(x, 0.f) & 0xffffu); }
__device__ __forceinline__ float bf2f(bf16 b) { return __uint_as_float((unsigned)b << 16); }
__device__ __forceinline__ float bflo(unsigned p) { return __uint_as_float(p << 16); }
__device__ __forceinline__ float bfhi(unsigned p) { return __uint_as_float(p & 0xffff0000u); }
__device__ __forceinline__ float sigmoidf_(float x) { return 1.f / (1.f + __expf(-x)); }
__device__ __forceinline__ float logsigmoidf_(float x) { return fminf(x, 0.f) - log1pf(__expf(-fabsf(x))); }
__device__ __forceinline__ float gelu_tanh(float y) { const float x = 0.7978845608028654f * (y + 0.044715f * y * y * y); const float t = __builtin_amdgcn_exp2f(2.f * LOG2E * x); return 0.5f * y * (2.f - 2.f * __builtin_amdgcn_rcpf(t + 1.f)); }
__device__ __forceinline__ float wave_sum(float v) {
#pragma unroll
    for (int o = 1; o < 64; o <<= 1) v += __shfl_xor(v, o);
    return v;
}

__device__ __forceinline__ int fresh_tid() { int t = threadIdx.x; asm volatile("" : "+v"(t)); return t; }
#define XB_TMO      128
#define XB_XCNT(j)  (256  + 64 * (j))
#define XB_XSUB(j)  (1280 + 64 * (j))
#define XB_XGEN(j)  (2304 + 64 * (j))
#define XB_TOP      3328
#define XB_TOPGEN   3392
#define XCD_BAR_WORDS 3456
#define XB_SPIN_CAP (1u << 18)

__device__ __forceinline__ unsigned xb_ld(unsigned* p)              { return __hip_atomic_load(p, __ATOMIC_RELAXED, __HIP_MEMORY_SCOPE_AGENT); }
__device__ __forceinline__ unsigned xb_add(unsigned* p, unsigned v) { return __hip_atomic_fetch_add(p, v, __ATOMIC_RELAXED, __HIP_MEMORY_SCOPE_AGENT); }
__device__ __forceinline__ unsigned xb_xcc_id() { return (unsigned)__builtin_amdgcn_s_getreg((3 << 11) | 20) & 0xFu; }
#define XB_SPIN(cond, bar) do { unsigned _sp = 0; while (cond) { __builtin_amdgcn_s_sleep(1); \
    if ((++_sp & 255u) == 0u) { if (xb_ld(&(bar)[XB_TMO])) break; if (_sp > XB_SPIN_CAP) { atomicAdd(&(bar)[XB_TMO], 1u); break; } } } } while (0)

struct XcdBarrier {
    unsigned* bar; unsigned x;
    volatile LAS unsigned* st;
};

__device__ __forceinline__ XcdBarrier xcd_barrier_post(unsigned* bar, volatile LAS unsigned* st) {
    XcdBarrier b; b.bar = bar; b.x = xb_xcc_id(); b.st = st;
    if (threadIdx.x == 0) (void)xb_add(&bar[XB_XCNT(b.x)], 1u);
    return b;
}
__device__ __forceinline__ void xcd_barrier_complete(unsigned* bar, unsigned x, unsigned& nloc, unsigned& nx) {
    const unsigned G = gridDim.x * gridDim.y * gridDim.z;
    unsigned sum, cnt, mine, sp = 0u;
    for (;;) {
        sum = 0u; cnt = 0u; mine = 0u;
#pragma unroll
        for (unsigned j = 0; j < 16; ++j) { const unsigned c = xb_ld(&bar[XB_XCNT(j)]); sum += c; cnt += (c > 0u) ? 1u : 0u; mine = (j == x) ? c : mine; }
        if (sum == G) break;
        __builtin_amdgcn_s_sleep(1);
        if ((++sp & 255u) == 0u) { if (xb_ld(&bar[XB_TMO])) break; if (sp > XB_SPIN_CAP) { atomicAdd(&bar[XB_TMO], 1u); break; } }
    }
    nloc = mine > 0u ? mine : 1u; nx = cnt > 0u ? cnt : 1u;
}

__device__ __forceinline__ void xcd_barrier(const XcdBarrier& b) {
    asm volatile("s_waitcnt vmcnt(0)" ::: "memory");
    __syncthreads();
    if (threadIdx.x == 0) {
        unsigned* bar = b.bar;
        __builtin_amdgcn_s_waitcnt(0);
        unsigned nloc = b.st[0], nx = b.st[1];
        if (nloc == 0u) { xcd_barrier_complete(bar, b.x, nloc, nx); b.st[0] = nloc; b.st[1] = nx; }
        const unsigned old = xb_add(&bar[XB_XSUB(b.x)], 1u);
        const unsigned gen = old / nloc;
        if (old + 1u == (gen + 1u) * nloc) {
            __builtin_amdgcn_fence(__ATOMIC_RELEASE, "agent");
            asm volatile("s_waitcnt vmcnt(0)" ::: "memory");
            const unsigned og = xb_add(&bar[XB_TOP], 1u);
            const unsigned tg = og / nx;
            if (og + 1u == (tg + 1u) * nx) xb_add(&bar[XB_TOPGEN], 1u);
            else XB_SPIN(xb_ld(&bar[XB_TOPGEN]) == tg, bar);
            __builtin_amdgcn_fence(__ATOMIC_ACQUIRE, "agent");
            xb_add(&bar[XB_XGEN(b.x)], 1u);
            asm volatile("s_waitcnt vmcnt(0)" ::: "memory");
        } else {
            XB_SPIN(xb_ld(&bar[XB_XGEN(b.x)]) == gen, bar);
            __builtin_amdgcn_fence(__ATOMIC_ACQUIRE, "agent");
            asm volatile("s_waitcnt vmcnt(0)" ::: "memory");
        }
    }
    __syncthreads();
}


struct Args { const float* in[20]; float* out; unsigned char* ws; };

__device__ __forceinline__ void transpose_item(const float* W, int K, int N, bf16* WT, int mode, LAS float* scr, int item, int lane) {
    const int nblk = (N + 31) / 32, kb = item / nblk, nb = item % nblk, k0 = 64 * kb, n0 = 32 * nb;
    const int nn = n0 + (lane & 31); const bool ok = nn < N;
#pragma unroll 8
    for (int i = 0; i < 32; ++i) { const int kk = 2 * i + (lane >> 5); scr[kk * 33 + (lane & 31)] = ok ? W[(size_t)(k0 + kk) * N + nn] : 0.f; }
    LDS_WAIT(); asm volatile("" ::: "memory");
    const int c = lane & 7;
    int r0 = n0; if (mode) r0 = 256 * (n0 >> 7) + (n0 & 127) + (mode == 2 ? 128 : 0);
#pragma unroll
    for (int j = 0; j < 4; ++j) { const int n = (lane >> 3) + 8 * j; const LAS float* s = scr + (8 * c) * 33 + n;
        v4u o; o.x = pk2(s[0 * 33], s[1 * 33]); o.y = pk2(s[2 * 33], s[3 * 33]); o.z = pk2(s[4 * 33], s[5 * 33]); o.w = pk2(s[6 * 33], s[7 * 33]);
        if (n0 + n < N) *(GAS v4u*)(WT + (size_t)(r0 + n) * K + k0 + 8 * c) = o; }
    LDS_WAIT(); asm volatile("" ::: "memory");
}

__device__ __forceinline__ void p0_prologue(const Args& args, LAS unsigned char* lds, int tid, int lane, int wave, int vcu, int G) {
    unsigned char* ws = args.ws;
    const int bx = blockIdx.x;
    if (bx < 192) {
        LAS float* cs = (LAS float*)lds;
        LAS float* red = (LAS float*)(lds + 16384);
        const float* c = args.in[1];
        for (int i = tid; i < 4096; i += 512) { const float v = c[i]; cs[i] = v / (1.f + __expf(-v)); }
        __syncthreads();
        const int mat = bx / 24, cg = bx % 24;
        const float* Wp = args.in[2] + (size_t)mat * 2048 * 6144 + cg * 256 + lane * 4;
        f32x4 a0 = {0.f, 0.f, 0.f, 0.f}, a1 = {0.f, 0.f, 0.f, 0.f};
        const int kbeg = wave * 256;
#pragma unroll 8
        for (int k = kbeg; k < kbeg + 256; ++k) { const f32x4 w = *(const GAS f32x4*)(Wp + (size_t)k * 6144); const float c0 = cs[k], c1 = cs[2048 + k]; a0 += c0 * w; a1 += c1 * w; }
        *(LAS f32x4*)(red + (wave * 2 + 0) * 256 + lane * 4) = a0; *(LAS f32x4*)(red + (wave * 2 + 1) * 256 + lane * 4) = a1;
        __syncthreads();
        { const int b = tid >> 8, col = tid & 255; float s = args.in[3][mat * 6144 + cg * 256 + col];
#pragma unroll
          for (int w = 0; w < 8; ++w) s += red[(w * 2 + b) * 256 + col];
          ((float*)(ws + WS_MOD))[(mat * 2 + b) * 6144 + cg * 256 + col] = s; }
        __syncthreads();
    }
    LAS float* scr = (LAS float*)(lds + wave * 16384);
    const int gw = vcu * NWAVES + wave, NGW = G * NWAVES;
    constexpr int I_ABIN = 32 * 161, I_SQ = 32 * 64, I_QKV = 32 * 192, I_W1 = 32 * 176, I_W2 = 88 * 64;
    constexpr int NITEMS = 2 * (I_ABIN + 2 * I_SQ + I_QKV) + 4 * (2 * I_W1 + I_W2);
    for (int it = gw; it < NITEMS; it += NGW) {
        int r = it;
        if (r < 2 * I_ABIN) { const int j = r / I_ABIN; transpose_item(args.in[9] + (size_t)j * 2048 * AB_IN, 2048, AB_IN, (bf16*)(ws + WS_WABIN) + (size_t)j * AB_IN_PAD * 2048, 0, scr, r % I_ABIN, lane); continue; } r -= 2 * I_ABIN;
        if (r < 2 * I_SQ) { const int j = r / I_SQ; transpose_item(args.in[10] + (size_t)j * 2048 * 2048, 2048, 2048, (bf16*)(ws + WS_WABOUT) + (size_t)j * 2048 * 2048, 0, scr, r % I_SQ, lane); continue; } r -= 2 * I_SQ;
        if (r < 2 * I_QKV) { const int j = r / I_QKV; transpose_item(args.in[18] + (size_t)j * 2048 * 6144, 2048, 6144, (bf16*)(ws + WS_WQKV) + (size_t)j * 6144 * 2048, 0, scr, r % I_QKV, lane); continue; } r -= 2 * I_QKV;
        if (r < 2 * I_SQ) { const int j = r / I_SQ; transpose_item(args.in[19] + (size_t)j * 2048 * 2048, 2048, 2048, (bf16*)(ws + WS_WSBO) + (size_t)j * 2048 * 2048, 0, scr, r % I_SQ, lane); continue; } r -= 2 * I_SQ;
        if (r < 4 * I_W1) { const int l = r / I_W1; transpose_item(args.in[6] + (size_t)l * 2048 * FF, 2048, FF, (bf16*)(ws + WS_W13) + (size_t)l * 2 * FF * 2048, 1, scr, r % I_W1, lane); continue; } r -= 4 * I_W1;
        if (r < 4 * I_W1) { const int l = r / I_W1; transpose_item(args.in[7] + (size_t)l * 2048 * FF, 2048, FF, (bf16*)(ws + WS_W13) + (size_t)l * 2 * FF * 2048, 2, scr, r % I_W1, lane); continue; } r -= 4 * I_W1;
        { const int l = r / I_W2; transpose_item(args.in[8] + (size_t)l * FF * 2048, FF, 2048, (bf16*)(ws + WS_W2) + (size_t)l * 2048 * FF, 0, scr, r % I_W2, lane); }
    }
}

__device__ __forceinline__ void norm_phase(const float* xin, const float* g, const float* mod  , bf16* HN, int lane, int gw, int NGW) {
    const int rows_per = (M + NGW - 1) / NGW;
    int curb = -1; f32x4 gs[8], sh[8];
    for (int i = 0; i < rows_per; ++i) {
        const int row = gw * rows_per + i; if (row >= M) break;
        const int b = row / SEQ;
        if (b != curb) { curb = b;
#pragma unroll
            for (int j = 0; j < 8; ++j) { const int col = 4 * lane + 256 * j; const f32x4 gg = *(const GAS f32x4*)(g + col), sc = *(const GAS f32x4*)(mod + b * 6144 + 2048 + col); gs[j] = gg * (1.f + sc); sh[j] = *(const GAS f32x4*)(mod + b * 6144 + col); } }
        const GAS f32x4* xr = (const GAS f32x4*)(xin + (size_t)row * DM) + lane;
        f32x4 v[8]; float ss = 0.f;
#pragma unroll
        for (int j = 0; j < 8; ++j) { v[j] = xr[64 * j]; ss += (v[j].x * v[j].x + v[j].y * v[j].y) + (v[j].z * v[j].z + v[j].w * v[j].w); }
        const float rstd = 1.f / sqrtf(wave_sum(ss) * (1.f / DM) + EPS);
        GAS v2u* o8 = (GAS v2u*)(HN + (size_t)row * DM) + lane;
#pragma unroll
        for (int j = 0; j < 8; ++j) { const f32x4 y = v[j] * rstd * gs[j] + sh[j]; v2u w; w.x = pk2(y.x, y.y); w.y = pk2(y.z, y.w); o8[64 * j] = w; }
    }
}
__device__ __forceinline__ void final_norm_phase(const float* xin, const float* g, float* out, int lane, int gw, int NGW) {
    f32x4 gs[8];
#pragma unroll
    for (int j = 0; j < 8; ++j) gs[j] = *(const GAS f32x4*)(g + 4 * lane + 256 * j);
    for (int row = gw; row < M; row += NGW) {
        const GAS f32x4* xr = (const GAS f32x4*)(xin + (size_t)row * DM) + lane;
        f32x4 v[8]; float ss = 0.f;
#pragma unroll
        for (int j = 0; j < 8; ++j) { v[j] = xr[64 * j]; ss += (v[j].x * v[j].x + v[j].y * v[j].y) + (v[j].z * v[j].z + v[j].w * v[j].w); }
        const float rstd = 1.f / sqrtf(wave_sum(ss) * (1.f / DM) + EPS);
        GAS f32x4* o = (GAS f32x4*)(out + (size_t)row * DM) + lane;
#pragma unroll
        for (int j = 0; j < 8; ++j) o[64 * j] = v[j] * rstd * gs[j];
    }
}

struct MixP {
    const float *XA, *IG, *FG; const bf16 *YA, *Qm, *Km, *Vm, *Om; bf16* MIX;
    const float *conv_w, *conv_b, *gate_w, *gate_b, *lam, *mgb, *mng;
    float *DC, *DN, *NIN, *MLOC, *BLAST, *MIN, *HLOC, *PCUM, *AGGP, *AGGH, *HTMP; bf16* CIN;
};

__device__ __forceinline__ void mx1_rglru_unit(const MixP& P, LAS unsigned char* lds, int tid, int b, int n, int c) {
    LAS float* XC = (LAS float*)lds;
    LAS float* AS = (LAS float*)(lds + 65536);
    const int e = tid & 127, tg = tid >> 7, chn = n * 128 + e;
    const size_t rowbase = (size_t)b * SEQ; const int t0 = c * CH;
    {
        float w[4]; for (int j = 0; j < 4; ++j) w[j] = P.conv_w[j * LRU_W + chn];
        const float cb = P.conv_b[chn];
        for (int i = 0; i < 32; ++i) { const int tt = tg * 32 + i, t = t0 + tt; float acc = cb;
#pragma unroll
            for (int j = 0; j < 4; ++j) { const int ts = t - 3 + j; if (ts >= 0) acc += w[j] * P.XA[(rowbase + ts) * LRU_W + chn]; }
            XC[tt * 128 + e] = acc; }
    }
    __syncthreads();
    float ar[32], ai[32];
    { const float br = P.gate_b[chn], bi = P.gate_b[LRU_W + chn];
#pragma unroll
      for (int i = 0; i < 32; ++i) { ar[i] = br; ai[i] = bi; } }
    { const float* Wr = P.gate_w + ((size_t)(0 * NBLK + n) * 128) * 128 + e; const float* Wi = P.gate_w + ((size_t)(1 * NBLK + n) * 128) * 128 + e;
      for (int d = 0; d < 128; ++d) { const float wr = Wr[d * 128], wi = Wi[d * 128];
#pragma unroll
          for (int i = 0; i < 32; ++i) { const float x = XC[(tg * 32 + i) * 128 + d]; ar[i] += x * wr; ai[i] += x * wi; } } }
    __syncthreads();
    { const float ls = logsigmoidf_(P.lam[chn]);
#pragma unroll
      for (int i = 0; i < 32; ++i) { const int tt = tg * 32 + i; const float r = sigmoidf_(ar[i]), ig = sigmoidf_(ai[i]); const float la = 8.f * r * ls; const float a = __expf(la);
          const float mult = sqrtf(-expm1f(2.f * la)); const float xv = XC[tt * 128 + e]; AS[tt * 128 + e] = a; XC[tt * 128 + e] = mult * (ig * xv); } }
    __syncthreads();
    if (tid < 128) { float h = 0.f, pp = 1.f;
        for (int tt = 0; tt < 128; ++tt) { const float a = AS[tt * 128 + e], u = XC[tt * 128 + e]; h = a * h + u; pp *= a; const size_t o = (rowbase + t0 + tt) * LRU_W + chn; P.HLOC[o] = h; P.PCUM[o] = pp; }
        P.AGGP[(b * NCH + c) * LRU_W + chn] = pp; P.AGGH[(b * NCH + c) * LRU_W + chn] = h; }
    __syncthreads();
}

__device__ __forceinline__ void mx3_rglru_unit(const MixP& P, int tid, int b, int c, int half) {
    const int chn = half * 512 + tid;
    float carry = 0.f;
    for (int c2 = 0; c2 < c; ++c2) carry = P.AGGP[(b * NCH + c2) * LRU_W + chn] * carry + P.AGGH[(b * NCH + c2) * LRU_W + chn];
    for (int tt = 0; tt < CH; ++tt) { const size_t row = (size_t)b * SEQ + c * CH + tt; const float h = P.HLOC[row * LRU_W + chn] + P.PCUM[row * LRU_W + chn] * carry;
        const float y = bf2f(P.YA[row * LRU_W + chn]); P.MIX[row * DM + chn] = f2bf(h * gelu_tanh(y)); }
}

__device__ __forceinline__ void mx1_mlstm_unit(const MixP& P, LAS unsigned char* lds, int tid, int b, int h, int c) {
    LAS bf16* VS = (LAS bf16*)lds;
    LAS float* KS = (LAS float*)(lds + 65536);
    LAS float* sm = (LAS float*)(lds + SM_OFF); LAS float *s_li = sm, *s_lf = sm + 128, *s_bc = sm + 256, *s_g = sm + 384, *s_sc = sm + 768;
    const size_t rowbase = (size_t)b * SEQ + c * CH; const int uidx = (b * MH + h) * NCH + c;
    if (tid < 128) { s_li[tid] = P.IG[(rowbase + tid) * 4 + h] + P.mgb[h]; s_lf[tid] = logsigmoidf_(P.FG[(rowbase + tid) * 4 + h] + P.mgb[MH + h]); }
    __syncthreads();
    if (tid == 0) { float acc = 0.f, G = -INFINITY; for (int s = 0; s < 128; ++s) { acc += s_lf[s]; s_bc[s] = acc; const float g = s_li[s] - acc; s_g[s] = g; G = fmaxf(G, g); } s_sc[0] = G; s_sc[1] = acc; }
    __syncthreads();
    { const float G = s_sc[0]; const int s = tid >> 2, q = tid & 3; const float w = __expf(s_g[s] - G);
      const bf16* vp = P.Vm + (rowbase + s) * MLW + h * DV;
#pragma unroll
      for (int i = 0; i < 8; ++i) { const int ch = q + 4 * i; *(LAS v4u*)(VS + s * 256 + ch * 8) = *(const GAS v4u*)(vp + ch * 8); }
      const bf16* kp = P.Km + (rowbase + s) * MQK + h * DK + q * 32;
#pragma unroll
      for (int i = 0; i < 4; ++i) { const v4u kk = *(const GAS v4u*)(kp + i * 8); LAS float* d = KS + s * 128 + q * 32 + i * 8;
          d[0] = w * bflo(kk.x); d[1] = w * bfhi(kk.x); d[2] = w * bflo(kk.y); d[3] = w * bfhi(kk.y); d[4] = w * bflo(kk.z); d[5] = w * bfhi(kk.z); d[6] = w * bflo(kk.w); d[7] = w * bfhi(kk.w); } }
    __syncthreads();
    { const int d = tid & 127, vg = tid >> 7;
      float* dc = P.DC + ((size_t)uidx * DV + vg * 64) * DK + d;
#pragma unroll 1
      for (int i = 0; i < 64; ++i) { const LAS bf16* vcol = VS + vg * 64 + i; float acc = 0.f;
#pragma unroll 8
          for (int s = 0; s < 128; ++s) acc += KS[s * 128 + d] * bf2f(vcol[s * 256]);
          dc[(size_t)i * DK] = acc; }
      if (tid < 128) { float a = 0.f; for (int s = 0; s < 128; ++s) a += KS[s * 128 + tid]; P.DN[uidx * DK + tid] = a; }
      if (tid == 0) { P.MLOC[uidx] = s_sc[1] + s_sc[0]; P.BLAST[uidx] = s_sc[1]; } }
    __syncthreads();
}

__device__ __forceinline__ void mx2_mlstm(const MixP& P, LAS unsigned char* lds, int tid, int gtid, int NT) {
    LAS float* sm = (LAS float*)(lds + SM_OFF); LAS float *s_dec = sm, *s_scl = sm + 256, *s_min = sm + 512;
    if (tid < 8) { float m = 0.f; for (int k = 0; k < NCH; ++k) { const int u = tid * NCH + k; s_min[u] = m; const float bl = P.BLAST[u], ml = P.MLOC[u]; const float mn = fmaxf(bl + m, ml);
        s_dec[u] = __expf(bl + m - mn); s_scl[u] = __expf(ml - mn); m = mn; } }
    __syncthreads();
    for (int e = gtid; e < 8 * DV * DK; e += NT) { const int chain = e / (DV * DK), idx = e % (DV * DK); float cv = 0.f;
        for (int k = 0; k < NCH; ++k) { const int u = chain * NCH + k; const size_t o = (size_t)u * (DV * DK) + idx; P.CIN[o] = f2bf(cv); cv = s_dec[u] * cv + s_scl[u] * P.DC[o]; } }
    if (gtid < 8 * DK) { const int chain = gtid / DK, d = gtid % DK; float nv = 0.f;
        for (int k = 0; k < NCH; ++k) { const int u = chain * NCH + k; P.NIN[u * DK + d] = nv; nv = s_dec[u] * nv + s_scl[u] * P.DN[u * DK + d]; } }
    if (gtid < 256) P.MIN[gtid] = s_min[gtid];
    __syncthreads();
}

__device__ __forceinline__ void mx3_mlstm_unit(const MixP& P, LAS unsigned char* lds, int tid, int lane, int wave, int b, int h, int c) {
    constexpr int SS = 129, KSTR = 130;
    LAS float* S = (LAS float*)lds;
    LAS bf16* QS = (LAS bf16*)(lds + 66048);
    LAS bf16* KSb = (LAS bf16*)(lds + 66048 + 32768);
    LAS float* sm = (LAS float*)(lds + SM_OFF); LAS float *s_li = sm, *s_lf = sm + 128, *s_bc = sm + 256, *s_g = sm + 384, *s_M = sm + 512, *s_dn = sm + 640, *s_wi = sm + 768, *s_nin = sm + 896;
    const size_t rowbase = (size_t)b * SEQ + c * CH; const int uidx = (b * MH + h) * NCH + c;
    const float m_in = P.MIN[uidx];
    if (tid < 128) { s_li[tid] = P.IG[(rowbase + tid) * 4 + h] + P.mgb[h]; s_lf[tid] = logsigmoidf_(P.FG[(rowbase + tid) * 4 + h] + P.mgb[MH + h]); s_nin[tid] = P.NIN[uidx * DK + tid]; }
    { const int s = tid >> 2, q = tid & 3;
      const bf16* qp = P.Qm + (rowbase + s) * MQK + h * DK + q * 32; const bf16* kp = P.Km + (rowbase + s) * MQK + h * DK + q * 32;
#pragma unroll
      for (int i = 0; i < 4; ++i) { *(LAS v4u*)(QS + s * 128 + q * 32 + i * 8) = *(const GAS v4u*)(qp + i * 8);
          const v4u kk = *(const GAS v4u*)(kp + i * 8); LAS unsigned* kd = (LAS unsigned*)(KSb + s * KSTR + q * 32 + i * 8); kd[0] = kk.x; kd[1] = kk.y; kd[2] = kk.z; kd[3] = kk.w; } }
    __syncthreads();
    if (tid == 0) { float acc = 0.f, cm = m_in; for (int s = 0; s < 128; ++s) { acc += s_lf[s]; s_bc[s] = acc; const float g = s_li[s] - acc; s_g[s] = g; cm = fmaxf(cm, g); s_M[s] = cm; s_wi[s] = __expf(m_in - cm); } }
    __syncthreads();
    { const int s = tid & 127, tg = tid >> 7;
      const float gs = s_g[s]; const LAS unsigned* krow = (const LAS unsigned*)(KSb + s * KSTR);
#pragma unroll 1
      for (int i = 0; i < 32; ++i) { const int t = tg * 32 + i; float acc = 0.f; const LAS unsigned* qrow = (const LAS unsigned*)(QS + t * 128);
#pragma unroll 8
          for (int d2 = 0; d2 < 64; ++d2) { const unsigned qp = qrow[d2], kp = krow[d2]; acc += bflo(qp) * bflo(kp) + bfhi(qp) * bfhi(kp); }
          S[t * SS + s] = (s <= t) ? acc * __expf(gs - s_M[t]) : 0.f; } }
    __syncthreads();
    if (tid < 128) { const int t = tid; float den = 0.f; for (int s = 0; s < 128; ++s) den += S[t * SS + s];
        float qn = 0.f; for (int d = 0; d < 128; ++d) qn += bf2f(QS[t * 128 + d]) * s_nin[d];
        den += s_wi[t] * qn; const float mt = s_bc[t] + s_M[t]; s_dn[t] = 1.f / fmaxf(fabsf(den), __expf(-mt)); }
    __syncthreads();
    { const int v = tid & 255, tg = tid >> 8;
      const bf16* cp = P.CIN + ((size_t)uidx * DV + v) * DK;
      const bf16* vp = P.Vm + rowbase * MLW + h * DV + v;
      float* ht = P.HTMP + (size_t)uidx * CH * DV;
#pragma unroll 1
      for (int i = 0; i < 64; ++i) { const int t = tg * 64 + i; float acc = 0.f; const LAS unsigned* qrow = (const LAS unsigned*)(QS + t * 128);
#pragma unroll 4
          for (int d2 = 0; d2 < 64; ++d2) { const unsigned qp = qrow[d2]; const unsigned cc = *(const GAS unsigned*)(cp + 2 * d2); acc += bflo(qp) * bflo(cc) + bfhi(qp) * bfhi(cc); }
          acc *= s_wi[t];
          const LAS float* srow = S + t * SS;
#pragma unroll 4
          for (int s = 0; s < 128; ++s) acc += srow[s] * bf2f(*(const GAS bf16*)(vp + (size_t)s * MLW));
          ht[t * DV + v] = acc * s_dn[t]; } }
    __syncthreads();
    const float* HS = P.HTMP + (size_t)uidx * CH * DV;
    for (int i = 0; i < 16; ++i) { const int t = wave * 16 + i; const f32x4 hv = *(const GAS f32x4*)(HS + t * 256 + 4 * lane);
        const float ss = wave_sum((hv.x * hv.x + hv.y * hv.y) + (hv.z * hv.z + hv.w * hv.w)); const float rstd = 1.f / sqrtf(ss * (1.f / DV) + EPS);
        const f32x4 ng = *(const GAS f32x4*)(P.mng + h * DV + 4 * lane); const v2u ob = *(const GAS v2u*)(P.Om + (rowbase + t) * MLW + h * DV + 4 * lane);
        const float o0 = sigmoidf_(bflo(ob.x)), o1 = sigmoidf_(bfhi(ob.x)), o2 = sigmoidf_(bflo(ob.y)), o3 = sigmoidf_(bfhi(ob.y));
        v2u w; w.x = pk2(hv.x * rstd * ng.x * o0, hv.y * rstd * ng.y * o1); w.y = pk2(hv.z * rstd * ng.z * o2, hv.w * rstd * ng.w * o3);
        *(GAS v2u*)(P.MIX + (rowbase + t) * DM + LRU_W + h * DV + 4 * lane) = w; }
    __syncthreads();
}

__device__ __forceinline__ void attn_v1_phase(const bf16* Q, const bf16* K, const bf16* V, bf16* O, LAS unsigned char* lds, int lane, int wave, int gw, int NGW) {
    LAS float* qs = (LAS float*)(lds + wave * 512);
    for (int u = gw; u < BATCH * SBH * SEQ; u += NGW) {
        const int bh = u & 31, t = u >> 5, b = bh >> 4, h = bh & 15;
        const size_t rowbase = (size_t)b * SEQ;
        { const unsigned qp = *(const GAS unsigned*)(Q + (rowbase + t) * DM + h * SBD + 2 * lane); qs[2 * lane] = bflo(qp); qs[2 * lane + 1] = bfhi(qp); }
        LDS_WAIT();
        float o0 = 0.f, o1 = 0.f, carry = 0.f;
        for (int kb = (t - 1) >> 6; kb >= 0 && t > 0; --kb) {
            const int s = kb * 64 + lane; const bool valid = s < t;
            const bf16* kp = K + (rowbase + s) * DM + h * SBD;
            float z = 0.f;
#pragma unroll
            for (int i = 0; i < 16; ++i) { const v4u kk = *(const GAS v4u*)(kp + i * 8); const LAS float* qq = qs + i * 8;
                z += qq[0] * bflo(kk.x) + qq[1] * bfhi(kk.x) + qq[2] * bflo(kk.y) + qq[3] * bfhi(kk.y) + qq[4] * bflo(kk.z) + qq[5] * bfhi(kk.z) + qq[6] * bflo(kk.w) + qq[7] * bfhi(kk.w); }
            const float sp = valid ? (fmaxf(z, 0.f) + __builtin_amdgcn_logf(1.f + __builtin_amdgcn_exp2f(-fabsf(z)))) : 0.f;
            float x = sp;
#pragma unroll
            for (int off = 1; off < 64; off <<= 1) { const float y = __shfl_down(x, off); if (lane + off < 64) x += y; }
            const float R = x + carry; carry += __shfl(x, 0);
            const float A = valid ? __builtin_amdgcn_exp2f(z - R) : 0.f;
            const bf16* vp = V + (rowbase + kb * 64) * DM + h * SBD + 2 * lane;
            for (int l = 0; l < 64; ++l) { const float a = __shfl(A, l); const unsigned pr = *(const GAS unsigned*)(vp + (size_t)l * DM); o0 += a * bflo(pr); o1 += a * bfhi(pr); }
        }
        *(GAS unsigned*)(O + (rowbase + t) * DM + h * SBD + 2 * lane) = pk2(o0, o1);
    }
}

__global__ void __launch_bounds__(NWAVES * 64, 2) fwd_kernel(Args args) {
    extern __shared__ __attribute__((aligned(16))) unsigned char lds_raw[];
    LAS unsigned char* lds = (LAS unsigned char*)lds_raw;
    const int tid0 = threadIdx.x;
    const int G = gridDim.x, bx = blockIdx.x; const int vcu = (G % 8 == 0) ? (bx % 8) * (G / 8) + bx / 8 : bx;
    const int NGW = G * NWAVES;
#define FRESH() const int tid = fresh_tid(), lane = tid & 63, wave = __builtin_amdgcn_readfirstlane(tid >> 6), gw = vcu * NWAVES + wave; (void)lane; (void)gw
    unsigned char* ws = args.ws;
    volatile LAS unsigned* MISC = (volatile LAS unsigned*)(lds + MISC_OFF);
    if (tid0 < 64) MISC[tid0] = 0u;
    __syncthreads();
    XcdBarrier bar = xcd_barrier_post((unsigned*)(ws + WS_CTL) + CW_BAR, MISC + 8);
#define GRID_BAR() do { XcdBarrier b2_ = bar; asm volatile("" : "+s"(b2_.x)); asm volatile("" : "+s"(b2_.bar)); xcd_barrier(b2_); } while (0)

    float* X = args.out;
    float* MOD = (float*)(ws + WS_MOD);
    bf16* HN = (bf16*)(ws + WS_HN); bf16* MIX = (bf16*)(ws + WS_MIX); bf16* ACT = (bf16*)(ws + WS_ACT);

    { FRESH(); p0_prologue(args, lds, tid, lane, wave, vcu, G); }
    GRID_BAR();

    for (int layer = 0; layer < DEPTH; ++layer) {
        const int j = layer >> 1;
        const float* xin = (layer == 0) ? args.in[0] : X;
        { FRESH(); norm_phase(xin, args.in[4] + (size_t)(layer * 2 + 0) * DM, MOD + (size_t)(layer * 2 + 0) * 2 * 6144, HN, lane, gw, NGW); }
        GRID_BAR();
        if ((layer & 1) == 0) {
            MixP P;
            P.XA = (const float*)(ws + WS_P0); P.YA = (const bf16*)(ws + WS_P0 + 32 * MiB); P.Qm = (const bf16*)(ws + WS_P0 + 48 * MiB); P.Km = (const bf16*)(ws + WS_P0 + 56 * MiB);
            P.Vm = (const bf16*)(ws + WS_P0 + 64 * MiB); P.Om = (const bf16*)(ws + WS_P0 + 80 * MiB); P.IG = (const float*)(ws + WS_IG); P.FG = (const float*)(ws + WS_IG + 128 * 1024); P.MIX = MIX;
            P.conv_w = args.in[11] + (size_t)j * 4 * LRU_W; P.conv_b = args.in[12] + (size_t)j * LRU_W; P.gate_w = args.in[13] + (size_t)j * 2 * NBLK * BW * BW; P.gate_b = args.in[14] + (size_t)j * 2 * LRU_W;
            P.lam = args.in[15] + (size_t)j * LRU_W; P.mgb = args.in[16] + (size_t)j * 2 * MH; P.mng = args.in[17] + (size_t)j * MLW;
            P.DC = (float*)(ws + WS_DC); P.CIN = (bf16*)(ws + WS_CIN); P.DN = (float*)(ws + WS_SMALL); P.NIN = (float*)(ws + WS_SMALL + 128 * 1024); P.MLOC = (float*)(ws + WS_SMALL + 256 * 1024);
            P.BLAST = (float*)(ws + WS_SMALL + 257 * 1024); P.MIN = (float*)(ws + WS_SMALL + 258 * 1024); P.HLOC = (float*)(ws + WS_HLOC); P.PCUM = (float*)(ws + WS_PCUM);
            P.AGGP = (float*)(ws + WS_AGG); P.AGGH = (float*)(ws + WS_AGG + 256 * 1024); P.HTMP = (float*)(ws + WS_HTMP);
            { pg8::Gemm g{HN, (const bf16*)(ws + WS_WABIN) + (size_t)j * AB_IN_PAD * 2048, M, AB_IN_PAD, DM}; pg8::StaticOrder S; S.init(M, AB_IN_PAD, G, bx);
              pg8::EpiInProj E{(float*)(ws + WS_P0), (bf16*)(ws + WS_P0 + 32 * MiB), (bf16*)(ws + WS_P0 + 48 * MiB), (bf16*)(ws + WS_P0 + 56 * MiB), (bf16*)(ws + WS_P0 + 64 * MiB), (bf16*)(ws + WS_P0 + 80 * MiB),
                               (float*)(ws + WS_IG), (float*)(ws + WS_IG + 128 * 1024), 0.08838834764831845f};
              pg8::gemm_phase<pg8::EpiInProj, pg8::StaticOrder, PG8_ALIGN, PG8_SP2>(lds, g, S, E); }
            GRID_BAR();
            { FRESH(); for (int u = vcu; u < 768; u += G) {
                if (u < 256) mx1_mlstm_unit(P, lds, tid, u >> 7, (u >> 5) & 3, u & 31);
                else { const int r = u - 256; mx1_rglru_unit(P, lds, tid, r >> 8, (r >> 5) & 7, r & 31); }
            } }
            GRID_BAR();
            { FRESH(); mx2_mlstm(P, lds, tid, vcu * 512 + tid, G * 512); }
            GRID_BAR();
            { FRESH(); for (int u = vcu; u < 384; u += G) {
                if (u < 256) mx3_mlstm_unit(P, lds, tid, lane, wave, u >> 7, (u >> 5) & 3, u & 31);
                else { const int r = u - 256; mx3_rglru_unit(P, tid, r >> 6, (r >> 1) & 31, r & 1); }
            } }
            GRID_BAR();
        } else {
            { pg8::Gemm g{HN, (const bf16*)(ws + WS_WQKV) + (size_t)j * 6144 * 2048, M, 6144, DM}; pg8::StaticOrder S; S.init(M, 6144, G, bx);
              pg8::EpiBf16Split E{(bf16*)(ws + WS_P0), DM, DM, (size_t)M * DM, 0.08838834764831845f * LOG2E};
              pg8::gemm_phase<pg8::EpiBf16Split, pg8::StaticOrder, PG8_ALIGN, PG8_SP2>(lds, g, S, E); }
            GRID_BAR();
            { FRESH(); attn_v1_phase((const bf16*)(ws + WS_P0), (const bf16*)(ws + WS_P0) + (size_t)M * DM, (const bf16*)(ws + WS_P0) + (size_t)2 * M * DM, MIX, lds, lane, wave, gw, NGW); }
            GRID_BAR();
        }
        { const bf16* Bt = ((layer & 1) == 0) ? (const bf16*)(ws + WS_WABOUT) + (size_t)j * 2048 * 2048 : (const bf16*)(ws + WS_WSBO) + (size_t)j * 2048 * 2048;
          pg8::Gemm g{MIX, Bt, M, DM, DM}; pg8::StaticOrder S; S.init(M, DM, G, bx);
          pg8::EpiResid E{xin, X, MOD + (size_t)(layer * 2 + 0) * 2 * 6144 + 4096};
          pg8::gemm_phase<pg8::EpiResid, pg8::StaticOrder, PG8_ALIGN, PG8_SP2>(lds, g, S, E); }
        GRID_BAR();
        { FRESH(); norm_phase(X, args.in[4] + (size_t)(layer * 2 + 1) * DM, MOD + (size_t)(layer * 2 + 1) * 2 * 6144, HN, lane, gw, NGW); }
        GRID_BAR();
        { pg8::Gemm g{HN, (const bf16*)(ws + WS_W13) + (size_t)layer * 2 * FF * 2048, M, 2 * FF, DM}; pg8::StaticOrder S; S.init(M, 2 * FF, G, bx);
          pg8::EpiSwiGLU E{ACT};
          pg8::gemm_phase<pg8::EpiSwiGLU, pg8::StaticOrder, PG8_ALIGN, PG8_SP2>(lds, g, S, E); }
        GRID_BAR();
        { pg8::Gemm g{ACT, (const bf16*)(ws + WS_W2) + (size_t)layer * 2048 * FF, M, DM, FF}; pg8::StaticOrder S; S.init(M, DM, G, bx);
          pg8::EpiResid E{X, X, MOD + (size_t)(layer * 2 + 1) * 2 * 6144 + 4096};
          pg8::gemm_phase<pg8::EpiResid, pg8::StaticOrder, PG8_ALIGN, PG8_SP2>(lds, g, S, E); }
        GRID_BAR();
    }
    { FRESH(); final_norm_phase(X, args.in[5], X, lane, gw, NGW); }
}

extern "C" void kernel_launch(void* const* d_in, const int* in_sizes, int n_in, void* d_out, int out_size, void* d_ws, size_t ws_size, hipStream_t stream) {
    static int grid = 0;
    if (grid == 0) {
        if (n_in != 20 || in_sizes[0] != M * DM || out_size != M * DM || ws_size < WS_END) { fprintf(stderr, "kernel_launch: unexpected shapes: n_in %d in0 %d out %d ws %zu (need %zu); nothing launched\n", n_in, n_in > 0 ? in_sizes[0] : -1, out_size, ws_size, (size_t)WS_END); grid = -1; return; }
        int dev = 0, cus = 0, per_cu = 0;
        if (hipGetDevice(&dev) != hipSuccess || hipDeviceGetAttribute(&cus, hipDeviceAttributeMultiprocessorCount, dev) != hipSuccess) { fprintf(stderr, "kernel_launch: device query failed\n"); grid = -1; return; }
        if (hipFuncSetAttribute((const void*)fwd_kernel, hipFuncAttributeMaxDynamicSharedMemorySize, LDS_BYTES) != hipSuccess) { fprintf(stderr, "kernel_launch: hipFuncSetAttribute failed\n"); grid = -1; return; }
        if (hipOccupancyMaxActiveBlocksPerMultiprocessor(&per_cu, (const void*)fwd_kernel, NWAVES * 64, LDS_BYTES) != hipSuccess || per_cu < 1)
            fprintf(stderr, "kernel_launch: note: occupancy query reports %d workgroups per CU\n", per_cu);
        (void)hipGetLastError();
        grid = cus;
    }
    if (grid < 0) return;
    if (hipMemsetAsync((char*)d_ws + WS_CTL, 0, CTL_ZERO_BYTES, stream) != hipSuccess) { fprintf(stderr, "kernel_launch: memset failed\n"); return; }
    Args a{};
    for (int i = 0; i < 20; ++i) a.in[i] = (const float*)d_in[i];
    a.out = (float*)d_out; a.ws = (unsigned char*)d_ws;
    hipLaunchKernelGGL(fwd_kernel, dim3(grid), dim3(NWAVES * 64), LDS_BYTES, stream, a);
    const hipError_t le = hipPeekAtLastError();
    if (le != hipSuccess) fprintf(stderr, "kernel_launch: launch failed: %s\n", hipGetErrorName(le));
}
```

```cpp
#include <hip/hip_runtime.h>
#include <cstdio>
#include <cstdint>

constexpr int NWAVES = 8;
constexpr int BATCH = 2, SEQ = 4096, DM = 2048, DEPTH = 4, M = BATCH * SEQ;
constexpr int LRU_W = 1024, NBLK = 8, BW = 128;
constexpr int MLW = 1024, MH = 4, DV = 256, DK = 128, MQK = 512, CH = 128, NCH = SEQ / CH;
constexpr int AB_IN = 5128, AB_IN_PAD = 5376;
constexpr int SBH = 16, SBD = 128;
constexpr int FF = 5632;
constexpr float EPS = 1e-6f;
constexpr float LOG2E = 1.4426950408889634f, LN2 = 0.6931471805599453f;

constexpr size_t MiB = 1u << 20;
constexpr size_t WS_CTL = 0, CTL_ZERO_BYTES = 1 * MiB;
constexpr size_t WS_MOD = 1 * MiB;
constexpr size_t WS_WABIN = 2 * MiB;
constexpr size_t WS_WABOUT = 44 * MiB;
constexpr size_t WS_WQKV = 60 * MiB;
constexpr size_t WS_WSBO = 108 * MiB;
constexpr size_t WS_W13 = 124 * MiB;
constexpr size_t WS_W2 = 300 * MiB;
constexpr size_t WS_HN = 388 * MiB;
constexpr size_t WS_P0 = 420 * MiB;
constexpr size_t WS_IG = 516 * MiB;
constexpr size_t WS_MIX = 517 * MiB;
constexpr size_t WS_ACT = 549 * MiB;
constexpr size_t WS_DC = 637 * MiB;
constexpr size_t WS_CIN = 669 * MiB;
constexpr size_t WS_SMALL = 685 * MiB;
constexpr size_t WS_HLOC = 686 * MiB;
constexpr size_t WS_PCUM = 718 * MiB;
constexpr size_t WS_AGG = 750 * MiB;
constexpr size_t WS_HTMP = 752 * MiB;
constexpr size_t WS_END = 784 * MiB;
constexpr int CW_BAR = 4096;

constexpr int BIG_BYTES = 147456;
constexpr int MISC_OFF = BIG_BYTES;
constexpr int SM_OFF = BIG_BYTES + 1024;
constexpr int LDS_BYTES = 163840;

namespace pg8 {
#define PG8_LAS __attribute__((address_space(3)))
typedef unsigned short bf16_t;
typedef short bf16x8 __attribute__((ext_vector_type(8)));
typedef float f32x4 __attribute__((ext_vector_type(4)));
typedef unsigned u32x4 __attribute__((ext_vector_type(4)));
constexpr int BM = 256, BK = 64, HALF = 128, HTB = HALF * BK * 2  , STAGE_BYTES = 8 * HTB, NXCD = 8, WGM = 8;

__host__ __device__ __forceinline__ int lds_byte(int r, int c) { const int st = (r >> 4) * 2 + (c >> 5), rr = r & 15, cc = c & 31, ob = rr * 64 + cc * 2; return st * 1024 + (ob ^ (((ob >> 9) & 1) << 5)); }
__host__ __device__ __forceinline__ void stage_rc(int b, int& R, int& C) { const int st = b / 1024, sb = b % 1024, swz = sb ^ (((sb >> 9) & 1) << 5); R = (st >> 1) * 16 + swz / 64; C = (st & 1) * 32 + (swz % 64) / 2; }
__host__ __device__ __forceinline__ int perm32(int rho) { const int n = rho >> 4, i = rho & 15; return 8 * (i >> 2) + 4 * n + (i & 3); }

struct Unit { int pm, pn; };
struct Gemm { const bf16_t* A; const bf16_t* Bt; int M, N, K; };

struct StaticOrder {
    int nM, nN, nwg, G, c;
    __host__ __device__ void init(int M, int N, int G_, int c_) { nM = M / BM; nN = N / BM; nwg = nM * nN; G = G_; c = c_; }
    __host__ __device__ bool next(int i, Unit& u) const {
        const long L = (long)i * G + c; if (L >= nwg) return false;
        int wgid = (int)L; { const int q = nwg / NXCD, r = nwg % NXCD, xcd = wgid % NXCD, off = wgid / NXCD; wgid = (xcd < r ? xcd * (q + 1) : r * (q + 1) + (xcd - r) * q) + off; }
        const int nig = WGM * nN, gid = wgid / nig, fm = gid * WGM, gsz = (nM - fm) < WGM ? (nM - fm) : WGM;
        u.pm = fm + ((wgid % nig) % gsz); u.pn = (wgid % nig) / gsz; return true;
    }
    __device__ __forceinline__ void a_ready(const Unit&) const {}
    __device__ __forceinline__ void done(const Unit&) const {}
};

__device__ __forceinline__ unsigned cvt_pk_bf16(float lo, float hi) { unsigned r; asm volatile("v_cvt_pk_bf16_f32 %0, %1, %2" : "=v"(r) : "v"(lo), "v"(hi)); return r; }
typedef float f32x2 __attribute__((ext_vector_type(2)));
__device__ __forceinline__ u32x4 pack8(f32x4 v0, f32x4 v1) { u32x4 w; w.x = cvt_pk_bf16(v0[0], v0[1]); w.y = cvt_pk_bf16(v0[2], v0[3]); w.z = cvt_pk_bf16(v1[0], v1[1]); w.w = cvt_pk_bf16(v1[2], v1[3]); return w; }

struct EpiBf16Split {
    static constexpr bool PERM = true, AFTER_DRAIN = false;
    bf16_t* O; int ldc; int split_cols; size_t split_stride; float scale0;
    __device__ __forceinline__ void operator()(const f32x4 (&acc)[2][2][4][2], const Unit& u, int wr, int wc, int fr, int fq) const {
        const int row0 = u.pm * BM + wr * 64 + fr; int colt = u.pn * BM; bf16_t* base = O;
        float sc = 1.f; { const int t = colt / split_cols; base += (size_t)t * split_stride; colt -= t * split_cols; if (t == 0) sc = scale0; }
        const int col0 = colt + wc * 32 + 8 * fq;
#pragma unroll
        for (int ai = 0; ai < 2; ++ai)
#pragma unroll
            for (int m = 0; m < 4; ++m) { bf16_t* rowp = base + (size_t)(row0 + ai * HALF + m * 16) * ldc + col0;
#pragma unroll
                for (int bj = 0; bj < 2; ++bj) { *(u32x4*)(rowp + bj * HALF) = pack8(acc[ai][bj][m][0] * sc, acc[ai][bj][m][1] * sc); } }
    }
};

struct EpiResid {
    static constexpr bool PERM = true, AFTER_DRAIN = false;
    const float* base; float* out; const float* gate0;
    __device__ __forceinline__ void operator()(const f32x4 (&acc)[2][2][4][2], const Unit& u, int wr, int wc, int fr, int fq) const {
        const int row0 = u.pm * BM + wr * 64 + fr, col0 = u.pn * BM + wc * 32 + 8 * fq;
        const float* gp = gate0 + (u.pm >= 16 ? 6144 : 0) + col0;
        f32x4 gv[2][2];
#pragma unroll
        for (int bj = 0; bj < 2; ++bj)
#pragma unroll
            for (int n = 0; n < 2; ++n) gv[bj][n] = *(const f32x4*)(gp + bj * HALF + 4 * n);
#pragma unroll
        for (int ai = 0; ai < 2; ++ai)
#pragma unroll
            for (int m = 0; m < 4; ++m) { const size_t off = (size_t)(row0 + ai * HALF + m * 16) * 2048 + col0;
#pragma unroll
                for (int bj = 0; bj < 2; ++bj)
#pragma unroll
                    for (int n = 0; n < 2; ++n) { const f32x4 b = *(const f32x4*)(base + off + bj * HALF + 4 * n); *(f32x4*)(out + off + bj * HALF + 4 * n) = b + gv[bj][n] * acc[ai][bj][m][n]; }
                if (m & 1) asm volatile("" ::: "memory"); }
    }
};

struct EpiSwiGLU {
    static constexpr bool PERM = true, AFTER_DRAIN = false;
    bf16_t* O;
    static __device__ __forceinline__ f32x4 silu_mul(f32x4 a, f32x4 b) { f32x4 r;
#pragma unroll
        for (int i = 0; i < 4; ++i) { const float e = __builtin_amdgcn_exp2f(-a[i] * 1.4426950408889634f); r[i] = a[i] * __builtin_amdgcn_rcpf(1.f + e) * b[i]; }
        return r; }
    __device__ __forceinline__ void operator()(const f32x4 (&acc)[2][2][4][2], const Unit& u, int wr, int wc, int fr, int fq) const {
        const int row0 = u.pm * BM + wr * 64 + fr, col0 = u.pn * HALF + wc * 32 + 8 * fq;
#pragma unroll
        for (int ai = 0; ai < 2; ++ai)
#pragma unroll
            for (int m = 0; m < 4; ++m) { bf16_t* rowp = O + (size_t)(row0 + ai * HALF + m * 16) * 5632 + col0;
                *(u32x4*)rowp = pack8(silu_mul(acc[ai][0][m][0], acc[ai][1][m][0]), silu_mul(acc[ai][0][m][1], acc[ai][1][m][1])); }
    }
};

struct EpiInProj {
    static constexpr bool PERM = true, AFTER_DRAIN = false;
    float* XA; bf16_t *YA, *Qm, *Km, *Vm, *Om; float *IG, *FG; float kscale;
    __device__ __forceinline__ void operator()(const f32x4 (&acc)[2][2][4][2], const Unit& u, int wr, int wc, int fr, int fq) const {
        const int pn = u.pn, row0 = u.pm * BM + wr * 64 + fr, cl = wc * 32 + 8 * fq;
        if (pn < 4) {
#pragma unroll
            for (int ai = 0; ai < 2; ++ai)
#pragma unroll
                for (int m = 0; m < 4; ++m) { float* rp = XA + (size_t)(row0 + ai * HALF + m * 16) * 1024 + pn * 256 + cl;
#pragma unroll
                    for (int bj = 0; bj < 2; ++bj)
#pragma unroll
                        for (int n = 0; n < 2; ++n) *(f32x4*)(rp + bj * HALF + 4 * n) = acc[ai][bj][m][n]; }
        } else if (pn < 20) {
            bf16_t* base; int ld, colt; float sc = 1.f;
            if (pn < 8) { base = YA; ld = 1024; colt = (pn - 4) * 256; }
            else if (pn < 10) { base = Qm; ld = 512; colt = (pn - 8) * 256; }
            else if (pn < 12) { base = Km; ld = 512; colt = (pn - 10) * 256; sc = kscale; }
            else if (pn < 16) { base = Vm; ld = 1024; colt = (pn - 12) * 256; }
            else { base = Om; ld = 1024; colt = (pn - 16) * 256; }
#pragma unroll
            for (int ai = 0; ai < 2; ++ai)
#pragma unroll
                for (int m = 0; m < 4; ++m) { bf16_t* rowp = base + (size_t)(row0 + ai * HALF + m * 16) * ld + colt + cl;
#pragma unroll
                    for (int bj = 0; bj < 2; ++bj) *(u32x4*)(rowp + bj * HALF) = pack8(acc[ai][bj][m][0] * sc, acc[ai][bj][m][1] * sc); }
        } else {
            if (wc == 0 && fq == 0) {
#pragma unroll
                for (int ai = 0; ai < 2; ++ai)
#pragma unroll
                    for (int m = 0; m < 4; ++m) { const size_t r = (size_t)(row0 + ai * HALF + m * 16); *(f32x4*)(IG + r * 4) = acc[ai][0][m][0]; *(f32x4*)(FG + r * 4) = acc[ai][0][m][1]; }
            }
        }
    }
};

template <class Epi, class Sched, bool ALIGN_EPI = false, bool SP2 = false>
__device__ __forceinline__ void gemm_phase(PG8_LAS unsigned char* lds, const Gemm g, const Sched& S, const Epi& E) {
    int tid_ = threadIdx.x; asm volatile("" : "+v"(tid_)); const int tid = tid_, wid = __builtin_amdgcn_readfirstlane(tid >> 6), lane = tid & 63, wr = wid >> 2, wc = wid & 3, fr = lane & 15, fq = lane >> 4;
    const int K = g.K, nt = K / BK;
    unsigned voffA[2], voffB[2];
#pragma unroll
    for (int i = 0; i < 2; ++i) { int R, C; stage_rc(tid * 16 + i * 8192, R, C); const int Rb = Epi::PERM ? ((R & ~31) + perm32(R & 31)) : R;
        voffA[i] = (unsigned)(R * K + C) * 2u; voffB[i] = (unsigned)(Rb * K + C) * 2u; }
    const size_t kstep = (size_t)(BK * 2);
    const size_t hstep = (size_t)HALF * K * 2;
    const size_t tstep = 2 * hstep;
    const unsigned ldsw = (unsigned)wid * 1024u;
    const int aoff = lds_byte(wr * 64 + fr, fq * 8), boff = lds_byte(wc * 32 + fr, fq * 8);
#define PG8_SA(b, h) (((b) * 2 + (h)) * HTB)
#define PG8_SB(b, h) ((4 + (b) * 2 + (h)) * HTB)
#define PG8_STAGE(bufoff, gbase, voff) do { _Pragma("unroll") for (int _i = 0; _i < 2; ++_i) \
        __builtin_amdgcn_global_load_lds((const unsigned*)((const char*)(gbase) + (voff)[_i]), (PG8_LAS unsigned*)(lds + (bufoff) + ldsw + _i * 8192), 16, 0, 0); } while (0)
#define PG8_LDA(dst, b, h) do { _Pragma("unroll") for (int m = 0; m < 4; ++m) _Pragma("unroll") for (int k = 0; k < 2; ++k) dst[m][k] = *(const PG8_LAS bf16x8*)(lds + PG8_SA(b, h) + aoff + m * 2048 + k * 1024); } while (0)
#define PG8_LDB(dst, b, h) do { _Pragma("unroll") for (int n = 0; n < 2; ++n) _Pragma("unroll") for (int k = 0; k < 2; ++k) dst[n][k] = *(const PG8_LAS bf16x8*)(lds + PG8_SB(b, h) + boff + n * 2048 + k * 1024); } while (0)
#define PG8_MMA(ai, bj, At, Bt) do { __builtin_amdgcn_s_setprio(1); _Pragma("unroll") for (int m = 0; m < 4; ++m) _Pragma("unroll") for (int n = 0; n < 2; ++n) _Pragma("unroll") for (int k = 0; k < 2; ++k) \
        acc[ai][bj][m][n] = __builtin_amdgcn_mfma_f32_16x16x32_bf16(Bt[n][k], At[m][k], acc[ai][bj][m][n], 0, 0, 0); __builtin_amdgcn_s_setprio(0); } while (0)
#define PG8_WAIT_V(n) asm volatile("s_waitcnt vmcnt(" #n ")" ::: "memory")
#define PG8_WAIT_L(n) asm volatile("s_waitcnt lgkmcnt(" #n ")" ::: "memory")
#define PG8_BAR __builtin_amdgcn_s_barrier()
#define PG8_SCHED __builtin_amdgcn_sched_barrier(0)
    Unit cur, nxt; int ui = 0;
    if (!S.next(0, cur)) return;
    f32x4 acc[2][2][4][2];
#pragma unroll
    for (int a = 0; a < 2; ++a)
#pragma unroll
        for (int b = 0; b < 2; ++b)
#pragma unroll
            for (int m = 0; m < 4; ++m)
#pragma unroll
                for (int n = 0; n < 2; ++n) acc[a][b][m][n] = (f32x4){0.f, 0.f, 0.f, 0.f};
    bf16x8 At[4][2], B0[2][2], B1[2][2];
    const char* cA = (const char*)g.A + (size_t)cur.pm * tstep; const char* cB = (const char*)g.Bt + (size_t)cur.pn * tstep;
    S.a_ready(cur);
    if constexpr (SP2) {
        PG8_STAGE(PG8_SB(0, 0), cB, voffB); PG8_STAGE(PG8_SB(0, 1), cB + hstep, voffB); PG8_STAGE(PG8_SA(0, 0), cA, voffA); PG8_STAGE(PG8_SA(0, 1), cA + hstep, voffA);
        if (wr == 1) PG8_BAR;
        PG8_WAIT_V(2); PG8_BAR;
        PG8_STAGE(PG8_SB(1, 0), cB + kstep, voffB); PG8_STAGE(PG8_SA(1, 0), cA + kstep, voffA); PG8_STAGE(PG8_SB(1, 1), cB + hstep + kstep, voffB);
        PG8_WAIT_V(6); PG8_BAR;
    } else {
        PG8_STAGE(PG8_SB(0, 0), cB, voffB); PG8_STAGE(PG8_SA(0, 0), cA, voffA); PG8_STAGE(PG8_SB(0, 1), cB + hstep, voffB); PG8_STAGE(PG8_SA(0, 1), cA + hstep, voffA);
        if (wr == 1) PG8_BAR;
        PG8_WAIT_V(4); PG8_BAR;
        PG8_STAGE(PG8_SB(1, 0), cB + kstep, voffB); PG8_STAGE(PG8_SA(1, 0), cA + kstep, voffA); PG8_STAGE(PG8_SB(1, 1), cB + hstep + kstep, voffB);
        PG8_WAIT_V(6); PG8_BAR;
    }
    for (;;) {
        const bool has_next = S.next(ui + 1, nxt);
        const char* nA = has_next ? (const char*)g.A + (size_t)nxt.pm * tstep : cA; const char* nB = has_next ? (const char*)g.Bt + (size_t)nxt.pn * tstep : cB;
        for (int t = 0; t < nt; t += 2) {
            const bool last = (t == nt - 2);
            const char* a1 = cA + (size_t)(t + 1) * kstep;
            const char* a2 = last ? nA : cA + (size_t)(t + 2) * kstep; const char* b2 = last ? nB : cB + (size_t)(t + 2) * kstep;
            const char* a3 = a2 + kstep; const char* b3 = b2 + kstep;
            if (last && has_next) S.a_ready(nxt);
            if constexpr (SP2) {
            PG8_LDB(B0, 0, 0); PG8_LDB(B1, 0, 1); PG8_SCHED; PG8_LDA(At, 0, 0); PG8_STAGE(PG8_SA(1, 1), a1 + hstep, voffA);
            PG8_WAIT_V(8); PG8_WAIT_L(0); PG8_BAR; PG8_MMA(0, 0, At, B0); PG8_MMA(0, 1, At, B1); PG8_BAR; PG8_SCHED;
            PG8_LDA(At, 0, 1); PG8_STAGE(PG8_SB(0, 0), b2, voffB); PG8_STAGE(PG8_SB(0, 1), b2 + hstep, voffB); PG8_STAGE(PG8_SA(0, 0), a2, voffA);
            PG8_WAIT_V(8); PG8_WAIT_L(0); PG8_BAR; PG8_MMA(1, 0, At, B0); PG8_MMA(1, 1, At, B1); PG8_BAR; PG8_SCHED;
            PG8_LDB(B0, 1, 0); PG8_LDB(B1, 1, 1); PG8_SCHED; PG8_LDA(At, 1, 0); PG8_STAGE(PG8_SA(0, 1), a2 + hstep, voffA);
            PG8_WAIT_V(8); PG8_WAIT_L(0); PG8_BAR; PG8_MMA(0, 0, At, B0); PG8_MMA(0, 1, At, B1); PG8_BAR; PG8_SCHED;
            PG8_LDA(At, 1, 1); PG8_STAGE(PG8_SB(1, 0), b3, voffB); PG8_STAGE(PG8_SB(1, 1), b3 + hstep, voffB); PG8_STAGE(PG8_SA(1, 0), a3, voffA);
            PG8_WAIT_V(8); PG8_WAIT_L(0); PG8_BAR; PG8_MMA(1, 0, At, B0); PG8_MMA(1, 1, At, B1); PG8_BAR; PG8_SCHED;
            } else {
            PG8_LDB(B0, 0, 0); PG8_SCHED; PG8_LDA(At, 0, 0); PG8_STAGE(PG8_SA(1, 1), a1 + hstep, voffA);
            PG8_WAIT_L(8); PG8_BAR; PG8_WAIT_L(0); PG8_MMA(0, 0, At, B0); PG8_BAR; PG8_SCHED;
            PG8_LDB(B1, 0, 1); PG8_STAGE(PG8_SB(0, 0), b2, voffB);
            PG8_BAR; PG8_WAIT_L(0); PG8_MMA(0, 1, At, B1); PG8_BAR;
            PG8_LDA(At, 0, 1); PG8_STAGE(PG8_SA(0, 0), a2, voffA);
            PG8_BAR; PG8_WAIT_L(0); PG8_MMA(1, 0, At, B0); PG8_BAR; PG8_SCHED;
            PG8_STAGE(PG8_SB(0, 1), b2 + hstep, voffB);
            PG8_WAIT_V(6); PG8_BAR; PG8_MMA(1, 1, At, B1); PG8_BAR;
            PG8_LDB(B0, 1, 0); PG8_SCHED; PG8_LDA(At, 1, 0); PG8_STAGE(PG8_SA(0, 1), a2 + hstep, voffA);
            PG8_WAIT_L(8); PG8_BAR; PG8_WAIT_L(0); PG8_MMA(0, 0, At, B0); PG8_BAR; PG8_SCHED;
            PG8_LDB(B1, 1, 1); PG8_STAGE(PG8_SB(1, 0), b3, voffB);
            PG8_BAR; PG8_WAIT_L(0); PG8_MMA(0, 1, At, B1); PG8_BAR;
            PG8_LDA(At, 1, 1); PG8_STAGE(PG8_SA(1, 0), a3, voffA);
            PG8_BAR; PG8_WAIT_L(0); PG8_MMA(1, 0, At, B0); PG8_BAR; PG8_SCHED;
            PG8_STAGE(PG8_SB(1, 1), b3 + hstep, voffB);
            PG8_WAIT_V(6); PG8_BAR; PG8_MMA(1, 1, At, B1); PG8_BAR;
            }
        }
        if constexpr (ALIGN_EPI) { if (wr == 0) PG8_BAR; }
        if constexpr (!Epi::AFTER_DRAIN) { E(acc, cur, wr, wc, fr, fq); S.done(cur); }
        if (!has_next) break;
#pragma unroll
        for (int a = 0; a < 2; ++a)
#pragma unroll
            for (int b = 0; b < 2; ++b)
#pragma unroll
                for (int m = 0; m < 4; ++m)
#pragma unroll
                    for (int n = 0; n < 2; ++n) acc[a][b][m][n] = (f32x4){0.f, 0.f, 0.f, 0.f};
        cur = nxt; cA = nA; cB = nB; ++ui;
        if constexpr (ALIGN_EPI) { if (wr == 1) PG8_BAR; }
    }
    PG8_WAIT_V(0);
    if constexpr (!ALIGN_EPI) { if (wr == 0) PG8_BAR; }
    PG8_BAR;
    if constexpr (Epi::AFTER_DRAIN) { E.fused(acc, cur, wr, wc, fr, fq, lds, wid, lane); S.done(cur); }
#undef PG8_SA
#undef PG8_SB
#undef PG8_STAGE
#undef PG8_LDA
#undef PG8_LDB
#undef PG8_MMA
#undef PG8_WAIT_V
#undef PG8_WAIT_L
#undef PG8_BAR
#undef PG8_SCHED
}
}
#ifndef PG8_SP2
#define PG8_SP2 true
#endif
#ifndef PG8_ALIGN
#define PG8_ALIGN true
#endif

#define GAS __attribute__((address_space(1)))
#define LAS __attribute__((address_space(3)))
typedef unsigned short bf16;
typedef unsigned v4u __attribute__((ext_vector_type(4)));
typedef unsigned v2u __attribute__((ext_vector_type(2)));
typedef float f32x4 __attribute__((ext_vector_type(4)));
typedef short bf16x8 __attribute__((ext_vector_type(8)));
typedef GAS unsigned gu32;
#define RLX_AGENT __ATOMIC_RELAXED, __HIP_MEMORY_SCOPE_AGENT
#define LDS_WAIT() asm volatile("s_waitcnt lgkmcnt(0)" ::: "memory")
#define VM_WAIT() asm volatile("s_waitcnt vmcnt(0)" ::: "memory")
__device__ __forceinline__ unsigned pk2(float lo, float hi) { return pg8::cvt_pk_bf16(lo, hi); }
__device__ __forceinline__ bf16 f2bf(float x) { return (bf16)(pg8::cvt_pk_bf16(x, 0.f) & 0xffffu); }
__device__ __forceinline__ float bf2f(bf16 b) { return __uint_as_float((unsigned)b << 16); }
__device__ __forceinline__ float bflo(unsigned p) { return __uint_as_float(p << 16); }
__device__ __forceinline__ float bfhi(unsigned p) { return __uint_as_float(p & 0xffff0000u); }
__device__ __forceinline__ float sigmoidf_(float x) { return 1.f / (1.f + __expf(-x)); }
__device__ __forceinline__ float logsigmoidf_(float x) { return fminf(x, 0.f) - log1pf(__expf(-fabsf(x))); }
__device__ __forceinline__ float gelu_tanh(float y) { const float x = 0.7978845608028654f * (y + 0.044715f * y * y * y); const float t = __builtin_amdgcn_exp2f(2.f * LOG2E * x); return 0.5f * y * (2.f - 2.f * __builtin_amdgcn_rcpf(t + 1.f)); }
__device__ __forceinline__ float wave_sum(float v) {
#pragma unroll
    for (int o = 1; o < 64; o <<= 1) v += __shfl_xor(v, o);
    return v;
}

__device__ __forceinline__ int fresh_tid() { int t = threadIdx.x; asm volatile("" : "+v"(t)); return t; }
#define XB_TMO      128
#define XB_XCNT(j)  (256  + 64 * (j))
#define XB_XSUB(j)  (1280 + 64 * (j))
#define XB_XGEN(j)  (2304 + 64 * (j))
#define XB_TOP      3328
#define XB_TOPGEN   3392
#define XCD_BAR_WORDS 3456
#define XB_SPIN_CAP (1u << 18)

__device__ __forceinline__ unsigned xb_ld(unsigned* p)              { return __hip_atomic_load(p, __ATOMIC_RELAXED, __HIP_MEMORY_SCOPE_AGENT); }
__device__ __forceinline__ unsigned xb_add(unsigned* p, unsigned v) { return __hip_atomic_fetch_add(p, v, __ATOMIC_RELAXED, __HIP_MEMORY_SCOPE_AGENT); }
__device__ __forceinline__ unsigned xb_xcc_id() { return (unsigned)__builtin_amdgcn_s_getreg((3 << 11) | 20) & 0xFu; }
#define XB_SPIN(cond, bar) do { unsigned _sp = 0; while (cond) { __builtin_amdgcn_s_sleep(1); \
    if ((++_sp & 255u) == 0u) { if (xb_ld(&(bar)[XB_TMO])) break; if (_sp > XB_SPIN_CAP) { atomicAdd(&(bar)[XB_TMO], 1u); break; } } } } while (0)

struct XcdBarrier {
    unsigned* bar; unsigned x;
    volatile LAS unsigned* st;
};

__device__ __forceinline__ XcdBarrier xcd_barrier_post(unsigned* bar, volatile LAS unsigned* st) {
    XcdBarrier b; b.bar = bar; b.x = xb_xcc_id(); b.st = st;
    if (threadIdx.x == 0) (void)xb_add(&bar[XB_XCNT(b.x)], 1u);
    return b;
}
__device__ __forceinline__ void xcd_barrier_complete(unsigned* bar, unsigned x, unsigned& nloc, unsigned& nx) {
    const unsigned G = gridDim.x * gridDim.y * gridDim.z;
    unsigned sum, cnt, mine, sp = 0u;
    for (;;) {
        sum = 0u; cnt = 0u; mine = 0u;
#pragma unroll
        for (unsigned j = 0; j < 16; ++j) { const unsigned c = xb_ld(&bar[XB_XCNT(j)]); sum += c; cnt += (c > 0u) ? 1u : 0u; mine = (j == x) ? c : mine; }
        if (sum == G) break;
        __builtin_amdgcn_s_sleep(1);
        if ((++sp & 255u) == 0u) { if (xb_ld(&bar[XB_TMO])) break; if (sp > XB_SPIN_CAP) { atomicAdd(&bar[XB_TMO], 1u); break; } }
    }
    nloc = mine > 0u ? mine : 1u; nx = cnt > 0u ? cnt : 1u;
}

__device__ __forceinline__ void xcd_barrier(const XcdBarrier& b) {
    asm volatile("s_waitcnt vmcnt(0)" ::: "memory");
    __syncthreads();
    if (threadIdx.x == 0) {
        unsigned* bar = b.bar;
        __builtin_amdgcn_s_waitcnt(0);
        unsigned nloc = b.st[0], nx = b.st[1];
        if (nloc == 0u) { xcd_barrier_complete(bar, b.x, nloc, nx); b.st[0] = nloc; b.st[1] = nx; }
        const unsigned old = xb_add(&bar[XB_XSUB(b.x)], 1u);
        const unsigned gen = old / nloc;
        if (old + 1u == (gen + 1u) * nloc) {
            __builtin_amdgcn_fence(__ATOMIC_RELEASE, "agent");
            asm volatile("s_waitcnt vmcnt(0)" ::: "memory");
            const unsigned og = xb_add(&bar[XB_TOP], 1u);
            const unsigned tg = og / nx;
            if (og + 1u == (tg + 1u) * nx) xb_add(&bar[XB_TOPGEN], 1u);
            else XB_SPIN(xb_ld(&bar[XB_TOPGEN]) == tg, bar);
            __builtin_amdgcn_fence(__ATOMIC_ACQUIRE, "agent");
            xb_add(&bar[XB_XGEN(b.x)], 1u);
            asm volatile("s_waitcnt vmcnt(0)" ::: "memory");
        } else {
            XB_SPIN(xb_ld(&bar[XB_XGEN(b.x)]) == gen, bar);
            __builtin_amdgcn_fence(__ATOMIC_ACQUIRE, "agent");
            asm volatile("s_waitcnt vmcnt(0)" ::: "memory");
        }
    }
    __syncthreads();
}


struct Args { const float* in[20]; float* out; unsigned char* ws; };

__device__ __forceinline__ void transpose_item(const float* W, int K, int N, bf16* WT, int mode, LAS float* scr, int item, int lane) {
    const int nblk = (N + 31) / 32, kb = item / nblk, nb = item % nblk, k0 = 64 * kb, n0 = 32 * nb;
    const int nn = n0 + (lane & 31); const bool ok = nn < N;
#pragma unroll 8
    for (int i = 0; i < 32; ++i) { const int kk = 2 * i + (lane >> 5); scr[kk * 33 + (lane & 31)] = ok ? W[(size_t)(k0 + kk) * N + nn] : 0.f; }
    LDS_WAIT(); asm volatile("" ::: "memory");
    const int c = lane & 7;
    int r0 = n0; if (mode) r0 = 256 * (n0 >> 7) + (n0 & 127) + (mode == 2 ? 128 : 0);
#pragma unroll
    for (int j = 0; j < 4; ++j) { const int n = (lane >> 3) + 8 * j; const LAS float* s = scr + (8 * c) * 33 + n;
        v4u o; o.x = pk2(s[0 * 33], s[1 * 33]); o.y = pk2(s[2 * 33], s[3 * 33]); o.z = pk2(s[4 * 33], s[5 * 33]); o.w = pk2(s[6 * 33], s[7 * 33]);
        if (n0 + n < N) *(GAS v4u*)(WT + (size_t)(r0 + n) * K + k0 + 8 * c) = o; }
    LDS_WAIT(); asm volatile("" ::: "memory");
}

__device__ __forceinline__ void p0_prologue(const Args& args, LAS unsigned char* lds, int tid, int lane, int wave, int vcu, int G) {
    unsigned char* ws = args.ws;
    const int bx = blockIdx.x;
    if (bx < 192) {
        LAS float* cs = (LAS float*)lds;
        LAS float* red = (LAS float*)(lds + 16384);
        const float* c = args.in[1];
        for (int i = tid; i < 4096; i += 512) { const float v = c[i]; cs[i] = v / (1.f + __expf(-v)); }
        __syncthreads();
        const int mat = bx / 24, cg = bx % 24;
        const float* Wp = args.in[2] + (size_t)mat * 2048 * 6144 + cg * 256 + lane * 4;
        f32x4 a0 = {0.f, 0.f, 0.f, 0.f}, a1 = {0.f, 0.f, 0.f, 0.f};
        const int kbeg = wave * 256;
#pragma unroll 8
        for (int k = kbeg; k < kbeg + 256; ++k) { const f32x4 w = *(const GAS f32x4*)(Wp + (size_t)k * 6144); const float c0 = cs[k], c1 = cs[2048 + k]; a0 += c0 * w; a1 += c1 * w; }
        *(LAS f32x4*)(red + (wave * 2 + 0) * 256 + lane * 4) = a0; *(LAS f32x4*)(red + (wave * 2 + 1) * 256 + lane * 4) = a1;
        __syncthreads();
        { const int b = tid >> 8, col = tid & 255; float s = args.in[3][mat * 6144 + cg * 256 + col];
#pragma unroll
          for (int w = 0; w < 8; ++w) s += red[(w * 2 + b) * 256 + col];
          ((float*)(ws + WS_MOD))[(mat * 2 + b) * 6144 + cg * 256 + col] = s; }
        __syncthreads();
    }
    LAS float* scr = (LAS float*)(lds + wave * 16384);
    const int gw = vcu * NWAVES + wave, NGW = G * NWAVES;
    constexpr int I_ABIN = 32 * 161, I_SQ = 32 * 64, I_QKV = 32 * 192, I_W1 = 32 * 176, I_W2 = 88 * 64;
    constexpr int NITEMS = 2 * (I_ABIN + 2 * I_SQ + I_QKV) + 4 * (2 * I_W1 + I_W2);
    for (int it = gw; it < NITEMS; it += NGW) {
        int r = it;
        if (r < 2 * I_ABIN) { const int j = r / I_ABIN; transpose_item(args.in[9] + (size_t)j * 2048 * AB_IN, 2048, AB_IN, (bf16*)(ws + WS_WABIN) + (size_t)j * AB_IN_PAD * 2048, 0, scr, r % I_ABIN, lane); continue; } r -= 2 * I_ABIN;
        if (r < 2 * I_SQ) { const int j = r / I_SQ; transpose_item(args.in[10] + (size_t)j * 2048 * 2048, 2048, 2048, (bf16*)(ws + WS_WABOUT) + (size_t)j * 2048 * 2048, 0, scr, r % I_SQ, lane); continue; } r -= 2 * I_SQ;
        if (r < 2 * I_QKV) { const int j = r / I_QKV; transpose_item(args.in[18] + (size_t)j * 2048 * 6144, 2048, 6144, (bf16*)(ws + WS_WQKV) + (size_t)j * 6144 * 2048, 0, scr, r % I_QKV, lane); continue; } r -= 2 * I_QKV;
        if (r < 2 * I_SQ) { const int j = r / I_SQ; transpose_item(args.in[19] + (size_t)j * 2048 * 2048, 2048, 2048, (bf16*)(ws + WS_WSBO) + (size_t)j * 2048 * 2048, 0, scr, r % I_SQ, lane); continue; } r -= 2 * I_SQ;
        if (r < 4 * I_W1) { const int l = r / I_W1; transpose_item(args.in[6] + (size_t)l * 2048 * FF, 2048, FF, (bf16*)(ws + WS_W13) + (size_t)l * 2 * FF * 2048, 1, scr, r % I_W1, lane); continue; } r -= 4 * I_W1;
        if (r < 4 * I_W1) { const int l = r / I_W1; transpose_item(args.in[7] + (size_t)l * 2048 * FF, 2048, FF, (bf16*)(ws + WS_W13) + (size_t)l * 2 * FF * 2048, 2, scr, r % I_W1, lane); continue; } r -= 4 * I_W1;
        { const int l = r / I_W2; transpose_item(args.in[8] + (size_t)l * FF * 2048, FF, 2048, (bf16*)(ws + WS_W2) + (size_t)l * 2048 * FF, 0, scr, r % I_W2, lane); }
    }
}

__device__ __forceinline__ void norm_phase(const float* xin, const float* g, const float* mod  , bf16* HN, int lane, int gw, int NGW) {
    const int rows_per = (M + NGW - 1) / NGW;
    int curb = -1; f32x4 gs[8], sh[8];
    for (int i = 0; i < rows_per; ++i) {
        const int row = gw * rows_per + i; if (row >= M) break;
        const int b = row / SEQ;
        if (b != curb) { curb = b;
#pragma unroll
            for (int j = 0; j < 8; ++j) { const int col = 4 * lane + 256 * j; const f32x4 gg = *(const GAS f32x4*)(g + col), sc = *(const GAS f32x4*)(mod + b * 6144 + 2048 + col); gs[j] = gg * (1.f + sc); sh[j] = *(const GAS f32x4*)(mod + b * 6144 + col); } }
        const GAS f32x4* xr = (const GAS f32x4*)(xin + (size_t)row * DM) + lane;
        f32x4 v[8]; float ss = 0.f;
#pragma unroll
        for (int j = 0; j < 8; ++j) { v[j] = xr[64 * j]; ss += (v[j].x * v[j].x + v[j].y * v[j].y) + (v[j].z * v[j].z + v[j].w * v[j].w); }
        const float rstd = 1.f / sqrtf(wave_sum(ss) * (1.f / DM) + EPS);
        GAS v2u* o8 = (GAS v2u*)(HN + (size_t)row * DM) + lane;
#pragma unroll
        for (int j = 0; j < 8; ++j) { const f32x4 y = v[j] * rstd * gs[j] + sh[j]; v2u w; w.x = pk2(y.x, y.y); w.y = pk2(y.z, y.w); o8[64 * j] = w; }
    }
}
__device__ __forceinline__ void final_norm_phase(const float* xin, const float* g, float* out, int lane, int gw, int NGW) {
    f32x4 gs[8];
#pragma unroll
    for (int j = 0; j < 8; ++j) gs[j] = *(const GAS f32x4*)(g + 4 * lane + 256 * j);
    for (int row = gw; row < M; row += NGW) {
        const GAS f32x4* xr = (const GAS f32x4*)(xin + (size_t)row * DM) + lane;
        f32x4 v[8]; float ss = 0.f;
#pragma unroll
        for (int j = 0; j < 8; ++j) { v[j] = xr[64 * j]; ss += (v[j].x * v[j].x + v[j].y * v[j].y) + (v[j].z * v[j].z + v[j].w * v[j].w); }
        const float rstd = 1.f / sqrtf(wave_sum(ss) * (1.f / DM) + EPS);
        GAS f32x4* o = (GAS f32x4*)(out + (size_t)row * DM) + lane;
#pragma unroll
        for (int j = 0; j < 8; ++j) o[64 * j] = v[j] * rstd * gs[j];
    }
}

struct MixP {
    const float *XA, *IG, *FG; const bf16 *YA, *Qm, *Km, *Vm, *Om; bf16* MIX;
    const float *conv_w, *conv_b, *gate_w, *gate_b, *lam, *mgb, *mng;
    float *DC, *DN, *NIN, *MLOC, *BLAST, *MIN, *HLOC, *PCUM, *AGGP, *AGGH, *HTMP; bf16* CIN;
};

__device__ __forceinline__ void mx1_rglru_unit(const MixP& P, LAS unsigned char* lds, int tid, int b, int n, int c) {
    LAS float* XC = (LAS float*)lds;
    LAS float* AS = (LAS float*)(lds + 65536);
    const int e = tid & 127, tg = tid >> 7, chn = n * 128 + e;
    const size_t rowbase = (size_t)b * SEQ; const int t0 = c * CH;
    {
        float w[4]; for (int j = 0; j < 4; ++j) w[j] = P.conv_w[j * LRU_W + chn];
        const float cb = P.conv_b[chn];
        for (int i = 0; i < 32; ++i) { const int tt = tg * 32 + i, t = t0 + tt; float acc = cb;
#pragma unroll
            for (int j = 0; j < 4; ++j) { const int ts = t - 3 + j; if (ts >= 0) acc += w[j] * P.XA[(rowbase + ts) * LRU_W + chn]; }
            XC[tt * 128 + e] = acc; }
    }
    __syncthreads();
    float ar[32], ai[32];
    { const float br = P.gate_b[chn], bi = P.gate_b[LRU_W + chn];
#pragma unroll
      for (int i = 0; i < 32; ++i) { ar[i] = br; ai[i] = bi; } }
    { const float* Wr = P.gate_w + ((size_t)(0 * NBLK + n) * 128) * 128 + e; const float* Wi = P.gate_w + ((size_t)(1 * NBLK + n) * 128) * 128 + e;
      for (int d = 0; d < 128; ++d) { const float wr = Wr[d * 128], wi = Wi[d * 128];
#pragma unroll
          for (int i = 0; i < 32; ++i) { const float x = XC[(tg * 32 + i) * 128 + d]; ar[i] += x * wr; ai[i] += x * wi; } } }
    __syncthreads();
    { const float ls = logsigmoidf_(P.lam[chn]);
#pragma unroll
      for (int i = 0; i < 32; ++i) { const int tt = tg * 32 + i; const float r = sigmoidf_(ar[i]), ig = sigmoidf_(ai[i]); const float la = 8.f * r * ls; const float a = __expf(la);
          const float mult = sqrtf(-expm1f(2.f * la)); const float xv = XC[tt * 128 + e]; AS[tt * 128 + e] = a; XC[tt * 128 + e] = mult * (ig * xv); } }
    __syncthreads();
    if (tid < 128) { float h = 0.f, pp = 1.f;
        for (int tt = 0; tt < 128; ++tt) { const float a = AS[tt * 128 + e], u = XC[tt * 128 + e]; h = a * h + u; pp *= a; const size_t o = (rowbase + t0 + tt) * LRU_W + chn; P.HLOC[o] = h; P.PCUM[o] = pp; }
        P.AGGP[(b * NCH + c) * LRU_W + chn] = pp; P.AGGH[(b * NCH + c) * LRU_W + chn] = h; }
    __syncthreads();
}

__device__ __forceinline__ void mx3_rglru_unit(const MixP& P, int tid, int b, int c, int half) {
    const int chn = half * 512 + tid;
    float carry = 0.f;
    for (int c2 = 0; c2 < c; ++c2) carry = P.AGGP[(b * NCH + c2) * LRU_W + chn] * carry + P.AGGH[(b * NCH + c2) * LRU_W + chn];
    for (int tt = 0; tt < CH; ++tt) { const size_t row = (size_t)b * SEQ + c * CH + tt; const float h = P.HLOC[row * LRU_W + chn] + P.PCUM[row * LRU_W + chn] * carry;
        const float y = bf2f(P.YA[row * LRU_W + chn]); P.MIX[row * DM + chn] = f2bf(h * gelu_tanh(y)); }
}

__device__ __forceinline__ void mx1_mlstm_unit(const MixP& P, LAS unsigned char* lds, int tid, int b, int h, int c) {
    LAS bf16* VS = (LAS bf16*)lds;
    LAS float* KS = (LAS float*)(lds + 65536);
    LAS float* sm = (LAS float*)(lds + SM_OFF); LAS float *s_li = sm, *s_lf = sm + 128, *s_bc = sm + 256, *s_g = sm + 384, *s_sc = sm + 768;
    const size_t rowbase = (size_t)b * SEQ + c * CH; const int uidx = (b * MH + h) * NCH + c;
    if (tid < 128) { s_li[tid] = P.IG[(rowbase + tid) * 4 + h] + P.mgb[h]; s_lf[tid] = logsigmoidf_(P.FG[(rowbase + tid) * 4 + h] + P.mgb[MH + h]); }
    __syncthreads();
    if (tid == 0) { float acc = 0.f, G = -INFINITY; for (int s = 0; s < 128; ++s) { acc += s_lf[s]; s_bc[s] = acc; const float g = s_li[s] - acc; s_g[s] = g; G = fmaxf(G, g); } s_sc[0] = G; s_sc[1] = acc; }
    __syncthreads();
    { const float G = s_sc[0]; const int s = tid >> 2, q = tid & 3; const float w = __expf(s_g[s] - G);
      const bf16* vp = P.Vm + (rowbase + s) * MLW + h * DV;
#pragma unroll
      for (int i = 0; i < 8; ++i) { const int ch = q + 4 * i; *(LAS v4u*)(VS + s * 256 + ch * 8) = *(const GAS v4u*)(vp + ch * 8); }
      const bf16* kp = P.Km + (rowbase + s) * MQK + h * DK + q * 32;
#pragma unroll
      for (int i = 0; i < 4; ++i) { const v4u kk = *(const GAS v4u*)(kp + i * 8); LAS float* d = KS + s * 128 + q * 32 + i * 8;
          d[0] = w * bflo(kk.x); d[1] = w * bfhi(kk.x); d[2] = w * bflo(kk.y); d[3] = w * bfhi(kk.y); d[4] = w * bflo(kk.z); d[5] = w * bfhi(kk.z); d[6] = w * bflo(kk.w); d[7] = w * bfhi(kk.w); } }
    __syncthreads();
    { const int d = tid & 127, vg = tid >> 7;
      float* dc = P.DC + ((size_t)uidx * DV + vg * 64) * DK + d;
#pragma unroll 1
      for (int i = 0; i < 64; ++i) { const LAS bf16* vcol = VS + vg * 64 + i; float acc = 0.f;
#pragma unroll 8
          for (int s = 0; s < 128; ++s) acc += KS[s * 128 + d] * bf2f(vcol[s * 256]);
          dc[(size_t)i * DK] = acc; }
      if (tid < 128) { float a = 0.f; for (int s = 0; s < 128; ++s) a += KS[s * 128 + tid]; P.DN[uidx * DK + tid] = a; }
      if (tid == 0) { P.MLOC[uidx] = s_sc[1] + s_sc[0]; P.BLAST[uidx] = s_sc[1]; } }
    __syncthreads();
}

__device__ __forceinline__ void mx2_mlstm(const MixP& P, LAS unsigned char* lds, int tid, int gtid, int NT) {
    LAS float* sm = (LAS float*)(lds + SM_OFF); LAS float *s_dec = sm, *s_scl = sm + 256, *s_min = sm + 512;
    if (tid < 8) { float m = 0.f; for (int k = 0; k < NCH; ++k) { const int u = tid * NCH + k; s_min[u] = m; const float bl = P.BLAST[u], ml = P.MLOC[u]; const float mn = fmaxf(bl + m, ml);
        s_dec[u] = __expf(bl + m - mn); s_scl[u] = __expf(ml - mn); m = mn; } }
    __syncthreads();
    for (int e = gtid; e < 8 * DV * DK; e += NT) { const int chain = e / (DV * DK), idx = e % (DV * DK); float cv = 0.f;
        for (int k = 0; k < NCH; ++k) { const int u = chain * NCH + k; const size_t o = (size_t)u * (DV * DK) + idx; P.CIN[o] = f2bf(cv); cv = s_dec[u] * cv + s_scl[u] * P.DC[o]; } }
    if (gtid < 8 * DK) { const int chain = gtid / DK, d = gtid % DK; float nv = 0.f;
        for (int k = 0; k < NCH; ++k) { const int u = chain * NCH + k; P.NIN[u * DK + d] = nv; nv = s_dec[u] * nv + s_scl[u] * P.DN[u * DK + d]; } }
    if (gtid < 256) P.MIN[gtid] = s_min[gtid];
    __syncthreads();
}

__device__ __forceinline__ void mx3_mlstm_unit(const MixP& P, LAS unsigned char* lds, int tid, int lane, int wave, int b, int h, int c) {
    constexpr int SS = 129, KSTR = 130;
    LAS float* S = (LAS float*)lds;
    LAS bf16* QS = (LAS bf16*)(lds + 66048);
    LAS bf16* KSb = (LAS bf16*)(lds + 66048 + 32768);
    LAS float* sm = (LAS float*)(lds + SM_OFF); LAS float *s_li = sm, *s_lf = sm + 128, *s_bc = sm + 256, *s_g = sm + 384, *s_M = sm + 512, *s_dn = sm + 640, *s_wi = sm + 768, *s_nin = sm + 896;
    const size_t rowbase = (size_t)b * SEQ + c * CH; const int uidx = (b * MH + h) * NCH + c;
    const float m_in = P.MIN[uidx];
    if (tid < 128) { s_li[tid] = P.IG[(rowbase + tid) * 4 + h] + P.mgb[h]; s_lf[tid] = logsigmoidf_(P.FG[(rowbase + tid) * 4 + h] + P.mgb[MH + h]); s_nin[tid] = P.NIN[uidx * DK + tid]; }
    { const int s = tid >> 2, q = tid & 3;
      const bf16* qp = P.Qm + (rowbase + s) * MQK + h * DK + q * 32; const bf16* kp = P.Km + (rowbase + s) * MQK + h * DK + q * 32;
#pragma unroll
      for (int i = 0; i < 4; ++i) { *(LAS v4u*)(QS + s * 128 + q * 32 + i * 8) = *(const GAS v4u*)(qp + i * 8);
          const v4u kk = *(const GAS v4u*)(kp + i * 8); LAS unsigned* kd = (LAS unsigned*)(KSb + s * KSTR + q * 32 + i * 8); kd[0] = kk.x; kd[1] = kk.y; kd[2] = kk.z; kd[3] = kk.w; } }
    __syncthreads();
    if (tid == 0) { float acc = 0.f, cm = m_in; for (int s = 0; s < 128; ++s) { acc += s_lf[s]; s_bc[s] = acc; const float g = s_li[s] - acc; s_g[s] = g; cm = fmaxf(cm, g); s_M[s] = cm; s_wi[s] = __expf(m_in - cm); } }
    __syncthreads();
    { const int s = tid & 127, tg = tid >> 7;
      const float gs = s_g[s]; const LAS unsigned* krow = (const LAS unsigned*)(KSb + s * KSTR);
#pragma unroll 1
      for (int i = 0; i < 32; ++i) { const int t = tg * 32 + i; float acc = 0.f; const LAS unsigned* qrow = (const LAS unsigned*)(QS + t * 128);
#pragma unroll 8
          for (int d2 = 0; d2 < 64; ++d2) { const unsigned qp = qrow[d2], kp = krow[d2]; acc += bflo(qp) * bflo(kp) + bfhi(qp) * bfhi(kp); }
          S[t * SS + s] = (s <= t) ? acc * __expf(gs - s_M[t]) : 0.f; } }
    __syncthreads();
    if (tid < 128) { const int t = tid; float den = 0.f; for (int s = 0; s < 128; ++s) den += S[t * SS + s];
        float qn = 0.f; for (int d = 0; d < 128; ++d) qn += bf2f(QS[t * 128 + d]) * s_nin[d];
        den += s_wi[t] * qn; const float mt = s_bc[t] + s_M[t]; s_dn[t] = 1.f / fmaxf(fabsf(den), __expf(-mt)); }
    __syncthreads();
    { const int v = tid & 255, tg = tid >> 8;
      const bf16* cp = P.CIN + ((size_t)uidx * DV + v) * DK;
      const bf16* vp = P.Vm + rowbase * MLW + h * DV + v;
      float* ht = P.HTMP + (size_t)uidx * CH * DV;
#pragma unroll 1
      for (int i = 0; i < 64; ++i) { const int t = tg * 64 + i; float acc = 0.f; const LAS unsigned* qrow = (const LAS unsigned*)(QS + t * 128);
#pragma unroll 4
          for (int d2 = 0; d2 < 64; ++d2) { const unsigned qp = qrow[d2]; const unsigned cc = *(const GAS unsigned*)(cp + 2 * d2); acc += bflo(qp) * bflo(cc) + bfhi(qp) * bfhi(cc); }
          acc *= s_wi[t];
          const LAS float* srow = S + t * SS;
#pragma unroll 4
          for (int s = 0; s < 128; ++s) acc += srow[s] * bf2f(*(const GAS bf16*)(vp + (size_t)s * MLW));
          ht[t * DV + v] = acc * s_dn[t]; } }
    __syncthreads();
    const float* HS = P.HTMP + (size_t)uidx * CH * DV;
    for (int i = 0; i < 16; ++i) { const int t = wave * 16 + i; const f32x4 hv = *(const GAS f32x4*)(HS + t * 256 + 4 * lane);
        const float ss = wave_sum((hv.x * hv.x + hv.y * hv.y) + (hv.z * hv.z + hv.w * hv.w)); const float rstd = 1.f / sqrtf(ss * (1.f / DV) + EPS);
        const f32x4 ng = *(const GAS f32x4*)(P.mng + h * DV + 4 * lane); const v2u ob = *(const GAS v2u*)(P.Om + (rowbase + t) * MLW + h * DV + 4 * lane);
        const float o0 = sigmoidf_(bflo(ob.x)), o1 = sigmoidf_(bfhi(ob.x)), o2 = sigmoidf_(bflo(ob.y)), o3 = sigmoidf_(bfhi(ob.y));
        v2u w; w.x = pk2(hv.x * rstd * ng.x * o0, hv.y * rstd * ng.y * o1); w.y = pk2(hv.z * rstd * ng.z * o2, hv.w * rstd * ng.w * o3);
        *(GAS v2u*)(P.MIX + (rowbase + t) * DM + LRU_W + h * DV + 4 * lane) = w; }
    __syncthreads();
}

__device__ __forceinline__ void attn_v1_phase(const bf16* Q, const bf16* K, const bf16* V, bf16* O, LAS unsigned char* lds, int lane, int wave, int gw, int NGW) {
    LAS float* qs = (LAS float*)(lds + wave * 512);
    for (int u = gw; u < BATCH * SBH * SEQ; u += NGW) {
        const int bh = u & 31, t = u >> 5, b = bh >> 4, h = bh & 15;
        const size_t rowbase = (size_t)b * SEQ;
        { const unsigned qp = *(const GAS unsigned*)(Q + (rowbase + t) * DM + h * SBD + 2 * lane); qs[2 * lane] = bflo(qp); qs[2 * lane + 1] = bfhi(qp); }
        LDS_WAIT();
        float o0 = 0.f, o1 = 0.f, carry = 0.f;
        for (int kb = (t - 1) >> 6; kb >= 0 && t > 0; --kb) {
            const int s = kb * 64 + lane; const bool valid = s < t;
            const bf16* kp = K + (rowbase + s) * DM + h * SBD;
            float z = 0.f;
#pragma unroll
            for (int i = 0; i < 16; ++i) { const v4u kk = *(const GAS v4u*)(kp + i * 8); const LAS float* qq = qs + i * 8;
                z += qq[0] * bflo(kk.x) + qq[1] * bfhi(kk.x) + qq[2] * bflo(kk.y) + qq[3] * bfhi(kk.y) + qq[4] * bflo(kk.z) + qq[5] * bfhi(kk.z) + qq[6] * bflo(kk.w) + qq[7] * bfhi(kk.w); }
            const float sp = valid ? (fmaxf(z, 0.f) + __builtin_amdgcn_logf(1.f + __builtin_amdgcn_exp2f(-fabsf(z)))) : 0.f;
            float x = sp;
#pragma unroll
            for (int off = 1; off < 64; off <<= 1) { const float y = __shfl_down(x, off); if (lane + off < 64) x += y; }
            const float R = x + carry; carry += __shfl(x, 0);
            const float A = valid ? __builtin_amdgcn_exp2f(z - R) : 0.f;
            const bf16* vp = V + (rowbase + kb * 64) * DM + h * SBD + 2 * lane;
            for (int l = 0; l < 64; ++l) { const float a = __shfl(A, l); const unsigned pr = *(const GAS unsigned*)(vp + (size_t)l * DM); o0 += a * bflo(pr); o1 += a * bfhi(pr); }
        }
        *(GAS unsigned*)(O + (rowbase + t) * DM + h * SBD + 2 * lane) = pk2(o0, o1);
    }
}

namespace sba {
typedef float f32x16 __attribute__((ext_vector_type(16)));
typedef short v4i16_t __attribute__((ext_vector_type(4)));
typedef float f32x2_t __attribute__((ext_vector_type(2))); typedef __bf16 bf16x2_t __attribute__((ext_vector_type(2)));
__device__ __forceinline__ unsigned cvtpk_s(float lo, float hi) { f32x2_t v = {lo, hi}; bf16x2_t b = __builtin_convertvector(v, bf16x2_t); return __builtin_bit_cast(unsigned, b); }
__device__ __forceinline__ int img_off(int row, int ch) { return 256 * row + 16 * (ch ^ (((row & 3) << 2) | ((row >> 2) & 3))); }
__device__ __forceinline__ v4i16_t vtr(const LAS unsigned char* p) { return __builtin_amdgcn_ds_read_tr16_b64_v4i16((LAS v4i16_t*)p); }

__device__ __forceinline__ void sb_weights(f32x16& p, float& carry, int hi) {
    float sp[16];
#pragma unroll
    for (int r = 0; r < 16; ++r) { const float z = p[r]; const float l = __builtin_amdgcn_logf(1.f + __builtin_amdgcn_exp2f(-__builtin_fabsf(z))); sp[r] = __builtin_fmaxf(z, 0.f) + l; }
    float E[4], Od[4];
#pragma unroll
    for (int m = 0; m < 4; ++m) { sp[4 * m + 2] += sp[4 * m + 3]; sp[4 * m + 1] += sp[4 * m + 2]; sp[4 * m] += sp[4 * m + 1];
        const unsigned tv = __float_as_uint(sp[4 * m]); auto rr = __builtin_amdgcn_permlane32_swap(tv, tv, false, false); E[m] = __uint_as_float(rr[0]); Od[m] = __uint_as_float(rr[1]); }
    float SP[4]; SP[3] = carry; SP[2] = SP[3] + (E[3] + Od[3]); SP[1] = SP[2] + (E[2] + Od[2]); SP[0] = SP[1] + (E[1] + Od[1]); carry = SP[0] + (E[0] + Od[0]);
    const float f0 = (hi == 0) ? 1.f : 0.f;
#pragma unroll
    for (int m = 0; m < 4; ++m) { const float off = SP[m] + f0 * Od[m];
#pragma unroll
        for (int i = 0; i < 4; ++i) { const int r = 4 * m + i; p[r] = __builtin_amdgcn_exp2f(p[r] - (sp[r] + off)); } }
}
__device__ __forceinline__ void sb_mask(f32x16& p, int lim  ) {
#pragma unroll
    for (int r = 0; r < 16; ++r) p[r] = ((r & 3) + 8 * (r >> 2) < lim) ? p[r] : -INFINITY;
}

__device__ __forceinline__ void attn_unit(const bf16* Q, const bf16* K, const bf16* V, bf16* O, LAS unsigned char* lds, int tid, int b, int h, int qb) {
    const int lane = tid & 63, wave = __builtin_amdgcn_readfirstlane(tid >> 6), r32 = lane & 31, hi = lane >> 5;
    const size_t rowbase = (size_t)b * SEQ; const int q0 = qb * 256, Qw = q0 + 32 * wave, t = Qw + r32;
    bf16x8 qf[8];
    { const bf16* qp = Q + (rowbase + t) * DM + h * SBD + hi * 8;
#pragma unroll
      for (int d = 0; d < 8; ++d) qf[d] = *(const GAS bf16x8*)(qp + d * 16); }
    f32x16 o[4];
#pragma unroll
    for (int i = 0; i < 4; ++i)
#pragma unroll
        for (int r = 0; r < 16; ++r) o[i][r] = 0.f;
    float carry = 0.f;
    const int NT = 4 * qb + 4;
    const int sr = tid >> 4, sc = tid & 15;
    const GAS unsigned char* kg = (const GAS unsigned char*)(K + rowbase * DM + h * SBD); const GAS unsigned char* vg = (const GAS unsigned char*)(V + rowbase * DM + h * SBD);
    const unsigned goff = (unsigned)(sr * DM + sc * 8) * 2u;
    const int w0 = img_off(sr, sc), w1 = img_off(sr + 32, sc);
    v4u sk0, sk1, sv0, sv1;
#define SB_LOAD(kt) do { const unsigned o_ = goff + (unsigned)(kt) * (64u * DM * 2u); sk0 = *(const GAS v4u*)(kg + o_); sk1 = *(const GAS v4u*)(kg + o_ + 32u * DM * 2u); sv0 = *(const GAS v4u*)(vg + o_); sv1 = *(const GAS v4u*)(vg + o_ + 32u * DM * 2u); } while (0)
#define SB_WRITE(buf) do { LAS unsigned char* kb_ = lds + (buf) * 16384; LAS unsigned char* vb_ = lds + 32768 + (buf) * 16384; *(LAS v4u*)(kb_ + w0) = sk0; *(LAS v4u*)(kb_ + w1) = sk1; *(LAS v4u*)(vb_ + w0) = sv0; *(LAS v4u*)(vb_ + w1) = sv1; } while (0)
    const int krt = ((r32 & 3) << 2) | ((r32 >> 2) & 3);
    const int i16 = lane & 15, q4 = i16 >> 2, p4 = i16 & 3, gb = (lane >> 4) & 1;
    const int vlow0 = ((2 * gb + (p4 >> 1)) ^ hi), vlow1 = vlow0 ^ 2;
    const int vrow0 = 256 * (4 * hi + q4) + 8 * (p4 & 1);
    SB_LOAD(NT - 1); SB_WRITE(0); __syncthreads();
    for (int it = 0; it < NT; ++it) {
        const int kt = NT - 1 - it, buf = it & 1, key0 = kt * 64;
        if (it + 1 < NT) SB_LOAD(kt - 1);
        const bool skip = key0 >= Qw + 31, full = key0 + 63 < Qw;
        if (!skip) {
            const LAS unsigned char* Kb = lds + buf * 16384; const LAS unsigned char* Vb = lds + 32768 + buf * 16384;
            f32x16 p0, p1;
#pragma unroll
            for (int r = 0; r < 16; ++r) { p0[r] = 0.f; p1[r] = 0.f; }
#pragma unroll
            for (int d = 0; d < 8; ++d) { const int off = 256 * r32 + 16 * ((2 * d + hi) ^ krt);
                const bf16x8 k0 = *(const LAS bf16x8*)(Kb + off), k1 = *(const LAS bf16x8*)(Kb + off + 8192);
                p0 = __builtin_amdgcn_mfma_f32_32x32x16_bf16(k0, qf[d], p0, 0, 0, 0); p1 = __builtin_amdgcn_mfma_f32_32x32x16_bf16(k1, qf[d], p1, 0, 0, 0); }
            bf16x8 af[2][2];
#define SB_PACK(P, u) do { _Pragma("unroll") for (int s = 0; s < 2; ++s) { v4u aw; aw.x = cvtpk_s(P[8 * s], P[8 * s + 1]); aw.y = cvtpk_s(P[8 * s + 2], P[8 * s + 3]); aw.z = cvtpk_s(P[8 * s + 4], P[8 * s + 5]); aw.w = cvtpk_s(P[8 * s + 6], P[8 * s + 7]); af[u][s] = __builtin_bit_cast(bf16x8, aw); } } while (0)
            if (!full) { sb_mask(p1, t - key0 - 32 - 4 * hi); sb_mask(p0, t - key0 - 4 * hi); }
            sb_weights(p1, carry, hi); SB_PACK(p1, 1); __builtin_amdgcn_sched_barrier(0); sb_weights(p0, carry, hi); SB_PACK(p0, 0);
#undef SB_PACK
            __builtin_amdgcn_sched_barrier(0);
#pragma unroll
            for (int u = 0; u < 2; ++u)
#pragma unroll
                for (int s = 0; s < 2; ++s) {
#pragma unroll
                    for (int db = 0; db < 4; ++db) {
                        const int c0 = (((db ^ q4) << 2) | vlow0), c1 = (((db ^ q4) << 2) | vlow1);
                        const v4i16_t lo = vtr(Vb + vrow0 + 256 * (32 * u + 16 * s) + 16 * c0), hh = vtr(Vb + vrow0 + 256 * (32 * u + 16 * s + 8) + 16 * c1);
                        const bf16x8 vf = {lo[0], lo[1], lo[2], lo[3], hh[0], hh[1], hh[2], hh[3]};
                        o[db] = __builtin_amdgcn_mfma_f32_32x32x16_bf16(vf, af[u][s], o[db], 0, 0, 0);
                    }
                }
        }
        if (it + 1 < NT) SB_WRITE(buf ^ 1);
        __syncthreads();
    }
#undef SB_LOAD
#undef SB_WRITE
    bf16* op = O + (rowbase + t) * DM + h * SBD + 4 * hi;
#pragma unroll
    for (int db = 0; db < 4; ++db)
#pragma unroll
        for (int g = 0; g < 4; ++g) { v2u w; w.x = cvtpk_s(o[db][4 * g], o[db][4 * g + 1]); w.y = cvtpk_s(o[db][4 * g + 2], o[db][4 * g + 3]); *(GAS v2u*)(op + 32 * db + 8 * g) = w; }
}

__device__ __forceinline__ void attn_phase(const bf16* Q, const bf16* K, const bf16* V, bf16* O, LAS unsigned char* lds, int tid, int vcu, int G) {
    for (int pi = vcu; pi < 256; pi += G) {
        const int bh = pi >> 3, x = pi & 7;
#pragma unroll 1
        for (int uu = 0; uu < 2; ++uu) attn_unit(Q, K, V, O, lds, tid, bh >> 4, bh & 15, uu ? x : 15 - x);
    }
}
}

__global__ void __launch_bounds__(NWAVES * 64, 2) fwd_kernel(Args args) {
    extern __shared__ __attribute__((aligned(16))) unsigned char lds_raw[];
    LAS unsigned char* lds = (LAS unsigned char*)lds_raw;
    const int tid0 = threadIdx.x;
    const int G = gridDim.x, bx = blockIdx.x; const int vcu = (G % 8 == 0) ? (bx % 8) * (G / 8) + bx / 8 : bx;
    const int NGW = G * NWAVES;
#define FRESH() const int tid = fresh_tid(), lane = tid & 63, wave = __builtin_amdgcn_readfirstlane(tid >> 6), gw = vcu * NWAVES + wave; (void)lane; (void)gw
    unsigned char* ws = args.ws;
    volatile LAS unsigned* MISC = (volatile LAS unsigned*)(lds + MISC_OFF);
    if (tid0 < 64) MISC[tid0] = 0u;
    __syncthreads();
    XcdBarrier bar = xcd_barrier_post((unsigned*)(ws + WS_CTL) + CW_BAR, MISC + 8);
#define GRID_BAR() do { XcdBarrier b2_ = bar; asm volatile("" : "+s"(b2_.x)); asm volatile("" : "+s"(b2_.bar)); xcd_barrier(b2_); } while (0)

    float* X = args.out;
    float* MOD = (float*)(ws + WS_MOD);
    bf16* HN = (bf16*)(ws + WS_HN); bf16* MIX = (bf16*)(ws + WS_MIX); bf16* ACT = (bf16*)(ws + WS_ACT);

    { FRESH(); p0_prologue(args, lds, tid, lane, wave, vcu, G); }
    GRID_BAR();

    for (int layer = 0; layer < DEPTH; ++layer) {
        const int j = layer >> 1;
        const float* xin = (layer == 0) ? args.in[0] : X;
        { FRESH(); norm_phase(xin, args.in[4] + (size_t)(layer * 2 + 0) * DM, MOD + (size_t)(layer * 2 + 0) * 2 * 6144, HN, lane, gw, NGW); }
        GRID_BAR();
        if ((layer & 1) == 0) {
            MixP P;
            P.XA = (const float*)(ws + WS_P0); P.YA = (const bf16*)(ws + WS_P0 + 32 * MiB); P.Qm = (const bf16*)(ws + WS_P0 + 48 * MiB); P.Km = (const bf16*)(ws + WS_P0 + 56 * MiB);
            P.Vm = (const bf16*)(ws + WS_P0 + 64 * MiB); P.Om = (const bf16*)(ws + WS_P0 + 80 * MiB); P.IG = (const float*)(ws + WS_IG); P.FG = (const float*)(ws + WS_IG + 128 * 1024); P.MIX = MIX;
            P.conv_w = args.in[11] + (size_t)j * 4 * LRU_W; P.conv_b = args.in[12] + (size_t)j * LRU_W; P.gate_w = args.in[13] + (size_t)j * 2 * NBLK * BW * BW; P.gate_b = args.in[14] + (size_t)j * 2 * LRU_W;
            P.lam = args.in[15] + (size_t)j * LRU_W; P.mgb = args.in[16] + (size_t)j * 2 * MH; P.mng = args.in[17] + (size_t)j * MLW;
            P.DC = (float*)(ws + WS_DC); P.CIN = (bf16*)(ws + WS_CIN); P.DN = (float*)(ws + WS_SMALL); P.NIN = (float*)(ws + WS_SMALL + 128 * 1024); P.MLOC = (float*)(ws + WS_SMALL + 256 * 1024);
            P.BLAST = (float*)(ws + WS_SMALL + 257 * 1024); P.MIN = (float*)(ws + WS_SMALL + 258 * 1024); P.HLOC = (float*)(ws + WS_HLOC); P.PCUM = (float*)(ws + WS_PCUM);
            P.AGGP = (float*)(ws + WS_AGG); P.AGGH = (float*)(ws + WS_AGG + 256 * 1024); P.HTMP = (float*)(ws + WS_HTMP);
            { pg8::Gemm g{HN, (const bf16*)(ws + WS_WABIN) + (size_t)j * AB_IN_PAD * 2048, M, AB_IN_PAD, DM}; pg8::StaticOrder S; S.init(M, AB_IN_PAD, G, bx);
              pg8::EpiInProj E{(float*)(ws + WS_P0), (bf16*)(ws + WS_P0 + 32 * MiB), (bf16*)(ws + WS_P0 + 48 * MiB), (bf16*)(ws + WS_P0 + 56 * MiB), (bf16*)(ws + WS_P0 + 64 * MiB), (bf16*)(ws + WS_P0 + 80 * MiB),
                               (float*)(ws + WS_IG), (float*)(ws + WS_IG + 128 * 1024), 0.08838834764831845f};
              pg8::gemm_phase<pg8::EpiInProj, pg8::StaticOrder, PG8_ALIGN, PG8_SP2>(lds, g, S, E); }
            GRID_BAR();
            { FRESH(); for (int u = vcu; u < 768; u += G) {
                if (u < 256) mx1_mlstm_unit(P, lds, tid, u >> 7, (u >> 5) & 3, u & 31);
                else { const int r = u - 256; mx1_rglru_unit(P, lds, tid, r >> 8, (r >> 5) & 7, r & 31); }
            } }
            GRID_BAR();
            { FRESH(); mx2_mlstm(P, lds, tid, vcu * 512 + tid, G * 512); }
            GRID_BAR();
            { FRESH(); for (int u = vcu; u < 384; u += G) {
                if (u < 256) mx3_mlstm_unit(P, lds, tid, lane, wave, u >> 7, (u >> 5) & 3, u & 31);
                else { const int r = u - 256; mx3_rglru_unit(P, tid, r >> 6, (r >> 1) & 31, r & 1); }
            } }
            GRID_BAR();
        } else {
            { pg8::Gemm g{HN, (const bf16*)(ws + WS_WQKV) + (size_t)j * 6144 * 2048, M, 6144, DM}; pg8::StaticOrder S; S.init(M, 6144, G, bx);
              pg8::EpiBf16Split E{(bf16*)(ws + WS_P0), DM, DM, (size_t)M * DM, 0.08838834764831845f * LOG2E};
              pg8::gemm_phase<pg8::EpiBf16Split, pg8::StaticOrder, PG8_ALIGN, PG8_SP2>(lds, g, S, E); }
            GRID_BAR();
            { FRESH(); sba::attn_phase((const bf16*)(ws + WS_P0), (const bf16*)(ws + WS_P0) + (size_t)M * DM, (const bf16*)(ws + WS_P0) + (size_t)2 * M * DM, MIX, lds, tid, vcu, G); }
            GRID_BAR();
        }
        { const bf16* Bt = ((layer & 1) == 0) ? (const bf16*)(ws + WS_WABOUT) + (size_t)j * 2048 * 2048 : (const bf16*)(ws + WS_WSBO) + (size_t)j * 2048 * 2048;
          pg8::Gemm g{MIX, Bt, M, DM, DM}; pg8::StaticOrder S; S.init(M, DM, G, bx);
          pg8::EpiResid E{xin, X, MOD + (size_t)(layer * 2 + 0) * 2 * 6144 + 4096};
          pg8::gemm_phase<pg8::EpiResid, pg8::StaticOrder, PG8_ALIGN, PG8_SP2>(lds, g, S, E); }
        GRID_BAR();
        { FRESH(); norm_phase(X, args.in[4] + (size_t)(layer * 2 + 1) * DM, MOD + (size_t)(layer * 2 + 1) * 2 * 6144, HN, lane, gw, NGW); }
        GRID_BAR();
        { pg8::Gemm g{HN, (const bf16*)(ws + WS_W13) + (size_t)layer * 2 * FF * 2048, M, 2 * FF, DM}; pg8::StaticOrder S; S.init(M, 2 * FF, G, bx);
          pg8::EpiSwiGLU E{ACT};
          pg8::gemm_phase<pg8::EpiSwiGLU, pg8::StaticOrder, PG8_ALIGN, PG8_SP2>(lds, g, S, E); }
        GRID_BAR();
        { pg8::Gemm g{ACT, (const bf16*)(ws + WS_W2) + (size_t)layer * 2048 * FF, M, DM, FF}; pg8::StaticOrder S; S.init(M, DM, G, bx);
          pg8::EpiResid E{X, X, MOD + (size_t)(layer * 2 + 1) * 2 * 6144 + 4096};
          pg8::gemm_phase<pg8::EpiResid, pg8::StaticOrder, PG8_ALIGN, PG8_SP2>(lds, g, S, E); }
        GRID_BAR();
    }
    { FRESH(); final_norm_phase(X, args.in[5], X, lane, gw, NGW); }
}

extern "C" void kernel_launch(void* const* d_in, const int* in_sizes, int n_in, void* d_out, int out_size, void* d_ws, size_t ws_size, hipStream_t stream) {
    static int grid = 0;
    if (grid == 0) {
        if (n_in != 20 || in_sizes[0] != M * DM || out_size != M * DM || ws_size < WS_END) { fprintf(stderr, "kernel_launch: unexpected shapes: n_in %d in0 %d out %d ws %zu (need %zu); nothing launched\n", n_in, n_in > 0 ? in_sizes[0] : -1, out_size, ws_size, (size_t)WS_END); grid = -1; return; }
        int dev = 0, cus = 0, per_cu = 0;
        if (hipGetDevice(&dev) != hipSuccess || hipDeviceGetAttribute(&cus, hipDeviceAttributeMultiprocessorCount, dev) != hipSuccess) { fprintf(stderr, "kernel_launch: device query failed\n"); grid = -1; return; }
        if (hipFuncSetAttribute((const void*)fwd_kernel, hipFuncAttributeMaxDynamicSharedMemorySize, LDS_BYTES) != hipSuccess) { fprintf(stderr, "kernel_launch: hipFuncSetAttribute failed\n"); grid = -1; return; }
        if (hipOccupancyMaxActiveBlocksPerMultiprocessor(&per_cu, (const void*)fwd_kernel, NWAVES * 64, LDS_BYTES) != hipSuccess || per_cu < 1)
            fprintf(stderr, "kernel_launch: note: occupancy query reports %d workgroups per CU\n", per_cu);
        (void)hipGetLastError();
        grid = cus;
    }
    if (grid < 0) return;
    if (hipMemsetAsync((char*)d_ws + WS_CTL, 0, CTL_ZERO_BYTES, stream) != hipSuccess) { fprintf(stderr, "kernel_launch: memset failed\n"); return; }
    Args a{};
    for (int i = 0; i < 20; ++i) a.in[i] = (const float*)d_in[i];
    a.out = (float*)d_out; a.ws = (unsigned char*)d_ws;
    hipLaunchKernelGGL(fwd_kernel, dim3(grid), dim3(NWAVES * 64), LDS_BYTES, stream, a);
    const hipError_t le = hipPeekAtLastError();
    if (le != hipSuccess) fprintf(stderr, "kernel_launch: launch failed: %s\n", hipGetErrorName(le));
}
```

```cpp
#include <hip/hip_runtime.h>
#include <cstdio>
#include <cstdint>

constexpr int NWAVES = 8;
constexpr int BATCH = 2, SEQ = 4096, DM = 2048, DEPTH = 4, M = BATCH * SEQ;
constexpr int LRU_W = 1024, NBLK = 8, BW = 128;
constexpr int MLW = 1024, MH = 4, DV = 256, DK = 128, MQK = 512, CH = 128, NCH = SEQ / CH;
constexpr int AB_IN = 5128, AB_IN_PAD = 5376;
constexpr int SBH = 16, SBD = 128;
constexpr int FF = 5632;
constexpr float EPS = 1e-6f;
constexpr float LOG2E = 1.4426950408889634f, LN2 = 0.6931471805599453f;

constexpr size_t MiB = 1u << 20;
constexpr size_t WS_CTL = 0, CTL_ZERO_BYTES = 1 * MiB;
constexpr size_t WS_MOD = 1 * MiB;
constexpr size_t WS_WABIN = 2 * MiB;
constexpr size_t WS_WABOUT = 44 * MiB;
constexpr size_t WS_WQKV = 60 * MiB;
constexpr size_t WS_WSBO = 108 * MiB;
constexpr size_t WS_W13 = 124 * MiB;
constexpr size_t WS_W2 = 300 * MiB;
constexpr size_t WS_HN = 388 * MiB;
constexpr size_t WS_P0 = 420 * MiB;
constexpr size_t WS_IG = 516 * MiB;
constexpr size_t WS_MIX = 517 * MiB;
constexpr size_t WS_ACT = 549 * MiB;
constexpr size_t WS_DC = 637 * MiB;
constexpr size_t WS_CIN = 669 * MiB;
constexpr size_t WS_SMALL = 685 * MiB;
constexpr size_t WS_HLOC = 686 * MiB;
constexpr size_t WS_PCUM = 718 * MiB;
constexpr size_t WS_AGG = 750 * MiB;
constexpr size_t WS_HTMP = 752 * MiB;
constexpr size_t WS_END = 784 * MiB;
constexpr int CW_BAR = 4096;

constexpr int BIG_BYTES = 147456;
constexpr int MISC_OFF = BIG_BYTES;
constexpr int SM_OFF = BIG_BYTES + 1024;
constexpr int LDS_BYTES = 163840;

namespace pg8 {
#define PG8_LAS __attribute__((address_space(3)))
typedef unsigned short bf16_t;
typedef short bf16x8 __attribute__((ext_vector_type(8)));
typedef float f32x4 __attribute__((ext_vector_type(4)));
typedef unsigned u32x4 __attribute__((ext_vector_type(4)));
constexpr int BM = 256, BK = 64, HALF = 128, HTB = HALF * BK * 2  , STAGE_BYTES = 8 * HTB, NXCD = 8, WGM = 8;

__host__ __device__ __forceinline__ int lds_byte(int r, int c) { const int st = (r >> 4) * 2 + (c >> 5), rr = r & 15, cc = c & 31, ob = rr * 64 + cc * 2; return st * 1024 + (ob ^ (((ob >> 9) & 1) << 5)); }
__host__ __device__ __forceinline__ void stage_rc(int b, int& R, int& C) { const int st = b / 1024, sb = b % 1024, swz = sb ^ (((sb >> 9) & 1) << 5); R = (st >> 1) * 16 + swz / 64; C = (st & 1) * 32 + (swz % 64) / 2; }
__host__ __device__ __forceinline__ int perm32(int rho) { const int n = rho >> 4, i = rho & 15; return 8 * (i >> 2) + 4 * n + (i & 3); }

struct Unit { int pm, pn; };
struct Gemm { const bf16_t* A; const bf16_t* Bt; int M, N, K; };

struct StaticOrder {
    int nM, nN, nwg, G, c;
    __host__ __device__ void init(int M, int N, int G_, int c_) { nM = M / BM; nN = N / BM; nwg = nM * nN; G = G_; c = c_; }
    __host__ __device__ bool next(int i, Unit& u) const {
        const long L = (long)i * G + c; if (L >= nwg) return false;
        int wgid = (int)L; { const int q = nwg / NXCD, r = nwg % NXCD, xcd = wgid % NXCD, off = wgid / NXCD; wgid = (xcd < r ? xcd * (q + 1) : r * (q + 1) + (xcd - r) * q) + off; }
        const int nig = WGM * nN, gid = wgid / nig, fm = gid * WGM, gsz = (nM - fm) < WGM ? (nM - fm) : WGM;
        u.pm = fm + ((wgid % nig) % gsz); u.pn = (wgid % nig) / gsz; return true;
    }
    __device__ __forceinline__ void a_ready(const Unit&) const {}
    __device__ __forceinline__ void done(const Unit&) const {}
};

__device__ __forceinline__ unsigned cvt_pk_bf16(float lo, float hi) { unsigned r; asm volatile("v_cvt_pk_bf16_f32 %0, %1, %2" : "=v"(r) : "v"(lo), "v"(hi)); return r; }
typedef float f32x2 __attribute__((ext_vector_type(2)));
__device__ __forceinline__ u32x4 pack8(f32x4 v0, f32x4 v1) { u32x4 w; w.x = cvt_pk_bf16(v0[0], v0[1]); w.y = cvt_pk_bf16(v0[2], v0[3]); w.z = cvt_pk_bf16(v1[0], v1[1]); w.w = cvt_pk_bf16(v1[2], v1[3]); return w; }

struct EpiBf16Split {
    static constexpr bool PERM = true, AFTER_DRAIN = false;
    bf16_t* O; int ldc; int split_cols; size_t split_stride; float scale0;
    __device__ __forceinline__ void operator()(const f32x4 (&acc)[2][2][4][2], const Unit& u, int wr, int wc, int fr, int fq) const {
        const int row0 = u.pm * BM + wr * 64 + fr; int colt = u.pn * BM; bf16_t* base = O;
        float sc = 1.f; { const int t = colt / split_cols; base += (size_t)t * split_stride; colt -= t * split_cols; if (t == 0) sc = scale0; }
        const int col0 = colt + wc * 32 + 8 * fq;
#pragma unroll
        for (int ai = 0; ai < 2; ++ai)
#pragma unroll
            for (int m = 0; m < 4; ++m) { bf16_t* rowp = base + (size_t)(row0 + ai * HALF + m * 16) * ldc + col0;
#pragma unroll
                for (int bj = 0; bj < 2; ++bj) { *(u32x4*)(rowp + bj * HALF) = pack8(acc[ai][bj][m][0] * sc, acc[ai][bj][m][1] * sc); } }
    }
};

struct EpiResid {
    static constexpr bool PERM = true, AFTER_DRAIN = false;
    const float* base; float* out; const float* gate0;
    __device__ __forceinline__ void operator()(const f32x4 (&acc)[2][2][4][2], const Unit& u, int wr, int wc, int fr, int fq) const {
        const int row0 = u.pm * BM + wr * 64 + fr, col0 = u.pn * BM + wc * 32 + 8 * fq;
        const float* gp = gate0 + (u.pm >= 16 ? 6144 : 0) + col0;
        f32x4 gv[2][2];
#pragma unroll
        for (int bj = 0; bj < 2; ++bj)
#pragma unroll
            for (int n = 0; n < 2; ++n) gv[bj][n] = *(const f32x4*)(gp + bj * HALF + 4 * n);
#pragma unroll
        for (int ai = 0; ai < 2; ++ai)
#pragma unroll
            for (int m = 0; m < 4; ++m) { const size_t off = (size_t)(row0 + ai * HALF + m * 16) * 2048 + col0;
#pragma unroll
                for (int bj = 0; bj < 2; ++bj)
#pragma unroll
                    for (int n = 0; n < 2; ++n) { const f32x4 b = *(const f32x4*)(base + off + bj * HALF + 4 * n); *(f32x4*)(out + off + bj * HALF + 4 * n) = b + gv[bj][n] * acc[ai][bj][m][n]; }
                if (m & 1) asm volatile("" ::: "memory"); }
    }
};

struct EpiSwiGLU {
    static constexpr bool PERM = true, AFTER_DRAIN = false;
    bf16_t* O;
    static __device__ __forceinline__ f32x4 silu_mul(f32x4 a, f32x4 b) { f32x4 r;
#pragma unroll
        for (int i = 0; i < 4; ++i) { const float e = __builtin_amdgcn_exp2f(-a[i] * 1.4426950408889634f); r[i] = a[i] * __builtin_amdgcn_rcpf(1.f + e) * b[i]; }
        return r; }
    __device__ __forceinline__ void operator()(const f32x4 (&acc)[2][2][4][2], const Unit& u, int wr, int wc, int fr, int fq) const {
        const int row0 = u.pm * BM + wr * 64 + fr, col0 = u.pn * HALF + wc * 32 + 8 * fq;
#pragma unroll
        for (int ai = 0; ai < 2; ++ai)
#pragma unroll
            for (int m = 0; m < 4; ++m) { bf16_t* rowp = O + (size_t)(row0 + ai * HALF + m * 16) * 5632 + col0;
                *(u32x4*)rowp = pack8(silu_mul(acc[ai][0][m][0], acc[ai][1][m][0]), silu_mul(acc[ai][0][m][1], acc[ai][1][m][1])); }
    }
};

struct EpiInProj {
    static constexpr bool PERM = true, AFTER_DRAIN = false;
    float* XA; bf16_t *YA, *Qm, *Km, *Vm, *Om; float *IG, *FG; float kscale;
    __device__ __forceinline__ void operator()(const f32x4 (&acc)[2][2][4][2], const Unit& u, int wr, int wc, int fr, int fq) const {
        const int pn = u.pn, row0 = u.pm * BM + wr * 64 + fr, cl = wc * 32 + 8 * fq;
        if (pn < 4) {
#pragma unroll
            for (int ai = 0; ai < 2; ++ai)
#pragma unroll
                for (int m = 0; m < 4; ++m) { float* rp = XA + (size_t)(row0 + ai * HALF + m * 16) * 1024 + pn * 256 + cl;
#pragma unroll
                    for (int bj = 0; bj < 2; ++bj)
#pragma unroll
                        for (int n = 0; n < 2; ++n) *(f32x4*)(rp + bj * HALF + 4 * n) = acc[ai][bj][m][n]; }
        } else if (pn < 20) {
            bf16_t* base; int ld, colt; float sc = 1.f;
            if (pn < 8) { base = YA; ld = 1024; colt = (pn - 4) * 256; }
            else if (pn < 10) { base = Qm; ld = 512; colt = (pn - 8) * 256; }
            else if (pn < 12) { base = Km; ld = 512; colt = (pn - 10) * 256; sc = kscale; }
            else if (pn < 16) { base = Vm; ld = 1024; colt = (pn - 12) * 256; }
            else { base = Om; ld = 1024; colt = (pn - 16) * 256; }
#pragma unroll
            for (int ai = 0; ai < 2; ++ai)
#pragma unroll
                for (int m = 0; m < 4; ++m) { bf16_t* rowp = base + (size_t)(row0 + ai * HALF + m * 16) * ld + colt + cl;
#pragma unroll
                    for (int bj = 0; bj < 2; ++bj) *(u32x4*)(rowp + bj * HALF) = pack8(acc[ai][bj][m][0] * sc, acc[ai][bj][m][1] * sc); }
        } else {
            if (wc == 0 && fq == 0) {
#pragma unroll
                for (int ai = 0; ai < 2; ++ai)
#pragma unroll
                    for (int m = 0; m < 4; ++m) { const size_t r = (size_t)(row0 + ai * HALF + m * 16); *(f32x4*)(IG + r * 4) = acc[ai][0][m][0]; *(f32x4*)(FG + r * 4) = acc[ai][0][m][1]; }
            }
        }
    }
};

template <class Epi, class Sched, bool ALIGN_EPI = false, bool SP2 = false>
__device__ __forceinline__ void gemm_phase(PG8_LAS unsigned char* lds, const Gemm g, const Sched& S, const Epi& E, int tid_in) {
    const int tid = tid_in, wid = __builtin_amdgcn_readfirstlane(tid >> 6), lane = tid & 63, wr = wid >> 2, wc = wid & 3, fr = lane & 15, fq = lane >> 4;
    const int K = g.K, nt = K / BK;
    unsigned voffA[2], voffB[2];
#pragma unroll
    for (int i = 0; i < 2; ++i) { int R, C; stage_rc(tid * 16 + i * 8192, R, C); const int Rb = Epi::PERM ? ((R & ~31) + perm32(R & 31)) : R;
        voffA[i] = (unsigned)(R * K + C) * 2u; voffB[i] = (unsigned)(Rb * K + C) * 2u; }
    const size_t kstep = (size_t)(BK * 2);
    const size_t hstep = (size_t)HALF * K * 2;
    const size_t tstep = 2 * hstep;
    const unsigned ldsw = (unsigned)wid * 1024u;
    const int aoff = lds_byte(wr * 64 + fr, fq * 8), boff = lds_byte(wc * 32 + fr, fq * 8);
#define PG8_SA(b, h) (((b) * 2 + (h)) * HTB)
#define PG8_SB(b, h) ((4 + (b) * 2 + (h)) * HTB)
#define PG8_STAGE(bufoff, gbase, voff) do { _Pragma("unroll") for (int _i = 0; _i < 2; ++_i) \
        __builtin_amdgcn_global_load_lds((const unsigned*)((const char*)(gbase) + (voff)[_i]), (PG8_LAS unsigned*)(lds + (bufoff) + ldsw + _i * 8192), 16, 0, 0); } while (0)
#define PG8_LDA(dst, b, h) do { _Pragma("unroll") for (int m = 0; m < 4; ++m) _Pragma("unroll") for (int k = 0; k < 2; ++k) dst[m][k] = *(const PG8_LAS bf16x8*)(lds + PG8_SA(b, h) + aoff + m * 2048 + k * 1024); } while (0)
#define PG8_LDB(dst, b, h) do { _Pragma("unroll") for (int n = 0; n < 2; ++n) _Pragma("unroll") for (int k = 0; k < 2; ++k) dst[n][k] = *(const PG8_LAS bf16x8*)(lds + PG8_SB(b, h) + boff + n * 2048 + k * 1024); } while (0)
#define PG8_MMA(ai, bj, At, Bt) do { __builtin_amdgcn_s_setprio(1); _Pragma("unroll") for (int m = 0; m < 4; ++m) _Pragma("unroll") for (int n = 0; n < 2; ++n) _Pragma("unroll") for (int k = 0; k < 2; ++k) \
        acc[ai][bj][m][n] = __builtin_amdgcn_mfma_f32_16x16x32_bf16(Bt[n][k], At[m][k], acc[ai][bj][m][n], 0, 0, 0); __builtin_amdgcn_s_setprio(0); } while (0)
#define PG8_WAIT_V(n) asm volatile("s_waitcnt vmcnt(" #n ")" ::: "memory")
#define PG8_WAIT_L(n) asm volatile("s_waitcnt lgkmcnt(" #n ")" ::: "memory")
#define PG8_BAR __builtin_amdgcn_s_barrier()
#define PG8_SCHED __builtin_amdgcn_sched_barrier(0)
    Unit cur, nxt; int ui = 0;
    if (!S.next(0, cur)) return;
    f32x4 acc[2][2][4][2];
#pragma unroll
    for (int a = 0; a < 2; ++a)
#pragma unroll
        for (int b = 0; b < 2; ++b)
#pragma unroll
            for (int m = 0; m < 4; ++m)
#pragma unroll
                for (int n = 0; n < 2; ++n) acc[a][b][m][n] = (f32x4){0.f, 0.f, 0.f, 0.f};
    bf16x8 At[4][2], B0[2][2], B1[2][2];
    const char* cA = (const char*)g.A + (size_t)cur.pm * tstep; const char* cB = (const char*)g.Bt + (size_t)cur.pn * tstep;
    S.a_ready(cur);
    if constexpr (SP2) {
        PG8_STAGE(PG8_SB(0, 0), cB, voffB); PG8_STAGE(PG8_SB(0, 1), cB + hstep, voffB); PG8_STAGE(PG8_SA(0, 0), cA, voffA); PG8_STAGE(PG8_SA(0, 1), cA + hstep, voffA);
        if (wr == 1) PG8_BAR;
        PG8_WAIT_V(2); PG8_BAR;
        PG8_STAGE(PG8_SB(1, 0), cB + kstep, voffB); PG8_STAGE(PG8_SA(1, 0), cA + kstep, voffA); PG8_STAGE(PG8_SB(1, 1), cB + hstep + kstep, voffB);
        PG8_WAIT_V(6); PG8_BAR;
    } else {
        PG8_STAGE(PG8_SB(0, 0), cB, voffB); PG8_STAGE(PG8_SA(0, 0), cA, voffA); PG8_STAGE(PG8_SB(0, 1), cB + hstep, voffB); PG8_STAGE(PG8_SA(0, 1), cA + hstep, voffA);
        if (wr == 1) PG8_BAR;
        PG8_WAIT_V(4); PG8_BAR;
        PG8_STAGE(PG8_SB(1, 0), cB + kstep, voffB); PG8_STAGE(PG8_SA(1, 0), cA + kstep, voffA); PG8_STAGE(PG8_SB(1, 1), cB + hstep + kstep, voffB);
        PG8_WAIT_V(6); PG8_BAR;
    }
    for (;;) {
        const bool has_next = S.next(ui + 1, nxt);
        const char* nA = has_next ? (const char*)g.A + (size_t)nxt.pm * tstep : cA; const char* nB = has_next ? (const char*)g.Bt + (size_t)nxt.pn * tstep : cB;
        for (int t = 0; t < nt; t += 2) {
            const bool last = (t == nt - 2);
            const char* a1 = cA + (size_t)(t + 1) * kstep;
            const char* a2 = last ? nA : cA + (size_t)(t + 2) * kstep; const char* b2 = last ? nB : cB + (size_t)(t + 2) * kstep;
            const char* a3 = a2 + kstep; const char* b3 = b2 + kstep;
            if (last && has_next) S.a_ready(nxt);
            if constexpr (SP2) {
            PG8_LDB(B0, 0, 0); PG8_LDB(B1, 0, 1); PG8_SCHED; PG8_LDA(At, 0, 0); PG8_STAGE(PG8_SA(1, 1), a1 + hstep, voffA);
            PG8_WAIT_V(8); PG8_WAIT_L(0); PG8_BAR; PG8_MMA(0, 0, At, B0); PG8_MMA(0, 1, At, B1); PG8_BAR; PG8_SCHED;
            PG8_LDA(At, 0, 1); PG8_STAGE(PG8_SB(0, 0), b2, voffB); PG8_STAGE(PG8_SB(0, 1), b2 + hstep, voffB); PG8_STAGE(PG8_SA(0, 0), a2, voffA);
            PG8_WAIT_V(8); PG8_WAIT_L(0); PG8_BAR; PG8_MMA(1, 0, At, B0); PG8_MMA(1, 1, At, B1); PG8_BAR; PG8_SCHED;
            PG8_LDB(B0, 1, 0); PG8_LDB(B1, 1, 1); PG8_SCHED; PG8_LDA(At, 1, 0); PG8_STAGE(PG8_SA(0, 1), a2 + hstep, voffA);
            PG8_WAIT_V(8); PG8_WAIT_L(0); PG8_BAR; PG8_MMA(0, 0, At, B0); PG8_MMA(0, 1, At, B1); PG8_BAR; PG8_SCHED;
            PG8_LDA(At, 1, 1); PG8_STAGE(PG8_SB(1, 0), b3, voffB); PG8_STAGE(PG8_SB(1, 1), b3 + hstep, voffB); PG8_STAGE(PG8_SA(1, 0), a3, voffA);
            PG8_WAIT_V(8); PG8_WAIT_L(0); PG8_BAR; PG8_MMA(1, 0, At, B0); PG8_MMA(1, 1, At, B1); PG8_BAR; PG8_SCHED;
            } else {
            PG8_LDB(B0, 0, 0); PG8_SCHED; PG8_LDA(At, 0, 0); PG8_STAGE(PG8_SA(1, 1), a1 + hstep, voffA);
            PG8_WAIT_L(8); PG8_BAR; PG8_WAIT_L(0); PG8_MMA(0, 0, At, B0); PG8_BAR; PG8_SCHED;
            PG8_LDB(B1, 0, 1); PG8_STAGE(PG8_SB(0, 0), b2, voffB);
            PG8_BAR; PG8_WAIT_L(0); PG8_MMA(0, 1, At, B1); PG8_BAR;
            PG8_LDA(At, 0, 1); PG8_STAGE(PG8_SA(0, 0), a2, voffA);
            PG8_BAR; PG8_WAIT_L(0); PG8_MMA(1, 0, At, B0); PG8_BAR; PG8_SCHED;
            PG8_STAGE(PG8_SB(0, 1), b2 + hstep, voffB);
            PG8_WAIT_V(6); PG8_BAR; PG8_MMA(1, 1, At, B1); PG8_BAR;
            PG8_LDB(B0, 1, 0); PG8_SCHED; PG8_LDA(At, 1, 0); PG8_STAGE(PG8_SA(0, 1), a2 + hstep, voffA);
            PG8_WAIT_L(8); PG8_BAR; PG8_WAIT_L(0); PG8_MMA(0, 0, At, B0); PG8_BAR; PG8_SCHED;
            PG8_LDB(B1, 1, 1); PG8_STAGE(PG8_SB(1, 0), b3, voffB);
            PG8_BAR; PG8_WAIT_L(0); PG8_MMA(0, 1, At, B1); PG8_BAR;
            PG8_LDA(At, 1, 1); PG8_STAGE(PG8_SA(1, 0), a3, voffA);
            PG8_BAR; PG8_WAIT_L(0); PG8_MMA(1, 0, At, B0); PG8_BAR; PG8_SCHED;
            PG8_STAGE(PG8_SB(1, 1), b3 + hstep, voffB);
            PG8_WAIT_V(6); PG8_BAR; PG8_MMA(1, 1, At, B1); PG8_BAR;
            }
        }
        if constexpr (ALIGN_EPI) { if (wr == 0) PG8_BAR; }
        if constexpr (!Epi::AFTER_DRAIN) { E(acc, cur, wr, wc, fr, fq); S.done(cur); }
        if (!has_next) break;
#pragma unroll
        for (int a = 0; a < 2; ++a)
#pragma unroll
            for (int b = 0; b < 2; ++b)
#pragma unroll
                for (int m = 0; m < 4; ++m)
#pragma unroll
                    for (int n = 0; n < 2; ++n) acc[a][b][m][n] = (f32x4){0.f, 0.f, 0.f, 0.f};
        cur = nxt; cA = nA; cB = nB; ++ui;
        if constexpr (ALIGN_EPI) { if (wr == 1) PG8_BAR; }
    }
    PG8_WAIT_V(0);
    if constexpr (!ALIGN_EPI) { if (wr == 0) PG8_BAR; }
    PG8_BAR;
    if constexpr (Epi::AFTER_DRAIN) { E.fused(acc, cur, wr, wc, fr, fq, lds, wid, lane); S.done(cur); }
#undef PG8_SA
#undef PG8_SB
#undef PG8_STAGE
#undef PG8_LDA
#undef PG8_LDB
#undef PG8_MMA
#undef PG8_WAIT_V
#undef PG8_WAIT_L
#undef PG8_BAR
#undef PG8_SCHED
}
}
#ifndef PG8_SP2
#define PG8_SP2 true
#endif
#ifndef PG8_ALIGN
#define PG8_ALIGN true
#endif

#define GAS __attribute__((address_space(1)))
#define LAS __attribute__((address_space(3)))
typedef unsigned short bf16;
typedef unsigned v4u __attribute__((ext_vector_type(4)));
typedef unsigned v2u __attribute__((ext_vector_type(2)));
typedef float f32x4 __attribute__((ext_vector_type(4)));
typedef short bf16x8 __attribute__((ext_vector_type(8)));
typedef GAS unsigned gu32;
#define RLX_AGENT __ATOMIC_RELAXED, __HIP_MEMORY_SCOPE_AGENT
#define LDS_WAIT() asm volatile("s_waitcnt lgkmcnt(0)" ::: "memory")
#define VM_WAIT() asm volatile("s_waitcnt vmcnt(0)" ::: "memory")
__device__ __forceinline__ unsigned pk2(float lo, float hi) { return pg8::cvt_pk_bf16(lo, hi); }
__device__ __forceinline__ bf16 f2bf(float x) { return (bf16)(pg8::cvt_pk_bf16(x, 0.f) & 0xffffu); }
__device__ __forceinline__ float bf2f(bf16 b) { return __uint_as_float((unsigned)b << 16); }
__device__ __forceinline__ float bflo(unsigned p) { return __uint_as_float(p << 16); }
__device__ __forceinline__ float bfhi(unsigned p) { return __uint_as_float(p & 0xffff0000u); }
__device__ __forceinline__ float sigmoidf_(float x) { return 1.f / (1.f + __expf(-x)); }
__device__ __forceinline__ float logsigmoidf_(float x) { return fminf(x, 0.f) - log1pf(__expf(-fabsf(x))); }
__device__ __forceinline__ float gelu_tanh(float y) { const float x = 0.7978845608028654f * (y + 0.044715f * y * y * y); const float t = __builtin_amdgcn_exp2f(2.f * LOG2E * x); return 0.5f * y * (2.f - 2.f * __builtin_amdgcn_rcpf(t + 1.f)); }
template <int X> __device__ __forceinline__ float swz_xor(float v) { return __int_as_float(__builtin_amdgcn_ds_swizzle(__float_as_int(v), (X << 10) | 0x1f)); }
__device__ __forceinline__ float xor32(float v) { const unsigned u = __float_as_uint(v); auto rr = __builtin_amdgcn_permlane32_swap(u, u, false, false); const unsigned a = rr[0], b = rr[1]; return __uint_as_float(a ^ b ^ u); }
__device__ __forceinline__ float wave_sum(float v) { v += swz_xor<1>(v); v += swz_xor<2>(v); v += swz_xor<4>(v); v += swz_xor<8>(v); v += swz_xor<16>(v); v += xor32(v); return v; }
__device__ __forceinline__ float wave_max(float v) { v = fmaxf(v, swz_xor<1>(v)); v = fmaxf(v, swz_xor<2>(v)); v = fmaxf(v, swz_xor<4>(v)); v = fmaxf(v, swz_xor<8>(v)); v = fmaxf(v, swz_xor<16>(v)); v = fmaxf(v, xor32(v)); return v; }
__device__ __forceinline__ float lane_up(float x, int off, int lane) { const int src = (lane >= off) ? lane - off : lane; return __int_as_float(__builtin_amdgcn_ds_bpermute(src << 2, __float_as_int(x))); }
__device__ __forceinline__ int fresh_tid(int wave_s) { int l; asm volatile("v_mbcnt_lo_u32_b32 %0, -1, 0\n\tv_mbcnt_hi_u32_b32 %0, -1, %0" : "=v"(l)); int w = wave_s; asm volatile("" : "+s"(w)); int t = w * 64 + l; asm volatile("" : "+v"(t)); return t; }
#define XB_TMO      128
#define XB_XCNT(j)  (256  + 64 * (j))
#define XB_XSUB(j)  (1280 + 64 * (j))
#define XB_XGEN(j)  (2304 + 64 * (j))
#define XB_TOP      3328
#define XB_TOPGEN   3392
#define XCD_BAR_WORDS 3456
#define XB_SPIN_CAP (1u << 18)

__device__ __forceinline__ unsigned xb_ld(unsigned* p)              { return __hip_atomic_load(p, __ATOMIC_RELAXED, __HIP_MEMORY_SCOPE_AGENT); }
__device__ __forceinline__ unsigned xb_add(unsigned* p, unsigned v) { return __hip_atomic_fetch_add(p, v, __ATOMIC_RELAXED, __HIP_MEMORY_SCOPE_AGENT); }
__device__ __forceinline__ unsigned xb_xcc_id() { return (unsigned)__builtin_amdgcn_s_getreg((3 << 11) | 20) & 0xFu; }
#define XB_SPIN(cond, bar) do { unsigned _sp = 0; while (cond) { __builtin_amdgcn_s_sleep(1); \
    if ((++_sp & 255u) == 0u) { if (xb_ld(&(bar)[XB_TMO])) break; if (_sp > XB_SPIN_CAP) { atomicAdd(&(bar)[XB_TMO], 1u); break; } } } } while (0)

struct XcdBarrier {
    unsigned* bar; unsigned x;
    volatile LAS unsigned* st;
};

__device__ __forceinline__ XcdBarrier xcd_barrier_post(unsigned* bar, volatile LAS unsigned* st) {
    XcdBarrier b; b.bar = bar; b.x = xb_xcc_id(); b.st = st;
    if (threadIdx.x == 0) (void)xb_add(&bar[XB_XCNT(b.x)], 1u);
    return b;
}
__device__ __forceinline__ void xcd_barrier_complete(unsigned* bar, unsigned x, unsigned& nloc, unsigned& nx) {
    const unsigned G = gridDim.x * gridDim.y * gridDim.z;
    unsigned sum, cnt, mine, sp = 0u;
    for (;;) {
        sum = 0u; cnt = 0u; mine = 0u;
#pragma unroll
        for (unsigned j = 0; j < 16; ++j) { const unsigned c = xb_ld(&bar[XB_XCNT(j)]); sum += c; cnt += (c > 0u) ? 1u : 0u; mine = (j == x) ? c : mine; }
        if (sum == G) break;
        __builtin_amdgcn_s_sleep(1);
        if ((++sp & 255u) == 0u) { if (xb_ld(&bar[XB_TMO])) break; if (sp > XB_SPIN_CAP) { atomicAdd(&bar[XB_TMO], 1u); break; } }
    }
    nloc = mine > 0u ? mine : 1u; nx = cnt > 0u ? cnt : 1u;
}

__device__ __forceinline__ void xcd_barrier(const XcdBarrier& b) {
    asm volatile("s_waitcnt vmcnt(0)" ::: "memory");
    __syncthreads();
    if (threadIdx.x == 0) {
        unsigned* bar = b.bar;
        __builtin_amdgcn_s_waitcnt(0);
        unsigned nloc = b.st[0], nx = b.st[1];
        if (nloc == 0u) { xcd_barrier_complete(bar, b.x, nloc, nx); b.st[0] = nloc; b.st[1] = nx; }
        const unsigned old = xb_add(&bar[XB_XSUB(b.x)], 1u);
        const unsigned gen = old / nloc;
        if (old + 1u == (gen + 1u) * nloc) {
            __builtin_amdgcn_fence(__ATOMIC_RELEASE, "agent");
            asm volatile("s_waitcnt vmcnt(0)" ::: "memory");
            const unsigned og = xb_add(&bar[XB_TOP], 1u);
            const unsigned tg = og / nx;
            if (og + 1u == (tg + 1u) * nx) xb_add(&bar[XB_TOPGEN], 1u);
            else XB_SPIN(xb_ld(&bar[XB_TOPGEN]) == tg, bar);
            __builtin_amdgcn_fence(__ATOMIC_ACQUIRE, "agent");
            xb_add(&bar[XB_XGEN(b.x)], 1u);
            asm volatile("s_waitcnt vmcnt(0)" ::: "memory");
        } else {
            XB_SPIN(xb_ld(&bar[XB_XGEN(b.x)]) == gen, bar);
            __builtin_amdgcn_fence(__ATOMIC_ACQUIRE, "agent");
            asm volatile("s_waitcnt vmcnt(0)" ::: "memory");
        }
    }
    __syncthreads();
}


struct Args { const float* in[20]; float* out; unsigned char* ws; };
typedef const __attribute__((address_space(4))) Args* KArgs;

__device__ __forceinline__ void transpose_item(const float* W, int K, int N, bf16* WT, int mode, LAS float* scr, int item, int lane) {
    const int nblk = (N + 31) / 32, kb = item / nblk, nb = item % nblk, k0 = 64 * kb, n0 = 32 * nb;
    const int nn = n0 + (lane & 31); const bool ok = nn < N;
#pragma unroll 8
    for (int i = 0; i < 32; ++i) { const int kk = 2 * i + (lane >> 5); scr[kk * 33 + (lane & 31)] = ok ? W[(size_t)(k0 + kk) * N + nn] : 0.f; }
    LDS_WAIT(); asm volatile("" ::: "memory");
    const int c = lane & 7;
    int r0 = n0; if (mode) r0 = 256 * (n0 >> 7) + (n0 & 127) + (mode == 2 ? 128 : 0);
#pragma unroll
    for (int j = 0; j < 4; ++j) { const int n = (lane >> 3) + 8 * j; const LAS float* s = scr + (8 * c) * 33 + n;
        v4u o; o.x = pk2(s[0 * 33], s[1 * 33]); o.y = pk2(s[2 * 33], s[3 * 33]); o.z = pk2(s[4 * 33], s[5 * 33]); o.w = pk2(s[6 * 33], s[7 * 33]);
        if (n0 + n < N) *(GAS v4u*)(WT + (size_t)(r0 + n) * K + k0 + 8 * c) = o; }
    LDS_WAIT(); asm volatile("" ::: "memory");
}

__device__ __forceinline__ void p0_prologue(KArgs args, LAS unsigned char* lds, int tid, int lane, int wave, int vcu, int G) {
    unsigned char* ws = args->ws;
    const int bx = blockIdx.x;
    if (bx < 192) {
        LAS float* cs = (LAS float*)lds;
        LAS float* red = (LAS float*)(lds + 16384);
        const float* c = args->in[1];
        for (int i = tid; i < 4096; i += 512) { const float v = c[i]; cs[i] = v / (1.f + __expf(-v)); }
        __syncthreads();
        const int mat = bx / 24, cg = bx % 24;
        const float* Wp = args->in[2] + (size_t)mat * 2048 * 6144 + cg * 256 + lane * 4;
        f32x4 a0 = {0.f, 0.f, 0.f, 0.f}, a1 = {0.f, 0.f, 0.f, 0.f};
        const int kbeg = wave * 256;
#pragma unroll 8
        for (int k = kbeg; k < kbeg + 256; ++k) { const f32x4 w = *(const GAS f32x4*)(Wp + (size_t)k * 6144); const float c0 = cs[k], c1 = cs[2048 + k]; a0 += c0 * w; a1 += c1 * w; }
        *(LAS f32x4*)(red + (wave * 2 + 0) * 256 + lane * 4) = a0; *(LAS f32x4*)(red + (wave * 2 + 1) * 256 + lane * 4) = a1;
        __syncthreads();
        { const int b = tid >> 8, col = tid & 255; float s = args->in[3][mat * 6144 + cg * 256 + col];
#pragma unroll
          for (int w = 0; w < 8; ++w) s += red[(w * 2 + b) * 256 + col];
          ((float*)(ws + WS_MOD))[(mat * 2 + b) * 6144 + cg * 256 + col] = s; }
        __syncthreads();
    }
    LAS float* scr = (LAS float*)(lds + wave * 16384);
    const int gw = vcu * NWAVES + wave, NGW = G * NWAVES;
    constexpr int I_ABIN = 32 * 161, I_SQ = 32 * 64, I_QKV = 32 * 192, I_W1 = 32 * 176, I_W2 = 88 * 64;
    constexpr int NITEMS = 2 * (I_ABIN + 2 * I_SQ + I_QKV) + 4 * (2 * I_W1 + I_W2);
    for (int it = gw; it < NITEMS; it += NGW) {
        int r = it;
        if (r < 2 * I_ABIN) { const int j = r / I_ABIN; transpose_item(args->in[9] + (size_t)j * 2048 * AB_IN, 2048, AB_IN, (bf16*)(ws + WS_WABIN) + (size_t)j * AB_IN_PAD * 2048, 0, scr, r % I_ABIN, lane); continue; } r -= 2 * I_ABIN;
        if (r < 2 * I_SQ) { const int j = r / I_SQ; transpose_item(args->in[10] + (size_t)j * 2048 * 2048, 2048, 2048, (bf16*)(ws + WS_WABOUT) + (size_t)j * 2048 * 2048, 0, scr, r % I_SQ, lane); continue; } r -= 2 * I_SQ;
        if (r < 2 * I_QKV) { const int j = r / I_QKV; transpose_item(args->in[18] + (size_t)j * 2048 * 6144, 2048, 6144, (bf16*)(ws + WS_WQKV) + (size_t)j * 6144 * 2048, 0, scr, r % I_QKV, lane); continue; } r -= 2 * I_QKV;
        if (r < 2 * I_SQ) { const int j = r / I_SQ; transpose_item(args->in[19] + (size_t)j * 2048 * 2048, 2048, 2048, (bf16*)(ws + WS_WSBO) + (size_t)j * 2048 * 2048, 0, scr, r % I_SQ, lane); continue; } r -= 2 * I_SQ;
        if (r < 4 * I_W1) { const int l = r / I_W1; transpose_item(args->in[6] + (size_t)l * 2048 * FF, 2048, FF, (bf16*)(ws + WS_W13) + (size_t)l * 2 * FF * 2048, 1, scr, r % I_W1, lane); continue; } r -= 4 * I_W1;
        if (r < 4 * I_W1) { const int l = r / I_W1; transpose_item(args->in[7] + (size_t)l * 2048 * FF, 2048, FF, (bf16*)(ws + WS_W13) + (size_t)l * 2 * FF * 2048, 2, scr, r % I_W1, lane); continue; } r -= 4 * I_W1;
        { const int l = r / I_W2; transpose_item(args->in[8] + (size_t)l * FF * 2048, FF, 2048, (bf16*)(ws + WS_W2) + (size_t)l * 2048 * FF, 0, scr, r % I_W2, lane); }
    }
}

__device__ __forceinline__ void norm_phase(const float* xin, const float* g, const float* mod  , bf16* HN, int lane, int gw, int NGW) {
    int curb = -1; f32x4 gs[8], sh[8];
    for (int row = gw; row < M; row += NGW) {
        const int b = row >= SEQ ? 1 : 0;
        if (b != curb) { curb = b;
#pragma unroll
            for (int j = 0; j < 8; ++j) { const int col = 4 * lane + 256 * j; const f32x4 gg = *(const GAS f32x4*)(g + col), sc = *(const GAS f32x4*)(mod + b * 6144 + 2048 + col); gs[j] = gg * (1.f + sc); sh[j] = *(const GAS f32x4*)(mod + b * 6144 + col); } }
        const GAS f32x4* xr = (const GAS f32x4*)(xin + (size_t)row * DM) + lane;
        f32x4 v[8]; float ss = 0.f;
#pragma unroll
        for (int j = 0; j < 8; ++j) { v[j] = xr[64 * j]; ss += (v[j].x * v[j].x + v[j].y * v[j].y) + (v[j].z * v[j].z + v[j].w * v[j].w); }
        const float rstd = 1.f / sqrtf(wave_sum(ss) * (1.f / DM) + EPS);
        GAS v2u* o8 = (GAS v2u*)(HN + (size_t)row * DM) + lane;
#pragma unroll
        for (int j = 0; j < 8; ++j) { const f32x4 y = v[j] * rstd * gs[j] + sh[j]; v2u w; w.x = pk2(y.x, y.y); w.y = pk2(y.z, y.w); o8[64 * j] = w; }
    }
}
__device__ __forceinline__ void final_norm_phase(const float* xin, const float* g, float* out, int lane, int gw, int NGW) {
    f32x4 gs[8];
#pragma unroll
    for (int j = 0; j < 8; ++j) gs[j] = *(const GAS f32x4*)(g + 4 * lane + 256 * j);
    for (int row = gw; row < M; row += NGW) {
        const GAS f32x4* xr = (const GAS f32x4*)(xin + (size_t)row * DM) + lane;
        f32x4 v[8]; float ss = 0.f;
#pragma unroll
        for (int j = 0; j < 8; ++j) { v[j] = xr[64 * j]; ss += (v[j].x * v[j].x + v[j].y * v[j].y) + (v[j].z * v[j].z + v[j].w * v[j].w); }
        const float rstd = 1.f / sqrtf(wave_sum(ss) * (1.f / DM) + EPS);
        GAS f32x4* o = (GAS f32x4*)(out + (size_t)row * DM) + lane;
#pragma unroll
        for (int j = 0; j < 8; ++j) o[64 * j] = v[j] * rstd * gs[j];
    }
}

struct MixP {
    const float *XA, *IG, *FG; const bf16 *YA, *Qm, *Km, *Vm, *Om; bf16* MIX;
    const float *conv_w, *conv_b, *gate_w, *gate_b, *lam, *mgb, *mng;
    float *DC, *DN, *NIN, *MLOC, *BLAST, *MIN, *HLOC, *PCUM, *AGGP, *AGGH, *HTMP; bf16* CIN;
};

__device__ __forceinline__ void mx1_rglru_unit(const MixP& P, LAS unsigned char* lds, int tid, int b, int n, int c) {
    LAS float* XC = (LAS float*)lds;
    LAS float* AS = (LAS float*)(lds + 65536);
    const int e = tid & 127, tg = tid >> 7, chn = n * 128 + e;
    const size_t rowbase = (size_t)b * SEQ; const int t0 = c * CH;
    {
        float w[4]; for (int j = 0; j < 4; ++j) w[j] = P.conv_w[j * LRU_W + chn];
        const float cb = P.conv_b[chn];
        for (int i = 0; i < 32; ++i) { const int tt = tg * 32 + i, t = t0 + tt; float acc = cb;
#pragma unroll
            for (int j = 0; j < 4; ++j) { const int ts = t - 3 + j; if (ts >= 0) acc += w[j] * P.XA[(rowbase + ts) * LRU_W + chn]; }
            XC[tt * 128 + e] = acc; }
    }
    __syncthreads();
    float ar[32], ai[32];
    { const float br = P.gate_b[chn], bi = P.gate_b[LRU_W + chn];
#pragma unroll
      for (int i = 0; i < 32; ++i) { ar[i] = br; ai[i] = bi; } }
    { const float* Wr = P.gate_w + ((size_t)(0 * NBLK + n) * 128) * 128 + e; const float* Wi = P.gate_w + ((size_t)(1 * NBLK + n) * 128) * 128 + e;
      for (int d = 0; d < 128; ++d) { const float wr = Wr[d * 128], wi = Wi[d * 128];
#pragma unroll
          for (int i = 0; i < 32; ++i) { const float x = XC[(tg * 32 + i) * 128 + d]; ar[i] += x * wr; ai[i] += x * wi; } } }
    __syncthreads();
    { const float ls = logsigmoidf_(P.lam[chn]);
#pragma unroll
      for (int i = 0; i < 32; ++i) { const int tt = tg * 32 + i; const float r = sigmoidf_(ar[i]), ig = sigmoidf_(ai[i]); const float la = 8.f * r * ls; const float a = __expf(la);
          const float mult = sqrtf(-expm1f(2.f * la)); const float xv = XC[tt * 128 + e]; AS[tt * 128 + e] = a; XC[tt * 128 + e] = mult * (ig * xv); } }
    __syncthreads();
    if (tid < 128) { float h = 0.f, pp = 1.f;
        for (int tt = 0; tt < 128; ++tt) { const float a = AS[tt * 128 + e], u = XC[tt * 128 + e]; h = a * h + u; pp *= a; const size_t o = (rowbase + t0 + tt) * LRU_W + chn; P.HLOC[o] = h; P.PCUM[o] = pp; }
        P.AGGP[(b * NCH + c) * LRU_W + chn] = pp; P.AGGH[(b * NCH + c) * LRU_W + chn] = h; }
    __syncthreads();
}

__device__ __forceinline__ void mx3_rglru_unit(const MixP& P, int tid, int b, int c, int half) {
    const int chn = half * 512 + tid;
    float carry = 0.f;
    for (int c2 = 0; c2 < c; ++c2) carry = P.AGGP[(b * NCH + c2) * LRU_W + chn] * carry + P.AGGH[(b * NCH + c2) * LRU_W + chn];
    for (int tt = 0; tt < CH; ++tt) { const size_t row = (size_t)b * SEQ + c * CH + tt; const float h = P.HLOC[row * LRU_W + chn] + P.PCUM[row * LRU_W + chn] * carry;
        const float y = bf2f(P.YA[row * LRU_W + chn]); P.MIX[row * DM + chn] = f2bf(h * gelu_tanh(y)); }
}

__device__ __forceinline__ void mx1_mlstm_unit(const MixP& P, LAS unsigned char* lds, int tid, int b, int h, int c) {
    LAS bf16* VS = (LAS bf16*)lds;
    LAS float* KS = (LAS float*)(lds + 65536);
    LAS float* sm = (LAS float*)(lds + SM_OFF); LAS float *s_li = sm, *s_lf = sm + 128, *s_bc = sm + 256, *s_g = sm + 384, *s_sc = sm + 768;
    const size_t rowbase = (size_t)b * SEQ + c * CH; const int uidx = (b * MH + h) * NCH + c;
    if (tid < 128) { s_li[tid] = P.IG[(rowbase + tid) * 4 + h] + P.mgb[h]; s_lf[tid] = logsigmoidf_(P.FG[(rowbase + tid) * 4 + h] + P.mgb[MH + h]); }
    __syncthreads();
    if (tid == 0) { float acc = 0.f, G = -INFINITY; for (int s = 0; s < 128; ++s) { acc += s_lf[s]; s_bc[s] = acc; const float g = s_li[s] - acc; s_g[s] = g; G = fmaxf(G, g); } s_sc[0] = G; s_sc[1] = acc; }
    __syncthreads();
    { const float G = s_sc[0]; const int s = tid >> 2, q = tid & 3; const float w = __expf(s_g[s] - G);
      const bf16* vp = P.Vm + (rowbase + s) * MLW + h * DV;
#pragma unroll
      for (int i = 0; i < 8; ++i) { const int ch = q + 4 * i; *(LAS v4u*)(VS + s * 256 + ch * 8) = *(const GAS v4u*)(vp + ch * 8); }
      const bf16* kp = P.Km + (rowbase + s) * MQK + h * DK + q * 32;
#pragma unroll
      for (int i = 0; i < 4; ++i) { const v4u kk = *(const GAS v4u*)(kp + i * 8); LAS float* d = KS + s * 128 + q * 32 + i * 8;
          d[0] = w * bflo(kk.x); d[1] = w * bfhi(kk.x); d[2] = w * bflo(kk.y); d[3] = w * bfhi(kk.y); d[4] = w * bflo(kk.z); d[5] = w * bfhi(kk.z); d[6] = w * bflo(kk.w); d[7] = w * bfhi(kk.w); } }
    __syncthreads();
    { const int d = tid & 127, vg = tid >> 7;
      float* dc = P.DC + ((size_t)uidx * DV + vg * 64) * DK + d;
#pragma unroll 1
      for (int i = 0; i < 64; ++i) { const LAS bf16* vcol = VS + vg * 64 + i; float acc = 0.f;
#pragma unroll 8
          for (int s = 0; s < 128; ++s) acc += KS[s * 128 + d] * bf2f(vcol[s * 256]);
          dc[(size_t)i * DK] = acc; }
      if (tid < 128) { float a = 0.f; for (int s = 0; s < 128; ++s) a += KS[s * 128 + tid]; P.DN[uidx * DK + tid] = a; }
      if (tid == 0) { P.MLOC[uidx] = s_sc[1] + s_sc[0]; P.BLAST[uidx] = s_sc[1]; } }
    __syncthreads();
}

__device__ __forceinline__ void mx2_mlstm(const MixP& P, LAS unsigned char* lds, int tid, int gtid, int NT) {
    LAS float* sm = (LAS float*)(lds + SM_OFF); LAS float *s_dec = sm, *s_scl = sm + 256, *s_min = sm + 512;
    if (tid < 8) { float m = 0.f; for (int k = 0; k < NCH; ++k) { const int u = tid * NCH + k; s_min[u] = m; const float bl = P.BLAST[u], ml = P.MLOC[u]; const float mn = fmaxf(bl + m, ml);
        s_dec[u] = __expf(bl + m - mn); s_scl[u] = __expf(ml - mn); m = mn; } }
    __syncthreads();
    for (int e = gtid; e < 8 * DV * DK; e += NT) { const int chain = e / (DV * DK), idx = e % (DV * DK); float cv = 0.f;
        for (int k = 0; k < NCH; ++k) { const int u = chain * NCH + k; const size_t o = (size_t)u * (DV * DK) + idx; P.CIN[o] = f2bf(cv); cv = s_dec[u] * cv + s_scl[u] * P.DC[o]; } }
    if (gtid < 8 * DK) { const int chain = gtid / DK, d = gtid % DK; float nv = 0.f;
        for (int k = 0; k < NCH; ++k) { const int u = chain * NCH + k; P.NIN[u * DK + d] = nv; nv = s_dec[u] * nv + s_scl[u] * P.DN[u * DK + d]; } }
    if (gtid < 256) P.MIN[gtid] = s_min[gtid];
    __syncthreads();
}

__device__ __forceinline__ void mx3_mlstm_unit(const MixP& P, LAS unsigned char* lds, int tid, int lane, int wave, int b, int h, int c) {
    constexpr int SS = 129, KSTR = 130;
    LAS float* S = (LAS float*)lds;
    LAS bf16* QS = (LAS bf16*)(lds + 66048);
    LAS bf16* KSb = (LAS bf16*)(lds + 66048 + 32768);
    LAS float* sm = (LAS float*)(lds + SM_OFF); LAS float *s_li = sm, *s_lf = sm + 128, *s_bc = sm + 256, *s_g = sm + 384, *s_M = sm + 512, *s_dn = sm + 640, *s_wi = sm + 768, *s_nin = sm + 896;
    const size_t rowbase = (size_t)b * SEQ + c * CH; const int uidx = (b * MH + h) * NCH + c;
    const float m_in = P.MIN[uidx];
    if (tid < 128) { s_li[tid] = P.IG[(rowbase + tid) * 4 + h] + P.mgb[h]; s_lf[tid] = logsigmoidf_(P.FG[(rowbase + tid) * 4 + h] + P.mgb[MH + h]); s_nin[tid] = P.NIN[uidx * DK + tid]; }
    { const int s = tid >> 2, q = tid & 3;
      const bf16* qp = P.Qm + (rowbase + s) * MQK + h * DK + q * 32; const bf16* kp = P.Km + (rowbase + s) * MQK + h * DK + q * 32;
#pragma unroll
      for (int i = 0; i < 4; ++i) { *(LAS v4u*)(QS + s * 128 + q * 32 + i * 8) = *(const GAS v4u*)(qp + i * 8);
          const v4u kk = *(const GAS v4u*)(kp + i * 8); LAS unsigned* kd = (LAS unsigned*)(KSb + s * KSTR + q * 32 + i * 8); kd[0] = kk.x; kd[1] = kk.y; kd[2] = kk.z; kd[3] = kk.w; } }
    __syncthreads();
    if (tid == 0) { float acc = 0.f, cm = m_in; for (int s = 0; s < 128; ++s) { acc += s_lf[s]; s_bc[s] = acc; const float g = s_li[s] - acc; s_g[s] = g; cm = fmaxf(cm, g); s_M[s] = cm; s_wi[s] = __expf(m_in - cm); } }
    __syncthreads();
    { const int s = tid & 127, tg = tid >> 7;
      const float gs = s_g[s]; const LAS unsigned* krow = (const LAS unsigned*)(KSb + s * KSTR);
#pragma unroll 1
      for (int i = 0; i < 32; ++i) { const int t = tg * 32 + i; float acc = 0.f; const LAS unsigned* qrow = (const LAS unsigned*)(QS + t * 128);
#pragma unroll 8
          for (int d2 = 0; d2 < 64; ++d2) { const unsigned qp = qrow[d2], kp = krow[d2]; acc += bflo(qp) * bflo(kp) + bfhi(qp) * bfhi(kp); }
          S[t * SS + s] = (s <= t) ? acc * __expf(gs - s_M[t]) : 0.f; } }
    __syncthreads();
    if (tid < 128) { const int t = tid; float den = 0.f; for (int s = 0; s < 128; ++s) den += S[t * SS + s];
        float qn = 0.f; for (int d = 0; d < 128; ++d) qn += bf2f(QS[t * 128 + d]) * s_nin[d];
        den += s_wi[t] * qn; const float mt = s_bc[t] + s_M[t]; s_dn[t] = 1.f / fmaxf(fabsf(den), __expf(-mt)); }
    __syncthreads();
    { const int v = tid & 255, tg = tid >> 8;
      const bf16* cp = P.CIN + ((size_t)uidx * DV + v) * DK;
      const bf16* vp = P.Vm + rowbase * MLW + h * DV + v;
      float* ht = P.HTMP + (size_t)uidx * CH * DV;
#pragma unroll 1
      for (int i = 0; i < 64; ++i) { const int t = tg * 64 + i; float acc = 0.f; const LAS unsigned* qrow = (const LAS unsigned*)(QS + t * 128);
#pragma unroll 4
          for (int d2 = 0; d2 < 64; ++d2) { const unsigned qp = qrow[d2]; const unsigned cc = *(const GAS unsigned*)(cp + 2 * d2); acc += bflo(qp) * bflo(cc) + bfhi(qp) * bfhi(cc); }
          acc *= s_wi[t];
          const LAS float* srow = S + t * SS;
#pragma unroll 4
          for (int s = 0; s < 128; ++s) acc += srow[s] * bf2f(*(const GAS bf16*)(vp + (size_t)s * MLW));
          ht[t * DV + v] = acc * s_dn[t]; } }
    __syncthreads();
    const float* HS = P.HTMP + (size_t)uidx * CH * DV;
    for (int i = 0; i < 16; ++i) { const int t = wave * 16 + i; const f32x4 hv = *(const GAS f32x4*)(HS + t * 256 + 4 * lane);
        const float ss = wave_sum((hv.x * hv.x + hv.y * hv.y) + (hv.z * hv.z + hv.w * hv.w)); const float rstd = 1.f / sqrtf(ss * (1.f / DV) + EPS);
        const f32x4 ng = *(const GAS f32x4*)(P.mng + h * DV + 4 * lane); const v2u ob = *(const GAS v2u*)(P.Om + (rowbase + t) * MLW + h * DV + 4 * lane);
        const float o0 = sigmoidf_(bflo(ob.x)), o1 = sigmoidf_(bfhi(ob.x)), o2 = sigmoidf_(bflo(ob.y)), o3 = sigmoidf_(bfhi(ob.y));
        v2u w; w.x = pk2(hv.x * rstd * ng.x * o0, hv.y * rstd * ng.y * o1); w.y = pk2(hv.z * rstd * ng.z * o2, hv.w * rstd * ng.w * o3);
        *(GAS v2u*)(P.MIX + (rowbase + t) * DM + LRU_W + h * DV + 4 * lane) = w; }
    __syncthreads();
}

__device__ __forceinline__ void attn_v1_phase(const bf16* Q, const bf16* K, const bf16* V, bf16* O, LAS unsigned char* lds, int lane, int wave, int gw, int NGW) {
    LAS float* qs = (LAS float*)(lds + wave * 512);
    for (int u = gw; u < BATCH * SBH * SEQ; u += NGW) {
        const int bh = u & 31, t = u >> 5, b = bh >> 4, h = bh & 15;
        const size_t rowbase = (size_t)b * SEQ;
        { const unsigned qp = *(const GAS unsigned*)(Q + (rowbase + t) * DM + h * SBD + 2 * lane); qs[2 * lane] = bflo(qp); qs[2 * lane + 1] = bfhi(qp); }
        LDS_WAIT();
        float o0 = 0.f, o1 = 0.f, carry = 0.f;
        for (int kb = (t - 1) >> 6; kb >= 0 && t > 0; --kb) {
            const int s = kb * 64 + lane; const bool valid = s < t;
            const bf16* kp = K + (rowbase + s) * DM + h * SBD;
            float z = 0.f;
#pragma unroll
            for (int i = 0; i < 16; ++i) { const v4u kk = *(const GAS v4u*)(kp + i * 8); const LAS float* qq = qs + i * 8;
                z += qq[0] * bflo(kk.x) + qq[1] * bfhi(kk.x) + qq[2] * bflo(kk.y) + qq[3] * bfhi(kk.y) + qq[4] * bflo(kk.z) + qq[5] * bfhi(kk.z) + qq[6] * bflo(kk.w) + qq[7] * bfhi(kk.w); }
            const float sp = valid ? (fmaxf(z, 0.f) + __builtin_amdgcn_logf(1.f + __builtin_amdgcn_exp2f(-fabsf(z)))) : 0.f;
            float x = sp;
#pragma unroll
            for (int off = 1; off < 64; off <<= 1) { const float y = __shfl_down(x, off); if (lane + off < 64) x += y; }
            const float R = x + carry; carry += __shfl(x, 0);
            const float A = valid ? __builtin_amdgcn_exp2f(z - R) : 0.f;
            const bf16* vp = V + (rowbase + kb * 64) * DM + h * SBD + 2 * lane;
            for (int l = 0; l < 64; ++l) { const float a = __shfl(A, l); const unsigned pr = *(const GAS unsigned*)(vp + (size_t)l * DM); o0 += a * bflo(pr); o1 += a * bfhi(pr); }
        }
        *(GAS unsigned*)(O + (rowbase + t) * DM + h * SBD + 2 * lane) = pk2(o0, o1);
    }
}

namespace sba {
typedef float f32x16 __attribute__((ext_vector_type(16)));
typedef short v4i16_t __attribute__((ext_vector_type(4)));
typedef float f32x2_t __attribute__((ext_vector_type(2))); typedef __bf16 bf16x2_t __attribute__((ext_vector_type(2)));
__device__ __forceinline__ unsigned cvtpk_s(float lo, float hi) { f32x2_t v = {lo, hi}; bf16x2_t b = __builtin_convertvector(v, bf16x2_t); return __builtin_bit_cast(unsigned, b); }
__device__ __forceinline__ int img_off(int row, int ch) { return 256 * row + 16 * (ch ^ (((row & 3) << 2) | ((row >> 2) & 3))); }
__device__ __forceinline__ v4i16_t vtr(const LAS unsigned char* p) { return __builtin_amdgcn_ds_read_tr16_b64_v4i16((LAS v4i16_t*)p); }

__device__ __forceinline__ void sb_weights(f32x16& p, float& carry, int hi) {
    float sp[16];
#pragma unroll
    for (int r = 0; r < 16; ++r) { const float z = p[r]; const float l = __builtin_amdgcn_logf(1.f + __builtin_amdgcn_exp2f(-__builtin_fabsf(z))); sp[r] = __builtin_fmaxf(z, 0.f) + l; }
    float E[4], Od[4];
#pragma unroll
    for (int m = 0; m < 4; ++m) { sp[4 * m + 2] += sp[4 * m + 3]; sp[4 * m + 1] += sp[4 * m + 2]; sp[4 * m] += sp[4 * m + 1];
        const unsigned tv = __float_as_uint(sp[4 * m]); auto rr = __builtin_amdgcn_permlane32_swap(tv, tv, false, false); E[m] = __uint_as_float(rr[0]); Od[m] = __uint_as_float(rr[1]); }
    float SP[4]; SP[3] = carry; SP[2] = SP[3] + (E[3] + Od[3]); SP[1] = SP[2] + (E[2] + Od[2]); SP[0] = SP[1] + (E[1] + Od[1]); carry = SP[0] + (E[0] + Od[0]);
    const float f0 = (hi == 0) ? 1.f : 0.f;
#pragma unroll
    for (int m = 0; m < 4; ++m) { const float off = SP[m] + f0 * Od[m];
#pragma unroll
        for (int i = 0; i < 4; ++i) { const int r = 4 * m + i; p[r] = __builtin_amdgcn_exp2f(p[r] - (sp[r] + off)); } }
}
__device__ __forceinline__ void sb_mask(f32x16& p, int lim  ) {
#pragma unroll
    for (int r = 0; r < 16; ++r) p[r] = ((r & 3) + 8 * (r >> 2) < lim) ? p[r] : -INFINITY;
}

__device__ __forceinline__ void attn_unit(const bf16* Q, const bf16* K, const bf16* V, bf16* O, LAS unsigned char* lds, int tid, int b, int h, int qb) {
    const int lane = tid & 63, wave = __builtin_amdgcn_readfirstlane(tid >> 6), r32 = lane & 31, hi = lane >> 5;
    const size_t rowbase = (size_t)b * SEQ; const int q0 = qb * 256, Qw = q0 + 32 * wave, t = Qw + r32;
    bf16x8 qf[8];
    { const bf16* qp = Q + (rowbase + t) * DM + h * SBD + hi * 8;
#pragma unroll
      for (int d = 0; d < 8; ++d) qf[d] = *(const GAS bf16x8*)(qp + d * 16); }
    f32x16 o[4];
#pragma unroll
    for (int i = 0; i < 4; ++i)
#pragma unroll
        for (int r = 0; r < 16; ++r) o[i][r] = 0.f;
    float carry = 0.f;
    const int NT = 4 * qb + 4;
    const int sr = tid >> 4, sc = tid & 15;
    const GAS unsigned char* kg = (const GAS unsigned char*)(K + rowbase * DM + h * SBD); const GAS unsigned char* vg = (const GAS unsigned char*)(V + rowbase * DM + h * SBD);
    const unsigned goff = (unsigned)(sr * DM + sc * 8) * 2u;
    const int w0 = img_off(sr, sc), w1 = img_off(sr + 32, sc);
    v4u sk0, sk1, sv0, sv1;
#define SB_LOAD(kt) do { const unsigned o_ = goff + (unsigned)(kt) * (64u * DM * 2u); sk0 = *(const GAS v4u*)(kg + o_); sk1 = *(const GAS v4u*)(kg + o_ + 32u * DM * 2u); sv0 = *(const GAS v4u*)(vg + o_); sv1 = *(const GAS v4u*)(vg + o_ + 32u * DM * 2u); } while (0)
#define SB_WRITE(buf) do { LAS unsigned char* kb_ = lds + (buf) * 16384; LAS unsigned char* vb_ = lds + 32768 + (buf) * 16384; *(LAS v4u*)(kb_ + w0) = sk0; *(LAS v4u*)(kb_ + w1) = sk1; *(LAS v4u*)(vb_ + w0) = sv0; *(LAS v4u*)(vb_ + w1) = sv1; } while (0)
    const int krt = ((r32 & 3) << 2) | ((r32 >> 2) & 3);
    const int i16 = lane & 15, q4 = i16 >> 2, p4 = i16 & 3, gb = (lane >> 4) & 1;
    const int vlow0 = ((2 * gb + (p4 >> 1)) ^ hi), vlow1 = vlow0 ^ 2;
    const int vrow0 = 256 * (4 * hi + q4) + 8 * (p4 & 1);
    SB_LOAD(NT - 1); SB_WRITE(0); __syncthreads();
    for (int it = 0; it < NT; ++it) {
        const int kt = NT - 1 - it, buf = it & 1, key0 = kt * 64;
        if (it + 1 < NT) SB_LOAD(kt - 1);
        const bool skip = key0 >= Qw + 31, full = key0 + 63 < Qw;
        if (!skip) {
            const LAS unsigned char* Kb = lds + buf * 16384; const LAS unsigned char* Vb = lds + 32768 + buf * 16384;
            f32x16 p0, p1;
#pragma unroll
            for (int r = 0; r < 16; ++r) { p0[r] = 0.f; p1[r] = 0.f; }
#pragma unroll
            for (int d = 0; d < 8; ++d) { const int off = 256 * r32 + 16 * ((2 * d + hi) ^ krt);
                const bf16x8 k0 = *(const LAS bf16x8*)(Kb + off), k1 = *(const LAS bf16x8*)(Kb + off + 8192);
                p0 = __builtin_amdgcn_mfma_f32_32x32x16_bf16(k0, qf[d], p0, 0, 0, 0); p1 = __builtin_amdgcn_mfma_f32_32x32x16_bf16(k1, qf[d], p1, 0, 0, 0); }
            bf16x8 af[2][2];
#define SB_PACK(P, u) do { _Pragma("unroll") for (int s = 0; s < 2; ++s) { v4u aw; aw.x = cvtpk_s(P[8 * s], P[8 * s + 1]); aw.y = cvtpk_s(P[8 * s + 2], P[8 * s + 3]); aw.z = cvtpk_s(P[8 * s + 4], P[8 * s + 5]); aw.w = cvtpk_s(P[8 * s + 6], P[8 * s + 7]); af[u][s] = __builtin_bit_cast(bf16x8, aw); } } while (0)
            if (!full) { sb_mask(p1, t - key0 - 32 - 4 * hi); sb_mask(p0, t - key0 - 4 * hi); }
            sb_weights(p1, carry, hi); SB_PACK(p1, 1); __builtin_amdgcn_sched_barrier(0); sb_weights(p0, carry, hi); SB_PACK(p0, 0);
#undef SB_PACK
            __builtin_amdgcn_sched_barrier(0);
#pragma unroll
            for (int u = 0; u < 2; ++u)
#pragma unroll
                for (int s = 0; s < 2; ++s) {
#pragma unroll
                    for (int db = 0; db < 4; ++db) {
                        const int c0 = (((db ^ q4) << 2) | vlow0), c1 = (((db ^ q4) << 2) | vlow1);
                        const v4i16_t lo = vtr(Vb + vrow0 + 256 * (32 * u + 16 * s) + 16 * c0), hh = vtr(Vb + vrow0 + 256 * (32 * u + 16 * s + 8) + 16 * c1);
                        const bf16x8 vf = {lo[0], lo[1], lo[2], lo[3], hh[0], hh[1], hh[2], hh[3]};
                        o[db] = __builtin_amdgcn_mfma_f32_32x32x16_bf16(vf, af[u][s], o[db], 0, 0, 0);
                    }
                }
        }
        if (it + 1 < NT) SB_WRITE(buf ^ 1);
        __syncthreads();
    }
#undef SB_LOAD
#undef SB_WRITE
    bf16* op = O + (rowbase + t) * DM + h * SBD + 4 * hi;
#pragma unroll
    for (int db = 0; db < 4; ++db)
#pragma unroll
        for (int g = 0; g < 4; ++g) { v2u w; w.x = cvtpk_s(o[db][4 * g], o[db][4 * g + 1]); w.y = cvtpk_s(o[db][4 * g + 2], o[db][4 * g + 3]); *(GAS v2u*)(op + 32 * db + 8 * g) = w; }
}

__device__ __forceinline__ void attn_phase(const bf16* Q, const bf16* K, const bf16* V, bf16* O, LAS unsigned char* lds, int tid, int vcu, int G) {
    for (int pi = vcu; pi < 256; pi += G) {
        const int bh = pi >> 3, x = pi & 7;
#pragma unroll 1
        for (int uu = 0; uu < 2; ++uu) attn_unit(Q, K, V, O, lds, tid, bh >> 4, bh & 15, uu ? x : 15 - x);
    }
}
}

namespace mls {
using sba::f32x16; using sba::v4i16_t; using sba::cvtpk_s; using sba::img_off; using sba::vtr;
__device__ __forceinline__ float half_sum(float x) { const unsigned u = __float_as_uint(x); auto rr = __builtin_amdgcn_permlane32_swap(u, u, false, false); return __uint_as_float(rr[0]) + __uint_as_float(rr[1]); }

__device__ __forceinline__ void stage_v(const bf16* Vm, size_t rowbase, int h, LAS unsigned char* lds, int tid) {
    const int c32 = tid & 31; const bf16* vp = Vm + rowbase * MLW + h * DV + c32 * 8;
#pragma unroll
    for (int k = 0; k < 8; ++k) { const int row = (tid >> 5) + 16 * k; const v4u x = *(const GAS v4u*)(vp + (size_t)row * MLW); *(LAS v4u*)(lds + (c32 >> 4) * 32768 + img_off(row, c32 & 15)) = x; }
}
__device__ __forceinline__ void gate_scan(const MixP& P, size_t rowbase, int h, int lane, float& bc0, float& bc1, float& g0, float& g1) {
    const float li0 = P.IG[(rowbase + 2 * lane) * 4 + h] + P.mgb[h], li1 = P.IG[(rowbase + 2 * lane + 1) * 4 + h] + P.mgb[h];
    const float lf0 = logsigmoidf_(P.FG[(rowbase + 2 * lane) * 4 + h] + P.mgb[MH + h]), lf1 = logsigmoidf_(P.FG[(rowbase + 2 * lane + 1) * 4 + h] + P.mgb[MH + h]);
    const float ps = lf0 + lf1; float x = ps;
#pragma unroll
    for (int off = 1; off < 64; off <<= 1) { const float y = lane_up(x, off, lane); if (lane >= off) x += y; }
    bc0 = (x - ps) + lf0; bc1 = bc0 + lf1; g0 = li0 - bc0; g1 = li1 - bc1;
}

__device__ __forceinline__ void mx1_unit(const MixP& P, LAS unsigned char* lds, int tid, int b, int h, int c) {
    const int lane = tid & 63, wave = __builtin_amdgcn_readfirstlane(tid >> 6), r32 = lane & 31, hi = lane >> 5;
    LAS float* sm = (LAS float*)(lds + SM_OFF); LAS float *s_w = sm, *s_sc = sm + 128;
    const size_t rowbase = (size_t)b * SEQ + c * CH; const int uidx = (b * MH + h) * NCH + c;
    stage_v(P.Vm, rowbase, h, lds, tid);
    if (wave == 0) { float bc0, bc1, g0, g1; gate_scan(P, rowbase, h, lane, bc0, bc1, g0, g1);
        const float G = wave_max(fmaxf(g0, g1));
        s_w[2 * lane] = __expf(g0 - G); s_w[2 * lane + 1] = __expf(g1 - G);
        const float bl = __int_as_float(__builtin_amdgcn_readlane(__float_as_int(bc1), 63)); if (lane == 0) { s_sc[0] = G; s_sc[1] = bl; } }
    __syncthreads();
    { const int row = tid >> 2, q = tid & 3; const float w = s_w[row]; const bf16* kp = P.Km + (rowbase + row) * MQK + h * DK + q * 32;
#pragma unroll
      for (int i = 0; i < 4; ++i) { const v4u kk = *(const GAS v4u*)(kp + i * 8); v4u o;
          o.x = cvtpk_s(w * bflo(kk.x), w * bfhi(kk.x)); o.y = cvtpk_s(w * bflo(kk.y), w * bfhi(kk.y)); o.z = cvtpk_s(w * bflo(kk.z), w * bfhi(kk.z)); o.w = cvtpk_s(w * bflo(kk.w), w * bfhi(kk.w));
          *(LAS v4u*)(lds + 65536 + img_off(row, 4 * q + i)) = o; } }
    __syncthreads();
    f32x16 acc[4], accn[4];
#pragma unroll
    for (int i = 0; i < 4; ++i)
#pragma unroll
        for (int r = 0; r < 16; ++r) { acc[i][r] = 0.f; accn[i][r] = 0.f; }
    const int i16 = lane & 15, q4 = i16 >> 2, p4 = i16 & 3, gb = (lane >> 4) & 1;
    const int lowb = 2 * gb + (p4 >> 1);
    const int rowb = 256 * (8 * hi + q4) + 8 * (p4 & 1);
    const LAS unsigned char* Vb = lds + (wave >> 2) * 32768; const LAS unsigned char* Kb = lds + 65536;
    const int vdb = wave & 3;
    const bf16x8 ones = {0x3F80, 0x3F80, 0x3F80, 0x3F80, 0x3F80, 0x3F80, 0x3F80, 0x3F80};
#pragma unroll
    for (int ks = 0; ks < 8; ++ks) {
        const int lw0 = lowb ^ (2 * hi), lw1 = lowb ^ (2 * hi + 1);
        const v4i16_t vl = vtr(Vb + rowb + 256 * (16 * ks) + 16 * (((vdb ^ q4) << 2) | lw0)), vh2 = vtr(Vb + rowb + 256 * (16 * ks + 4) + 16 * (((vdb ^ q4) << 2) | lw1));
        const bf16x8 vf = {vl[0], vl[1], vl[2], vl[3], vh2[0], vh2[1], vh2[2], vh2[3]};
#pragma unroll
        for (int db = 0; db < 4; ++db) {
            const v4i16_t kl = vtr(Kb + rowb + 256 * (16 * ks) + 16 * (((db ^ q4) << 2) | lw0)), kh = vtr(Kb + rowb + 256 * (16 * ks + 4) + 16 * (((db ^ q4) << 2) | lw1));
            const bf16x8 kf = {kl[0], kl[1], kl[2], kl[3], kh[0], kh[1], kh[2], kh[3]};
            acc[db] = __builtin_amdgcn_mfma_f32_32x32x16_bf16(vf, kf, acc[db], 0, 0, 0);
            if (wave == 0) accn[db] = __builtin_amdgcn_mfma_f32_32x32x16_bf16(ones, kf, accn[db], 0, 0, 0);
        }
    }
    float* dc = P.DC + ((size_t)uidx * DV + 32 * wave) * DK + r32;
#pragma unroll
    for (int db = 0; db < 4; ++db)
#pragma unroll
        for (int r = 0; r < 16; ++r) dc[(size_t)((r & 3) + 8 * (r >> 2) + 4 * hi) * DK + 32 * db] = acc[db][r];
    if (wave == 0 && hi == 0) {
#pragma unroll
        for (int db = 0; db < 4; ++db) P.DN[uidx * DK + 32 * db + r32] = accn[db][0]; }
    if (tid == 0) { P.MLOC[uidx] = s_sc[1] + s_sc[0]; P.BLAST[uidx] = s_sc[1]; }
    __syncthreads();
}

__device__ __forceinline__ void mx3_unit(const MixP& P, LAS unsigned char* lds, int tid, int b, int h, int c) {
    const int lane = tid & 63, wave = __builtin_amdgcn_readfirstlane(tid >> 6), r32 = lane & 31, hi = lane >> 5;
    const int qb = wave & 3, vh = wave >> 2;
    LAS float* sm = (LAS float*)(lds + SM_OFF); LAS float *s_g2 = sm, *s_M2 = sm + 128, *s_bc = sm + 256, *s_nin = sm + 384, *s_part = sm + 512;
    const size_t rowbase = (size_t)b * SEQ + c * CH; const int uidx = (b * MH + h) * NCH + c;
    const float m_in = P.MIN[uidx];
    stage_v(P.Vm, rowbase, h, lds, tid);
    if (wave == 0) { float bc0, bc1, g0, g1; gate_scan(P, rowbase, h, lane, bc0, bc1, g0, g1);
        float y = fmaxf(g0, g1);
#pragma unroll
        for (int off = 1; off < 64; off <<= 1) { const float z = lane_up(y, off, lane); if (lane >= off) y = fmaxf(y, z); }
        float ex = lane_up(y, 1, lane); if (lane == 0) ex = -INFINITY;
        const float M0 = fmaxf(m_in, fmaxf(ex, g0)), M1 = fmaxf(m_in, y);
        s_g2[2 * lane] = g0 * LOG2E; s_g2[2 * lane + 1] = g1 * LOG2E; s_M2[2 * lane] = M0 * LOG2E; s_M2[2 * lane + 1] = M1 * LOG2E; s_bc[2 * lane] = bc0; s_bc[2 * lane + 1] = bc1; }
    if (wave == 1) { s_nin[lane] = P.NIN[uidx * DK + lane]; s_nin[64 + lane] = P.NIN[uidx * DK + 64 + lane]; }
    const int t = 32 * qb + r32;
    bf16x8 qf[8];
    { const bf16* qp = P.Qm + (rowbase + t) * MQK + h * DK + hi * 8;
#pragma unroll
      for (int d = 0; d < 8; ++d) qf[d] = *(const GAS bf16x8*)(qp + d * 16); }
    __syncthreads();
    const float M2 = s_M2[t], bct = s_bc[t];
    const float wint = __builtin_amdgcn_exp2f(m_in * LOG2E - M2);
    f32x16 acc[4];
#pragma unroll
    for (int i = 0; i < 4; ++i)
#pragma unroll
        for (int r = 0; r < 16; ++r) acc[i][r] = 0.f;
    { const bf16* cp = P.CIN + ((size_t)uidx * DV + 128 * vh + r32) * DK + hi * 8;
#pragma unroll
      for (int vb = 0; vb < 4; ++vb)
#pragma unroll
          for (int d = 0; d < 8; ++d) { const bf16x8 cf = *(const GAS bf16x8*)(cp + (size_t)(32 * vb) * DK + d * 16); acc[vb] = __builtin_amdgcn_mfma_f32_32x32x16_bf16(cf, qf[d], acc[vb], 0, 0, 0); } }
#pragma unroll
    for (int i = 0; i < 4; ++i)
#pragma unroll
        for (int r = 0; r < 16; ++r) acc[i][r] *= wint;
    float qn = 0.f;
#pragma unroll
    for (int d = 0; d < 8; ++d)
#pragma unroll
        for (int j = 0; j < 8; ++j) qn += bf2f((bf16)qf[d][j]) * s_nin[16 * d + 8 * hi + j];
    float den = wint * half_sum(qn), dpart = 0.f;
    const int i16 = lane & 15, q4 = i16 >> 2, p4 = i16 & 3, gb = (lane >> 4) & 1;
    const int vlow0 = ((2 * gb + (p4 >> 1)) ^ hi), vlow1 = vlow0 ^ 2;
    const int vrow0 = 256 * (4 * hi + q4) + 8 * (p4 & 1);
    const LAS unsigned char* Vb = lds + vh * 32768;
    for (int kb = 0; kb <= qb; ++kb) {
        f32x16 p;
#pragma unroll
        for (int r = 0; r < 16; ++r) p[r] = 0.f;
        { const bf16* kp = P.Km + (rowbase + 32 * kb + r32) * MQK + h * DK + hi * 8;
#pragma unroll
          for (int d = 0; d < 8; ++d) { const bf16x8 kf = *(const GAS bf16x8*)(kp + d * 16); p = __builtin_amdgcn_mfma_f32_32x32x16_bf16(kf, qf[d], p, 0, 0, 0); } }
#pragma unroll
        for (int m = 0; m < 4; ++m) { const f32x4 gq = *(const LAS f32x4*)(s_g2 + 32 * kb + 8 * m + 4 * hi);
#pragma unroll
            for (int i = 0; i < 4; ++i) { const int r = 4 * m + i; float w = __builtin_amdgcn_exp2f(gq[i] - M2); if (kb == qb) w = (8 * m + 4 * hi + i <= r32) ? w : 0.f; p[r] *= w; dpart += p[r]; } }
        bf16x8 af[2];
#pragma unroll
        for (int s = 0; s < 2; ++s) { v4u aw; aw.x = cvtpk_s(p[8 * s], p[8 * s + 1]); aw.y = cvtpk_s(p[8 * s + 2], p[8 * s + 3]); aw.z = cvtpk_s(p[8 * s + 4], p[8 * s + 5]); aw.w = cvtpk_s(p[8 * s + 6], p[8 * s + 7]); af[s] = __builtin_bit_cast(bf16x8, aw); }
        const LAS unsigned char* Vk = Vb + 256 * 32 * kb;
#pragma unroll
        for (int s = 0; s < 2; ++s)
#pragma unroll
            for (int vb = 0; vb < 4; ++vb) {
                const int c0 = (((vb ^ q4) << 2) | vlow0), c1 = (((vb ^ q4) << 2) | vlow1);
                const v4i16_t lo = vtr(Vk + vrow0 + 256 * (16 * s) + 16 * c0), hh = vtr(Vk + vrow0 + 256 * (16 * s + 8) + 16 * c1);
                const bf16x8 vf = {lo[0], lo[1], lo[2], lo[3], hh[0], hh[1], hh[2], hh[3]};
                acc[vb] = __builtin_amdgcn_mfma_f32_32x32x16_bf16(vf, af[s], acc[vb], 0, 0, 0);
            }
    }
    den += half_sum(dpart);
    const float mt = bct + M2 * LN2;
    const float scl = 1.f / fmaxf(fabsf(den), __expf(-mt));
    float ss = 0.f;
#pragma unroll
    for (int i = 0; i < 4; ++i)
#pragma unroll
        for (int r = 0; r < 16; ++r) { acc[i][r] *= scl; ss += acc[i][r] * acc[i][r]; }
    ss = half_sum(ss);
    if (hi == 0) s_part[wave * 32 + r32] = ss;
    __syncthreads();
    const float tot = s_part[qb * 32 + r32] + s_part[(4 + qb) * 32 + r32];
    const float rstd = 1.f / sqrtf(tot * (1.f / DV) + EPS);
    { const int vbase = h * DV + 128 * vh + 4 * hi;
      const bf16* op = P.Om + (rowbase + t) * MLW + vbase; bf16* mp = P.MIX + (rowbase + t) * DM + LRU_W + vbase; const float* ng = P.mng + vbase;
#pragma unroll
      for (int vb = 0; vb < 4; ++vb)
#pragma unroll
          for (int g = 0; g < 4; ++g) { const int vo = 32 * vb + 8 * g; const f32x4 n4 = *(const GAS f32x4*)(ng + vo); const v2u ob = *(const GAS v2u*)(op + vo);
              const float o0 = sigmoidf_(bflo(ob.x)), o1 = sigmoidf_(bfhi(ob.x)), o2 = sigmoidf_(bflo(ob.y)), o3 = sigmoidf_(bfhi(ob.y));
              v2u w; w.x = cvtpk_s(acc[vb][4 * g] * rstd * n4.x * o0, acc[vb][4 * g + 1] * rstd * n4.y * o1); w.y = cvtpk_s(acc[vb][4 * g + 2] * rstd * n4.z * o2, acc[vb][4 * g + 3] * rstd * n4.w * o3);
              *(GAS v2u*)(mp + vo) = w; } }
    __syncthreads();
}
}
#ifndef MX1M_UNIT
#define MX1M_UNIT mls::mx1_unit
#endif
#ifndef MX3M_UNIT
#define MX3M_UNIT mls::mx3_unit
#endif

__device__ __forceinline__ KArgs fresh_args() { KArgs p = (KArgs)__builtin_amdgcn_kernarg_segment_ptr(); asm volatile("" : "+s"(p)); return p; }
__device__ __forceinline__ void fill_mixp(MixP& P, KArgs ap, unsigned char* ws, int j) {
    P.XA = (const float*)(ws + WS_P0); P.YA = (const bf16*)(ws + WS_P0 + 32 * MiB); P.Qm = (const bf16*)(ws + WS_P0 + 48 * MiB); P.Km = (const bf16*)(ws + WS_P0 + 56 * MiB);
    P.Vm = (const bf16*)(ws + WS_P0 + 64 * MiB); P.Om = (const bf16*)(ws + WS_P0 + 80 * MiB); P.IG = (const float*)(ws + WS_IG); P.FG = (const float*)(ws + WS_IG + 128 * 1024); P.MIX = (bf16*)(ws + WS_MIX);
    P.conv_w = ap->in[11] + (size_t)j * 4 * LRU_W; P.conv_b = ap->in[12] + (size_t)j * LRU_W; P.gate_w = ap->in[13] + (size_t)j * 2 * NBLK * BW * BW; P.gate_b = ap->in[14] + (size_t)j * 2 * LRU_W;
    P.lam = ap->in[15] + (size_t)j * LRU_W; P.mgb = ap->in[16] + (size_t)j * 2 * MH; P.mng = ap->in[17] + (size_t)j * MLW;
    P.DC = (float*)(ws + WS_DC); P.CIN = (bf16*)(ws + WS_CIN); P.DN = (float*)(ws + WS_SMALL); P.NIN = (float*)(ws + WS_SMALL + 128 * 1024); P.MLOC = (float*)(ws + WS_SMALL + 256 * 1024);
    P.BLAST = (float*)(ws + WS_SMALL + 257 * 1024); P.MIN = (float*)(ws + WS_SMALL + 258 * 1024); P.HLOC = (float*)(ws + WS_HLOC); P.PCUM = (float*)(ws + WS_PCUM);
    P.AGGP = (float*)(ws + WS_AGG); P.AGGH = (float*)(ws + WS_AGG + 256 * 1024); P.HTMP = (float*)(ws + WS_HTMP);
}
__global__ void __launch_bounds__(NWAVES * 64, 2) fwd_kernel(Args args) {
    extern __shared__ __attribute__((aligned(16))) unsigned char lds_raw[];
    LAS unsigned char* lds = (LAS unsigned char*)lds_raw;
    const int tid0 = threadIdx.x; const int wave_s = __builtin_amdgcn_readfirstlane(tid0 >> 6);
    const int G = gridDim.x, bx = blockIdx.x; const int vcu = (G % 8 == 0) ? (bx % 8) * (G / 8) + bx / 8 : bx;
    const int NGW = G * NWAVES;
#define FRESH() const int tid = fresh_tid(wave_s), lane = tid & 63, wave = __builtin_amdgcn_readfirstlane(tid >> 6), gw = vcu * NWAVES + wave; (void)lane; (void)gw; const KArgs ap = fresh_args(); unsigned char* const ws = ap->ws; (void)ws
    volatile LAS unsigned* MISC = (volatile LAS unsigned*)(lds + MISC_OFF);
    if (tid0 < 64) MISC[tid0] = 0u;
    __syncthreads();
    XcdBarrier bar = xcd_barrier_post((unsigned*)(args.ws + WS_CTL) + CW_BAR, MISC + 8);
#define GRID_BAR() do { XcdBarrier b2_ = bar; asm volatile("" : "+s"(b2_.x)); asm volatile("" : "+s"(b2_.bar)); xcd_barrier(b2_); } while (0)

    { FRESH(); p0_prologue(ap, lds, tid, lane, wave, vcu, G); }
    GRID_BAR();

    for (int layer = 0; layer < DEPTH; ++layer) {
        const int j = layer >> 1;
        { FRESH(); norm_phase((layer == 0) ? ap->in[0] : ap->out, ap->in[4] + (size_t)(layer * 2 + 0) * DM, (const float*)(ws + WS_MOD) + (size_t)(layer * 2 + 0) * 2 * 6144, (bf16*)(ws + WS_HN), lane, gw, NGW); }
        GRID_BAR();
        if ((layer & 1) == 0) {
            { FRESH(); pg8::Gemm g{(const bf16*)(ws + WS_HN), (const bf16*)(ws + WS_WABIN) + (size_t)j * AB_IN_PAD * 2048, M, AB_IN_PAD, DM}; pg8::StaticOrder S; S.init(M, AB_IN_PAD, G, bx);
              pg8::EpiInProj E{(float*)(ws + WS_P0), (bf16*)(ws + WS_P0 + 32 * MiB), (bf16*)(ws + WS_P0 + 48 * MiB), (bf16*)(ws + WS_P0 + 56 * MiB), (bf16*)(ws + WS_P0 + 64 * MiB), (bf16*)(ws + WS_P0 + 80 * MiB),
                               (float*)(ws + WS_IG), (float*)(ws + WS_IG + 128 * 1024), 0.08838834764831845f};
              pg8::gemm_phase<pg8::EpiInProj, pg8::StaticOrder, PG8_ALIGN, PG8_SP2>(lds, g, S, E, tid); }
            GRID_BAR();
            { FRESH(); MixP P; fill_mixp(P, ap, ws, j);
              for (int u = vcu; u < 768; u += G) {
                if (u < 256) MX1M_UNIT(P, lds, tid, u >> 7, (u >> 5) & 3, u & 31);
                else { const int r = u - 256; mx1_rglru_unit(P, lds, tid, r >> 8, (r >> 5) & 7, r & 31); }
            } }
            GRID_BAR();
            { FRESH(); MixP P; fill_mixp(P, ap, ws, j); mx2_mlstm(P, lds, tid, vcu * 512 + tid, G * 512); }
            GRID_BAR();
            { FRESH(); MixP P; fill_mixp(P, ap, ws, j);
              for (int u = vcu; u < 384; u += G) {
                if (u < 256) MX3M_UNIT(P, lds, tid, u >> 7, (u >> 5) & 3, u & 31);
                else { const int r = u - 256; mx3_rglru_unit(P, tid, r >> 6, (r >> 1) & 31, r & 1); }
            } }
            GRID_BAR();
        } else {
            { FRESH(); pg8::Gemm g{(const bf16*)(ws + WS_HN), (const bf16*)(ws + WS_WQKV) + (size_t)j * 6144 * 2048, M, 6144, DM}; pg8::StaticOrder S; S.init(M, 6144, G, bx);
              pg8::EpiBf16Split E{(bf16*)(ws + WS_P0), DM, DM, (size_t)M * DM, 0.08838834764831845f * LOG2E};
              pg8::gemm_phase<pg8::EpiBf16Split, pg8::StaticOrder, PG8_ALIGN, PG8_SP2>(lds, g, S, E, tid); }
            GRID_BAR();
            { FRESH(); sba::attn_phase((const bf16*)(ws + WS_P0), (const bf16*)(ws + WS_P0) + (size_t)M * DM, (const bf16*)(ws + WS_P0) + (size_t)2 * M * DM, (bf16*)(ws + WS_MIX), lds, tid, vcu, G); }
            GRID_BAR();
        }
        { FRESH(); const bf16* Bt = ((layer & 1) == 0) ? (const bf16*)(ws + WS_WABOUT) + (size_t)j * 2048 * 2048 : (const bf16*)(ws + WS_WSBO) + (size_t)j * 2048 * 2048;
          pg8::Gemm g{(const bf16*)(ws + WS_MIX), Bt, M, DM, DM}; pg8::StaticOrder S; S.init(M, DM, G, bx);
          pg8::EpiResid E{(layer == 0) ? ap->in[0] : ap->out, ap->out, (const float*)(ws + WS_MOD) + (size_t)(layer * 2 + 0) * 2 * 6144 + 4096};
          pg8::gemm_phase<pg8::EpiResid, pg8::StaticOrder, PG8_ALIGN, PG8_SP2>(lds, g, S, E, tid); }
        GRID_BAR();
        { FRESH(); norm_phase(ap->out, ap->in[4] + (size_t)(layer * 2 + 1) * DM, (const float*)(ws + WS_MOD) + (size_t)(layer * 2 + 1) * 2 * 6144, (bf16*)(ws + WS_HN), lane, gw, NGW); }
        GRID_BAR();
        { FRESH(); pg8::Gemm g{(const bf16*)(ws + WS_HN), (const bf16*)(ws + WS_W13) + (size_t)layer * 2 * FF * 2048, M, 2 * FF, DM}; pg8::StaticOrder S; S.init(M, 2 * FF, G, bx);
          pg8::EpiSwiGLU E{(bf16*)(ws + WS_ACT)};
          pg8::gemm_phase<pg8::EpiSwiGLU, pg8::StaticOrder, PG8_ALIGN, PG8_SP2>(lds, g, S, E, tid); }
        GRID_BAR();
        { FRESH(); pg8::Gemm g{(const bf16*)(ws + WS_ACT), (const bf16*)(ws + WS_W2) + (size_t)layer * 2048 * FF, M, DM, FF}; pg8::StaticOrder S; S.init(M, DM, G, bx);
          pg8::EpiResid E{ap->out, ap->out, (const float*)(ws + WS_MOD) + (size_t)(layer * 2 + 1) * 2 * 6144 + 4096};
          pg8::gemm_phase<pg8::EpiResid, pg8::StaticOrder, PG8_ALIGN, PG8_SP2>(lds, g, S, E, tid); }
        GRID_BAR();
    }
    { FRESH(); final_norm_phase(ap->out, ap->in[5], ap->out, lane, gw, NGW); }
}

extern "C" void kernel_launch(void* const* d_in, const int* in_sizes, int n_in, void* d_out, int out_size, void* d_ws, size_t ws_size, hipStream_t stream) {
    static int grid = 0;
    if (grid == 0) {
        if (n_in != 20 || in_sizes[0] != M * DM || out_size != M * DM || ws_size < WS_END) { fprintf(stderr, "kernel_launch: unexpected shapes: n_in %d in0 %d out %d ws %zu (need %zu); nothing launched\n", n_in, n_in > 0 ? in_sizes[0] : -1, out_size, ws_size, (size_t)WS_END); grid = -1; return; }
        int dev = 0, cus = 0, per_cu = 0;
        if (hipGetDevice(&dev) != hipSuccess || hipDeviceGetAttribute(&cus, hipDeviceAttributeMultiprocessorCount, dev) != hipSuccess) { fprintf(stderr, "kernel_launch: device query failed\n"); grid = -1; return; }
        if (hipFuncSetAttribute((const void*)fwd_kernel, hipFuncAttributeMaxDynamicSharedMemorySize, LDS_BYTES) != hipSuccess) { fprintf(stderr, "kernel_launch: hipFuncSetAttribute failed\n"); grid = -1; return; }
        if (hipOccupancyMaxActiveBlocksPerMultiprocessor(&per_cu, (const void*)fwd_kernel, NWAVES * 64, LDS_BYTES) != hipSuccess || per_cu < 1)
            fprintf(stderr, "kernel_launch: note: occupancy query reports %d workgroups per CU\n", per_cu);
        (void)hipGetLastError();
        grid = cus;
    }
    if (grid < 0) return;
    if (hipMemsetAsync((char*)d_ws + WS_CTL, 0, CTL_ZERO_BYTES, stream) != hipSuccess) { fprintf(stderr, "kernel_launch: memset failed\n"); return; }
    Args a{};
    for (int i = 0; i < 20; ++i) a.in[i] = (const float*)d_in[i];
    a.out = (float*)d_out; a.ws = (unsigned char*)d_ws;
    hipLaunchKernelGGL(fwd_kernel, dim3(grid), dim3(NWAVES * 64), LDS_BYTES, stream, a);
    const hipError_t le = hipPeekAtLastError();
    if (le != hipSuccess) fprintf(stderr, "kernel_launch: launch failed: %s\n", hipGetErrorName(le));
}
```

```cpp
#include <hip/hip_runtime.h>
#include <cstdio>
#include <cstdint>

constexpr int NWAVES = 8;
constexpr int BATCH = 2, SEQ = 4096, DM = 2048, DEPTH = 4, M = BATCH * SEQ;
constexpr int LRU_W = 1024, NBLK = 8, BW = 128;
constexpr int MLW = 1024, MH = 4, DV = 256, DK = 128, MQK = 512, CH = 128, NCH = SEQ / CH;
constexpr int AB_IN = 5128, AB_IN_PAD = 5376;
constexpr int SBH = 16, SBD = 128;
constexpr int FF = 5632;
constexpr float EPS = 1e-6f;
constexpr float LOG2E = 1.4426950408889634f, LN2 = 0.6931471805599453f;

constexpr size_t MiB = 1u << 20;
constexpr size_t WS_CTL = 0, CTL_ZERO_BYTES = 1 * MiB;
constexpr size_t WS_MOD = 1 * MiB;
constexpr size_t WS_WABIN = 2 * MiB;
constexpr size_t WS_WABOUT = 44 * MiB;
constexpr size_t WS_WQKV = 60 * MiB;
constexpr size_t WS_WSBO = 108 * MiB;
constexpr size_t WS_W13 = 124 * MiB;
constexpr size_t WS_W2 = 300 * MiB;
constexpr size_t WS_HN = 388 * MiB;
constexpr size_t WS_P0 = 420 * MiB;
constexpr size_t WS_IG = 516 * MiB;
constexpr size_t WS_MIX = 517 * MiB;
constexpr size_t WS_ACT = 549 * MiB;
constexpr size_t WS_DC = 637 * MiB;
constexpr size_t WS_CIN = 669 * MiB;
constexpr size_t WS_SMALL = 685 * MiB;
constexpr size_t WS_HLOC = 686 * MiB;
constexpr size_t WS_PCUM = 718 * MiB;
constexpr size_t WS_AGG = 750 * MiB;
constexpr size_t WS_HTMP = 752 * MiB;
constexpr size_t WS_WGT = 784 * MiB;
constexpr size_t WS_CARRY = 785 * MiB;
constexpr size_t WS_END = 786 * MiB;
constexpr int CW_BAR = 4096;

constexpr int BIG_BYTES = 147456;
constexpr int MISC_OFF = BIG_BYTES;
constexpr int SM_OFF = BIG_BYTES + 1024;
constexpr int LDS_BYTES = 163840;

namespace pg8 {
#define PG8_LAS __attribute__((address_space(3)))
typedef unsigned short bf16_t;
typedef short bf16x8 __attribute__((ext_vector_type(8)));
typedef float f32x4 __attribute__((ext_vector_type(4)));
typedef unsigned u32x4 __attribute__((ext_vector_type(4)));
constexpr int BM = 256, BK = 64, HALF = 128, HTB = HALF * BK * 2  , STAGE_BYTES = 8 * HTB, NXCD = 8, WGM = 8;

__host__ __device__ __forceinline__ int lds_byte(int r, int c) { const int st = (r >> 4) * 2 + (c >> 5), rr = r & 15, cc = c & 31, ob = rr * 64 + cc * 2; return st * 1024 + (ob ^ (((ob >> 9) & 1) << 5)); }
__host__ __device__ __forceinline__ void stage_rc(int b, int& R, int& C) { const int st = b / 1024, sb = b % 1024, swz = sb ^ (((sb >> 9) & 1) << 5); R = (st >> 1) * 16 + swz / 64; C = (st & 1) * 32 + (swz % 64) / 2; }
__host__ __device__ __forceinline__ int perm32(int rho) { const int n = rho >> 4, i = rho & 15; return 8 * (i >> 2) + 4 * n + (i & 3); }

struct Unit { int pm, pn; };
struct Gemm { const bf16_t* A; const bf16_t* Bt; int M, N, K; };

struct StaticOrder {
    int nM, nN, nwg, G, c;
    __host__ __device__ void init(int M, int N, int G_, int c_) { nM = M / BM; nN = N / BM; nwg = nM * nN; G = G_; c = c_; }
    __host__ __device__ bool next(int i, Unit& u) const {
        const long L = (long)i * G + c; if (L >= nwg) return false;
        int wgid = (int)L; { const int q = nwg / NXCD, r = nwg % NXCD, xcd = wgid % NXCD, off = wgid / NXCD; wgid = (xcd < r ? xcd * (q + 1) : r * (q + 1) + (xcd - r) * q) + off; }
        const int nig = WGM * nN, gid = wgid / nig, fm = gid * WGM, gsz = (nM - fm) < WGM ? (nM - fm) : WGM;
        u.pm = fm + ((wgid % nig) % gsz); u.pn = (wgid % nig) / gsz; return true;
    }
    __device__ __forceinline__ void a_ready(const Unit&) const {}
    __device__ __forceinline__ void done(const Unit&) const {}
};

__device__ __forceinline__ unsigned cvt_pk_bf16(float lo, float hi) { unsigned r; asm volatile("v_cvt_pk_bf16_f32 %0, %1, %2" : "=v"(r) : "v"(lo), "v"(hi)); return r; }
typedef float f32x2 __attribute__((ext_vector_type(2)));
__device__ __forceinline__ u32x4 pack8(f32x4 v0, f32x4 v1) { u32x4 w; w.x = cvt_pk_bf16(v0[0], v0[1]); w.y = cvt_pk_bf16(v0[2], v0[3]); w.z = cvt_pk_bf16(v1[0], v1[1]); w.w = cvt_pk_bf16(v1[2], v1[3]); return w; }

struct EpiBf16Split {
    static constexpr bool PERM = true, AFTER_DRAIN = false;
    bf16_t* O; int ldc; int split_cols; size_t split_stride; float scale0;
    __device__ __forceinline__ void operator()(const f32x4 (&acc)[2][2][4][2], const Unit& u, int wr, int wc, int fr, int fq) const {
        const int row0 = u.pm * BM + wr * 64 + fr; int colt = u.pn * BM; bf16_t* base = O;
        float sc = 1.f; { const int t = colt / split_cols; base += (size_t)t * split_stride; colt -= t * split_cols; if (t == 0) sc = scale0; }
        const int col0 = colt + wc * 32 + 8 * fq;
#pragma unroll
        for (int ai = 0; ai < 2; ++ai)
#pragma unroll
            for (int m = 0; m < 4; ++m) { bf16_t* rowp = base + (size_t)(row0 + ai * HALF + m * 16) * ldc + col0;
#pragma unroll
                for (int bj = 0; bj < 2; ++bj) { *(u32x4*)(rowp + bj * HALF) = pack8(acc[ai][bj][m][0] * sc, acc[ai][bj][m][1] * sc); } }
    }
};

struct EpiResid {
    static constexpr bool PERM = true, AFTER_DRAIN = false;
    const float* base; float* out; const float* gate0;
    __device__ __forceinline__ void operator()(const f32x4 (&acc)[2][2][4][2], const Unit& u, int wr, int wc, int fr, int fq) const {
        const int row0 = u.pm * BM + wr * 64 + fr, col0 = u.pn * BM + wc * 32 + 8 * fq;
        const float* gp = gate0 + (u.pm >= 16 ? 6144 : 0) + col0;
        f32x4 gv[2][2];
#pragma unroll
        for (int bj = 0; bj < 2; ++bj)
#pragma unroll
            for (int n = 0; n < 2; ++n) gv[bj][n] = *(const f32x4*)(gp + bj * HALF + 4 * n);
#pragma unroll
        for (int ai = 0; ai < 2; ++ai)
#pragma unroll
            for (int m = 0; m < 4; ++m) { const size_t off = (size_t)(row0 + ai * HALF + m * 16) * 2048 + col0;
#pragma unroll
                for (int bj = 0; bj < 2; ++bj)
#pragma unroll
                    for (int n = 0; n < 2; ++n) { const f32x4 b = *(const f32x4*)(base + off + bj * HALF + 4 * n); *(f32x4*)(out + off + bj * HALF + 4 * n) = b + gv[bj][n] * acc[ai][bj][m][n]; }
                if (m & 1) asm volatile("" ::: "memory"); }
    }
};

struct EpiSwiGLU {
    static constexpr bool PERM = true, AFTER_DRAIN = false;
    bf16_t* O;
    static __device__ __forceinline__ f32x4 silu_mul(f32x4 a, f32x4 b) { f32x4 r;
#pragma unroll
        for (int i = 0; i < 4; ++i) { const float e = __builtin_amdgcn_exp2f(-a[i] * 1.4426950408889634f); r[i] = a[i] * __builtin_amdgcn_rcpf(1.f + e) * b[i]; }
        return r; }
    __device__ __forceinline__ void operator()(const f32x4 (&acc)[2][2][4][2], const Unit& u, int wr, int wc, int fr, int fq) const {
        const int row0 = u.pm * BM + wr * 64 + fr, col0 = u.pn * HALF + wc * 32 + 8 * fq;
#pragma unroll
        for (int ai = 0; ai < 2; ++ai)
#pragma unroll
            for (int m = 0; m < 4; ++m) { bf16_t* rowp = O + (size_t)(row0 + ai * HALF + m * 16) * 5632 + col0;
                *(u32x4*)rowp = pack8(silu_mul(acc[ai][0][m][0], acc[ai][1][m][0]), silu_mul(acc[ai][0][m][1], acc[ai][1][m][1])); }
    }
};

struct EpiInProj {
    static constexpr bool PERM = true, AFTER_DRAIN = false;
    float* XA; bf16_t *YA, *Qm, *Km, *Vm, *Om; float *IG, *FG; float kscale;
    __device__ __forceinline__ void operator()(const f32x4 (&acc)[2][2][4][2], const Unit& u, int wr, int wc, int fr, int fq) const {
        const int pn = u.pn, row0 = u.pm * BM + wr * 64 + fr, cl = wc * 32 + 8 * fq;
        if (pn < 4) {
#pragma unroll
            for (int ai = 0; ai < 2; ++ai)
#pragma unroll
                for (int m = 0; m < 4; ++m) { float* rp = XA + (size_t)(row0 + ai * HALF + m * 16) * 1024 + pn * 256 + cl;
#pragma unroll
                    for (int bj = 0; bj < 2; ++bj)
#pragma unroll
                        for (int n = 0; n < 2; ++n) *(f32x4*)(rp + bj * HALF + 4 * n) = acc[ai][bj][m][n]; }
        } else if (pn < 20) {
            bf16_t* base; int ld, colt; float sc = 1.f;
            if (pn < 8) { base = YA; ld = 1024; colt = (pn - 4) * 256; }
            else if (pn < 10) { base = Qm; ld = 512; colt = (pn - 8) * 256; }
            else if (pn < 12) { base = Km; ld = 512; colt = (pn - 10) * 256; sc = kscale; }
            else if (pn < 16) { base = Vm; ld = 1024; colt = (pn - 12) * 256; }
            else { base = Om; ld = 1024; colt = (pn - 16) * 256; }
#pragma unroll
            for (int ai = 0; ai < 2; ++ai)
#pragma unroll
                for (int m = 0; m < 4; ++m) { bf16_t* rowp = base + (size_t)(row0 + ai * HALF + m * 16) * ld + colt + cl;
#pragma unroll
                    for (int bj = 0; bj < 2; ++bj) *(u32x4*)(rowp + bj * HALF) = pack8(acc[ai][bj][m][0] * sc, acc[ai][bj][m][1] * sc); }
        } else {
            if (wc == 0 && fq == 0) {
#pragma unroll
                for (int ai = 0; ai < 2; ++ai)
#pragma unroll
                    for (int m = 0; m < 4; ++m) { const size_t r = (size_t)(row0 + ai * HALF + m * 16); *(f32x4*)(IG + r * 4) = acc[ai][0][m][0]; *(f32x4*)(FG + r * 4) = acc[ai][0][m][1]; }
            }
        }
    }
};

template <class Epi, class Sched, bool ALIGN_EPI = false, bool SP2 = false>
__device__ __forceinline__ void gemm_phase(PG8_LAS unsigned char* lds, const Gemm g, const Sched& S, const Epi& E, int tid_in) {
    const int tid = tid_in, wid = __builtin_amdgcn_readfirstlane(tid >> 6), lane = tid & 63, wr = wid >> 2, wc = wid & 3, fr = lane & 15, fq = lane >> 4;
    const int K = g.K, nt = K / BK;
    unsigned voffA[2], voffB[2];
#pragma unroll
    for (int i = 0; i < 2; ++i) { int R, C; stage_rc(tid * 16 + i * 8192, R, C); const int Rb = Epi::PERM ? ((R & ~31) + perm32(R & 31)) : R;
        voffA[i] = (unsigned)(R * K + C) * 2u; voffB[i] = (unsigned)(Rb * K + C) * 2u; }
    const size_t kstep = (size_t)(BK * 2);
    const size_t hstep = (size_t)HALF * K * 2;
    const size_t tstep = 2 * hstep;
    const unsigned ldsw = (unsigned)wid * 1024u;
    const int aoff = lds_byte(wr * 64 + fr, fq * 8), boff = lds_byte(wc * 32 + fr, fq * 8);
#define PG8_SA(b, h) (((b) * 2 + (h)) * HTB)
#define PG8_SB(b, h) ((4 + (b) * 2 + (h)) * HTB)
#define PG8_STAGE(bufoff, gbase, voff) do { _Pragma("unroll") for (int _i = 0; _i < 2; ++_i) \
        __builtin_amdgcn_global_load_lds((const unsigned*)((const char*)(gbase) + (voff)[_i]), (PG8_LAS unsigned*)(lds + (bufoff) + ldsw + _i * 8192), 16, 0, 0); } while (0)
#define PG8_LDA(dst, b, h) do { _Pragma("unroll") for (int m = 0; m < 4; ++m) _Pragma("unroll") for (int k = 0; k < 2; ++k) dst[m][k] = *(const PG8_LAS bf16x8*)(lds + PG8_SA(b, h) + aoff + m * 2048 + k * 1024); } while (0)
#define PG8_LDB(dst, b, h) do { _Pragma("unroll") for (int n = 0; n < 2; ++n) _Pragma("unroll") for (int k = 0; k < 2; ++k) dst[n][k] = *(const PG8_LAS bf16x8*)(lds + PG8_SB(b, h) + boff + n * 2048 + k * 1024); } while (0)
#define PG8_MMA(ai, bj, At, Bt) do { __builtin_amdgcn_s_setprio(1); _Pragma("unroll") for (int m = 0; m < 4; ++m) _Pragma("unroll") for (int n = 0; n < 2; ++n) _Pragma("unroll") for (int k = 0; k < 2; ++k) \
        acc[ai][bj][m][n] = __builtin_amdgcn_mfma_f32_16x16x32_bf16(Bt[n][k], At[m][k], acc[ai][bj][m][n], 0, 0, 0); __builtin_amdgcn_s_setprio(0); } while (0)
#define PG8_WAIT_V(n) asm volatile("s_waitcnt vmcnt(" #n ")" ::: "memory")
#define PG8_WAIT_L(n) asm volatile("s_waitcnt lgkmcnt(" #n ")" ::: "memory")
#define PG8_BAR __builtin_amdgcn_s_barrier()
#define PG8_SCHED __builtin_amdgcn_sched_barrier(0)
    Unit cur, nxt; int ui = 0;
    if (!S.next(0, cur)) return;
    f32x4 acc[2][2][4][2];
#pragma unroll
    for (int a = 0; a < 2; ++a)
#pragma unroll
        for (int b = 0; b < 2; ++b)
#pragma unroll
            for (int m = 0; m < 4; ++m)
#pragma unroll
                for (int n = 0; n < 2; ++n) acc[a][b][m][n] = (f32x4){0.f, 0.f, 0.f, 0.f};
    bf16x8 At[4][2], B0[2][2], B1[2][2];
    const char* cA = (const char*)g.A + (size_t)cur.pm * tstep; const char* cB = (const char*)g.Bt + (size_t)cur.pn * tstep;
    S.a_ready(cur);
    if constexpr (SP2) {
        PG8_STAGE(PG8_SB(0, 0), cB, voffB); PG8_STAGE(PG8_SB(0, 1), cB + hstep, voffB); PG8_STAGE(PG8_SA(0, 0), cA, voffA); PG8_STAGE(PG8_SA(0, 1), cA + hstep, voffA);
        if (wr == 1) PG8_BAR;
        PG8_WAIT_V(2); PG8_BAR;
        PG8_STAGE(PG8_SB(1, 0), cB + kstep, voffB); PG8_STAGE(PG8_SA(1, 0), cA + kstep, voffA); PG8_STAGE(PG8_SB(1, 1), cB + hstep + kstep, voffB);
        PG8_WAIT_V(6); PG8_BAR;
    } else {
        PG8_STAGE(PG8_SB(0, 0), cB, voffB); PG8_STAGE(PG8_SA(0, 0), cA, voffA); PG8_STAGE(PG8_SB(0, 1), cB + hstep, voffB); PG8_STAGE(PG8_SA(0, 1), cA + hstep, voffA);
        if (wr == 1) PG8_BAR;
        PG8_WAIT_V(4); PG8_BAR;
        PG8_STAGE(PG8_SB(1, 0), cB + kstep, voffB); PG8_STAGE(PG8_SA(1, 0), cA + kstep, voffA); PG8_STAGE(PG8_SB(1, 1), cB + hstep + kstep, voffB);
        PG8_WAIT_V(6); PG8_BAR;
    }
    for (;;) {
        const bool has_next = S.next(ui + 1, nxt);
        const char* nA = has_next ? (const char*)g.A + (size_t)nxt.pm * tstep : cA; const char* nB = has_next ? (const char*)g.Bt + (size_t)nxt.pn * tstep : cB;
        for (int t = 0; t < nt; t += 2) {
            const bool last = (t == nt - 2);
            const char* a1 = cA + (size_t)(t + 1) * kstep;
            const char* a2 = last ? nA : cA + (size_t)(t + 2) * kstep; const char* b2 = last ? nB : cB + (size_t)(t + 2) * kstep;
            const char* a3 = a2 + kstep; const char* b3 = b2 + kstep;
            if (last && has_next) S.a_ready(nxt);
            if constexpr (SP2) {
            PG8_LDB(B0, 0, 0); PG8_LDB(B1, 0, 1); PG8_SCHED; PG8_LDA(At, 0, 0); PG8_STAGE(PG8_SA(1, 1), a1 + hstep, voffA);
            PG8_WAIT_V(8); PG8_WAIT_L(0); PG8_BAR; PG8_MMA(0, 0, At, B0); PG8_MMA(0, 1, At, B1); PG8_BAR; PG8_SCHED;
            PG8_LDA(At, 0, 1); PG8_STAGE(PG8_SB(0, 0), b2, voffB); PG8_STAGE(PG8_SB(0, 1), b2 + hstep, voffB); PG8_STAGE(PG8_SA(0, 0), a2, voffA);
            PG8_WAIT_V(8); PG8_WAIT_L(0); PG8_BAR; PG8_MMA(1, 0, At, B0); PG8_MMA(1, 1, At, B1); PG8_BAR; PG8_SCHED;
            PG8_LDB(B0, 1, 0); PG8_LDB(B1, 1, 1); PG8_SCHED; PG8_LDA(At, 1, 0); PG8_STAGE(PG8_SA(0, 1), a2 + hstep, voffA);
            PG8_WAIT_V(8); PG8_WAIT_L(0); PG8_BAR; PG8_MMA(0, 0, At, B0); PG8_MMA(0, 1, At, B1); PG8_BAR; PG8_SCHED;
            PG8_LDA(At, 1, 1); PG8_STAGE(PG8_SB(1, 0), b3, voffB); PG8_STAGE(PG8_SB(1, 1), b3 + hstep, voffB); PG8_STAGE(PG8_SA(1, 0), a3, voffA);
            PG8_WAIT_V(8); PG8_WAIT_L(0); PG8_BAR; PG8_MMA(1, 0, At, B0); PG8_MMA(1, 1, At, B1); PG8_BAR; PG8_SCHED;
            } else {
            PG8_LDB(B0, 0, 0); PG8_SCHED; PG8_LDA(At, 0, 0); PG8_STAGE(PG8_SA(1, 1), a1 + hstep, voffA);
            PG8_WAIT_L(8); PG8_BAR; PG8_WAIT_L(0); PG8_MMA(0, 0, At, B0); PG8_BAR; PG8_SCHED;
            PG8_LDB(B1, 0, 1); PG8_STAGE(PG8_SB(0, 0), b2, voffB);
            PG8_BAR; PG8_WAIT_L(0); PG8_MMA(0, 1, At, B1); PG8_BAR;
            PG8_LDA(At, 0, 1); PG8_STAGE(PG8_SA(0, 0), a2, voffA);
            PG8_BAR; PG8_WAIT_L(0); PG8_MMA(1, 0, At, B0); PG8_BAR; PG8_SCHED;
            PG8_STAGE(PG8_SB(0, 1), b2 + hstep, voffB);
            PG8_WAIT_V(6); PG8_BAR; PG8_MMA(1, 1, At, B1); PG8_BAR;
            PG8_LDB(B0, 1, 0); PG8_SCHED; PG8_LDA(At, 1, 0); PG8_STAGE(PG8_SA(0, 1), a2 + hstep, voffA);
            PG8_WAIT_L(8); PG8_BAR; PG8_WAIT_L(0); PG8_MMA(0, 0, At, B0); PG8_BAR; PG8_SCHED;
            PG8_LDB(B1, 1, 1); PG8_STAGE(PG8_SB(1, 0), b3, voffB);
            PG8_BAR; PG8_WAIT_L(0); PG8_MMA(0, 1, At, B1); PG8_BAR;
            PG8_LDA(At, 1, 1); PG8_STAGE(PG8_SA(1, 0), a3, voffA);
            PG8_BAR; PG8_WAIT_L(0); PG8_MMA(1, 0, At, B0); PG8_BAR; PG8_SCHED;
            PG8_STAGE(PG8_SB(1, 1), b3 + hstep, voffB);
            PG8_WAIT_V(6); PG8_BAR; PG8_MMA(1, 1, At, B1); PG8_BAR;
            }
        }
        if constexpr (ALIGN_EPI) { if (wr == 0) PG8_BAR; }
        if constexpr (!Epi::AFTER_DRAIN) { E(acc, cur, wr, wc, fr, fq); S.done(cur); }
        if (!has_next) break;
#pragma unroll
        for (int a = 0; a < 2; ++a)
#pragma unroll
            for (int b = 0; b < 2; ++b)
#pragma unroll
                for (int m = 0; m < 4; ++m)
#pragma unroll
                    for (int n = 0; n < 2; ++n) acc[a][b][m][n] = (f32x4){0.f, 0.f, 0.f, 0.f};
        cur = nxt; cA = nA; cB = nB; ++ui;
        if constexpr (ALIGN_EPI) { if (wr == 1) PG8_BAR; }
    }
    PG8_WAIT_V(0);
    if constexpr (!ALIGN_EPI) { if (wr == 0) PG8_BAR; }
    PG8_BAR;
    if constexpr (Epi::AFTER_DRAIN) { E.fused(acc, cur, wr, wc, fr, fq, lds, wid, lane); S.done(cur); }
#undef PG8_SA
#undef PG8_SB
#undef PG8_STAGE
#undef PG8_LDA
#undef PG8_LDB
#undef PG8_MMA
#undef PG8_WAIT_V
#undef PG8_WAIT_L
#undef PG8_BAR
#undef PG8_SCHED
}
}
#ifndef PG8_SP2
#define PG8_SP2 true
#endif
#ifndef PG8_ALIGN
#define PG8_ALIGN true
#endif

#define GAS __attribute__((address_space(1)))
#define LAS __attribute__((address_space(3)))
typedef unsigned short bf16;
typedef unsigned v4u __attribute__((ext_vector_type(4)));
typedef unsigned v2u __attribute__((ext_vector_type(2)));
typedef float f32x4 __attribute__((ext_vector_type(4)));
typedef short bf16x8 __attribute__((ext_vector_type(8)));
typedef GAS unsigned gu32;
#define RLX_AGENT __ATOMIC_RELAXED, __HIP_MEMORY_SCOPE_AGENT
#define LDS_WAIT() asm volatile("s_waitcnt lgkmcnt(0)" ::: "memory")
#define VM_WAIT() asm volatile("s_waitcnt vmcnt(0)" ::: "memory")
__device__ __forceinline__ unsigned pk2(float lo, float hi) { return pg8::cvt_pk_bf16(lo, hi); }
__device__ __forceinline__ bf16 f2bf(float x) { return (bf16)(pg8::cvt_pk_bf16(x, 0.f) & 0xffffu); }
__device__ __forceinline__ float bf2f(bf16 b) { return __uint_as_float((unsigned)b << 16); }
__device__ __forceinline__ float bflo(unsigned p) { return __uint_as_float(p << 16); }
__device__ __forceinline__ float bfhi(unsigned p) { return __uint_as_float(p & 0xffff0000u); }
__device__ __forceinline__ float sigmoidf_(float x) { return 1.f / (1.f + __expf(-x)); }
__device__ __forceinline__ float logsigmoidf_(float x) { return fminf(x, 0.f) - log1pf(__expf(-fabsf(x))); }
__device__ __forceinline__ float gelu_tanh(float y) { const float x = 0.7978845608028654f * (y + 0.044715f * y * y * y); const float t = __builtin_amdgcn_exp2f(2.f * LOG2E * x); return 0.5f * y * (2.f - 2.f * __builtin_amdgcn_rcpf(t + 1.f)); }
template <int X> __device__ __forceinline__ float swz_xor(float v) { return __int_as_float(__builtin_amdgcn_ds_swizzle(__float_as_int(v), (X << 10) | 0x1f)); }
__device__ __forceinline__ float xor32(float v) { const unsigned u = __float_as_uint(v); auto rr = __builtin_amdgcn_permlane32_swap(u, u, false, false); const unsigned a = rr[0], b = rr[1]; return __uint_as_float(a ^ b ^ u); }
__device__ __forceinline__ float wave_sum(float v) { v += swz_xor<1>(v); v += swz_xor<2>(v); v += swz_xor<4>(v); v += swz_xor<8>(v); v += swz_xor<16>(v); v += xor32(v); return v; }
__device__ __forceinline__ float wave_max(float v) { v = fmaxf(v, swz_xor<1>(v)); v = fmaxf(v, swz_xor<2>(v)); v = fmaxf(v, swz_xor<4>(v)); v = fmaxf(v, swz_xor<8>(v)); v = fmaxf(v, swz_xor<16>(v)); v = fmaxf(v, xor32(v)); return v; }
__device__ __forceinline__ float lane_up(float x, int off, int lane) { const int src = (lane >= off) ? lane - off : lane; return __int_as_float(__builtin_amdgcn_ds_bpermute(src << 2, __float_as_int(x))); }
__device__ __forceinline__ int fresh_tid(int wave_s) { int l; asm volatile("v_mbcnt_lo_u32_b32 %0, -1, 0\n\tv_mbcnt_hi_u32_b32 %0, -1, %0" : "=v"(l)); int w = wave_s; asm volatile("" : "+s"(w)); int t = w * 64 + l; asm volatile("" : "+v"(t)); return t; }
#define XB_TMO      128
#define XB_XCNT(j)  (256  + 64 * (j))
#define XB_XSUB(j)  (1280 + 64 * (j))
#define XB_XGEN(j)  (2304 + 64 * (j))
#define XB_TOP      3328
#define XB_TOPGEN   3392
#define XCD_BAR_WORDS 3456
#define XB_SPIN_CAP (1u << 18)

__device__ __forceinline__ unsigned xb_ld(unsigned* p)              { return __hip_atomic_load(p, __ATOMIC_RELAXED, __HIP_MEMORY_SCOPE_AGENT); }
__device__ __forceinline__ unsigned xb_add(unsigned* p, unsigned v) { return __hip_atomic_fetch_add(p, v, __ATOMIC_RELAXED, __HIP_MEMORY_SCOPE_AGENT); }
__device__ __forceinline__ unsigned xb_xcc_id() { return (unsigned)__builtin_amdgcn_s_getreg((3 << 11) | 20) & 0xFu; }
#define XB_SPIN(cond, bar) do { unsigned _sp = 0; while (cond) { __builtin_amdgcn_s_sleep(1); \
    if ((++_sp & 255u) == 0u) { if (xb_ld(&(bar)[XB_TMO])) break; if (_sp > XB_SPIN_CAP) { atomicAdd(&(bar)[XB_TMO], 1u); break; } } } } while (0)

struct XcdBarrier {
    unsigned* bar; unsigned x;
    volatile LAS unsigned* st;
};

__device__ __forceinline__ XcdBarrier xcd_barrier_post(unsigned* bar, volatile LAS unsigned* st) {
    XcdBarrier b; b.bar = bar; b.x = xb_xcc_id(); b.st = st;
    if (threadIdx.x == 0) (void)xb_add(&bar[XB_XCNT(b.x)], 1u);
    return b;
}
__device__ __forceinline__ void xcd_barrier_complete(unsigned* bar, unsigned x, unsigned& nloc, unsigned& nx) {
    const unsigned G = gridDim.x * gridDim.y * gridDim.z;
    unsigned sum, cnt, mine, sp = 0u;
    for (;;) {
        sum = 0u; cnt = 0u; mine = 0u;
#pragma unroll
        for (unsigned j = 0; j < 16; ++j) { const unsigned c = xb_ld(&bar[XB_XCNT(j)]); sum += c; cnt += (c > 0u) ? 1u : 0u; mine = (j == x) ? c : mine; }
        if (sum == G) break;
        __builtin_amdgcn_s_sleep(1);
        if ((++sp & 255u) == 0u) { if (xb_ld(&bar[XB_TMO])) break; if (sp > XB_SPIN_CAP) { atomicAdd(&bar[XB_TMO], 1u); break; } }
    }
    nloc = mine > 0u ? mine : 1u; nx = cnt > 0u ? cnt : 1u;
}

__device__ __forceinline__ void xcd_barrier(const XcdBarrier& b) {
    asm volatile("s_waitcnt vmcnt(0)" ::: "memory");
    __syncthreads();
    if (threadIdx.x == 0) {
        unsigned* bar = b.bar;
        __builtin_amdgcn_s_waitcnt(0);
        unsigned nloc = b.st[0], nx = b.st[1];
        if (nloc == 0u) { xcd_barrier_complete(bar, b.x, nloc, nx); b.st[0] = nloc; b.st[1] = nx; }
        const unsigned old = xb_add(&bar[XB_XSUB(b.x)], 1u);
        const unsigned gen = old / nloc;
        if (old + 1u == (gen + 1u) * nloc) {
            __builtin_amdgcn_fence(__ATOMIC_RELEASE, "agent");
            asm volatile("s_waitcnt vmcnt(0)" ::: "memory");
            const unsigned og = xb_add(&bar[XB_TOP], 1u);
            const unsigned tg = og / nx;
            if (og + 1u == (tg + 1u) * nx) xb_add(&bar[XB_TOPGEN], 1u);
            else XB_SPIN(xb_ld(&bar[XB_TOPGEN]) == tg, bar);
            __builtin_amdgcn_fence(__ATOMIC_ACQUIRE, "agent");
            xb_add(&bar[XB_XGEN(b.x)], 1u);
            asm volatile("s_waitcnt vmcnt(0)" ::: "memory");
        } else {
            XB_SPIN(xb_ld(&bar[XB_XGEN(b.x)]) == gen, bar);
            __builtin_amdgcn_fence(__ATOMIC_ACQUIRE, "agent");
            asm volatile("s_waitcnt vmcnt(0)" ::: "memory");
        }
    }
    __syncthreads();
}


struct Args { const float* in[20]; float* out; unsigned char* ws; };
typedef const __attribute__((address_space(4))) Args* KArgs;

__device__ __forceinline__ void transpose_item(const float* W, int K, int N, bf16* WT, int mode, LAS float* scr, int item, int lane) {
    const int nblk = (N + 31) / 32, kb = item / nblk, nb = item % nblk, k0 = 64 * kb, n0 = 32 * nb;
    const int nn = n0 + (lane & 31); const bool ok = nn < N;
#pragma unroll 8
    for (int i = 0; i < 32; ++i) { const int kk = 2 * i + (lane >> 5); scr[kk * 33 + (lane & 31)] = ok ? W[(size_t)(k0 + kk) * N + nn] : 0.f; }
    LDS_WAIT(); asm volatile("" ::: "memory");
    const int c = lane & 7;
    int r0 = n0; if (mode) r0 = 256 * (n0 >> 7) + (n0 & 127) + (mode == 2 ? 128 : 0);
#pragma unroll
    for (int j = 0; j < 4; ++j) { const int n = (lane >> 3) + 8 * j; const LAS float* s = scr + (8 * c) * 33 + n;
        v4u o; o.x = pk2(s[0 * 33], s[1 * 33]); o.y = pk2(s[2 * 33], s[3 * 33]); o.z = pk2(s[4 * 33], s[5 * 33]); o.w = pk2(s[6 * 33], s[7 * 33]);
        if (n0 + n < N) *(GAS v4u*)(WT + (size_t)(r0 + n) * K + k0 + 8 * c) = o; }
    LDS_WAIT(); asm volatile("" ::: "memory");
}

__device__ __forceinline__ void p0_prologue(KArgs args, LAS unsigned char* lds, int tid, int lane, int wave, int vcu, int G) {
    unsigned char* ws = args->ws;
    const int bx = blockIdx.x;
    if (bx < 192) {
        LAS float* cs = (LAS float*)lds;
        LAS float* red = (LAS float*)(lds + 16384);
        const float* c = args->in[1];
        for (int i = tid; i < 4096; i += 512) { const float v = c[i]; cs[i] = v / (1.f + __expf(-v)); }
        __syncthreads();
        const int mat = bx / 24, cg = bx % 24;
        const float* Wp = args->in[2] + (size_t)mat * 2048 * 6144 + cg * 256 + lane * 4;
        f32x4 a0 = {0.f, 0.f, 0.f, 0.f}, a1 = {0.f, 0.f, 0.f, 0.f};
        const int kbeg = wave * 256;
#pragma unroll 8
        for (int k = kbeg; k < kbeg + 256; ++k) { const f32x4 w = *(const GAS f32x4*)(Wp + (size_t)k * 6144); const float c0 = cs[k], c1 = cs[2048 + k]; a0 += c0 * w; a1 += c1 * w; }
        *(LAS f32x4*)(red + (wave * 2 + 0) * 256 + lane * 4) = a0; *(LAS f32x4*)(red + (wave * 2 + 1) * 256 + lane * 4) = a1;
        __syncthreads();
        { const int b = tid >> 8, col = tid & 255; float s = args->in[3][mat * 6144 + cg * 256 + col];
#pragma unroll
          for (int w = 0; w < 8; ++w) s += red[(w * 2 + b) * 256 + col];
          ((float*)(ws + WS_MOD))[(mat * 2 + b) * 6144 + cg * 256 + col] = s; }
        __syncthreads();
    }
    LAS float* scr = (LAS float*)(lds + wave * 16384);
    const int gw = vcu * NWAVES + wave, NGW = G * NWAVES;
    constexpr int I_ABIN = 32 * 161, I_SQ = 32 * 64, I_QKV = 32 * 192, I_W1 = 32 * 176, I_W2 = 88 * 64;
    constexpr int NITEMS = 2 * (I_ABIN + 2 * I_SQ + I_QKV) + 4 * (2 * I_W1 + I_W2) + 256;
    for (int it = gw; it < NITEMS; it += NGW) {
        int r = it;
        if (r < 2 * I_ABIN) { const int j = r / I_ABIN; transpose_item(args->in[9] + (size_t)j * 2048 * AB_IN, 2048, AB_IN, (bf16*)(ws + WS_WABIN) + (size_t)j * AB_IN_PAD * 2048, 0, scr, r % I_ABIN, lane); continue; } r -= 2 * I_ABIN;
        if (r < 2 * I_SQ) { const int j = r / I_SQ; transpose_item(args->in[10] + (size_t)j * 2048 * 2048, 2048, 2048, (bf16*)(ws + WS_WABOUT) + (size_t)j * 2048 * 2048, 0, scr, r % I_SQ, lane); continue; } r -= 2 * I_SQ;
        if (r < 2 * I_QKV) { const int j = r / I_QKV; transpose_item(args->in[18] + (size_t)j * 2048 * 6144, 2048, 6144, (bf16*)(ws + WS_WQKV) + (size_t)j * 6144 * 2048, 0, scr, r % I_QKV, lane); continue; } r -= 2 * I_QKV;
        if (r < 2 * I_SQ) { const int j = r / I_SQ; transpose_item(args->in[19] + (size_t)j * 2048 * 2048, 2048, 2048, (bf16*)(ws + WS_WSBO) + (size_t)j * 2048 * 2048, 0, scr, r % I_SQ, lane); continue; } r -= 2 * I_SQ;
        if (r < 4 * I_W1) { const int l = r / I_W1; transpose_item(args->in[6] + (size_t)l * 2048 * FF, 2048, FF, (bf16*)(ws + WS_W13) + (size_t)l * 2 * FF * 2048, 1, scr, r % I_W1, lane); continue; } r -= 4 * I_W1;
        if (r < 4 * I_W1) { const int l = r / I_W1; transpose_item(args->in[7] + (size_t)l * 2048 * FF, 2048, FF, (bf16*)(ws + WS_W13) + (size_t)l * 2 * FF * 2048, 2, scr, r % I_W1, lane); continue; } r -= 4 * I_W1;
        if (r < 4 * I_W2) { const int l = r / I_W2; transpose_item(args->in[8] + (size_t)l * FF * 2048, FF, 2048, (bf16*)(ws + WS_W2) + (size_t)l * 2048 * FF, 0, scr, r % I_W2, lane); continue; } r -= 4 * I_W2;
        { const int mat = r >> 3; transpose_item(args->in[13] + (size_t)mat * 16384, 128, 128, (bf16*)(ws + WS_WGT) + (size_t)mat * 16384, 0, scr, r & 7, lane); }
    }
}

__device__ __forceinline__ void norm_phase(const float* xin, const float* g, const float* mod  , bf16* HN, int lane, int gw, int NGW) {
    int curb = -1; f32x4 gs[8], sh[8];
    for (int row = gw; row < M; row += NGW) {
        const int b = row >= SEQ ? 1 : 0;
        if (b != curb) { curb = b;
#pragma unroll
            for (int j = 0; j < 8; ++j) { const int col = 4 * lane + 256 * j; const f32x4 gg = *(const GAS f32x4*)(g + col), sc = *(const GAS f32x4*)(mod + b * 6144 + 2048 + col); gs[j] = gg * (1.f + sc); sh[j] = *(const GAS f32x4*)(mod + b * 6144 + col); } }
        const GAS f32x4* xr = (const GAS f32x4*)(xin + (size_t)row * DM) + lane;
        f32x4 v[8]; float ss = 0.f;
#pragma unroll
        for (int j = 0; j < 8; ++j) { v[j] = xr[64 * j]; ss += (v[j].x * v[j].x + v[j].y * v[j].y) + (v[j].z * v[j].z + v[j].w * v[j].w); }
        const float rstd = 1.f / sqrtf(wave_sum(ss) * (1.f / DM) + EPS);
        GAS v2u* o8 = (GAS v2u*)(HN + (size_t)row * DM) + lane;
#pragma unroll
        for (int j = 0; j < 8; ++j) { const f32x4 y = v[j] * rstd * gs[j] + sh[j]; v2u w; w.x = pk2(y.x, y.y); w.y = pk2(y.z, y.w); o8[64 * j] = w; }
    }
}
__device__ __forceinline__ void final_norm_phase(const float* xin, const float* g, float* out, int lane, int gw, int NGW) {
    f32x4 gs[8];
#pragma unroll
    for (int j = 0; j < 8; ++j) gs[j] = *(const GAS f32x4*)(g + 4 * lane + 256 * j);
    for (int row = gw; row < M; row += NGW) {
        const GAS f32x4* xr = (const GAS f32x4*)(xin + (size_t)row * DM) + lane;
        f32x4 v[8]; float ss = 0.f;
#pragma unroll
        for (int j = 0; j < 8; ++j) { v[j] = xr[64 * j]; ss += (v[j].x * v[j].x + v[j].y * v[j].y) + (v[j].z * v[j].z + v[j].w * v[j].w); }
        const float rstd = 1.f / sqrtf(wave_sum(ss) * (1.f / DM) + EPS);
        GAS f32x4* o = (GAS f32x4*)(out + (size_t)row * DM) + lane;
#pragma unroll
        for (int j = 0; j < 8; ++j) o[64 * j] = v[j] * rstd * gs[j];
    }
}

struct MixP {
    const float *XA, *IG, *FG; const bf16 *YA, *Qm, *Km, *Vm, *Om; bf16* MIX;
    const float *conv_w, *conv_b, *gate_w, *gate_b, *lam, *mgb, *mng;
    float *DC, *DN, *NIN, *MLOC, *BLAST, *MIN, *HLOC, *PCUM, *AGGP, *AGGH, *HTMP; bf16* CIN;
};

__device__ __forceinline__ void mx1_rglru_unit(const MixP& P, LAS unsigned char* lds, int tid, int b, int n, int c) {
    LAS float* XC = (LAS float*)lds;
    LAS float* AS = (LAS float*)(lds + 65536);
    const int e = tid & 127, tg = tid >> 7, chn = n * 128 + e;
    const size_t rowbase = (size_t)b * SEQ; const int t0 = c * CH;
    {
        float w[4]; for (int j = 0; j < 4; ++j) w[j] = P.conv_w[j * LRU_W + chn];
        const float cb = P.conv_b[chn];
        for (int i = 0; i < 32; ++i) { const int tt = tg * 32 + i, t = t0 + tt; float acc = cb;
#pragma unroll
            for (int j = 0; j < 4; ++j) { const int ts = t - 3 + j; if (ts >= 0) acc += w[j] * P.XA[(rowbase + ts) * LRU_W + chn]; }
            XC[tt * 128 + e] = acc; }
    }
    __syncthreads();
    float ar[32], ai[32];
    { const float br = P.gate_b[chn], bi = P.gate_b[LRU_W + chn];
#pragma unroll
      for (int i = 0; i < 32; ++i) { ar[i] = br; ai[i] = bi; } }
    { const float* Wr = P.gate_w + ((size_t)(0 * NBLK + n) * 128) * 128 + e; const float* Wi = P.gate_w + ((size_t)(1 * NBLK + n) * 128) * 128 + e;
      for (int d = 0; d < 128; ++d) { const float wr = Wr[d * 128], wi = Wi[d * 128];
#pragma unroll
          for (int i = 0; i < 32; ++i) { const float x = XC[(tg * 32 + i) * 128 + d]; ar[i] += x * wr; ai[i] += x * wi; } } }
    __syncthreads();
    { const float ls = logsigmoidf_(P.lam[chn]);
#pragma unroll
      for (int i = 0; i < 32; ++i) { const int tt = tg * 32 + i; const float r = sigmoidf_(ar[i]), ig = sigmoidf_(ai[i]); const float la = 8.f * r * ls; const float a = __expf(la);
          const float mult = sqrtf(-expm1f(2.f * la)); const float xv = XC[tt * 128 + e]; AS[tt * 128 + e] = a; XC[tt * 128 + e] = mult * (ig * xv); } }
    __syncthreads();
    if (tid < 128) { float h = 0.f, pp = 1.f;
        for (int tt = 0; tt < 128; ++tt) { const float a = AS[tt * 128 + e], u = XC[tt * 128 + e]; h = a * h + u; pp *= a; const size_t o = (rowbase + t0 + tt) * LRU_W + chn; P.HLOC[o] = h; P.PCUM[o] = pp; }
        P.AGGP[(b * NCH + c) * LRU_W + chn] = pp; P.AGGH[(b * NCH + c) * LRU_W + chn] = h; }
    __syncthreads();
}

__device__ __forceinline__ void mx3_rglru_unit(const MixP& P, int tid, int b, int c, int half) {
    const int chn = half * 512 + tid;
    float carry = 0.f;
    for (int c2 = 0; c2 < c; ++c2) carry = P.AGGP[(b * NCH + c2) * LRU_W + chn] * carry + P.AGGH[(b * NCH + c2) * LRU_W + chn];
    for (int tt = 0; tt < CH; ++tt) { const size_t row = (size_t)b * SEQ + c * CH + tt; const float h = P.HLOC[row * LRU_W + chn] + P.PCUM[row * LRU_W + chn] * carry;
        const float y = bf2f(P.YA[row * LRU_W + chn]); P.MIX[row * DM + chn] = f2bf(h * gelu_tanh(y)); }
}

__device__ __forceinline__ void mx1_mlstm_unit(const MixP& P, LAS unsigned char* lds, int tid, int b, int h, int c) {
    LAS bf16* VS = (LAS bf16*)lds;
    LAS float* KS = (LAS float*)(lds + 65536);
    LAS float* sm = (LAS float*)(lds + SM_OFF); LAS float *s_li = sm, *s_lf = sm + 128, *s_bc = sm + 256, *s_g = sm + 384, *s_sc = sm + 768;
    const size_t rowbase = (size_t)b * SEQ + c * CH; const int uidx = (b * MH + h) * NCH + c;
    if (tid < 128) { s_li[tid] = P.IG[(rowbase + tid) * 4 + h] + P.mgb[h]; s_lf[tid] = logsigmoidf_(P.FG[(rowbase + tid) * 4 + h] + P.mgb[MH + h]); }
    __syncthreads();
    if (tid == 0) { float acc = 0.f, G = -INFINITY; for (int s = 0; s < 128; ++s) { acc += s_lf[s]; s_bc[s] = acc; const float g = s_li[s] - acc; s_g[s] = g; G = fmaxf(G, g); } s_sc[0] = G; s_sc[1] = acc; }
    __syncthreads();
    { const float G = s_sc[0]; const int s = tid >> 2, q = tid & 3; const float w = __expf(s_g[s] - G);
      const bf16* vp = P.Vm + (rowbase + s) * MLW + h * DV;
#pragma unroll
      for (int i = 0; i < 8; ++i) { const int ch = q + 4 * i; *(LAS v4u*)(VS + s * 256 + ch * 8) = *(const GAS v4u*)(vp + ch * 8); }
      const bf16* kp = P.Km + (rowbase + s) * MQK + h * DK + q * 32;
#pragma unroll
      for (int i = 0; i < 4; ++i) { const v4u kk = *(const GAS v4u*)(kp + i * 8); LAS float* d = KS + s * 128 + q * 32 + i * 8;
          d[0] = w * bflo(kk.x); d[1] = w * bfhi(kk.x); d[2] = w * bflo(kk.y); d[3] = w * bfhi(kk.y); d[4] = w * bflo(kk.z); d[5] = w * bfhi(kk.z); d[6] = w * bflo(kk.w); d[7] = w * bfhi(kk.w); } }
    __syncthreads();
    { const int d = tid & 127, vg = tid >> 7;
      float* dc = P.DC + ((size_t)uidx * DV + vg * 64) * DK + d;
#pragma unroll 1
      for (int i = 0; i < 64; ++i) { const LAS bf16* vcol = VS + vg * 64 + i; float acc = 0.f;
#pragma unroll 8
          for (int s = 0; s < 128; ++s) acc += KS[s * 128 + d] * bf2f(vcol[s * 256]);
          dc[(size_t)i * DK] = acc; }
      if (tid < 128) { float a = 0.f; for (int s = 0; s < 128; ++s) a += KS[s * 128 + tid]; P.DN[uidx * DK + tid] = a; }
      if (tid == 0) { P.MLOC[uidx] = s_sc[1] + s_sc[0]; P.BLAST[uidx] = s_sc[1]; } }
    __syncthreads();
}

__device__ __forceinline__ void mx2_mlstm(const MixP& P, LAS unsigned char* lds, int tid, int gtid, int NT) {
    LAS float* sm = (LAS float*)(lds + SM_OFF); LAS float *s_dec = sm, *s_scl = sm + 256, *s_min = sm + 512;
    if (tid < 8) { float m = 0.f; for (int k = 0; k < NCH; ++k) { const int u = tid * NCH + k; s_min[u] = m; const float bl = P.BLAST[u], ml = P.MLOC[u]; const float mn = fmaxf(bl + m, ml);
        s_dec[u] = __expf(bl + m - mn); s_scl[u] = __expf(ml - mn); m = mn; } }
    __syncthreads();
    for (int e = gtid; e < 8 * DV * DK; e += NT) { const int chain = e / (DV * DK), idx = e % (DV * DK); float cv = 0.f;
        for (int k = 0; k < NCH; ++k) { const int u = chain * NCH + k; const size_t o = (size_t)u * (DV * DK) + idx; P.CIN[o] = f2bf(cv); cv = s_dec[u] * cv + s_scl[u] * P.DC[o]; } }
    if (gtid < 8 * DK) { const int chain = gtid / DK, d = gtid % DK; float nv = 0.f;
        for (int k = 0; k < NCH; ++k) { const int u = chain * NCH + k; P.NIN[u * DK + d] = nv; nv = s_dec[u] * nv + s_scl[u] * P.DN[u * DK + d]; } }
    if (gtid < 256) P.MIN[gtid] = s_min[gtid];
    __syncthreads();
}

__device__ __forceinline__ void mx3_mlstm_unit(const MixP& P, LAS unsigned char* lds, int tid, int lane, int wave, int b, int h, int c) {
    constexpr int SS = 129, KSTR = 130;
    LAS float* S = (LAS float*)lds;
    LAS bf16* QS = (LAS bf16*)(lds + 66048);
    LAS bf16* KSb = (LAS bf16*)(lds + 66048 + 32768);
    LAS float* sm = (LAS float*)(lds + SM_OFF); LAS float *s_li = sm, *s_lf = sm + 128, *s_bc = sm + 256, *s_g = sm + 384, *s_M = sm + 512, *s_dn = sm + 640, *s_wi = sm + 768, *s_nin = sm + 896;
    const size_t rowbase = (size_t)b * SEQ + c * CH; const int uidx = (b * MH + h) * NCH + c;
    const float m_in = P.MIN[uidx];
    if (tid < 128) { s_li[tid] = P.IG[(rowbase + tid) * 4 + h] + P.mgb[h]; s_lf[tid] = logsigmoidf_(P.FG[(rowbase + tid) * 4 + h] + P.mgb[MH + h]); s_nin[tid] = P.NIN[uidx * DK + tid]; }
    { const int s = tid >> 2, q = tid & 3;
      const bf16* qp = P.Qm + (rowbase + s) * MQK + h * DK + q * 32; const bf16* kp = P.Km + (rowbase + s) * MQK + h * DK + q * 32;
#pragma unroll
      for (int i = 0; i < 4; ++i) { *(LAS v4u*)(QS + s * 128 + q * 32 + i * 8) = *(const GAS v4u*)(qp + i * 8);
          const v4u kk = *(const GAS v4u*)(kp + i * 8); LAS unsigned* kd = (LAS unsigned*)(KSb + s * KSTR + q * 32 + i * 8); kd[0] = kk.x; kd[1] = kk.y; kd[2] = kk.z; kd[3] = kk.w; } }
    __syncthreads();
    if (tid == 0) { float acc = 0.f, cm = m_in; for (int s = 0; s < 128; ++s) { acc += s_lf[s]; s_bc[s] = acc; const float g = s_li[s] - acc; s_g[s] = g; cm = fmaxf(cm, g); s_M[s] = cm; s_wi[s] = __expf(m_in - cm); } }
    __syncthreads();
    { const int s = tid & 127, tg = tid >> 7;
      const float gs = s_g[s]; const LAS unsigned* krow = (const LAS unsigned*)(KSb + s * KSTR);
#pragma unroll 1
      for (int i = 0; i < 32; ++i) { const int t = tg * 32 + i; float acc = 0.f; const LAS unsigned* qrow = (const LAS unsigned*)(QS + t * 128);
#pragma unroll 8
          for (int d2 = 0; d2 < 64; ++d2) { const unsigned qp = qrow[d2], kp = krow[d2]; acc += bflo(qp) * bflo(kp) + bfhi(qp) * bfhi(kp); }
          S[t * SS + s] = (s <= t) ? acc * __expf(gs - s_M[t]) : 0.f; } }
    __syncthreads();
    if (tid < 128) { const int t = tid; float den = 0.f; for (int s = 0; s < 128; ++s) den += S[t * SS + s];
        float qn = 0.f; for (int d = 0; d < 128; ++d) qn += bf2f(QS[t * 128 + d]) * s_nin[d];
        den += s_wi[t] * qn; const float mt = s_bc[t] + s_M[t]; s_dn[t] = 1.f / fmaxf(fabsf(den), __expf(-mt)); }
    __syncthreads();
    { const int v = tid & 255, tg = tid >> 8;
      const bf16* cp = P.CIN + ((size_t)uidx * DV + v) * DK;
      const bf16* vp = P.Vm + rowbase * MLW + h * DV + v;
      float* ht = P.HTMP + (size_t)uidx * CH * DV;
#pragma unroll 1
      for (int i = 0; i < 64; ++i) { const int t = tg * 64 + i; float acc = 0.f; const LAS unsigned* qrow = (const LAS unsigned*)(QS + t * 128);
#pragma unroll 4
          for (int d2 = 0; d2 < 64; ++d2) { const unsigned qp = qrow[d2]; const unsigned cc = *(const GAS unsigned*)(cp + 2 * d2); acc += bflo(qp) * bflo(cc) + bfhi(qp) * bfhi(cc); }
          acc *= s_wi[t];
          const LAS float* srow = S + t * SS;
#pragma unroll 4
          for (int s = 0; s < 128; ++s) acc += srow[s] * bf2f(*(const GAS bf16*)(vp + (size_t)s * MLW));
          ht[t * DV + v] = acc * s_dn[t]; } }
    __syncthreads();
    const float* HS = P.HTMP + (size_t)uidx * CH * DV;
    for (int i = 0; i < 16; ++i) { const int t = wave * 16 + i; const f32x4 hv = *(const GAS f32x4*)(HS + t * 256 + 4 * lane);
        const float ss = wave_sum((hv.x * hv.x + hv.y * hv.y) + (hv.z * hv.z + hv.w * hv.w)); const float rstd = 1.f / sqrtf(ss * (1.f / DV) + EPS);
        const f32x4 ng = *(const GAS f32x4*)(P.mng + h * DV + 4 * lane); const v2u ob = *(const GAS v2u*)(P.Om + (rowbase + t) * MLW + h * DV + 4 * lane);
        const float o0 = sigmoidf_(bflo(ob.x)), o1 = sigmoidf_(bfhi(ob.x)), o2 = sigmoidf_(bflo(ob.y)), o3 = sigmoidf_(bfhi(ob.y));
        v2u w; w.x = pk2(hv.x * rstd * ng.x * o0, hv.y * rstd * ng.y * o1); w.y = pk2(hv.z * rstd * ng.z * o2, hv.w * rstd * ng.w * o3);
        *(GAS v2u*)(P.MIX + (rowbase + t) * DM + LRU_W + h * DV + 4 * lane) = w; }
    __syncthreads();
}

__device__ __forceinline__ void attn_v1_phase(const bf16* Q, const bf16* K, const bf16* V, bf16* O, LAS unsigned char* lds, int lane, int wave, int gw, int NGW) {
    LAS float* qs = (LAS float*)(lds + wave * 512);
    for (int u = gw; u < BATCH * SBH * SEQ; u += NGW) {
        const int bh = u & 31, t = u >> 5, b = bh >> 4, h = bh & 15;
        const size_t rowbase = (size_t)b * SEQ;
        { const unsigned qp = *(const GAS unsigned*)(Q + (rowbase + t) * DM + h * SBD + 2 * lane); qs[2 * lane] = bflo(qp); qs[2 * lane + 1] = bfhi(qp); }
        LDS_WAIT();
        float o0 = 0.f, o1 = 0.f, carry = 0.f;
        for (int kb = (t - 1) >> 6; kb >= 0 && t > 0; --kb) {
            const int s = kb * 64 + lane; const bool valid = s < t;
            const bf16* kp = K + (rowbase + s) * DM + h * SBD;
            float z = 0.f;
#pragma unroll
            for (int i = 0; i < 16; ++i) { const v4u kk = *(const GAS v4u*)(kp + i * 8); const LAS float* qq = qs + i * 8;
                z += qq[0] * bflo(kk.x) + qq[1] * bfhi(kk.x) + qq[2] * bflo(kk.y) + qq[3] * bfhi(kk.y) + qq[4] * bflo(kk.z) + qq[5] * bfhi(kk.z) + qq[6] * bflo(kk.w) + qq[7] * bfhi(kk.w); }
            const float sp = valid ? (fmaxf(z, 0.f) + __builtin_amdgcn_logf(1.f + __builtin_amdgcn_exp2f(-fabsf(z)))) : 0.f;
            float x = sp;
#pragma unroll
            for (int off = 1; off < 64; off <<= 1) { const float y = __shfl_down(x, off); if (lane + off < 64) x += y; }
            const float R = x + carry; carry += __shfl(x, 0);
            const float A = valid ? __builtin_amdgcn_exp2f(z - R) : 0.f;
            const bf16* vp = V + (rowbase + kb * 64) * DM + h * SBD + 2 * lane;
            for (int l = 0; l < 64; ++l) { const float a = __shfl(A, l); const unsigned pr = *(const GAS unsigned*)(vp + (size_t)l * DM); o0 += a * bflo(pr); o1 += a * bfhi(pr); }
        }
        *(GAS unsigned*)(O + (rowbase + t) * DM + h * SBD + 2 * lane) = pk2(o0, o1);
    }
}

namespace sba {
typedef float f32x16 __attribute__((ext_vector_type(16)));
typedef short v4i16_t __attribute__((ext_vector_type(4)));
typedef float f32x2_t __attribute__((ext_vector_type(2))); typedef __bf16 bf16x2_t __attribute__((ext_vector_type(2)));
__device__ __forceinline__ unsigned cvtpk_s(float lo, float hi) { f32x2_t v = {lo, hi}; bf16x2_t b = __builtin_convertvector(v, bf16x2_t); return __builtin_bit_cast(unsigned, b); }
__device__ __forceinline__ int img_off(int row, int ch) { return 256 * row + 16 * (ch ^ (((row & 3) << 2) | ((row >> 2) & 3))); }
__device__ __forceinline__ v4i16_t vtr(const LAS unsigned char* p) { return __builtin_amdgcn_ds_read_tr16_b64_v4i16((LAS v4i16_t*)p); }

__device__ __forceinline__ void sb_weights(f32x16& p, float& carry, int hi) {
    float sp[16];
#pragma unroll
    for (int r = 0; r < 16; ++r) { const float z = p[r]; const float l = __builtin_amdgcn_logf(1.f + __builtin_amdgcn_exp2f(-__builtin_fabsf(z))); sp[r] = __builtin_fmaxf(z, 0.f) + l; }
    float E[4], Od[4];
#pragma unroll
    for (int m = 0; m < 4; ++m) { sp[4 * m + 2] += sp[4 * m + 3]; sp[4 * m + 1] += sp[4 * m + 2]; sp[4 * m] += sp[4 * m + 1];
        const unsigned tv = __float_as_uint(sp[4 * m]); auto rr = __builtin_amdgcn_permlane32_swap(tv, tv, false, false); E[m] = __uint_as_float(rr[0]); Od[m] = __uint_as_float(rr[1]); }
    float SP[4]; SP[3] = carry; SP[2] = SP[3] + (E[3] + Od[3]); SP[1] = SP[2] + (E[2] + Od[2]); SP[0] = SP[1] + (E[1] + Od[1]); carry = SP[0] + (E[0] + Od[0]);
    const float f0 = (hi == 0) ? 1.f : 0.f;
#pragma unroll
    for (int m = 0; m < 4; ++m) { const float off = SP[m] + f0 * Od[m];
#pragma unroll
        for (int i = 0; i < 4; ++i) { const int r = 4 * m + i; p[r] = __builtin_amdgcn_exp2f(p[r] - (sp[r] + off)); } }
}
__device__ __forceinline__ void sb_mask(f32x16& p, int lim  ) {
#pragma unroll
    for (int r = 0; r < 16; ++r) p[r] = ((r & 3) + 8 * (r >> 2) < lim) ? p[r] : -INFINITY;
}

__device__ __forceinline__ void attn_unit(const bf16* Q, const bf16* K, const bf16* V, bf16* O, LAS unsigned char* lds, int tid, int b, int h, int qb) {
    const int lane = tid & 63, wave = __builtin_amdgcn_readfirstlane(tid >> 6), r32 = lane & 31, hi = lane >> 5;
    const size_t rowbase = (size_t)b * SEQ; const int q0 = qb * 256, Qw = q0 + 32 * wave, t = Qw + r32;
    bf16x8 qf[8];
    { const bf16* qp = Q + (rowbase + t) * DM + h * SBD + hi * 8;
#pragma unroll
      for (int d = 0; d < 8; ++d) qf[d] = *(const GAS bf16x8*)(qp + d * 16); }
    f32x16 o[4];
#pragma unroll
    for (int i = 0; i < 4; ++i)
#pragma unroll
        for (int r = 0; r < 16; ++r) o[i][r] = 0.f;
    float carry = 0.f;
    const int NT = 4 * qb + 4;
    const int sr = tid >> 4, sc = tid & 15;
    const GAS unsigned char* kg = (const GAS unsigned char*)(K + rowbase * DM + h * SBD); const GAS unsigned char* vg = (const GAS unsigned char*)(V + rowbase * DM + h * SBD);
    const unsigned goff = (unsigned)(sr * DM + sc * 8) * 2u;
    const int w0 = img_off(sr, sc), w1 = img_off(sr + 32, sc);
    v4u sk0, sk1, sv0, sv1;
#define SB_LOAD(kt) do { const unsigned o_ = goff + (unsigned)(kt) * (64u * DM * 2u); sk0 = *(const GAS v4u*)(kg + o_); sk1 = *(const GAS v4u*)(kg + o_ + 32u * DM * 2u); sv0 = *(const GAS v4u*)(vg + o_); sv1 = *(const GAS v4u*)(vg + o_ + 32u * DM * 2u); } while (0)
#define SB_WRITE(buf) do { LAS unsigned char* kb_ = lds + (buf) * 16384; LAS unsigned char* vb_ = lds + 32768 + (buf) * 16384; *(LAS v4u*)(kb_ + w0) = sk0; *(LAS v4u*)(kb_ + w1) = sk1; *(LAS v4u*)(vb_ + w0) = sv0; *(LAS v4u*)(vb_ + w1) = sv1; } while (0)
    const int krt = ((r32 & 3) << 2) | ((r32 >> 2) & 3);
    const int i16 = lane & 15, q4 = i16 >> 2, p4 = i16 & 3, gb = (lane >> 4) & 1;
    const int vlow0 = ((2 * gb + (p4 >> 1)) ^ hi), vlow1 = vlow0 ^ 2;
    const int vrow0 = 256 * (4 * hi + q4) + 8 * (p4 & 1);
    SB_LOAD(NT - 1); SB_WRITE(0); __syncthreads();
    for (int it = 0; it < NT; ++it) {
        const int kt = NT - 1 - it, buf = it & 1, key0 = kt * 64;
        if (it + 1 < NT) SB_LOAD(kt - 1);
        const bool skip = key0 >= Qw + 31, full = key0 + 63 < Qw;
        if (!skip) {
            const LAS unsigned char* Kb = lds + buf * 16384; const LAS unsigned char* Vb = lds + 32768 + buf * 16384;
            f32x16 p0, p1;
#pragma unroll
            for (int r = 0; r < 16; ++r) { p0[r] = 0.f; p1[r] = 0.f; }
#pragma unroll
            for (int d = 0; d < 8; ++d) { const int off = 256 * r32 + 16 * ((2 * d + hi) ^ krt);
                const bf16x8 k0 = *(const LAS bf16x8*)(Kb + off), k1 = *(const LAS bf16x8*)(Kb + off + 8192);
                p0 = __builtin_amdgcn_mfma_f32_32x32x16_bf16(k0, qf[d], p0, 0, 0, 0); p1 = __builtin_amdgcn_mfma_f32_32x32x16_bf16(k1, qf[d], p1, 0, 0, 0); }
            bf16x8 af[2][2];
#define SB_PACK(P, u) do { _Pragma("unroll") for (int s = 0; s < 2; ++s) { v4u aw; aw.x = cvtpk_s(P[8 * s], P[8 * s + 1]); aw.y = cvtpk_s(P[8 * s + 2], P[8 * s + 3]); aw.z = cvtpk_s(P[8 * s + 4], P[8 * s + 5]); aw.w = cvtpk_s(P[8 * s + 6], P[8 * s + 7]); af[u][s] = __builtin_bit_cast(bf16x8, aw); } } while (0)
            if (!full) { sb_mask(p1, t - key0 - 32 - 4 * hi); sb_mask(p0, t - key0 - 4 * hi); }
            sb_weights(p1, carry, hi); SB_PACK(p1, 1); __builtin_amdgcn_sched_barrier(0); sb_weights(p0, carry, hi); SB_PACK(p0, 0);
#undef SB_PACK
            __builtin_amdgcn_sched_barrier(0);
#pragma unroll
            for (int u = 0; u < 2; ++u)
#pragma unroll
                for (int s = 0; s < 2; ++s) {
#pragma unroll
                    for (int db = 0; db < 4; ++db) {
                        const int c0 = (((db ^ q4) << 2) | vlow0), c1 = (((db ^ q4) << 2) | vlow1);
                        const v4i16_t lo = vtr(Vb + vrow0 + 256 * (32 * u + 16 * s) + 16 * c0), hh = vtr(Vb + vrow0 + 256 * (32 * u + 16 * s + 8) + 16 * c1);
                        const bf16x8 vf = {lo[0], lo[1], lo[2], lo[3], hh[0], hh[1], hh[2], hh[3]};
                        o[db] = __builtin_amdgcn_mfma_f32_32x32x16_bf16(vf, af[u][s], o[db], 0, 0, 0);
                    }
                }
        }
        if (it + 1 < NT) SB_WRITE(buf ^ 1);
        __syncthreads();
    }
#undef SB_LOAD
#undef SB_WRITE
    bf16* op = O + (rowbase + t) * DM + h * SBD + 4 * hi;
#pragma unroll
    for (int db = 0; db < 4; ++db)
#pragma unroll
        for (int g = 0; g < 4; ++g) { v2u w; w.x = cvtpk_s(o[db][4 * g], o[db][4 * g + 1]); w.y = cvtpk_s(o[db][4 * g + 2], o[db][4 * g + 3]); *(GAS v2u*)(op + 32 * db + 8 * g) = w; }
}

__device__ __forceinline__ void attn_phase(const bf16* Q, const bf16* K, const bf16* V, bf16* O, LAS unsigned char* lds, int tid, int vcu, int G) {
    for (int pi = vcu; pi < 256; pi += G) {
        const int bh = pi >> 3, x = pi & 7;
#pragma unroll 1
        for (int uu = 0; uu < 2; ++uu) attn_unit(Q, K, V, O, lds, tid, bh >> 4, bh & 15, uu ? x : 15 - x);
    }
}
}

namespace mls {
using sba::f32x16; using sba::v4i16_t; using sba::cvtpk_s; using sba::img_off; using sba::vtr;
__device__ __forceinline__ float half_sum(float x) { const unsigned u = __float_as_uint(x); auto rr = __builtin_amdgcn_permlane32_swap(u, u, false, false); return __uint_as_float(rr[0]) + __uint_as_float(rr[1]); }

__device__ __forceinline__ void stage_v(const bf16* Vm, size_t rowbase, int h, LAS unsigned char* lds, int tid) {
    const int c32 = tid & 31; const bf16* vp = Vm + rowbase * MLW + h * DV + c32 * 8;
#pragma unroll
    for (int k = 0; k < 8; ++k) { const int row = (tid >> 5) + 16 * k; const v4u x = *(const GAS v4u*)(vp + (size_t)row * MLW); *(LAS v4u*)(lds + (c32 >> 4) * 32768 + img_off(row, c32 & 15)) = x; }
}
__device__ __forceinline__ void gate_scan(const MixP& P, size_t rowbase, int h, int lane, float& bc0, float& bc1, float& g0, float& g1) {
    const float li0 = P.IG[(rowbase + 2 * lane) * 4 + h] + P.mgb[h], li1 = P.IG[(rowbase + 2 * lane + 1) * 4 + h] + P.mgb[h];
    const float lf0 = logsigmoidf_(P.FG[(rowbase + 2 * lane) * 4 + h] + P.mgb[MH + h]), lf1 = logsigmoidf_(P.FG[(rowbase + 2 * lane + 1) * 4 + h] + P.mgb[MH + h]);
    const float ps = lf0 + lf1; float x = ps;
#pragma unroll
    for (int off = 1; off < 64; off <<= 1) { const float y = lane_up(x, off, lane); if (lane >= off) x += y; }
    bc0 = (x - ps) + lf0; bc1 = bc0 + lf1; g0 = li0 - bc0; g1 = li1 - bc1;
}

__device__ __forceinline__ void mx1_unit(const MixP& P, LAS unsigned char* lds, int tid, int b, int h, int c) {
    const int lane = tid & 63, wave = __builtin_amdgcn_readfirstlane(tid >> 6), r32 = lane & 31, hi = lane >> 5;
    LAS float* sm = (LAS float*)(lds + SM_OFF); LAS float *s_w = sm, *s_sc = sm + 128;
    const size_t rowbase = (size_t)b * SEQ + c * CH; const int uidx = (b * MH + h) * NCH + c;
    stage_v(P.Vm, rowbase, h, lds, tid);
    if (wave == 0) { float bc0, bc1, g0, g1; gate_scan(P, rowbase, h, lane, bc0, bc1, g0, g1);
        const float G = wave_max(fmaxf(g0, g1));
        s_w[2 * lane] = __expf(g0 - G); s_w[2 * lane + 1] = __expf(g1 - G);
        const float bl = __int_as_float(__builtin_amdgcn_readlane(__float_as_int(bc1), 63)); if (lane == 0) { s_sc[0] = G; s_sc[1] = bl; } }
    __syncthreads();
    { const int row = tid >> 2, q = tid & 3; const float w = s_w[row]; const bf16* kp = P.Km + (rowbase + row) * MQK + h * DK + q * 32;
#pragma unroll
      for (int i = 0; i < 4; ++i) { const v4u kk = *(const GAS v4u*)(kp + i * 8); v4u o;
          o.x = cvtpk_s(w * bflo(kk.x), w * bfhi(kk.x)); o.y = cvtpk_s(w * bflo(kk.y), w * bfhi(kk.y)); o.z = cvtpk_s(w * bflo(kk.z), w * bfhi(kk.z)); o.w = cvtpk_s(w * bflo(kk.w), w * bfhi(kk.w));
          *(LAS v4u*)(lds + 65536 + img_off(row, 4 * q + i)) = o; } }
    __syncthreads();
    f32x16 acc[4], accn[4];
#pragma unroll
    for (int i = 0; i < 4; ++i)
#pragma unroll
        for (int r = 0; r < 16; ++r) { acc[i][r] = 0.f; accn[i][r] = 0.f; }
    const int i16 = lane & 15, q4 = i16 >> 2, p4 = i16 & 3, gb = (lane >> 4) & 1;
    const int lowb = 2 * gb + (p4 >> 1);
    const int rowb = 256 * (8 * hi + q4) + 8 * (p4 & 1);
    const LAS unsigned char* Vb = lds + (wave >> 2) * 32768; const LAS unsigned char* Kb = lds + 65536;
    const int vdb = wave & 3;
    const bf16x8 ones = {0x3F80, 0x3F80, 0x3F80, 0x3F80, 0x3F80, 0x3F80, 0x3F80, 0x3F80};
#pragma unroll
    for (int ks = 0; ks < 8; ++ks) {
        const int lw0 = lowb ^ (2 * hi), lw1 = lowb ^ (2 * hi + 1);
        const v4i16_t vl = vtr(Vb + rowb + 256 * (16 * ks) + 16 * (((vdb ^ q4) << 2) | lw0)), vh2 = vtr(Vb + rowb + 256 * (16 * ks + 4) + 16 * (((vdb ^ q4) << 2) | lw1));
        const bf16x8 vf = {vl[0], vl[1], vl[2], vl[3], vh2[0], vh2[1], vh2[2], vh2[3]};
#pragma unroll
        for (int db = 0; db < 4; ++db) {
            const v4i16_t kl = vtr(Kb + rowb + 256 * (16 * ks) + 16 * (((db ^ q4) << 2) | lw0)), kh = vtr(Kb + rowb + 256 * (16 * ks + 4) + 16 * (((db ^ q4) << 2) | lw1));
            const bf16x8 kf = {kl[0], kl[1], kl[2], kl[3], kh[0], kh[1], kh[2], kh[3]};
            acc[db] = __builtin_amdgcn_mfma_f32_32x32x16_bf16(vf, kf, acc[db], 0, 0, 0);
            if (wave == 0) accn[db] = __builtin_amdgcn_mfma_f32_32x32x16_bf16(ones, kf, accn[db], 0, 0, 0);
        }
    }
    float* dc = P.DC + ((size_t)uidx * DV + 32 * wave) * DK + r32;
#pragma unroll
    for (int db = 0; db < 4; ++db)
#pragma unroll
        for (int r = 0; r < 16; ++r) dc[(size_t)((r & 3) + 8 * (r >> 2) + 4 * hi) * DK + 32 * db] = acc[db][r];
    if (wave == 0 && hi == 0) {
#pragma unroll
        for (int db = 0; db < 4; ++db) P.DN[uidx * DK + 32 * db + r32] = accn[db][0]; }
    if (tid == 0) { P.MLOC[uidx] = s_sc[1] + s_sc[0]; P.BLAST[uidx] = s_sc[1]; }
    __syncthreads();
}

__device__ __forceinline__ void mx3_unit(const MixP& P, LAS unsigned char* lds, int tid, int b, int h, int c) {
    const int lane = tid & 63, wave = __builtin_amdgcn_readfirstlane(tid >> 6), r32 = lane & 31, hi = lane >> 5;
    const int qb = wave & 3, vh = wave >> 2;
    LAS float* sm = (LAS float*)(lds + SM_OFF); LAS float *s_g2 = sm, *s_M2 = sm + 128, *s_bc = sm + 256, *s_nin = sm + 384, *s_part = sm + 512;
    const size_t rowbase = (size_t)b * SEQ + c * CH; const int uidx = (b * MH + h) * NCH + c;
    const float m_in = P.MIN[uidx];
    stage_v(P.Vm, rowbase, h, lds, tid);
    if (wave == 0) { float bc0, bc1, g0, g1; gate_scan(P, rowbase, h, lane, bc0, bc1, g0, g1);
        float y = fmaxf(g0, g1);
#pragma unroll
        for (int off = 1; off < 64; off <<= 1) { const float z = lane_up(y, off, lane); if (lane >= off) y = fmaxf(y, z); }
        float ex = lane_up(y, 1, lane); if (lane == 0) ex = -INFINITY;
        const float M0 = fmaxf(m_in, fmaxf(ex, g0)), M1 = fmaxf(m_in, y);
        s_g2[2 * lane] = g0 * LOG2E; s_g2[2 * lane + 1] = g1 * LOG2E; s_M2[2 * lane] = M0 * LOG2E; s_M2[2 * lane + 1] = M1 * LOG2E; s_bc[2 * lane] = bc0; s_bc[2 * lane + 1] = bc1; }
    if (wave == 1) { s_nin[lane] = P.NIN[uidx * DK + lane]; s_nin[64 + lane] = P.NIN[uidx * DK + 64 + lane]; }
    const int t = 32 * qb + r32;
    bf16x8 qf[8];
    { const bf16* qp = P.Qm + (rowbase + t) * MQK + h * DK + hi * 8;
#pragma unroll
      for (int d = 0; d < 8; ++d) qf[d] = *(const GAS bf16x8*)(qp + d * 16); }
    __syncthreads();
    const float M2 = s_M2[t], bct = s_bc[t];
    const float wint = __builtin_amdgcn_exp2f(m_in * LOG2E - M2);
    f32x16 acc[4];
#pragma unroll
    for (int i = 0; i < 4; ++i)
#pragma unroll
        for (int r = 0; r < 16; ++r) acc[i][r] = 0.f;
    { const bf16* cp = P.CIN + ((size_t)uidx * DV + 128 * vh + r32) * DK + hi * 8;
#pragma unroll
      for (int vb = 0; vb < 4; ++vb)
#pragma unroll
          for (int d = 0; d < 8; ++d) { const bf16x8 cf = *(const GAS bf16x8*)(cp + (size_t)(32 * vb) * DK + d * 16); acc[vb] = __builtin_amdgcn_mfma_f32_32x32x16_bf16(cf, qf[d], acc[vb], 0, 0, 0); } }
#pragma unroll
    for (int i = 0; i < 4; ++i)
#pragma unroll
        for (int r = 0; r < 16; ++r) acc[i][r] *= wint;
    float qn = 0.f;
#pragma unroll
    for (int d = 0; d < 8; ++d)
#pragma unroll
        for (int j = 0; j < 8; ++j) qn += bf2f((bf16)qf[d][j]) * s_nin[16 * d + 8 * hi + j];
    float den = wint * half_sum(qn), dpart = 0.f;
    const int i16 = lane & 15, q4 = i16 >> 2, p4 = i16 & 3, gb = (lane >> 4) & 1;
    const int vlow0 = ((2 * gb + (p4 >> 1)) ^ hi), vlow1 = vlow0 ^ 2;
    const int vrow0 = 256 * (4 * hi + q4) + 8 * (p4 & 1);
    const LAS unsigned char* Vb = lds + vh * 32768;
    for (int kb = 0; kb <= qb; ++kb) {
        f32x16 p;
#pragma unroll
        for (int r = 0; r < 16; ++r) p[r] = 0.f;
        { const bf16* kp = P.Km + (rowbase + 32 * kb + r32) * MQK + h * DK + hi * 8;
#pragma unroll
          for (int d = 0; d < 8; ++d) { const bf16x8 kf = *(const GAS bf16x8*)(kp + d * 16); p = __builtin_amdgcn_mfma_f32_32x32x16_bf16(kf, qf[d], p, 0, 0, 0); } }
#pragma unroll
        for (int m = 0; m < 4; ++m) { const f32x4 gq = *(const LAS f32x4*)(s_g2 + 32 * kb + 8 * m + 4 * hi);
#pragma unroll
            for (int i = 0; i < 4; ++i) { const int r = 4 * m + i; float w = __builtin_amdgcn_exp2f(gq[i] - M2); if (kb == qb) w = (8 * m + 4 * hi + i <= r32) ? w : 0.f; p[r] *= w; dpart += p[r]; } }
        bf16x8 af[2];
#pragma unroll
        for (int s = 0; s < 2; ++s) { v4u aw; aw.x = cvtpk_s(p[8 * s], p[8 * s + 1]); aw.y = cvtpk_s(p[8 * s + 2], p[8 * s + 3]); aw.z = cvtpk_s(p[8 * s + 4], p[8 * s + 5]); aw.w = cvtpk_s(p[8 * s + 6], p[8 * s + 7]); af[s] = __builtin_bit_cast(bf16x8, aw); }
        const LAS unsigned char* Vk = Vb + 256 * 32 * kb;
#pragma unroll
        for (int s = 0; s < 2; ++s)
#pragma unroll
            for (int vb = 0; vb < 4; ++vb) {
                const int c0 = (((vb ^ q4) << 2) | vlow0), c1 = (((vb ^ q4) << 2) | vlow1);
                const v4i16_t lo = vtr(Vk + vrow0 + 256 * (16 * s) + 16 * c0), hh = vtr(Vk + vrow0 + 256 * (16 * s + 8) + 16 * c1);
                const bf16x8 vf = {lo[0], lo[1], lo[2], lo[3], hh[0], hh[1], hh[2], hh[3]};
                acc[vb] = __builtin_amdgcn_mfma_f32_32x32x16_bf16(vf, af[s], acc[vb], 0, 0, 0);
            }
    }
    den += half_sum(dpart);
    const float mt = bct + M2 * LN2;
    const float scl = 1.f / fmaxf(fabsf(den), __expf(-mt));
    float ss = 0.f;
#pragma unroll
    for (int i = 0; i < 4; ++i)
#pragma unroll
        for (int r = 0; r < 16; ++r) { acc[i][r] *= scl; ss += acc[i][r] * acc[i][r]; }
    ss = half_sum(ss);
    if (hi == 0) s_part[wave * 32 + r32] = ss;
    __syncthreads();
    const float tot = s_part[qb * 32 + r32] + s_part[(4 + qb) * 32 + r32];
    const float rstd = 1.f / sqrtf(tot * (1.f / DV) + EPS);
    { const int vbase = h * DV + 128 * vh + 4 * hi;
      const bf16* op = P.Om + (rowbase + t) * MLW + vbase; bf16* mp = P.MIX + (rowbase + t) * DM + LRU_W + vbase; const float* ng = P.mng + vbase;
#pragma unroll
      for (int vb = 0; vb < 4; ++vb)
#pragma unroll
          for (int g = 0; g < 4; ++g) { const int vo = 32 * vb + 8 * g; const f32x4 n4 = *(const GAS f32x4*)(ng + vo); const v2u ob = *(const GAS v2u*)(op + vo);
              const float o0 = sigmoidf_(bflo(ob.x)), o1 = sigmoidf_(bfhi(ob.x)), o2 = sigmoidf_(bflo(ob.y)), o3 = sigmoidf_(bfhi(ob.y));
              v2u w; w.x = cvtpk_s(acc[vb][4 * g] * rstd * n4.x * o0, acc[vb][4 * g + 1] * rstd * n4.y * o1); w.y = cvtpk_s(acc[vb][4 * g + 2] * rstd * n4.z * o2, acc[vb][4 * g + 3] * rstd * n4.w * o3);
              *(GAS v2u*)(mp + vo) = w; } }
    __syncthreads();
}
}

namespace rgl {
using sba::f32x16; using sba::img_off;
__device__ __forceinline__ float sig_fast(float x) { return __builtin_amdgcn_rcpf(1.f + __builtin_amdgcn_exp2f(-LOG2E * x)); }
__device__ __forceinline__ void swap_pair(float x, float& ev, float& od) { const unsigned u = __float_as_uint(x); auto rr = __builtin_amdgcn_permlane32_swap(u, u, false, false); ev = __uint_as_float(rr[0]); od = __uint_as_float(rr[1]); }

__device__ __forceinline__ void mx1_unit(const MixP& P, const bf16* WGT  , LAS unsigned char* lds, int tid, int b, int n, int c) {
    const int lane = tid & 63, wave = __builtin_amdgcn_readfirstlane(tid >> 6), r32 = lane & 31, hi = lane >> 5;
    LAS float* XC = (LAS float*)lds;
    LAS unsigned char* XB = lds + 65536;
    LAS float* s_agg = (LAS float*)(lds + SM_OFF);
    const size_t rowbase = (size_t)b * SEQ; const int t0 = c * CH;
    {
        const int e = tid & 127, tg = tid >> 7, chn = n * 128 + e;
        const float w0 = P.conv_w[chn], w1 = P.conv_w[LRU_W + chn], w2 = P.conv_w[2 * LRU_W + chn], w3 = P.conv_w[3 * LRU_W + chn], cb = P.conv_b[chn];
        const int ts = t0 + tg * 32; const float* xp = P.XA + (rowbase + ts) * LRU_W + chn;
        float x0 = (ts >= 3) ? xp[-3 * LRU_W] : 0.f, x1 = (ts >= 2) ? xp[-2 * LRU_W] : 0.f, x2 = (ts >= 1) ? xp[-1 * LRU_W] : 0.f;
        LAS unsigned char* xb = XB + 2 * (e & 7);
#pragma unroll 8
        for (int i = 0; i < 32; ++i) { const float x3 = xp[(size_t)i * LRU_W]; const float y = cb + w0 * x0 + w1 * x1 + w2 * x2 + w3 * x3; x0 = x1; x1 = x2; x2 = x3;
            const int tt = tg * 32 + i; XC[tt * 128 + e] = y; *(LAS bf16*)(xb + img_off(tt, e >> 3)) = f2bf(y); }
    }
    __syncthreads();
    const int tb = wave & 3, eh = wave >> 2;
    f32x16 ar[2], ai[2];
#pragma unroll
    for (int i = 0; i < 2; ++i)
#pragma unroll
        for (int r = 0; r < 16; ++r) { ar[i][r] = 0.f; ai[i][r] = 0.f; }
    { const int krt = ((r32 & 3) << 2) | ((r32 >> 2) & 3);
      const bf16* wr = WGT + ((size_t)(0 * NBLK + n) * 128 + 64 * eh + r32) * 128 + hi * 8; const bf16* wi = WGT + ((size_t)(1 * NBLK + n) * 128 + 64 * eh + r32) * 128 + hi * 8;
#pragma unroll
      for (int d = 0; d < 8; ++d) { const bf16x8 xf = *(const LAS bf16x8*)(XB + 256 * (32 * tb + r32) + 16 * ((2 * d + hi) ^ krt));
#pragma unroll
          for (int eb = 0; eb < 2; ++eb) { const bf16x8 fr = *(const GAS bf16x8*)(wr + (size_t)(32 * eb) * 128 + d * 16), fi = *(const GAS bf16x8*)(wi + (size_t)(32 * eb) * 128 + d * 16);
              ar[eb] = __builtin_amdgcn_mfma_f32_32x32x16_bf16(xf, fr, ar[eb], 0, 0, 0); ai[eb] = __builtin_amdgcn_mfma_f32_32x32x16_bf16(xf, fi, ai[eb], 0, 0, 0); } } }
    float BA[2], BH[2];
#pragma unroll
    for (int eb = 0; eb < 2; ++eb) {
        const int e = 64 * eh + 32 * eb + r32, chn = n * 128 + e;
        const float br = P.gate_b[chn], bi = P.gate_b[LRU_W + chn], ls8 = 8.f * LOG2E * logsigmoidf_(P.lam[chn]);
        float qa[4], qh[4];
#pragma unroll
        for (int m = 0; m < 4; ++m) { float A = 1.f, H = 0.f;
#pragma unroll
            for (int i = 0; i < 4; ++i) { const int r = 4 * m + i, tt = 32 * tb + 8 * m + 4 * hi + i;
                const float rg = sig_fast(ar[eb][r] + br), ig = sig_fast(ai[eb][r] + bi); const float a = __builtin_amdgcn_exp2f(rg * ls8); const float mult = __builtin_amdgcn_sqrtf(fmaxf(1.f - a * a, 0.f));
                const float u = mult * (ig * XC[tt * 128 + e]); H = a * H + u; A = A * a; ar[eb][r] = H; ai[eb][r] = A; }
            qa[m] = A; qh[m] = H; }
        float PA = 1.f, PH = 0.f;
#pragma unroll
        for (int m = 0; m < 4; ++m) { float ea, oa, eh_, oh; swap_pair(qa[m], ea, oa); swap_pair(qh[m], eh_, oh);
            const float pa_odd = ea * PA, ph_odd = ea * PH + eh_;
            const float ma = hi ? pa_odd : PA, mh = hi ? ph_odd : PH;
#pragma unroll
            for (int i = 0; i < 4; ++i) { const int r = 4 * m + i; ar[eb][r] += ai[eb][r] * mh; ai[eb][r] *= ma; }
            PA = oa * pa_odd; PH = oa * ph_odd + oh; }
        BA[eb] = PA; BH[eb] = PH;
        if (hi == 0) { s_agg[(tb * 128 + e) * 2] = PA; s_agg[(tb * 128 + e) * 2 + 1] = PH; }
    }
    __syncthreads();
#pragma unroll
    for (int eb = 0; eb < 2; ++eb) {
        const int e = 64 * eh + 32 * eb + r32, chn = n * 128 + e;
        float CA = 1.f, CHh = 0.f;
        for (int t2 = 0; t2 < tb; ++t2) { const float a = s_agg[(t2 * 128 + e) * 2], h = s_agg[(t2 * 128 + e) * 2 + 1]; CHh = a * CHh + h; CA = CA * a; }
#pragma unroll
        for (int r = 0; r < 16; ++r) { const int tt = 32 * tb + (r & 3) + 8 * (r >> 2) + 4 * hi; const size_t o = (rowbase + t0 + tt) * LRU_W + chn;
            P.HLOC[o] = ar[eb][r] + ai[eb][r] * CHh; P.PCUM[o] = ai[eb][r] * CA; }
        if (tb == 3 && hi == 0) { P.AGGP[(b * NCH + c) * LRU_W + chn] = BA[eb] * CA; P.AGGH[(b * NCH + c) * LRU_W + chn] = BA[eb] * CHh + BH[eb]; }
    }
    __syncthreads();
}

__device__ __forceinline__ void mx2_carry(const MixP& P, float* CARRY, int gtid) {
    if (gtid < BATCH * LRU_W) { const int b = gtid >> 10, chn = gtid & 1023; float carry = 0.f;
        for (int c = 0; c < NCH; ++c) { const int o = (b * NCH + c) * LRU_W + chn; CARRY[o] = carry; carry = P.AGGP[o] * carry + P.AGGH[o]; } }
}
__device__ __forceinline__ void mx3_unit(const MixP& P, const float* CARRY, int tid, int b, int c, int tq) {
    typedef float f32x2v __attribute__((ext_vector_type(2)));
    const int chn = 2 * tid; const f32x2v cr = *(const GAS f32x2v*)(CARRY + (b * NCH + c) * LRU_W + chn);
    const size_t row0 = (size_t)b * SEQ + c * CH + tq * 32;
#pragma unroll 4
    for (int i = 0; i < 32; ++i) { const size_t row = row0 + i; const f32x2v h = *(const GAS f32x2v*)(P.HLOC + row * LRU_W + chn), p = *(const GAS f32x2v*)(P.PCUM + row * LRU_W + chn);
        const unsigned yy = *(const GAS unsigned*)(P.YA + row * LRU_W + chn);
        *(GAS unsigned*)(P.MIX + row * DM + chn) = pk2((h.x + p.x * cr.x) * gelu_tanh(bflo(yy)), (h.y + p.y * cr.y) * gelu_tanh(bfhi(yy))); }
}
}
#ifndef MX1R_UNIT
#define MX1R_UNIT rgl::mx1_unit
#endif
#ifndef MX1M_UNIT
#define MX1M_UNIT mls::mx1_unit
#endif
#ifndef MX3M_UNIT
#define MX3M_UNIT mls::mx3_unit
#endif

__device__ __forceinline__ KArgs fresh_args() { KArgs p = (KArgs)__builtin_amdgcn_kernarg_segment_ptr(); asm volatile("" : "+s"(p)); return p; }
__device__ __forceinline__ void fill_mixp(MixP& P, KArgs ap, unsigned char* ws, int j) {
    P.XA = (const float*)(ws + WS_P0); P.YA = (const bf16*)(ws + WS_P0 + 32 * MiB); P.Qm = (const bf16*)(ws + WS_P0 + 48 * MiB); P.Km = (const bf16*)(ws + WS_P0 + 56 * MiB);
    P.Vm = (const bf16*)(ws + WS_P0 + 64 * MiB); P.Om = (const bf16*)(ws + WS_P0 + 80 * MiB); P.IG = (const float*)(ws + WS_IG); P.FG = (const float*)(ws + WS_IG + 128 * 1024); P.MIX = (bf16*)(ws + WS_MIX);
    P.conv_w = ap->in[11] + (size_t)j * 4 * LRU_W; P.conv_b = ap->in[12] + (size_t)j * LRU_W; P.gate_w = ap->in[13] + (size_t)j * 2 * NBLK * BW * BW; P.gate_b = ap->in[14] + (size_t)j * 2 * LRU_W;
    P.lam = ap->in[15] + (size_t)j * LRU_W; P.mgb = ap->in[16] + (size_t)j * 2 * MH; P.mng = ap->in[17] + (size_t)j * MLW;
    P.DC = (float*)(ws + WS_DC); P.CIN = (bf16*)(ws + WS_CIN); P.DN = (float*)(ws + WS_SMALL); P.NIN = (float*)(ws + WS_SMALL + 128 * 1024); P.MLOC = (float*)(ws + WS_SMALL + 256 * 1024);
    P.BLAST = (float*)(ws + WS_SMALL + 257 * 1024); P.MIN = (float*)(ws + WS_SMALL + 258 * 1024); P.HLOC = (float*)(ws + WS_HLOC); P.PCUM = (float*)(ws + WS_PCUM);
    P.AGGP = (float*)(ws + WS_AGG); P.AGGH = (float*)(ws + WS_AGG + 256 * 1024); P.HTMP = (float*)(ws + WS_HTMP);
}
__global__ void __launch_bounds__(NWAVES * 64, 2) fwd_kernel(Args args) {
    extern __shared__ __attribute__((aligned(16))) unsigned char lds_raw[];
    LAS unsigned char* lds = (LAS unsigned char*)lds_raw;
    const int tid0 = threadIdx.x; const int wave_s = __builtin_amdgcn_readfirstlane(tid0 >> 6);
    const int G = gridDim.x, bx = blockIdx.x; const int vcu = (G % 8 == 0) ? (bx % 8) * (G / 8) + bx / 8 : bx;
    const int NGW = G * NWAVES;
#define FRESH() const int tid = fresh_tid(wave_s), lane = tid & 63, wave = __builtin_amdgcn_readfirstlane(tid >> 6), gw = vcu * NWAVES + wave; (void)lane; (void)gw; const KArgs ap = fresh_args(); unsigned char* const ws = ap->ws; (void)ws
    volatile LAS unsigned* MISC = (volatile LAS unsigned*)(lds + MISC_OFF);
    if (tid0 < 64) MISC[tid0] = 0u;
    __syncthreads();
    XcdBarrier bar = xcd_barrier_post((unsigned*)(args.ws + WS_CTL) + CW_BAR, MISC + 8);
#define GRID_BAR() do { XcdBarrier b2_ = bar; asm volatile("" : "+s"(b2_.x)); asm volatile("" : "+s"(b2_.bar)); xcd_barrier(b2_); } while (0)

    { FRESH(); p0_prologue(ap, lds, tid, lane, wave, vcu, G); }
    GRID_BAR();

    for (int layer = 0; layer < DEPTH; ++layer) {
        const int j = layer >> 1;
        { FRESH(); norm_phase((layer == 0) ? ap->in[0] : ap->out, ap->in[4] + (size_t)(layer * 2 + 0) * DM, (const float*)(ws + WS_MOD) + (size_t)(layer * 2 + 0) * 2 * 6144, (bf16*)(ws + WS_HN), lane, gw, NGW); }
        GRID_BAR();
        if ((layer & 1) == 0) {
            { FRESH(); pg8::Gemm g{(const bf16*)(ws + WS_HN), (const bf16*)(ws + WS_WABIN) + (size_t)j * AB_IN_PAD * 2048, M, AB_IN_PAD, DM}; pg8::StaticOrder S; S.init(M, AB_IN_PAD, G, bx);
              pg8::EpiInProj E{(float*)(ws + WS_P0), (bf16*)(ws + WS_P0 + 32 * MiB), (bf16*)(ws + WS_P0 + 48 * MiB), (bf16*)(ws + WS_P0 + 56 * MiB), (bf16*)(ws + WS_P0 + 64 * MiB), (bf16*)(ws + WS_P0 + 80 * MiB),
                               (float*)(ws + WS_IG), (float*)(ws + WS_IG + 128 * 1024), 0.08838834764831845f};
              pg8::gemm_phase<pg8::EpiInProj, pg8::StaticOrder, PG8_ALIGN, PG8_SP2>(lds, g, S, E, tid); }
            GRID_BAR();
            { FRESH(); MixP P; fill_mixp(P, ap, ws, j);
              for (int u = vcu; u < 768; u += G) {
                if (u < 256) MX1M_UNIT(P, lds, tid, u >> 7, (u >> 5) & 3, u & 31);
                else { const int r = u - 256; MX1R_UNIT(P, (const bf16*)(ws + WS_WGT) + (size_t)j * 16 * 16384, lds, tid, r >> 8, (r >> 5) & 7, r & 31); }
            } }
            GRID_BAR();
            { FRESH(); MixP P; fill_mixp(P, ap, ws, j); mx2_mlstm(P, lds, tid, vcu * 512 + tid, G * 512); rgl::mx2_carry(P, (float*)(ws + WS_CARRY), vcu * 512 + tid); }
            GRID_BAR();
            { FRESH(); MixP P; fill_mixp(P, ap, ws, j);
              for (int u = vcu; u < 512; u += G) {
                if (u < 256) MX3M_UNIT(P, lds, tid, u >> 7, (u >> 5) & 3, u & 31);
                else { const int r = u - 256; rgl::mx3_unit(P, (const float*)(ws + WS_CARRY), tid, r >> 7, (r >> 2) & 31, r & 3); }
            } }
            GRID_BAR();
        } else {
            { FRESH(); pg8::Gemm g{(const bf16*)(ws + WS_HN), (const bf16*)(ws + WS_WQKV) + (size_t)j * 6144 * 2048, M, 6144, DM}; pg8::StaticOrder S; S.init(M, 6144, G, bx);
              pg8::EpiBf16Split E{(bf16*)(ws + WS_P0), DM, DM, (size_t)M * DM, 0.08838834764831845f * LOG2E};
              pg8::gemm_phase<pg8::EpiBf16Split, pg8::StaticOrder, PG8_ALIGN, PG8_SP2>(lds, g, S, E, tid); }
            GRID_BAR();
            { FRESH(); sba::attn_phase((const bf16*)(ws + WS_P0), (const bf16*)(ws + WS_P0) + (size_t)M * DM, (const bf16*)(ws + WS_P0) + (size_t)2 * M * DM, (bf16*)(ws + WS_MIX), lds, tid, vcu, G); }
            GRID_BAR();
        }
        { FRESH(); const bf16* Bt = ((layer & 1) == 0) ? (const bf16*)(ws + WS_WABOUT) + (size_t)j * 2048 * 2048 : (const bf16*)(ws + WS_WSBO) + (size_t)j * 2048 * 2048;
          pg8::Gemm g{(const bf16*)(ws + WS_MIX), Bt, M, DM, DM}; pg8::StaticOrder S; S.init(M, DM, G, bx);
          pg8::EpiResid E{(layer == 0) ? ap->in[0] : ap->out, ap->out, (const float*)(ws + WS_MOD) + (size_t)(layer * 2 + 0) * 2 * 6144 + 4096};
          pg8::gemm_phase<pg8::EpiResid, pg8::StaticOrder, PG8_ALIGN, PG8_SP2>(lds, g, S, E, tid); }
        GRID_BAR();
        { FRESH(); norm_phase(ap->out, ap->in[4] + (size_t)(layer * 2 + 1) * DM, (const float*)(ws + WS_MOD) + (size_t)(layer * 2 + 1) * 2 * 6144, (bf16*)(ws + WS_HN), lane, gw, NGW); }
        GRID_BAR();
        { FRESH(); pg8::Gemm g{(const bf16*)(ws + WS_HN), (const bf16*)(ws + WS_W13) + (size_t)layer * 2 * FF * 2048, M, 2 * FF, DM}; pg8::StaticOrder S; S.init(M, 2 * FF, G, bx);
          pg8::EpiSwiGLU E{(bf16*)(ws + WS_ACT)};
          pg8::gemm_phase<pg8::EpiSwiGLU, pg8::StaticOrder, PG8_ALIGN, PG8_SP2>(lds, g, S, E, tid); }
        GRID_BAR();
        { FRESH(); pg8::Gemm g{(const bf16*)(ws + WS_ACT), (const bf16*)(ws + WS_W2) + (size_t)layer * 2048 * FF, M, DM, FF}; pg8::StaticOrder S; S.init(M, DM, G, bx);
          pg8::EpiResid E{ap->out, ap->out, (const float*)(ws + WS_MOD) + (size_t)(layer * 2 + 1) * 2 * 6144 + 4096};
          pg8::gemm_phase<pg8::EpiResid, pg8::StaticOrder, PG8_ALIGN, PG8_SP2>(lds, g, S, E, tid); }
        GRID_BAR();
    }
    { FRESH(); final_norm_phase(ap->out, ap->in[5], ap->out, lane, gw, NGW); }
}

extern "C" void kernel_launch(void* const* d_in, const int* in_sizes, int n_in, void* d_out, int out_size, void* d_ws, size_t ws_size, hipStream_t stream) {
    static int grid = 0;
    if (grid == 0) {
        if (n_in != 20 || in_sizes[0] != M * DM || out_size != M * DM || ws_size < WS_END) { fprintf(stderr, "kernel_launch: unexpected shapes: n_in %d in0 %d out %d ws %zu (need %zu); nothing launched\n", n_in, n_in > 0 ? in_sizes[0] : -1, out_size, ws_size, (size_t)WS_END); grid = -1; return; }
        int dev = 0, cus = 0, per_cu = 0;
        if (hipGetDevice(&dev) != hipSuccess || hipDeviceGetAttribute(&cus, hipDeviceAttributeMultiprocessorCount, dev) != hipSuccess) { fprintf(stderr, "kernel_launch: device query failed\n"); grid = -1; return; }
        if (hipFuncSetAttribute((const void*)fwd_kernel, hipFuncAttributeMaxDynamicSharedMemorySize, LDS_BYTES) != hipSuccess) { fprintf(stderr, "kernel_launch: hipFuncSetAttribute failed\n"); grid = -1; return; }
        if (hipOccupancyMaxActiveBlocksPerMultiprocessor(&per_cu, (const void*)fwd_kernel, NWAVES * 64, LDS_BYTES) != hipSuccess || per_cu < 1)
            fprintf(stderr, "kernel_launch: note: occupancy query reports %d workgroups per CU\n", per_cu);
        (void)hipGetLastError();
        grid = cus;
    }
    if (grid < 0) return;
    if (hipMemsetAsync((char*)d_ws + WS_CTL, 0, CTL_ZERO_BYTES, stream) != hipSuccess) { fprintf(stderr, "kernel_launch: memset failed\n"); return; }
    Args a{};
    for (int i = 0; i < 20; ++i) a.in[i] = (const float*)d_in[i];
    a.out = (float*)d_out; a.ws = (unsigned char*)d_ws;
    hipLaunchKernelGGL(fwd_kernel, dim3(grid), dim3(NWAVES * 64), LDS_BYTES, stream, a);
    const hipError_t le = hipPeekAtLastError();
    if (le != hipSuccess) fprintf(stderr, "kernel_launch: launch failed: %s\n", hipGetErrorName(le));
}
```

```cpp
#define REPMASK 0
#include <hip/hip_runtime.h>
#include <cstdio>
#include <cstdint>

constexpr int NWAVES = 8;
constexpr int BATCH = 2, SEQ = 4096, DM = 2048, DEPTH = 4, M = BATCH * SEQ;
constexpr int LRU_W = 1024, NBLK = 8, BW = 128;
constexpr int MLW = 1024, MH = 4, DV = 256, DK = 128, MQK = 512, CH = 128, NCH = SEQ / CH;
constexpr int AB_IN = 5128, AB_IN_PAD = 5376;
constexpr int SBH = 16, SBD = 128;
constexpr int FF = 5632;
constexpr float EPS = 1e-6f;
constexpr float LOG2E = 1.4426950408889634f, LN2 = 0.6931471805599453f;

constexpr size_t MiB = 1u << 20;
constexpr size_t WS_CTL = 0, CTL_ZERO_BYTES = 1 * MiB;
constexpr size_t WS_MOD = 1 * MiB;
constexpr size_t WS_WABIN = 2 * MiB;
constexpr size_t WS_WABOUT = 44 * MiB;
constexpr size_t WS_WQKV = 60 * MiB;
constexpr size_t WS_WSBO = 108 * MiB;
constexpr size_t WS_W13 = 124 * MiB;
constexpr size_t WS_W2 = 300 * MiB;
constexpr size_t WS_HN = 388 * MiB;
constexpr size_t WS_P0 = 420 * MiB;
constexpr size_t WS_IG = 516 * MiB;
constexpr size_t WS_MIX = 517 * MiB;
constexpr size_t WS_ACT = 549 * MiB;
constexpr size_t WS_DC = 637 * MiB;
constexpr size_t WS_CIN = 669 * MiB;
constexpr size_t WS_SMALL = 685 * MiB;
constexpr size_t WS_HLOC = 686 * MiB;
constexpr size_t WS_PCUM = 718 * MiB;
constexpr size_t WS_AGG = 750 * MiB;
constexpr size_t WS_HTMP = 752 * MiB;
constexpr size_t WS_WGT = 784 * MiB;
constexpr size_t WS_CARRY = 785 * MiB;
constexpr size_t WS_END = 786 * MiB;
constexpr int CW_BAR = 4096;

constexpr int BIG_BYTES = 147456;
constexpr int MISC_OFF = BIG_BYTES;
constexpr int SM_OFF = BIG_BYTES + 1024;
constexpr int LDS_BYTES = 163840;

namespace pg8 {
#define PG8_LAS __attribute__((address_space(3)))
typedef unsigned short bf16_t;
typedef short bf16x8 __attribute__((ext_vector_type(8)));
typedef float f32x4 __attribute__((ext_vector_type(4)));
typedef unsigned u32x4 __attribute__((ext_vector_type(4)));
constexpr int BM = 256, BK = 64, HALF = 128, HTB = HALF * BK * 2  , STAGE_BYTES = 8 * HTB, NXCD = 8, WGM = 8;

__host__ __device__ __forceinline__ int lds_byte(int r, int c) { const int st = (r >> 4) * 2 + (c >> 5), rr = r & 15, cc = c & 31, ob = rr * 64 + cc * 2; return st * 1024 + (ob ^ (((ob >> 9) & 1) << 5)); }
__host__ __device__ __forceinline__ void stage_rc(int b, int& R, int& C) { const int st = b / 1024, sb = b % 1024, swz = sb ^ (((sb >> 9) & 1) << 5); R = (st >> 1) * 16 + swz / 64; C = (st & 1) * 32 + (swz % 64) / 2; }
__host__ __device__ __forceinline__ int perm32(int rho) { const int n = rho >> 4, i = rho & 15; return 8 * (i >> 2) + 4 * n + (i & 3); }

struct Unit { int pm, pn; };
struct Gemm { const bf16_t* A; const bf16_t* Bt; int M, N, K; };

struct StaticOrder {
    int nM, nN, nwg, G, c;
    __host__ __device__ void init(int M, int N, int G_, int c_) { nM = M / BM; nN = N / BM; nwg = nM * nN; G = G_; c = c_; }
    __host__ __device__ bool next(int i, Unit& u) const {
        const long L = (long)i * G + c; if (L >= nwg) return false;
        int wgid = (int)L; { const int q = nwg / NXCD, r = nwg % NXCD, xcd = wgid % NXCD, off = wgid / NXCD; wgid = (xcd < r ? xcd * (q + 1) : r * (q + 1) + (xcd - r) * q) + off; }
        const int nig = WGM * nN, gid = wgid / nig, fm = gid * WGM, gsz = (nM - fm) < WGM ? (nM - fm) : WGM;
        u.pm = fm + ((wgid % nig) % gsz); u.pn = (wgid % nig) / gsz; return true;
    }
    __device__ __forceinline__ void a_ready(const Unit&) const {}
    __device__ __forceinline__ void done(const Unit&) const {}
};

__device__ __forceinline__ unsigned cvt_pk_bf16(float lo, float hi) { unsigned r; asm volatile("v_cvt_pk_bf16_f32 %0, %1, %2" : "=v"(r) : "v"(lo), "v"(hi)); return r; }
typedef float f32x2 __attribute__((ext_vector_type(2)));
__device__ __forceinline__ u32x4 pack8(f32x4 v0, f32x4 v1) { u32x4 w; w.x = cvt_pk_bf16(v0[0], v0[1]); w.y = cvt_pk_bf16(v0[2], v0[3]); w.z = cvt_pk_bf16(v1[0], v1[1]); w.w = cvt_pk_bf16(v1[2], v1[3]); return w; }

struct EpiBf16Split {
    static constexpr bool PERM = true, AFTER_DRAIN = false;
    bf16_t* O; int ldc; int split_cols; size_t split_stride; float scale0;
    __device__ __forceinline__ void operator()(const f32x4 (&acc)[2][2][4][2], const Unit& u, int wr, int wc, int fr, int fq) const {
        const int row0 = u.pm * BM + wr * 64 + fr; int colt = u.pn * BM; bf16_t* base = O;
        float sc = 1.f; { const int t = colt / split_cols; base += (size_t)t * split_stride; colt -= t * split_cols; if (t == 0) sc = scale0; }
        const int col0 = colt + wc * 32 + 8 * fq;
#pragma unroll
        for (int ai = 0; ai < 2; ++ai)
#pragma unroll
            for (int m = 0; m < 4; ++m) { bf16_t* rowp = base + (size_t)(row0 + ai * HALF + m * 16) * ldc + col0;
#pragma unroll
                for (int bj = 0; bj < 2; ++bj) { *(u32x4*)(rowp + bj * HALF) = pack8(acc[ai][bj][m][0] * sc, acc[ai][bj][m][1] * sc); } }
    }
};

struct EpiResid {
    static constexpr bool PERM = true, AFTER_DRAIN = false;
    const float* base; float* out; const float* gate0;
    __device__ __forceinline__ void operator()(const f32x4 (&acc)[2][2][4][2], const Unit& u, int wr, int wc, int fr, int fq) const {
        const int row0 = u.pm * BM + wr * 64 + fr, col0 = u.pn * BM + wc * 32 + 8 * fq;
        const float* gp = gate0 + (u.pm >= 16 ? 6144 : 0) + col0;
        f32x4 gv[2][2];
#pragma unroll
        for (int bj = 0; bj < 2; ++bj)
#pragma unroll
            for (int n = 0; n < 2; ++n) gv[bj][n] = *(const f32x4*)(gp + bj * HALF + 4 * n);
#pragma unroll
        for (int ai = 0; ai < 2; ++ai)
#pragma unroll
            for (int m = 0; m < 4; ++m) { const size_t off = (size_t)(row0 + ai * HALF + m * 16) * 2048 + col0;
#pragma unroll
                for (int bj = 0; bj < 2; ++bj)
#pragma unroll
                    for (int n = 0; n < 2; ++n) { const f32x4 b = *(const f32x4*)(base + off + bj * HALF + 4 * n); *(f32x4*)(out + off + bj * HALF + 4 * n) = b + gv[bj][n] * acc[ai][bj][m][n]; }
                if (m & 1) asm volatile("" ::: "memory"); }
    }
};

struct EpiSwiGLU {
    static constexpr bool PERM = true, AFTER_DRAIN = false;
    bf16_t* O;
    static __device__ __forceinline__ f32x4 silu_mul(f32x4 a, f32x4 b) { f32x4 r;
#pragma unroll
        for (int i = 0; i < 4; ++i) { const float e = __builtin_amdgcn_exp2f(-a[i] * 1.4426950408889634f); r[i] = a[i] * __builtin_amdgcn_rcpf(1.f + e) * b[i]; }
        return r; }
    __device__ __forceinline__ void operator()(const f32x4 (&acc)[2][2][4][2], const Unit& u, int wr, int wc, int fr, int fq) const {
        const int row0 = u.pm * BM + wr * 64 + fr, col0 = u.pn * HALF + wc * 32 + 8 * fq;
#pragma unroll
        for (int ai = 0; ai < 2; ++ai)
#pragma unroll
            for (int m = 0; m < 4; ++m) { bf16_t* rowp = O + (size_t)(row0 + ai * HALF + m * 16) * 5632 + col0;
                *(u32x4*)rowp = pack8(silu_mul(acc[ai][0][m][0], acc[ai][1][m][0]), silu_mul(acc[ai][0][m][1], acc[ai][1][m][1])); }
    }
};

struct EpiInProj {
    static constexpr bool PERM = true, AFTER_DRAIN = false;
    float* XA; bf16_t *YA, *Qm, *Km, *Vm, *Om; float *IG, *FG; float kscale;
    __device__ __forceinline__ void operator()(const f32x4 (&acc)[2][2][4][2], const Unit& u, int wr, int wc, int fr, int fq) const {
        const int pn = u.pn, row0 = u.pm * BM + wr * 64 + fr, cl = wc * 32 + 8 * fq;
        if (pn < 4) {
#pragma unroll
            for (int ai = 0; ai < 2; ++ai)
#pragma unroll
                for (int m = 0; m < 4; ++m) { float* rp = XA + (size_t)(row0 + ai * HALF + m * 16) * 1024 + pn * 256 + cl;
#pragma unroll
                    for (int bj = 0; bj < 2; ++bj)
#pragma unroll
                        for (int n = 0; n < 2; ++n) *(f32x4*)(rp + bj * HALF + 4 * n) = acc[ai][bj][m][n]; }
        } else if (pn < 20) {
            bf16_t* base; int ld, colt; float sc = 1.f;
            if (pn < 8) { base = YA; ld = 1024; colt = (pn - 4) * 256; }
            else if (pn < 10) { base = Qm; ld = 512; colt = (pn - 8) * 256; }
            else if (pn < 12) { base = Km; ld = 512; colt = (pn - 10) * 256; sc = kscale; }
            else if (pn < 16) { base = Vm; ld = 1024; colt = (pn - 12) * 256; }
            else { base = Om; ld = 1024; colt = (pn - 16) * 256; }
#pragma unroll
            for (int ai = 0; ai < 2; ++ai)
#pragma unroll
                for (int m = 0; m < 4; ++m) { bf16_t* rowp = base + (size_t)(row0 + ai * HALF + m * 16) * ld + colt + cl;
#pragma unroll
                    for (int bj = 0; bj < 2; ++bj) *(u32x4*)(rowp + bj * HALF) = pack8(acc[ai][bj][m][0] * sc, acc[ai][bj][m][1] * sc); }
        } else {
            if (wc == 0 && fq == 0) {
#pragma unroll
                for (int ai = 0; ai < 2; ++ai)
#pragma unroll
                    for (int m = 0; m < 4; ++m) { const size_t r = (size_t)(row0 + ai * HALF + m * 16); *(f32x4*)(IG + r * 4) = acc[ai][0][m][0]; *(f32x4*)(FG + r * 4) = acc[ai][0][m][1]; }
            }
        }
    }
};

template <class Epi, class Sched, bool ALIGN_EPI = false, bool SP2 = false>
__device__ __forceinline__ void gemm_phase(PG8_LAS unsigned char* lds, const Gemm g, const Sched& S, const Epi& E, int tid_in) {
    const int tid = tid_in, wid = __builtin_amdgcn_readfirstlane(tid >> 6), lane = tid & 63, wr = wid >> 2, wc = wid & 3, fr = lane & 15, fq = lane >> 4;
    const int K = g.K, nt = K / BK;
    unsigned voffA[2], voffB[2];
#pragma unroll
    for (int i = 0; i < 2; ++i) { int R, C; stage_rc(tid * 16 + i * 8192, R, C); const int Rb = Epi::PERM ? ((R & ~31) + perm32(R & 31)) : R;
        voffA[i] = (unsigned)(R * K + C) * 2u; voffB[i] = (unsigned)(Rb * K + C) * 2u; }
    const size_t kstep = (size_t)(BK * 2);
    const size_t hstep = (size_t)HALF * K * 2;
    const size_t tstep = 2 * hstep;
    const unsigned ldsw = (unsigned)wid * 1024u;
    const int aoff = lds_byte(wr * 64 + fr, fq * 8), boff = lds_byte(wc * 32 + fr, fq * 8);
#define PG8_SA(b, h) (((b) * 2 + (h)) * HTB)
#define PG8_SB(b, h) ((4 + (b) * 2 + (h)) * HTB)
#define PG8_STAGE(bufoff, gbase, voff) do { _Pragma("unroll") for (int _i = 0; _i < 2; ++_i) \
        __builtin_amdgcn_global_load_lds((const unsigned*)((const char*)(gbase) + (voff)[_i]), (PG8_LAS unsigned*)(lds + (bufoff) + ldsw + _i * 8192), 16, 0, 0); } while (0)
#define PG8_LDA(dst, b, h) do { _Pragma("unroll") for (int m = 0; m < 4; ++m) _Pragma("unroll") for (int k = 0; k < 2; ++k) dst[m][k] = *(const PG8_LAS bf16x8*)(lds + PG8_SA(b, h) + aoff + m * 2048 + k * 1024); } while (0)
#define PG8_LDB(dst, b, h) do { _Pragma("unroll") for (int n = 0; n < 2; ++n) _Pragma("unroll") for (int k = 0; k < 2; ++k) dst[n][k] = *(const PG8_LAS bf16x8*)(lds + PG8_SB(b, h) + boff + n * 2048 + k * 1024); } while (0)
#define PG8_MMA(ai, bj, At, Bt) do { __builtin_amdgcn_s_setprio(1); _Pragma("unroll") for (int m = 0; m < 4; ++m) _Pragma("unroll") for (int n = 0; n < 2; ++n) _Pragma("unroll") for (int k = 0; k < 2; ++k) \
        acc[ai][bj][m][n] = __builtin_amdgcn_mfma_f32_16x16x32_bf16(Bt[n][k], At[m][k], acc[ai][bj][m][n], 0, 0, 0); __builtin_amdgcn_s_setprio(0); } while (0)
#define PG8_WAIT_V(n) asm volatile("s_waitcnt vmcnt(" #n ")" ::: "memory")
#define PG8_WAIT_L(n) asm volatile("s_waitcnt lgkmcnt(" #n ")" ::: "memory")
#define PG8_BAR __builtin_amdgcn_s_barrier()
#define PG8_SCHED __builtin_amdgcn_sched_barrier(0)
    Unit cur, nxt; int ui = 0;
    if (!S.next(0, cur)) return;
    f32x4 acc[2][2][4][2];
#pragma unroll
    for (int a = 0; a < 2; ++a)
#pragma unroll
        for (int b = 0; b < 2; ++b)
#pragma unroll
            for (int m = 0; m < 4; ++m)
#pragma unroll
                for (int n = 0; n < 2; ++n) acc[a][b][m][n] = (f32x4){0.f, 0.f, 0.f, 0.f};
    bf16x8 At[4][2], B0[2][2], B1[2][2];
    const char* cA = (const char*)g.A + (size_t)cur.pm * tstep; const char* cB = (const char*)g.Bt + (size_t)cur.pn * tstep;
    S.a_ready(cur);
    if constexpr (SP2) {
        PG8_STAGE(PG8_SB(0, 0), cB, voffB); PG8_STAGE(PG8_SB(0, 1), cB + hstep, voffB); PG8_STAGE(PG8_SA(0, 0), cA, voffA); PG8_STAGE(PG8_SA(0, 1), cA + hstep, voffA);
        if (wr == 1) PG8_BAR;
        PG8_WAIT_V(2); PG8_BAR;
        PG8_STAGE(PG8_SB(1, 0), cB + kstep, voffB); PG8_STAGE(PG8_SA(1, 0), cA + kstep, voffA); PG8_STAGE(PG8_SB(1, 1), cB + hstep + kstep, voffB);
        PG8_WAIT_V(6); PG8_BAR;
    } else {
        PG8_STAGE(PG8_SB(0, 0), cB, voffB); PG8_STAGE(PG8_SA(0, 0), cA, voffA); PG8_STAGE(PG8_SB(0, 1), cB + hstep, voffB); PG8_STAGE(PG8_SA(0, 1), cA + hstep, voffA);
        if (wr == 1) PG8_BAR;
        PG8_WAIT_V(4); PG8_BAR;
        PG8_STAGE(PG8_SB(1, 0), cB + kstep, voffB); PG8_STAGE(PG8_SA(1, 0), cA + kstep, voffA); PG8_STAGE(PG8_SB(1, 1), cB + hstep + kstep, voffB);
        PG8_WAIT_V(6); PG8_BAR;
    }
    for (;;) {
        const bool has_next = S.next(ui + 1, nxt);
        const char* nA = has_next ? (const char*)g.A + (size_t)nxt.pm * tstep : cA; const char* nB = has_next ? (const char*)g.Bt + (size_t)nxt.pn * tstep : cB;
        for (int t = 0; t < nt; t += 2) {
            const bool last = (t == nt - 2);
            const char* a1 = cA + (size_t)(t + 1) * kstep;
            const char* a2 = last ? nA : cA + (size_t)(t + 2) * kstep; const char* b2 = last ? nB : cB + (size_t)(t + 2) * kstep;
            const char* a3 = a2 + kstep; const char* b3 = b2 + kstep;
            if (last && has_next) S.a_ready(nxt);
            if constexpr (SP2) {
            PG8_LDB(B0, 0, 0); PG8_LDB(B1, 0, 1); PG8_SCHED; PG8_LDA(At, 0, 0); PG8_STAGE(PG8_SA(1, 1), a1 + hstep, voffA);
            PG8_WAIT_V(8); PG8_WAIT_L(0); PG8_BAR; PG8_MMA(0, 0, At, B0); PG8_MMA(0, 1, At, B1); PG8_BAR; PG8_SCHED;
            PG8_LDA(At, 0, 1); PG8_STAGE(PG8_SB(0, 0), b2, voffB); PG8_STAGE(PG8_SB(0, 1), b2 + hstep, voffB); PG8_STAGE(PG8_SA(0, 0), a2, voffA);
            PG8_WAIT_V(8); PG8_WAIT_L(0); PG8_BAR; PG8_MMA(1, 0, At, B0); PG8_MMA(1, 1, At, B1); PG8_BAR; PG8_SCHED;
            PG8_LDB(B0, 1, 0); PG8_LDB(B1, 1, 1); PG8_SCHED; PG8_LDA(At, 1, 0); PG8_STAGE(PG8_SA(0, 1), a2 + hstep, voffA);
            PG8_WAIT_V(8); PG8_WAIT_L(0); PG8_BAR; PG8_MMA(0, 0, At, B0); PG8_MMA(0, 1, At, B1); PG8_BAR; PG8_SCHED;
            PG8_LDA(At, 1, 1); PG8_STAGE(PG8_SB(1, 0), b3, voffB); PG8_STAGE(PG8_SB(1, 1), b3 + hstep, voffB); PG8_STAGE(PG8_SA(1, 0), a3, voffA);
            PG8_WAIT_V(8); PG8_WAIT_L(0); PG8_BAR; PG8_MMA(1, 0, At, B0); PG8_MMA(1, 1, At, B1); PG8_BAR; PG8_SCHED;
            } else {
            PG8_LDB(B0, 0, 0); PG8_SCHED; PG8_LDA(At, 0, 0); PG8_STAGE(PG8_SA(1, 1), a1 + hstep, voffA);
            PG8_WAIT_L(8); PG8_BAR; PG8_WAIT_L(0); PG8_MMA(0, 0, At, B0); PG8_BAR; PG8_SCHED;
            PG8_LDB(B1, 0, 1); PG8_STAGE(PG8_SB(0, 0), b2, voffB);
            PG8_BAR; PG8_WAIT_L(0); PG8_MMA(0, 1, At, B1); PG8_BAR;
            PG8_LDA(At, 0, 1); PG8_STAGE(PG8_SA(0, 0), a2, voffA);
            PG8_BAR; PG8_WAIT_L(0); PG8_MMA(1, 0, At, B0); PG8_BAR; PG8_SCHED;
            PG8_STAGE(PG8_SB(0, 1), b2 + hstep, voffB);
            PG8_WAIT_V(6); PG8_BAR; PG8_MMA(1, 1, At, B1); PG8_BAR;
            PG8_LDB(B0, 1, 0); PG8_SCHED; PG8_LDA(At, 1, 0); PG8_STAGE(PG8_SA(0, 1), a2 + hstep, voffA);
            PG8_WAIT_L(8); PG8_BAR; PG8_WAIT_L(0); PG8_MMA(0, 0, At, B0); PG8_BAR; PG8_SCHED;
            PG8_LDB(B1, 1, 1); PG8_STAGE(PG8_SB(1, 0), b3, voffB);
            PG8_BAR; PG8_WAIT_L(0); PG8_MMA(0, 1, At, B1); PG8_BAR;
            PG8_LDA(At, 1, 1); PG8_STAGE(PG8_SA(1, 0), a3, voffA);
            PG8_BAR; PG8_WAIT_L(0); PG8_MMA(1, 0, At, B0); PG8_BAR; PG8_SCHED;
            PG8_STAGE(PG8_SB(1, 1), b3 + hstep, voffB);
            PG8_WAIT_V(6); PG8_BAR; PG8_MMA(1, 1, At, B1); PG8_BAR;
            }
        }
        if constexpr (ALIGN_EPI) { if (wr == 0) PG8_BAR; }
        if constexpr (!Epi::AFTER_DRAIN) { E(acc, cur, wr, wc, fr, fq); S.done(cur); }
        if (!has_next) break;
#pragma unroll
        for (int a = 0; a < 2; ++a)
#pragma unroll
            for (int b = 0; b < 2; ++b)
#pragma unroll
                for (int m = 0; m < 4; ++m)
#pragma unroll
                    for (int n = 0; n < 2; ++n) acc[a][b][m][n] = (f32x4){0.f, 0.f, 0.f, 0.f};
        cur = nxt; cA = nA; cB = nB; ++ui;
        if constexpr (ALIGN_EPI) { if (wr == 1) PG8_BAR; }
    }
    PG8_WAIT_V(0);
    if constexpr (!ALIGN_EPI) { if (wr == 0) PG8_BAR; }
    PG8_BAR;
    if constexpr (Epi::AFTER_DRAIN) { E.fused(acc, cur, wr, wc, fr, fq, lds, wid, lane); S.done(cur); }
#undef PG8_SA
#undef PG8_SB
#undef PG8_STAGE
#undef PG8_LDA
#undef PG8_LDB
#undef PG8_MMA
#undef PG8_WAIT_V
#undef PG8_WAIT_L
#undef PG8_BAR
#undef PG8_SCHED
}
}
#ifndef PG8_SP2
#define PG8_SP2 true
#endif
#ifndef PG8_ALIGN
#define PG8_ALIGN true
#endif

#define GAS __attribute__((address_space(1)))
#define LAS __attribute__((address_space(3)))
typedef unsigned short bf16;
typedef unsigned v4u __attribute__((ext_vector_type(4)));
typedef unsigned v2u __attribute__((ext_vector_type(2)));
typedef float f32x4 __attribute__((ext_vector_type(4)));
typedef short bf16x8 __attribute__((ext_vector_type(8)));
typedef GAS unsigned gu32;
#define RLX_AGENT __ATOMIC_RELAXED, __HIP_MEMORY_SCOPE_AGENT
#define LDS_WAIT() asm volatile("s_waitcnt lgkmcnt(0)" ::: "memory")
#define VM_WAIT() asm volatile("s_waitcnt vmcnt(0)" ::: "memory")
__device__ __forceinline__ unsigned pk2(float lo, float hi) { return pg8::cvt_pk_bf16(lo, hi); }
__device__ __forceinline__ bf16 f2bf(float x) { return (bf16)(pg8::cvt_pk_bf16(x, 0.f) & 0xffffu); }
__device__ __forceinline__ float bf2f(bf16 b) { return __uint_as_float((unsigned)b << 16); }
__device__ __forceinline__ float bflo(unsigned p) { return __uint_as_float(p << 16); }
__device__ __forceinline__ float bfhi(unsigned p) { return __uint_as_float(p & 0xffff0000u); }
__device__ __forceinline__ float sigmoidf_(float x) { return 1.f / (1.f + __expf(-x)); }
__device__ __forceinline__ float logsigmoidf_(float x) { return fminf(x, 0.f) - log1pf(__expf(-fabsf(x))); }
__device__ __forceinline__ float gelu_tanh(float y) { const float x = 0.7978845608028654f * (y + 0.044715f * y * y * y); const float t = __builtin_amdgcn_exp2f(2.f * LOG2E * x); return 0.5f * y * (2.f - 2.f * __builtin_amdgcn_rcpf(t + 1.f)); }
template <int X> __device__ __forceinline__ float swz_xor(float v) { return __int_as_float(__builtin_amdgcn_ds_swizzle(__float_as_int(v), (X << 10) | 0x1f)); }
__device__ __forceinline__ float xor32(float v) { const unsigned u = __float_as_uint(v); auto rr = __builtin_amdgcn_permlane32_swap(u, u, false, false); const unsigned a = rr[0], b = rr[1]; return __uint_as_float(a ^ b ^ u); }
__device__ __forceinline__ float wave_sum(float v) { v += swz_xor<1>(v); v += swz_xor<2>(v); v += swz_xor<4>(v); v += swz_xor<8>(v); v += swz_xor<16>(v); v += xor32(v); return v; }
__device__ __forceinline__ float wave_max(float v) { v = fmaxf(v, swz_xor<1>(v)); v = fmaxf(v, swz_xor<2>(v)); v = fmaxf(v, swz_xor<4>(v)); v = fmaxf(v, swz_xor<8>(v)); v = fmaxf(v, swz_xor<16>(v)); v = fmaxf(v, xor32(v)); return v; }
__device__ __forceinline__ float lane_up(float x, int off, int lane) { const int src = (lane >= off) ? lane - off : lane; return __int_as_float(__builtin_amdgcn_ds_bpermute(src << 2, __float_as_int(x))); }
__device__ __forceinline__ int fresh_tid(int wave_s) { int l; asm volatile("v_mbcnt_lo_u32_b32 %0, -1, 0\n\tv_mbcnt_hi_u32_b32 %0, -1, %0" : "=v"(l)); int w = wave_s; asm volatile("" : "+s"(w)); int t = w * 64 + l; asm volatile("" : "+v"(t)); return t; }
#define XB_TMO      128
#define XB_XCNT(j)  (256  + 64 * (j))
#define XB_XSUB(j)  (1280 + 64 * (j))
#define XB_XGEN(j)  (2304 + 64 * (j))
#define XB_TOP      3328
#define XB_TOPGEN   3392
#define XCD_BAR_WORDS 3456
#define XB_SPIN_CAP (1u << 18)

__device__ __forceinline__ unsigned xb_ld(unsigned* p)              { return __hip_atomic_load(p, __ATOMIC_RELAXED, __HIP_MEMORY_SCOPE_AGENT); }
__device__ __forceinline__ unsigned xb_add(unsigned* p, unsigned v) { return __hip_atomic_fetch_add(p, v, __ATOMIC_RELAXED, __HIP_MEMORY_SCOPE_AGENT); }
__device__ __forceinline__ unsigned xb_xcc_id() { return (unsigned)__builtin_amdgcn_s_getreg((3 << 11) | 20) & 0xFu; }
#define XB_SPIN(cond, bar) do { unsigned _sp = 0; while (cond) { __builtin_amdgcn_s_sleep(1); \
    if ((++_sp & 255u) == 0u) { if (xb_ld(&(bar)[XB_TMO])) break; if (_sp > XB_SPIN_CAP) { atomicAdd(&(bar)[XB_TMO], 1u); break; } } } } while (0)

struct XcdBarrier {
    unsigned* bar; unsigned x;
    volatile LAS unsigned* st;
};

__device__ __forceinline__ XcdBarrier xcd_barrier_post(unsigned* bar, volatile LAS unsigned* st) {
    XcdBarrier b; b.bar = bar; b.x = xb_xcc_id(); b.st = st;
    if (threadIdx.x == 0) (void)xb_add(&bar[XB_XCNT(b.x)], 1u);
    return b;
}
__device__ __forceinline__ void xcd_barrier_complete(unsigned* bar, unsigned x, unsigned& nloc, unsigned& nx) {
    const unsigned G = gridDim.x * gridDim.y * gridDim.z;
    unsigned sum, cnt, mine, sp = 0u;
    for (;;) {
        sum = 0u; cnt = 0u; mine = 0u;
#pragma unroll
        for (unsigned j = 0; j < 16; ++j) { const unsigned c = xb_ld(&bar[XB_XCNT(j)]); sum += c; cnt += (c > 0u) ? 1u : 0u; mine = (j == x) ? c : mine; }
        if (sum == G) break;
        __builtin_amdgcn_s_sleep(1);
        if ((++sp & 255u) == 0u) { if (xb_ld(&bar[XB_TMO])) break; if (sp > XB_SPIN_CAP) { atomicAdd(&bar[XB_TMO], 1u); break; } }
    }
    nloc = mine > 0u ? mine : 1u; nx = cnt > 0u ? cnt : 1u;
}

__device__ __forceinline__ void xcd_barrier(const XcdBarrier& b) {
    asm volatile("s_waitcnt vmcnt(0)" ::: "memory");
    __syncthreads();
    if (threadIdx.x == 0) {
        unsigned* bar = b.bar;
        __builtin_amdgcn_s_waitcnt(0);
        unsigned nloc = b.st[0], nx = b.st[1];
        if (nloc == 0u) { xcd_barrier_complete(bar, b.x, nloc, nx); b.st[0] = nloc; b.st[1] = nx; }
        const unsigned old = xb_add(&bar[XB_XSUB(b.x)], 1u);
        const unsigned gen = old / nloc;
        if (old + 1u == (gen + 1u) * nloc) {
            __builtin_amdgcn_fence(__ATOMIC_RELEASE, "agent");
            asm volatile("s_waitcnt vmcnt(0)" ::: "memory");
            const unsigned og = xb_add(&bar[XB_TOP], 1u);
            const unsigned tg = og / nx;
            if (og + 1u == (tg + 1u) * nx) xb_add(&bar[XB_TOPGEN], 1u);
            else XB_SPIN(xb_ld(&bar[XB_TOPGEN]) == tg, bar);
            __builtin_amdgcn_fence(__ATOMIC_ACQUIRE, "agent");
            xb_add(&bar[XB_XGEN(b.x)], 1u);
            asm volatile("s_waitcnt vmcnt(0)" ::: "memory");
        } else {
            XB_SPIN(xb_ld(&bar[XB_XGEN(b.x)]) == gen, bar);
            __builtin_amdgcn_fence(__ATOMIC_ACQUIRE, "agent");
            asm volatile("s_waitcnt vmcnt(0)" ::: "memory");
        }
    }
    __syncthreads();
}


struct Args { const float* in[20]; float* out; unsigned char* ws; };
typedef const __attribute__((address_space(4))) Args* KArgs;

__device__ __forceinline__ void transpose_item(const float* W, int K, int N, bf16* WT, int mode, LAS float* scr, int item, int lane) {
    const int nblk = (N + 31) / 32, kb = item / nblk, nb = item % nblk, k0 = 64 * kb, n0 = 32 * nb;
    const int nn = n0 + (lane & 31); const bool ok = nn < N;
#pragma unroll 8
    for (int i = 0; i < 32; ++i) { const int kk = 2 * i + (lane >> 5); scr[kk * 33 + (lane & 31)] = ok ? W[(size_t)(k0 + kk) * N + nn] : 0.f; }
    LDS_WAIT(); asm volatile("" ::: "memory");
    const int c = lane & 7;
    int r0 = n0; if (mode) r0 = 256 * (n0 >> 7) + (n0 & 127) + (mode == 2 ? 128 : 0);
#pragma unroll
    for (int j = 0; j < 4; ++j) { const int n = (lane >> 3) + 8 * j; const LAS float* s = scr + (8 * c) * 33 + n;
        v4u o; o.x = pk2(s[0 * 33], s[1 * 33]); o.y = pk2(s[2 * 33], s[3 * 33]); o.z = pk2(s[4 * 33], s[5 * 33]); o.w = pk2(s[6 * 33], s[7 * 33]);
        if (n0 + n < N) *(GAS v4u*)(WT + (size_t)(r0 + n) * K + k0 + 8 * c) = o; }
    LDS_WAIT(); asm volatile("" ::: "memory");
}

__device__ __forceinline__ void transpose_item2(const float* W, int K, int N, bf16* WT, int mode, int item, int lane) {
    const int nblk = (N + 255) / 256, kb = item / nblk, nb = item % nblk, k0 = 32 * kb, n = 256 * nb + 4 * lane;
    if (n >= N) return;
    int r0 = n; if (mode) r0 = 256 * (n >> 7) + (n & 127) + (mode == 2 ? 128 : 0);
    const float* src = W + (size_t)k0 * N + n; bf16* dst = WT + (size_t)r0 * K + k0;
#pragma unroll
    for (int kk = 0; kk < 4; ++kk) {
        f32x4 v[8];
#pragma unroll
        for (int j = 0; j < 8; ++j) v[j] = *(const GAS f32x4*)(src + (size_t)(8 * kk + j) * N);
#pragma unroll
        for (int i = 0; i < 4; ++i) { v4u o; o.x = pk2(v[0][i], v[1][i]); o.y = pk2(v[2][i], v[3][i]); o.z = pk2(v[4][i], v[5][i]); o.w = pk2(v[6][i], v[7][i]); *(GAS v4u*)(dst + (size_t)i * K + 8 * kk) = o; }
    }
}

__device__ __forceinline__ void p0_prologue(KArgs args, LAS unsigned char* lds, int tid, int lane, int wave, int vcu, int G) {
    unsigned char* ws = args->ws;
    const int bx = blockIdx.x;
    if (bx < 192) {
        LAS float* cs = (LAS float*)lds;
        LAS float* red = (LAS float*)(lds + 16384);
        const float* c = args->in[1];
        for (int i = tid; i < 4096; i += 512) { const float v = c[i]; cs[i] = v / (1.f + __expf(-v)); }
        __syncthreads();
        const int mat = bx / 24, cg = bx % 24;
        const float* Wp = args->in[2] + (size_t)mat * 2048 * 6144 + cg * 256 + lane * 4;
        f32x4 a0 = {0.f, 0.f, 0.f, 0.f}, a1 = {0.f, 0.f, 0.f, 0.f};
        const int kbeg = wave * 256;
#pragma unroll 8
        for (int k = kbeg; k < kbeg + 256; ++k) { const f32x4 w = *(const GAS f32x4*)(Wp + (size_t)k * 6144); const float c0 = cs[k], c1 = cs[2048 + k]; a0 += c0 * w; a1 += c1 * w; }
        *(LAS f32x4*)(red + (wave * 2 + 0) * 256 + lane * 4) = a0; *(LAS f32x4*)(red + (wave * 2 + 1) * 256 + lane * 4) = a1;
        __syncthreads();
        { const int b = tid >> 8, col = tid & 255; float s = args->in[3][mat * 6144 + cg * 256 + col];
#pragma unroll
          for (int w = 0; w < 8; ++w) s += red[(w * 2 + b) * 256 + col];
          ((float*)(ws + WS_MOD))[(mat * 2 + b) * 6144 + cg * 256 + col] = s; }
        __syncthreads();
    }
    LAS float* scr = (LAS float*)(lds + wave * 16384);
    const int gw = vcu * NWAVES + wave, NGW = G * NWAVES;
    constexpr int I_ABIN = 32 * 161, I_SQ = 32 * 64, I_QKV = 32 * 192, I_W1 = 32 * 176, I_W2 = 88 * 64;
    constexpr int NITEMS = 2 * (I_ABIN + 2 * I_SQ + I_QKV) + 4 * (2 * I_W1 + I_W2) + 256;
    for (int it = gw; it < NITEMS; it += NGW) {
        int r = it;
        if (r < 2 * I_ABIN) { const int j = r / I_ABIN; transpose_item(args->in[9] + (size_t)j * 2048 * AB_IN, 2048, AB_IN, (bf16*)(ws + WS_WABIN) + (size_t)j * AB_IN_PAD * 2048, 0, scr, r % I_ABIN, lane); continue; } r -= 2 * I_ABIN;
        if (r < 2 * I_SQ) { const int j = r / I_SQ; transpose_item(args->in[10] + (size_t)j * 2048 * 2048, 2048, 2048, (bf16*)(ws + WS_WABOUT) + (size_t)j * 2048 * 2048, 0, scr, r % I_SQ, lane); continue; } r -= 2 * I_SQ;
        if (r < 2 * I_QKV) { const int j = r / I_QKV; transpose_item(args->in[18] + (size_t)j * 2048 * 6144, 2048, 6144, (bf16*)(ws + WS_WQKV) + (size_t)j * 6144 * 2048, 0, scr, r % I_QKV, lane); continue; } r -= 2 * I_QKV;
        if (r < 2 * I_SQ) { const int j = r / I_SQ; transpose_item(args->in[19] + (size_t)j * 2048 * 2048, 2048, 2048, (bf16*)(ws + WS_WSBO) + (size_t)j * 2048 * 2048, 0, scr, r % I_SQ, lane); continue; } r -= 2 * I_SQ;
        if (r < 4 * I_W1) { const int l = r / I_W1; transpose_item(args->in[6] + (size_t)l * 2048 * FF, 2048, FF, (bf16*)(ws + WS_W13) + (size_t)l * 2 * FF * 2048, 1, scr, r % I_W1, lane); continue; } r -= 4 * I_W1;
        if (r < 4 * I_W1) { const int l = r / I_W1; transpose_item(args->in[7] + (size_t)l * 2048 * FF, 2048, FF, (bf16*)(ws + WS_W13) + (size_t)l * 2 * FF * 2048, 2, scr, r % I_W1, lane); continue; } r -= 4 * I_W1;
        if (r < 4 * I_W2) { const int l = r / I_W2; transpose_item(args->in[8] + (size_t)l * FF * 2048, FF, 2048, (bf16*)(ws + WS_W2) + (size_t)l * 2048 * FF, 0, scr, r % I_W2, lane); continue; } r -= 4 * I_W2;
        { const int mat = r >> 3; transpose_item(args->in[13] + (size_t)mat * 16384, 128, 128, (bf16*)(ws + WS_WGT) + (size_t)mat * 16384, 0, scr, r & 7, lane); }
    }
}

__device__ __forceinline__ void norm_phase(const float* xin, const float* g, const float* mod  , bf16* HN, int lane, int gw, int NGW) {
    int curb = -1; f32x4 gs[8], sh[8];
    for (int row = gw; row < M; row += NGW) {
        const int b = row >= SEQ ? 1 : 0;
        if (b != curb) { curb = b;
#pragma unroll
            for (int j = 0; j < 8; ++j) { const int col = 4 * lane + 256 * j; const f32x4 gg = *(const GAS f32x4*)(g + col), sc = *(const GAS f32x4*)(mod + b * 6144 + 2048 + col); gs[j] = gg * (1.f + sc); sh[j] = *(const GAS f32x4*)(mod + b * 6144 + col); } }
        const GAS f32x4* xr = (const GAS f32x4*)(xin + (size_t)row * DM) + lane;
        f32x4 v[8]; float ss = 0.f;
#pragma unroll
        for (int j = 0; j < 8; ++j) { v[j] = xr[64 * j]; ss += (v[j].x * v[j].x + v[j].y * v[j].y) + (v[j].z * v[j].z + v[j].w * v[j].w); }
        const float rstd = 1.f / sqrtf(wave_sum(ss) * (1.f / DM) + EPS);
        GAS v2u* o8 = (GAS v2u*)(HN + (size_t)row * DM) + lane;
#pragma unroll
        for (int j = 0; j < 8; ++j) { const f32x4 y = v[j] * rstd * gs[j] + sh[j]; v2u w; w.x = pk2(y.x, y.y); w.y = pk2(y.z, y.w); o8[64 * j] = w; }
    }
}
__device__ __forceinline__ void final_norm_phase(const float* xin, const float* g, float* out, int lane, int gw, int NGW) {
    f32x4 gs[8];
#pragma unroll
    for (int j = 0; j < 8; ++j) gs[j] = *(const GAS f32x4*)(g + 4 * lane + 256 * j);
    for (int row = gw; row < M; row += NGW) {
        const GAS f32x4* xr = (const GAS f32x4*)(xin + (size_t)row * DM) + lane;
        f32x4 v[8]; float ss = 0.f;
#pragma unroll
        for (int j = 0; j < 8; ++j) { v[j] = xr[64 * j]; ss += (v[j].x * v[j].x + v[j].y * v[j].y) + (v[j].z * v[j].z + v[j].w * v[j].w); }
        const float rstd = 1.f / sqrtf(wave_sum(ss) * (1.f / DM) + EPS);
        GAS f32x4* o = (GAS f32x4*)(out + (size_t)row * DM) + lane;
#pragma unroll
        for (int j = 0; j < 8; ++j) o[64 * j] = v[j] * rstd * gs[j];
    }
}

struct MixP {
    const float *XA, *IG, *FG; const bf16 *YA, *Qm, *Km, *Vm, *Om; bf16* MIX;
    const float *conv_w, *conv_b, *gate_w, *gate_b, *lam, *mgb, *mng;
    float *DC, *DN, *NIN, *MLOC, *BLAST, *MIN, *HLOC, *PCUM, *AGGP, *AGGH, *HTMP; bf16* CIN;
};

__device__ __forceinline__ void mx1_rglru_unit(const MixP& P, LAS unsigned char* lds, int tid, int b, int n, int c) {
    LAS float* XC = (LAS float*)lds;
    LAS float* AS = (LAS float*)(lds + 65536);
    const int e = tid & 127, tg = tid >> 7, chn = n * 128 + e;
    const size_t rowbase = (size_t)b * SEQ; const int t0 = c * CH;
    {
        float w[4]; for (int j = 0; j < 4; ++j) w[j] = P.conv_w[j * LRU_W + chn];
        const float cb = P.conv_b[chn];
        for (int i = 0; i < 32; ++i) { const int tt = tg * 32 + i, t = t0 + tt; float acc = cb;
#pragma unroll
            for (int j = 0; j < 4; ++j) { const int ts = t - 3 + j; if (ts >= 0) acc += w[j] * P.XA[(rowbase + ts) * LRU_W + chn]; }
            XC[tt * 128 + e] = acc; }
    }
    __syncthreads();
    float ar[32], ai[32];
    { const float br = P.gate_b[chn], bi = P.gate_b[LRU_W + chn];
#pragma unroll
      for (int i = 0; i < 32; ++i) { ar[i] = br; ai[i] = bi; } }
    { const float* Wr = P.gate_w + ((size_t)(0 * NBLK + n) * 128) * 128 + e; const float* Wi = P.gate_w + ((size_t)(1 * NBLK + n) * 128) * 128 + e;
      for (int d = 0; d < 128; ++d) { const float wr = Wr[d * 128], wi = Wi[d * 128];
#pragma unroll
          for (int i = 0; i < 32; ++i) { const float x = XC[(tg * 32 + i) * 128 + d]; ar[i] += x * wr; ai[i] += x * wi; } } }
    __syncthreads();
    { const float ls = logsigmoidf_(P.lam[chn]);
#pragma unroll
      for (int i = 0; i < 32; ++i) { const int tt = tg * 32 + i; const float r = sigmoidf_(ar[i]), ig = sigmoidf_(ai[i]); const float la = 8.f * r * ls; const float a = __expf(la);
          const float mult = sqrtf(-expm1f(2.f * la)); const float xv = XC[tt * 128 + e]; AS[tt * 128 + e] = a; XC[tt * 128 + e] = mult * (ig * xv); } }
    __syncthreads();
    if (tid < 128) { float h = 0.f, pp = 1.f;
        for (int tt = 0; tt < 128; ++tt) { const float a = AS[tt * 128 + e], u = XC[tt * 128 + e]; h = a * h + u; pp *= a; const size_t o = (rowbase + t0 + tt) * LRU_W + chn; P.HLOC[o] = h; P.PCUM[o] = pp; }
        P.AGGP[(b * NCH + c) * LRU_W + chn] = pp; P.AGGH[(b * NCH + c) * LRU_W + chn] = h; }
    __syncthreads();
}

__device__ __forceinline__ void mx3_rglru_unit(const MixP& P, int tid, int b, int c, int half) {
    const int chn = half * 512 + tid;
    float carry = 0.f;
    for (int c2 = 0; c2 < c; ++c2) carry = P.AGGP[(b * NCH + c2) * LRU_W + chn] * carry + P.AGGH[(b * NCH + c2) * LRU_W + chn];
    for (int tt = 0; tt < CH; ++tt) { const size_t row = (size_t)b * SEQ + c * CH + tt; const float h = P.HLOC[row * LRU_W + chn] + P.PCUM[row * LRU_W + chn] * carry;
        const float y = bf2f(P.YA[row * LRU_W + chn]); P.MIX[row * DM + chn] = f2bf(h * gelu_tanh(y)); }
}

__device__ __forceinline__ void mx1_mlstm_unit(const MixP& P, LAS unsigned char* lds, int tid, int b, int h, int c) {
    LAS bf16* VS = (LAS bf16*)lds;
    LAS float* KS = (LAS float*)(lds + 65536);
    LAS float* sm = (LAS float*)(lds + SM_OFF); LAS float *s_li = sm, *s_lf = sm + 128, *s_bc = sm + 256, *s_g = sm + 384, *s_sc = sm + 768;
    const size_t rowbase = (size_t)b * SEQ + c * CH; const int uidx = (b * MH + h) * NCH + c;
    if (tid < 128) { s_li[tid] = P.IG[(rowbase + tid) * 4 + h] + P.mgb[h]; s_lf[tid] = logsigmoidf_(P.FG[(rowbase + tid) * 4 + h] + P.mgb[MH + h]); }
    __syncthreads();
    if (tid == 0) { float acc = 0.f, G = -INFINITY; for (int s = 0; s < 128; ++s) { acc += s_lf[s]; s_bc[s] = acc; const float g = s_li[s] - acc; s_g[s] = g; G = fmaxf(G, g); } s_sc[0] = G; s_sc[1] = acc; }
    __syncthreads();
    { const float G = s_sc[0]; const int s = tid >> 2, q = tid & 3; const float w = __expf(s_g[s] - G);
      const bf16* vp = P.Vm + (rowbase + s) * MLW + h * DV;
#pragma unroll
      for (int i = 0; i < 8; ++i) { const int ch = q + 4 * i; *(LAS v4u*)(VS + s * 256 + ch * 8) = *(const GAS v4u*)(vp + ch * 8); }
      const bf16* kp = P.Km + (rowbase + s) * MQK + h * DK + q * 32;
#pragma unroll
      for (int i = 0; i < 4; ++i) { const v4u kk = *(const GAS v4u*)(kp + i * 8); LAS float* d = KS + s * 128 + q * 32 + i * 8;
          d[0] = w * bflo(kk.x); d[1] = w * bfhi(kk.x); d[2] = w * bflo(kk.y); d[3] = w * bfhi(kk.y); d[4] = w * bflo(kk.z); d[5] = w * bfhi(kk.z); d[6] = w * bflo(kk.w); d[7] = w * bfhi(kk.w); } }
    __syncthreads();
    { const int d = tid & 127, vg = tid >> 7;
      float* dc = P.DC + ((size_t)uidx * DV + vg * 64) * DK + d;
#pragma unroll 1
      for (int i = 0; i < 64; ++i) { const LAS bf16* vcol = VS + vg * 64 + i; float acc = 0.f;
#pragma unroll 8
          for (int s = 0; s < 128; ++s) acc += KS[s * 128 + d] * bf2f(vcol[s * 256]);
          dc[(size_t)i * DK] = acc; }
      if (tid < 128) { float a = 0.f; for (int s = 0; s < 128; ++s) a += KS[s * 128 + tid]; P.DN[uidx * DK + tid] = a; }
      if (tid == 0) { P.MLOC[uidx] = s_sc[1] + s_sc[0]; P.BLAST[uidx] = s_sc[1]; } }
    __syncthreads();
}

__device__ __forceinline__ void mx2_mlstm(const MixP& P, LAS unsigned char* lds, int tid, int gtid, int NT) {
    LAS float* sm = (LAS float*)(lds + SM_OFF); LAS float *s_dec = sm, *s_scl = sm + 256, *s_min = sm + 512;
    if (tid < 8) { float m = 0.f; for (int k = 0; k < NCH; ++k) { const int u = tid * NCH + k; s_min[u] = m; const float bl = P.BLAST[u], ml = P.MLOC[u]; const float mn = fmaxf(bl + m, ml);
        s_dec[u] = __expf(bl + m - mn); s_scl[u] = __expf(ml - mn); m = mn; } }
    __syncthreads();
    typedef float f32x2v __attribute__((ext_vector_type(2)));
    for (int e2 = gtid; e2 < 8 * DV * DK / 2; e2 += NT) { const int chain = e2 / (DV * DK / 2), idx = (e2 % (DV * DK / 2)) * 2;
        const float* dcp = P.DC + (size_t)chain * NCH * (DV * DK) + idx; bf16* cip = P.CIN + (size_t)chain * NCH * (DV * DK) + idx;
        f32x2v d[NCH];
#pragma unroll
        for (int k = 0; k < NCH; ++k) d[k] = *(const GAS f32x2v*)(dcp + (size_t)k * (DV * DK));
        float c0 = 0.f, c1 = 0.f;
#pragma unroll
        for (int k = 0; k < NCH; ++k) { const int u = chain * NCH + k; *(GAS unsigned*)(cip + (size_t)k * (DV * DK)) = pk2(c0, c1); const float dd = s_dec[u], sc = s_scl[u]; c0 = dd * c0 + sc * d[k].x; c1 = dd * c1 + sc * d[k].y; } }
    if (gtid < 8 * DK) { const int chain = gtid / DK, dd_ = gtid % DK; float nv = 0.f; float dn[NCH];
#pragma unroll
        for (int k = 0; k < NCH; ++k) dn[k] = P.DN[(chain * NCH + k) * DK + dd_];
#pragma unroll
        for (int k = 0; k < NCH; ++k) { const int u = chain * NCH + k; P.NIN[u * DK + dd_] = nv; nv = s_dec[u] * nv + s_scl[u] * dn[k]; } }
    if (gtid < 256) P.MIN[gtid] = s_min[gtid];
    __syncthreads();
}

__device__ __forceinline__ void mx3_mlstm_unit(const MixP& P, LAS unsigned char* lds, int tid, int lane, int wave, int b, int h, int c) {
    constexpr int SS = 129, KSTR = 130;
    LAS float* S = (LAS float*)lds;
    LAS bf16* QS = (LAS bf16*)(lds + 66048);
    LAS bf16* KSb = (LAS bf16*)(lds + 66048 + 32768);
    LAS float* sm = (LAS float*)(lds + SM_OFF); LAS float *s_li = sm, *s_lf = sm + 128, *s_bc = sm + 256, *s_g = sm + 384, *s_M = sm + 512, *s_dn = sm + 640, *s_wi = sm + 768, *s_nin = sm + 896;
    const size_t rowbase = (size_t)b * SEQ + c * CH; const int uidx = (b * MH + h) * NCH + c;
    const float m_in = P.MIN[uidx];
    if (tid < 128) { s_li[tid] = P.IG[(rowbase + tid) * 4 + h] + P.mgb[h]; s_lf[tid] = logsigmoidf_(P.FG[(rowbase + tid) * 4 + h] + P.mgb[MH + h]); s_nin[tid] = P.NIN[uidx * DK + tid]; }
    { const int s = tid >> 2, q = tid & 3;
      const bf16* qp = P.Qm + (rowbase + s) * MQK + h * DK + q * 32; const bf16* kp = P.Km + (rowbase + s) * MQK + h * DK + q * 32;
#pragma unroll
      for (int i = 0; i < 4; ++i) { *(LAS v4u*)(QS + s * 128 + q * 32 + i * 8) = *(const GAS v4u*)(qp + i * 8);
          const v4u kk = *(const GAS v4u*)(kp + i * 8); LAS unsigned* kd = (LAS unsigned*)(KSb + s * KSTR + q * 32 + i * 8); kd[0] = kk.x; kd[1] = kk.y; kd[2] = kk.z; kd[3] = kk.w; } }
    __syncthreads();
    if (tid == 0) { float acc = 0.f, cm = m_in; for (int s = 0; s < 128; ++s) { acc += s_lf[s]; s_bc[s] = acc; const float g = s_li[s] - acc; s_g[s] = g; cm = fmaxf(cm, g); s_M[s] = cm; s_wi[s] = __expf(m_in - cm); } }
    __syncthreads();
    { const int s = tid & 127, tg = tid >> 7;
      const float gs = s_g[s]; const LAS unsigned* krow = (const LAS unsigned*)(KSb + s * KSTR);
#pragma unroll 1
      for (int i = 0; i < 32; ++i) { const int t = tg * 32 + i; float acc = 0.f; const LAS unsigned* qrow = (const LAS unsigned*)(QS + t * 128);
#pragma unroll 8
          for (int d2 = 0; d2 < 64; ++d2) { const unsigned qp = qrow[d2], kp = krow[d2]; acc += bflo(qp) * bflo(kp) + bfhi(qp) * bfhi(kp); }
          S[t * SS + s] = (s <= t) ? acc * __expf(gs - s_M[t]) : 0.f; } }
    __syncthreads();
    if (tid < 128) { const int t = tid; float den = 0.f; for (int s = 0; s < 128; ++s) den += S[t * SS + s];
        float qn = 0.f; for (int d = 0; d < 128; ++d) qn += bf2f(QS[t * 128 + d]) * s_nin[d];
        den += s_wi[t] * qn; const float mt = s_bc[t] + s_M[t]; s_dn[t] = 1.f / fmaxf(fabsf(den), __expf(-mt)); }
    __syncthreads();
    { const int v = tid & 255, tg = tid >> 8;
      const bf16* cp = P.CIN + ((size_t)uidx * DV + v) * DK;
      const bf16* vp = P.Vm + rowbase * MLW + h * DV + v;
      float* ht = P.HTMP + (size_t)uidx * CH * DV;
#pragma unroll 1
      for (int i = 0; i < 64; ++i) { const int t = tg * 64 + i; float acc = 0.f; const LAS unsigned* qrow = (const LAS unsigned*)(QS + t * 128);
#pragma unroll 4
          for (int d2 = 0; d2 < 64; ++d2) { const unsigned qp = qrow[d2]; const unsigned cc = *(const GAS unsigned*)(cp + 2 * d2); acc += bflo(qp) * bflo(cc) + bfhi(qp) * bfhi(cc); }
          acc *= s_wi[t];
          const LAS float* srow = S + t * SS;
#pragma unroll 4
          for (int s = 0; s < 128; ++s) acc += srow[s] * bf2f(*(const GAS bf16*)(vp + (size_t)s * MLW));
          ht[t * DV + v] = acc * s_dn[t]; } }
    __syncthreads();
    const float* HS = P.HTMP + (size_t)uidx * CH * DV;
    for (int i = 0; i < 16; ++i) { const int t = wave * 16 + i; const f32x4 hv = *(const GAS f32x4*)(HS + t * 256 + 4 * lane);
        const float ss = wave_sum((hv.x * hv.x + hv.y * hv.y) + (hv.z * hv.z + hv.w * hv.w)); const float rstd = 1.f / sqrtf(ss * (1.f / DV) + EPS);
        const f32x4 ng = *(const GAS f32x4*)(P.mng + h * DV + 4 * lane); const v2u ob = *(const GAS v2u*)(P.Om + (rowbase + t) * MLW + h * DV + 4 * lane);
        const float o0 = sigmoidf_(bflo(ob.x)), o1 = sigmoidf_(bfhi(ob.x)), o2 = sigmoidf_(bflo(ob.y)), o3 = sigmoidf_(bfhi(ob.y));
        v2u w; w.x = pk2(hv.x * rstd * ng.x * o0, hv.y * rstd * ng.y * o1); w.y = pk2(hv.z * rstd * ng.z * o2, hv.w * rstd * ng.w * o3);
        *(GAS v2u*)(P.MIX + (rowbase + t) * DM + LRU_W + h * DV + 4 * lane) = w; }
    __syncthreads();
}

__device__ __forceinline__ void attn_v1_phase(const bf16* Q, const bf16* K, const bf16* V, bf16* O, LAS unsigned char* lds, int lane, int wave, int gw, int NGW) {
    LAS float* qs = (LAS float*)(lds + wave * 512);
    for (int u = gw; u < BATCH * SBH * SEQ; u += NGW) {
        const int bh = u & 31, t = u >> 5, b = bh >> 4, h = bh & 15;
        const size_t rowbase = (size_t)b * SEQ;
        { const unsigned qp = *(const GAS unsigned*)(Q + (rowbase + t) * DM + h * SBD + 2 * lane); qs[2 * lane] = bflo(qp); qs[2 * lane + 1] = bfhi(qp); }
        LDS_WAIT();
        float o0 = 0.f, o1 = 0.f, carry = 0.f;
        for (int kb = (t - 1) >> 6; kb >= 0 && t > 0; --kb) {
            const int s = kb * 64 + lane; const bool valid = s < t;
            const bf16* kp = K + (rowbase + s) * DM + h * SBD;
            float z = 0.f;
#pragma unroll
            for (int i = 0; i < 16; ++i) { const v4u kk = *(const GAS v4u*)(kp + i * 8); const LAS float* qq = qs + i * 8;
                z += qq[0] * bflo(kk.x) + qq[1] * bfhi(kk.x) + qq[2] * bflo(kk.y) + qq[3] * bfhi(kk.y) + qq[4] * bflo(kk.z) + qq[5] * bfhi(kk.z) + qq[6] * bflo(kk.w) + qq[7] * bfhi(kk.w); }
            const float sp = valid ? (fmaxf(z, 0.f) + __builtin_amdgcn_logf(1.f + __builtin_amdgcn_exp2f(-fabsf(z)))) : 0.f;
            float x = sp;
#pragma unroll
            for (int off = 1; off < 64; off <<= 1) { const float y = __shfl_down(x, off); if (lane + off < 64) x += y; }
            const float R = x + carry; carry += __shfl(x, 0);
            const float A = valid ? __builtin_amdgcn_exp2f(z - R) : 0.f;
            const bf16* vp = V + (rowbase + kb * 64) * DM + h * SBD + 2 * lane;
            for (int l = 0; l < 64; ++l) { const float a = __shfl(A, l); const unsigned pr = *(const GAS unsigned*)(vp + (size_t)l * DM); o0 += a * bflo(pr); o1 += a * bfhi(pr); }
        }
        *(GAS unsigned*)(O + (rowbase + t) * DM + h * SBD + 2 * lane) = pk2(o0, o1);
    }
}

namespace sba {
typedef float f32x16 __attribute__((ext_vector_type(16)));
typedef short v4i16_t __attribute__((ext_vector_type(4)));
typedef float f32x2_t __attribute__((ext_vector_type(2))); typedef __bf16 bf16x2_t __attribute__((ext_vector_type(2)));
__device__ __forceinline__ unsigned cvtpk_s(float lo, float hi) { f32x2_t v = {lo, hi}; bf16x2_t b = __builtin_convertvector(v, bf16x2_t); return __builtin_bit_cast(unsigned, b); }
__device__ __forceinline__ int img_off(int row, int ch) { return 256 * row + 16 * (ch ^ (((row & 3) << 2) | ((row >> 2) & 3))); }
__device__ __forceinline__ v4i16_t vtr(const LAS unsigned char* p) { return __builtin_amdgcn_ds_read_tr16_b64_v4i16((LAS v4i16_t*)p); }

__device__ __forceinline__ void sb_weights(f32x16& p, float& carry, int hi) {
    float w[16];
#pragma unroll
    for (int r = 0; r < 16; ++r) { const float e = __builtin_amdgcn_exp2f(__builtin_fminf(p[r], 100.f)); p[r] = e; w[r] = __builtin_amdgcn_rcpf(1.f + e); }
    float E[4], Od[4];
#pragma unroll
    for (int m = 0; m < 4; ++m) { w[4 * m + 2] *= w[4 * m + 3]; w[4 * m + 1] *= w[4 * m + 2]; w[4 * m] *= w[4 * m + 1];
        const unsigned tv = __float_as_uint(w[4 * m]); auto rr = __builtin_amdgcn_permlane32_swap(tv, tv, false, false); E[m] = __uint_as_float(rr[0]); Od[m] = __uint_as_float(rr[1]); }
    float SP[4]; SP[3] = carry; SP[2] = SP[3] * (E[3] * Od[3]); SP[1] = SP[2] * (E[2] * Od[2]); SP[0] = SP[1] * (E[1] * Od[1]); carry = SP[0] * (E[0] * Od[0]);
#pragma unroll
    for (int m = 0; m < 4; ++m) { const float off = hi ? SP[m] : SP[m] * Od[m];
#pragma unroll
        for (int i = 0; i < 4; ++i) { const int r = 4 * m + i; p[r] = (p[r] * off) * w[r]; } }
}
__device__ __forceinline__ void sb_mask(f32x16& p, int lim  ) {
#pragma unroll
    for (int r = 0; r < 16; ++r) p[r] = ((r & 3) + 8 * (r >> 2) < lim) ? p[r] : -INFINITY;
}

__device__ __forceinline__ void attn_unit(const bf16* Q, const bf16* K, const bf16* V, bf16* O, LAS unsigned char* lds, int tid, int b, int h, int qb) {
    const int lane = tid & 63, wave = __builtin_amdgcn_readfirstlane(tid >> 6), r32 = lane & 31, hi = lane >> 5;
    const size_t rowbase = (size_t)b * SEQ; const int q0 = qb * 256, Qw = q0 + 32 * wave, t = Qw + r32;
    bf16x8 qf[8];
    { const bf16* qp = Q + (rowbase + t) * DM + h * SBD + hi * 8;
#pragma unroll
      for (int d = 0; d < 8; ++d) qf[d] = *(const GAS bf16x8*)(qp + d * 16); }
    f32x16 o[4];
#pragma unroll
    for (int i = 0; i < 4; ++i)
#pragma unroll
        for (int r = 0; r < 16; ++r) o[i][r] = 0.f;
    float carry = 1.f;
    const int NT = 4 * qb + 4;
    const int sr = tid >> 4, sc = tid & 15;
    const GAS unsigned char* kg = (const GAS unsigned char*)(K + rowbase * DM + h * SBD); const GAS unsigned char* vg = (const GAS unsigned char*)(V + rowbase * DM + h * SBD);
    const unsigned goff = (unsigned)(sr * DM + sc * 8) * 2u;
    const int w0 = img_off(sr, sc), w1 = img_off(sr + 32, sc);
    v4u sk0, sk1, sv0, sv1;
#define SB_LOAD(kt) do { const unsigned o_ = goff + (unsigned)(kt) * (64u * DM * 2u); sk0 = *(const GAS v4u*)(kg + o_); sk1 = *(const GAS v4u*)(kg + o_ + 32u * DM * 2u); sv0 = *(const GAS v4u*)(vg + o_); sv1 = *(const GAS v4u*)(vg + o_ + 32u * DM * 2u); } while (0)
#define SB_WRITE(buf) do { LAS unsigned char* kb_ = lds + (buf) * 16384; LAS unsigned char* vb_ = lds + 32768 + (buf) * 16384; *(LAS v4u*)(kb_ + w0) = sk0; *(LAS v4u*)(kb_ + w1) = sk1; *(LAS v4u*)(vb_ + w0) = sv0; *(LAS v4u*)(vb_ + w1) = sv1; } while (0)
    const int krt = ((r32 & 3) << 2) | ((r32 >> 2) & 3);
    const int i16 = lane & 15, q4 = i16 >> 2, p4 = i16 & 3, gb = (lane >> 4) & 1;
    const int vlow0 = ((2 * gb + (p4 >> 1)) ^ hi), vlow1 = vlow0 ^ 2;
    const int vrow0 = 256 * (4 * hi + q4) + 8 * (p4 & 1);
    SB_LOAD(NT - 1); SB_WRITE(0); __syncthreads();
    for (int it = 0; it < NT; ++it) {
        const int kt = NT - 1 - it, buf = it & 1, key0 = kt * 64;
        if (it + 1 < NT) SB_LOAD(kt - 1);
        const bool skip = key0 >= Qw + 31, full = key0 + 63 < Qw;
        if (!skip) {
            const LAS unsigned char* Kb = lds + buf * 16384; const LAS unsigned char* Vb = lds + 32768 + buf * 16384;
            f32x16 p0, p1;
#pragma unroll
            for (int r = 0; r < 16; ++r) { p0[r] = 0.f; p1[r] = 0.f; }
#pragma unroll
            for (int d = 0; d < 8; ++d) { const int off = 256 * r32 + 16 * ((2 * d + hi) ^ krt);
                const bf16x8 k0 = *(const LAS bf16x8*)(Kb + off), k1 = *(const LAS bf16x8*)(Kb + off + 8192);
                p0 = __builtin_amdgcn_mfma_f32_32x32x16_bf16(k0, qf[d], p0, 0, 0, 0); p1 = __builtin_amdgcn_mfma_f32_32x32x16_bf16(k1, qf[d], p1, 0, 0, 0); }
            bf16x8 af[2][2];
#define SB_PACK(P, u) do { _Pragma("unroll") for (int s = 0; s < 2; ++s) { v4u aw; aw.x = cvtpk_s(P[8 * s], P[8 * s + 1]); aw.y = cvtpk_s(P[8 * s + 2], P[8 * s + 3]); aw.z = cvtpk_s(P[8 * s + 4], P[8 * s + 5]); aw.w = cvtpk_s(P[8 * s + 6], P[8 * s + 7]); af[u][s] = __builtin_bit_cast(bf16x8, aw); } } while (0)
            if (!full) { sb_mask(p1, t - key0 - 32 - 4 * hi); sb_mask(p0, t - key0 - 4 * hi); }
            sb_weights(p1, carry, hi); SB_PACK(p1, 1); __builtin_amdgcn_sched_barrier(0); sb_weights(p0, carry, hi); SB_PACK(p0, 0);
#undef SB_PACK
            __builtin_amdgcn_sched_barrier(0);
#pragma unroll
            for (int u = 0; u < 2; ++u)
#pragma unroll
                for (int s = 0; s < 2; ++s) {
#pragma unroll
                    for (int db = 0; db < 4; ++db) {
                        const int c0 = (((db ^ q4) << 2) | vlow0), c1 = (((db ^ q4) << 2) | vlow1);
                        const v4i16_t lo = vtr(Vb + vrow0 + 256 * (32 * u + 16 * s) + 16 * c0), hh = vtr(Vb + vrow0 + 256 * (32 * u + 16 * s + 8) + 16 * c1);
                        const bf16x8 vf = {lo[0], lo[1], lo[2], lo[3], hh[0], hh[1], hh[2], hh[3]};
                        o[db] = __builtin_amdgcn_mfma_f32_32x32x16_bf16(vf, af[u][s], o[db], 0, 0, 0);
                    }
                }
        }
        if (it + 1 < NT) SB_WRITE(buf ^ 1);
        __syncthreads();
    }
#undef SB_LOAD
#undef SB_WRITE
    bf16* op = O + (rowbase + t) * DM + h * SBD + 4 * hi;
#pragma unroll
    for (int db = 0; db < 4; ++db)
#pragma unroll
        for (int g = 0; g < 4; ++g) { v2u w; w.x = cvtpk_s(o[db][4 * g], o[db][4 * g + 1]); w.y = cvtpk_s(o[db][4 * g + 2], o[db][4 * g + 3]); *(GAS v2u*)(op + 32 * db + 8 * g) = w; }
}

__device__ __forceinline__ void attn_phase(const bf16* Q, const bf16* K, const bf16* V, bf16* O, LAS unsigned char* lds, int tid, int vcu, int G) {
    for (int pi = vcu; pi < 256; pi += G) {
        const int bh = pi >> 3, x = pi & 7;
#pragma unroll 1
        for (int uu = 0; uu < 2; ++uu) attn_unit(Q, K, V, O, lds, tid, bh >> 4, bh & 15, uu ? x : 15 - x);
    }
}
}

namespace mls {
using sba::f32x16; using sba::v4i16_t; using sba::cvtpk_s; using sba::img_off; using sba::vtr;
__device__ __forceinline__ float half_sum(float x) { const unsigned u = __float_as_uint(x); auto rr = __builtin_amdgcn_permlane32_swap(u, u, false, false); return __uint_as_float(rr[0]) + __uint_as_float(rr[1]); }

__device__ __forceinline__ void stage_v(const bf16* Vm, size_t rowbase, int h, LAS unsigned char* lds, int tid) {
    const int c32 = tid & 31; const bf16* vp = Vm + rowbase * MLW + h * DV + c32 * 8;
#pragma unroll
    for (int k = 0; k < 8; ++k) { const int row = (tid >> 5) + 16 * k; const v4u x = *(const GAS v4u*)(vp + (size_t)row * MLW); *(LAS v4u*)(lds + (c32 >> 4) * 32768 + img_off(row, c32 & 15)) = x; }
}
__device__ __forceinline__ void gate_scan(const MixP& P, size_t rowbase, int h, int lane, float& bc0, float& bc1, float& g0, float& g1) {
    const float li0 = P.IG[(rowbase + 2 * lane) * 4 + h] + P.mgb[h], li1 = P.IG[(rowbase + 2 * lane + 1) * 4 + h] + P.mgb[h];
    const float lf0 = logsigmoidf_(P.FG[(rowbase + 2 * lane) * 4 + h] + P.mgb[MH + h]), lf1 = logsigmoidf_(P.FG[(rowbase + 2 * lane + 1) * 4 + h] + P.mgb[MH + h]);
    const float ps = lf0 + lf1; float x = ps;
#pragma unroll
    for (int off = 1; off < 64; off <<= 1) { const float y = lane_up(x, off, lane); if (lane >= off) x += y; }
    bc0 = (x - ps) + lf0; bc1 = bc0 + lf1; g0 = li0 - bc0; g1 = li1 - bc1;
}

__device__ __forceinline__ void mx1_unit(const MixP& P, LAS unsigned char* lds, int tid, int b, int h, int c) {
    const int lane = tid & 63, wave = __builtin_amdgcn_readfirstlane(tid >> 6), r32 = lane & 31, hi = lane >> 5;
    LAS float* sm = (LAS float*)(lds + SM_OFF); LAS float *s_w = sm, *s_sc = sm + 128;
    const size_t rowbase = (size_t)b * SEQ + c * CH; const int uidx = (b * MH + h) * NCH + c;
    stage_v(P.Vm, rowbase, h, lds, tid);
    if (wave == 0) { float bc0, bc1, g0, g1; gate_scan(P, rowbase, h, lane, bc0, bc1, g0, g1);
        const float G = wave_max(fmaxf(g0, g1));
        s_w[2 * lane] = __expf(g0 - G); s_w[2 * lane + 1] = __expf(g1 - G);
        const float bl = __int_as_float(__builtin_amdgcn_readlane(__float_as_int(bc1), 63)); if (lane == 0) { s_sc[0] = G; s_sc[1] = bl; } }
    __syncthreads();
    { const int row = tid >> 2, q = tid & 3; const float w = s_w[row]; const bf16* kp = P.Km + (rowbase + row) * MQK + h * DK + q * 32;
#pragma unroll
      for (int i = 0; i < 4; ++i) { const v4u kk = *(const GAS v4u*)(kp + i * 8); v4u o;
          o.x = cvtpk_s(w * bflo(kk.x), w * bfhi(kk.x)); o.y = cvtpk_s(w * bflo(kk.y), w * bfhi(kk.y)); o.z = cvtpk_s(w * bflo(kk.z), w * bfhi(kk.z)); o.w = cvtpk_s(w * bflo(kk.w), w * bfhi(kk.w));
          *(LAS v4u*)(lds + 65536 + img_off(row, 4 * q + i)) = o; } }
    __syncthreads();
    f32x16 acc[4], accn[4];
#pragma unroll
    for (int i = 0; i < 4; ++i)
#pragma unroll
        for (int r = 0; r < 16; ++r) { acc[i][r] = 0.f; accn[i][r] = 0.f; }
    const int i16 = lane & 15, q4 = i16 >> 2, p4 = i16 & 3, gb = (lane >> 4) & 1;
    const int lowb = 2 * gb + (p4 >> 1);
    const int rowb = 256 * (8 * hi + q4) + 8 * (p4 & 1);
    const LAS unsigned char* Vb = lds + (wave >> 2) * 32768; const LAS unsigned char* Kb = lds + 65536;
    const int vdb = wave & 3;
    const bf16x8 ones = {0x3F80, 0x3F80, 0x3F80, 0x3F80, 0x3F80, 0x3F80, 0x3F80, 0x3F80};
#pragma unroll
    for (int ks = 0; ks < 8; ++ks) {
        const int lw0 = lowb ^ (2 * hi), lw1 = lowb ^ (2 * hi + 1);
        const v4i16_t vl = vtr(Vb + rowb + 256 * (16 * ks) + 16 * (((vdb ^ q4) << 2) | lw0)), vh2 = vtr(Vb + rowb + 256 * (16 * ks + 4) + 16 * (((vdb ^ q4) << 2) | lw1));
        const bf16x8 vf = {vl[0], vl[1], vl[2], vl[3], vh2[0], vh2[1], vh2[2], vh2[3]};
#pragma unroll
        for (int db = 0; db < 4; ++db) {
            const v4i16_t kl = vtr(Kb + rowb + 256 * (16 * ks) + 16 * (((db ^ q4) << 2) | lw0)), kh = vtr(Kb + rowb + 256 * (16 * ks + 4) + 16 * (((db ^ q4) << 2) | lw1));
            const bf16x8 kf = {kl[0], kl[1], kl[2], kl[3], kh[0], kh[1], kh[2], kh[3]};
            acc[db] = __builtin_amdgcn_mfma_f32_32x32x16_bf16(vf, kf, acc[db], 0, 0, 0);
            if (wave == 0) accn[db] = __builtin_amdgcn_mfma_f32_32x32x16_bf16(ones, kf, accn[db], 0, 0, 0);
        }
    }
    float* dc = P.DC + ((size_t)uidx * DV + 32 * wave) * DK + r32;
#pragma unroll
    for (int db = 0; db < 4; ++db)
#pragma unroll
        for (int r = 0; r < 16; ++r) dc[(size_t)((r & 3) + 8 * (r >> 2) + 4 * hi) * DK + 32 * db] = acc[db][r];
    if (wave == 0 && hi == 0) {
#pragma unroll
        for (int db = 0; db < 4; ++db) P.DN[uidx * DK + 32 * db + r32] = accn[db][0]; }
    if (tid == 0) { P.MLOC[uidx] = s_sc[1] + s_sc[0]; P.BLAST[uidx] = s_sc[1]; }
    __syncthreads();
}

__device__ __forceinline__ void mx3_unit(const MixP& P, LAS unsigned char* lds, int tid, int b, int h, int c) {
    const int lane = tid & 63, wave = __builtin_amdgcn_readfirstlane(tid >> 6), r32 = lane & 31, hi = lane >> 5;
    const int qb = wave & 3, vh = wave >> 2;
    LAS float* sm = (LAS float*)(lds + SM_OFF); LAS float *s_g2 = sm, *s_M2 = sm + 128, *s_bc = sm + 256, *s_nin = sm + 384, *s_part = sm + 512;
    const size_t rowbase = (size_t)b * SEQ + c * CH; const int uidx = (b * MH + h) * NCH + c;
    const float m_in = P.MIN[uidx];
    stage_v(P.Vm, rowbase, h, lds, tid);
    if (wave == 0) { float bc0, bc1, g0, g1; gate_scan(P, rowbase, h, lane, bc0, bc1, g0, g1);
        float y = fmaxf(g0, g1);
#pragma unroll
        for (int off = 1; off < 64; off <<= 1) { const float z = lane_up(y, off, lane); if (lane >= off) y = fmaxf(y, z); }
        float ex = lane_up(y, 1, lane); if (lane == 0) ex = -INFINITY;
        const float M0 = fmaxf(m_in, fmaxf(ex, g0)), M1 = fmaxf(m_in, y);
        s_g2[2 * lane] = g0 * LOG2E; s_g2[2 * lane + 1] = g1 * LOG2E; s_M2[2 * lane] = M0 * LOG2E; s_M2[2 * lane + 1] = M1 * LOG2E; s_bc[2 * lane] = bc0; s_bc[2 * lane + 1] = bc1; }
    if (wave == 1) { s_nin[lane] = P.NIN[uidx * DK + lane]; s_nin[64 + lane] = P.NIN[uidx * DK + 64 + lane]; }
    const int t = 32 * qb + r32;
    bf16x8 qf[8];
    { const bf16* qp = P.Qm + (rowbase + t) * MQK + h * DK + hi * 8;
#pragma unroll
      for (int d = 0; d < 8; ++d) qf[d] = *(const GAS bf16x8*)(qp + d * 16); }
    __syncthreads();
    const float M2 = s_M2[t], bct = s_bc[t];
    const float wint = __builtin_amdgcn_exp2f(m_in * LOG2E - M2);
    f32x16 acc[4];
#pragma unroll
    for (int i = 0; i < 4; ++i)
#pragma unroll
        for (int r = 0; r < 16; ++r) acc[i][r] = 0.f;
    { const bf16* cp = P.CIN + ((size_t)uidx * DV + 128 * vh + r32) * DK + hi * 8;
#pragma unroll
      for (int vb = 0; vb < 4; ++vb)
#pragma unroll
          for (int d = 0; d < 8; ++d) { const bf16x8 cf = *(const GAS bf16x8*)(cp + (size_t)(32 * vb) * DK + d * 16); acc[vb] = __builtin_amdgcn_mfma_f32_32x32x16_bf16(cf, qf[d], acc[vb], 0, 0, 0); } }
#pragma unroll
    for (int i = 0; i < 4; ++i)
#pragma unroll
        for (int r = 0; r < 16; ++r) acc[i][r] *= wint;
    float qn = 0.f;
#pragma unroll
    for (int d = 0; d < 8; ++d)
#pragma unroll
        for (int j = 0; j < 8; ++j) qn += bf2f((bf16)qf[d][j]) * s_nin[16 * d + 8 * hi + j];
    float den = wint * half_sum(qn), dpart = 0.f;
    const int i16 = lane & 15, q4 = i16 >> 2, p4 = i16 & 3, gb = (lane >> 4) & 1;
    const int vlow0 = ((2 * gb + (p4 >> 1)) ^ hi), vlow1 = vlow0 ^ 2;
    const int vrow0 = 256 * (4 * hi + q4) + 8 * (p4 & 1);
    const LAS unsigned char* Vb = lds + vh * 32768;
    for (int kb = 0; kb <= qb; ++kb) {
        f32x16 p;
#pragma unroll
        for (int r = 0; r < 16; ++r) p[r] = 0.f;
        { const bf16* kp = P.Km + (rowbase + 32 * kb + r32) * MQK + h * DK + hi * 8;
#pragma unroll
          for (int d = 0; d < 8; ++d) { const bf16x8 kf = *(const GAS bf16x8*)(kp + d * 16); p = __builtin_amdgcn_mfma_f32_32x32x16_bf16(kf, qf[d], p, 0, 0, 0); } }
#pragma unroll
        for (int m = 0; m < 4; ++m) { const f32x4 gq = *(const LAS f32x4*)(s_g2 + 32 * kb + 8 * m + 4 * hi);
#pragma unroll
            for (int i = 0; i < 4; ++i) { const int r = 4 * m + i; float w = __builtin_amdgcn_exp2f(gq[i] - M2); if (kb == qb) w = (8 * m + 4 * hi + i <= r32) ? w : 0.f; p[r] *= w; dpart += p[r]; } }
        bf16x8 af[2];
#pragma unroll
        for (int s = 0; s < 2; ++s) { v4u aw; aw.x = cvtpk_s(p[8 * s], p[8 * s + 1]); aw.y = cvtpk_s(p[8 * s + 2], p[8 * s + 3]); aw.z = cvtpk_s(p[8 * s + 4], p[8 * s + 5]); aw.w = cvtpk_s(p[8 * s + 6], p[8 * s + 7]); af[s] = __builtin_bit_cast(bf16x8, aw); }
        const LAS unsigned char* Vk = Vb + 256 * 32 * kb;
#pragma unroll
        for (int s = 0; s < 2; ++s)
#pragma unroll
            for (int vb = 0; vb < 4; ++vb) {
                const int c0 = (((vb ^ q4) << 2) | vlow0), c1 = (((vb ^ q4) << 2) | vlow1);
                const v4i16_t lo = vtr(Vk + vrow0 + 256 * (16 * s) + 16 * c0), hh = vtr(Vk + vrow0 + 256 * (16 * s + 8) + 16 * c1);
                const bf16x8 vf = {lo[0], lo[1], lo[2], lo[3], hh[0], hh[1], hh[2], hh[3]};
                acc[vb] = __builtin_amdgcn_mfma_f32_32x32x16_bf16(vf, af[s], acc[vb], 0, 0, 0);
            }
    }
    den += half_sum(dpart);
    const float mt = bct + M2 * LN2;
    const float scl = 1.f / fmaxf(fabsf(den), __expf(-mt));
    float ss = 0.f;
#pragma unroll
    for (int i = 0; i < 4; ++i)
#pragma unroll
        for (int r = 0; r < 16; ++r) { acc[i][r] *= scl; ss += acc[i][r] * acc[i][r]; }
    ss = half_sum(ss);
    if (hi == 0) s_part[wave * 32 + r32] = ss;
    __syncthreads();
    const float tot = s_part[qb * 32 + r32] + s_part[(4 + qb) * 32 + r32];
    const float rstd = 1.f / sqrtf(tot * (1.f / DV) + EPS);
    { const int vbase = h * DV + 128 * vh + 4 * hi;
      const bf16* op = P.Om + (rowbase + t) * MLW + vbase; bf16* mp = P.MIX + (rowbase + t) * DM + LRU_W + vbase; const float* ng = P.mng + vbase;
#pragma unroll
      for (int vb = 0; vb < 4; ++vb)
#pragma unroll
          for (int g = 0; g < 4; ++g) { const int vo = 32 * vb + 8 * g; const f32x4 n4 = *(const GAS f32x4*)(ng + vo); const v2u ob = *(const GAS v2u*)(op + vo);
              const float o0 = sigmoidf_(bflo(ob.x)), o1 = sigmoidf_(bfhi(ob.x)), o2 = sigmoidf_(bflo(ob.y)), o3 = sigmoidf_(bfhi(ob.y));
              v2u w; w.x = cvtpk_s(acc[vb][4 * g] * rstd * n4.x * o0, acc[vb][4 * g + 1] * rstd * n4.y * o1); w.y = cvtpk_s(acc[vb][4 * g + 2] * rstd * n4.z * o2, acc[vb][4 * g + 3] * rstd * n4.w * o3);
              *(GAS v2u*)(mp + vo) = w; } }
    __syncthreads();
}
}

namespace rgl {
using sba::f32x16; using sba::img_off;
__device__ __forceinline__ float sig_fast(float x) { return __builtin_amdgcn_rcpf(1.f + __builtin_amdgcn_exp2f(-LOG2E * x)); }
__device__ __forceinline__ void swap_pair(float x, float& ev, float& od) { const unsigned u = __float_as_uint(x); auto rr = __builtin_amdgcn_permlane32_swap(u, u, false, false); ev = __uint_as_float(rr[0]); od = __uint_as_float(rr[1]); }

__device__ __forceinline__ void mx1_unit(const MixP& P, const bf16* WGT  , LAS unsigned char* lds, int tid, int b, int n, int c) {
    const int lane = tid & 63, wave = __builtin_amdgcn_readfirstlane(tid >> 6), r32 = lane & 31, hi = lane >> 5;
    LAS float* XC = (LAS float*)lds;
    LAS unsigned char* XB = lds + 65536;
    LAS float* s_agg = (LAS float*)(lds + SM_OFF);
    const size_t rowbase = (size_t)b * SEQ; const int t0 = c * CH;
    {
        const int e = tid & 127, tg = tid >> 7, chn = n * 128 + e;
        const float w0 = P.conv_w[chn], w1 = P.conv_w[LRU_W + chn], w2 = P.conv_w[2 * LRU_W + chn], w3 = P.conv_w[3 * LRU_W + chn], cb = P.conv_b[chn];
        const int ts = t0 + tg * 32; const float* xp = P.XA + (rowbase + ts) * LRU_W + chn;
        float x0 = (ts >= 3) ? xp[-3 * LRU_W] : 0.f, x1 = (ts >= 2) ? xp[-2 * LRU_W] : 0.f, x2 = (ts >= 1) ? xp[-1 * LRU_W] : 0.f;
        LAS unsigned char* xb = XB + 2 * (e & 7);
#pragma unroll 8
        for (int i = 0; i < 32; ++i) { const float x3 = xp[(size_t)i * LRU_W]; const float y = cb + w0 * x0 + w1 * x1 + w2 * x2 + w3 * x3; x0 = x1; x1 = x2; x2 = x3;
            const int tt = tg * 32 + i; XC[tt * 128 + e] = y; *(LAS bf16*)(xb + img_off(tt, e >> 3)) = f2bf(y); }
    }
    __syncthreads();
    const int tb = wave & 3, eh = wave >> 2;
    f32x16 ar[2], ai[2];
#pragma unroll
    for (int i = 0; i < 2; ++i)
#pragma unroll
        for (int r = 0; r < 16; ++r) { ar[i][r] = 0.f; ai[i][r] = 0.f; }
    { const int krt = ((r32 & 3) << 2) | ((r32 >> 2) & 3);
      const bf16* wr = WGT + ((size_t)(0 * NBLK + n) * 128 + 64 * eh + r32) * 128 + hi * 8; const bf16* wi = WGT + ((size_t)(1 * NBLK + n) * 128 + 64 * eh + r32) * 128 + hi * 8;
#pragma unroll
      for (int d = 0; d < 8; ++d) { const bf16x8 xf = *(const LAS bf16x8*)(XB + 256 * (32 * tb + r32) + 16 * ((2 * d + hi) ^ krt));
#pragma unroll
          for (int eb = 0; eb < 2; ++eb) { const bf16x8 fr = *(const GAS bf16x8*)(wr + (size_t)(32 * eb) * 128 + d * 16), fi = *(const GAS bf16x8*)(wi + (size_t)(32 * eb) * 128 + d * 16);
              ar[eb] = __builtin_amdgcn_mfma_f32_32x32x16_bf16(xf, fr, ar[eb], 0, 0, 0); ai[eb] = __builtin_amdgcn_mfma_f32_32x32x16_bf16(xf, fi, ai[eb], 0, 0, 0); } } }
    float BA[2], BH[2];
#pragma unroll
    for (int eb = 0; eb < 2; ++eb) {
        const int e = 64 * eh + 32 * eb + r32, chn = n * 128 + e;
        const float br = P.gate_b[chn], bi = P.gate_b[LRU_W + chn], ls8 = 8.f * LOG2E * logsigmoidf_(P.lam[chn]);
        float qa[4], qh[4];
#pragma unroll
        for (int m = 0; m < 4; ++m) { float A = 1.f, H = 0.f;
#pragma unroll
            for (int i = 0; i < 4; ++i) { const int r = 4 * m + i, tt = 32 * tb + 8 * m + 4 * hi + i;
                const float rg = sig_fast(ar[eb][r] + br), ig = sig_fast(ai[eb][r] + bi); const float a = __builtin_amdgcn_exp2f(rg * ls8); const float mult = __builtin_amdgcn_sqrtf(fmaxf(1.f - a * a, 0.f));
                const float u = mult * (ig * XC[tt * 128 + e]); H = a * H + u; A = A * a; ar[eb][r] = H; ai[eb][r] = A; }
            qa[m] = A; qh[m] = H; }
        float PA = 1.f, PH = 0.f;
#pragma unroll
        for (int m = 0; m < 4; ++m) { float ea, oa, eh_, oh; swap_pair(qa[m], ea, oa); swap_pair(qh[m], eh_, oh);
            const float pa_odd = ea * PA, ph_odd = ea * PH + eh_;
            const float ma = hi ? pa_odd : PA, mh = hi ? ph_odd : PH;
#pragma unroll
            for (int i = 0; i < 4; ++i) { const int r = 4 * m + i; ar[eb][r] += ai[eb][r] * mh; ai[eb][r] *= ma; }
            PA = oa * pa_odd; PH = oa * ph_odd + oh; }
        BA[eb] = PA; BH[eb] = PH;
        if (hi == 0) { s_agg[(tb * 128 + e) * 2] = PA; s_agg[(tb * 128 + e) * 2 + 1] = PH; }
    }
    __syncthreads();
#pragma unroll
    for (int eb = 0; eb < 2; ++eb) {
        const int e = 64 * eh + 32 * eb + r32, chn = n * 128 + e;
        float CA = 1.f, CHh = 0.f;
        for (int t2 = 0; t2 < tb; ++t2) { const float a = s_agg[(t2 * 128 + e) * 2], h = s_agg[(t2 * 128 + e) * 2 + 1]; CHh = a * CHh + h; CA = CA * a; }
#pragma unroll
        for (int r = 0; r < 16; ++r) { const int tt = 32 * tb + (r & 3) + 8 * (r >> 2) + 4 * hi; const size_t o = (rowbase + t0 + tt) * LRU_W + chn;
            P.HLOC[o] = ar[eb][r] + ai[eb][r] * CHh; P.PCUM[o] = ai[eb][r] * CA; }
        if (tb == 3 && hi == 0) { P.AGGP[(b * NCH + c) * LRU_W + chn] = BA[eb] * CA; P.AGGH[(b * NCH + c) * LRU_W + chn] = BA[eb] * CHh + BH[eb]; }
    }
    __syncthreads();
}

__device__ __forceinline__ void mx2_carry(const MixP& P, float* CARRY, int gtid, int NT) {
    const int g2 = NT - 1 - gtid;
    if (g2 < BATCH * LRU_W) { const int b = g2 >> 10, chn = g2 & 1023; float ap[NCH], ah[NCH];
#pragma unroll
        for (int c = 0; c < NCH; ++c) { const int o = (b * NCH + c) * LRU_W + chn; ap[c] = P.AGGP[o]; ah[c] = P.AGGH[o]; }
        float carry = 0.f;
#pragma unroll
        for (int c = 0; c < NCH; ++c) { CARRY[(b * NCH + c) * LRU_W + chn] = carry; carry = ap[c] * carry + ah[c]; } }
}
__device__ __forceinline__ void mx3_unit(const MixP& P, const float* CARRY, int tid, int b, int c, int tq) {
    typedef float f32x2v __attribute__((ext_vector_type(2)));
    const int chn = 2 * tid; const f32x2v cr = *(const GAS f32x2v*)(CARRY + (b * NCH + c) * LRU_W + chn);
    const size_t row0 = (size_t)b * SEQ + c * CH + tq * 32;
#pragma unroll 4
    for (int i = 0; i < 32; ++i) { const size_t row = row0 + i; const f32x2v h = *(const GAS f32x2v*)(P.HLOC + row * LRU_W + chn), p = *(const GAS f32x2v*)(P.PCUM + row * LRU_W + chn);
        const unsigned yy = *(const GAS unsigned*)(P.YA + row * LRU_W + chn);
        *(GAS unsigned*)(P.MIX + row * DM + chn) = pk2((h.x + p.x * cr.x) * gelu_tanh(bflo(yy)), (h.y + p.y * cr.y) * gelu_tanh(bfhi(yy))); }
}
}
#ifndef REPMASK
#define REPMASK 0
#endif
#define PHASE_REP(bit) for (int rep_ = 0; rep_ <= ((REPMASK >> (bit)) & 1); ++rep_)
#ifndef MX1R_UNIT
#define MX1R_UNIT rgl::mx1_unit
#endif
#ifndef MX1M_UNIT
#define MX1M_UNIT mls::mx1_unit
#endif
#ifndef MX3M_UNIT
#define MX3M_UNIT mls::mx3_unit
#endif

__device__ __forceinline__ KArgs fresh_args() { KArgs p = (KArgs)__builtin_amdgcn_kernarg_segment_ptr(); asm volatile("" : "+s"(p)); return p; }
__device__ __forceinline__ void fill_mixp(MixP& P, KArgs ap, unsigned char* ws, int j) {
    P.XA = (const float*)(ws + WS_P0); P.YA = (const bf16*)(ws + WS_P0 + 32 * MiB); P.Qm = (const bf16*)(ws + WS_P0 + 48 * MiB); P.Km = (const bf16*)(ws + WS_P0 + 56 * MiB);
    P.Vm = (const bf16*)(ws + WS_P0 + 64 * MiB); P.Om = (const bf16*)(ws + WS_P0 + 80 * MiB); P.IG = (const float*)(ws + WS_IG); P.FG = (const float*)(ws + WS_IG + 128 * 1024); P.MIX = (bf16*)(ws + WS_MIX);
    P.conv_w = ap->in[11] + (size_t)j * 4 * LRU_W; P.conv_b = ap->in[12] + (size_t)j * LRU_W; P.gate_w = ap->in[13] + (size_t)j * 2 * NBLK * BW * BW; P.gate_b = ap->in[14] + (size_t)j * 2 * LRU_W;
    P.lam = ap->in[15] + (size_t)j * LRU_W; P.mgb = ap->in[16] + (size_t)j * 2 * MH; P.mng = ap->in[17] + (size_t)j * MLW;
    P.DC = (float*)(ws + WS_DC); P.CIN = (bf16*)(ws + WS_CIN); P.DN = (float*)(ws + WS_SMALL); P.NIN = (float*)(ws + WS_SMALL + 128 * 1024); P.MLOC = (float*)(ws + WS_SMALL + 256 * 1024);
    P.BLAST = (float*)(ws + WS_SMALL + 257 * 1024); P.MIN = (float*)(ws + WS_SMALL + 258 * 1024); P.HLOC = (float*)(ws + WS_HLOC); P.PCUM = (float*)(ws + WS_PCUM);
    P.AGGP = (float*)(ws + WS_AGG); P.AGGH = (float*)(ws + WS_AGG + 256 * 1024); P.HTMP = (float*)(ws + WS_HTMP);
}
__global__ void __launch_bounds__(NWAVES * 64, 2) fwd_kernel(Args args) {
    extern __shared__ __attribute__((aligned(16))) unsigned char lds_raw[];
    LAS unsigned char* lds = (LAS unsigned char*)lds_raw;
    const int tid0 = threadIdx.x; const int wave_s = __builtin_amdgcn_readfirstlane(tid0 >> 6);
    const int G = gridDim.x, bx = blockIdx.x; const int vcu = (G % 8 == 0) ? (bx % 8) * (G / 8) + bx / 8 : bx;
    const int NGW = G * NWAVES;
#define FRESH() const int tid = fresh_tid(wave_s), lane = tid & 63, wave = __builtin_amdgcn_readfirstlane(tid >> 6), gw = vcu * NWAVES + wave; (void)lane; (void)gw; const KArgs ap = fresh_args(); unsigned char* const ws = ap->ws; (void)ws
    volatile LAS unsigned* MISC = (volatile LAS unsigned*)(lds + MISC_OFF);
    if (tid0 < 64) MISC[tid0] = 0u;
    __syncthreads();
    XcdBarrier bar = xcd_barrier_post((unsigned*)(args.ws + WS_CTL) + CW_BAR, MISC + 8);
#define GRID_BAR() do { XcdBarrier b2_ = bar; asm volatile("" : "+s"(b2_.x)); asm volatile("" : "+s"(b2_.bar)); xcd_barrier(b2_); } while (0)

PHASE_REP(0) {     { FRESH(); p0_prologue(ap, lds, tid, lane, wave, vcu, G); }
    GRID_BAR(); }

    for (int layer = 0; layer < DEPTH; ++layer) {
        const int j = layer >> 1;
PHASE_REP(1) {
        { FRESH(); norm_phase((layer == 0) ? ap->in[0] : ap->out, ap->in[4] + (size_t)(layer * 2 + 0) * DM, (const float*)(ws + WS_MOD) + (size_t)(layer * 2 + 0) * 2 * 6144, (bf16*)(ws + WS_HN), lane, gw, NGW); }
        GRID_BAR(); }
        if ((layer & 1) == 0) {
PHASE_REP(2) {
            { FRESH(); pg8::Gemm g{(const bf16*)(ws + WS_HN), (const bf16*)(ws + WS_WABIN) + (size_t)j * AB_IN_PAD * 2048, M, AB_IN_PAD, DM}; pg8::StaticOrder S; S.init(M, AB_IN_PAD, G, bx);
              pg8::EpiInProj E{(float*)(ws + WS_P0), (bf16*)(ws + WS_P0 + 32 * MiB), (bf16*)(ws + WS_P0 + 48 * MiB), (bf16*)(ws + WS_P0 + 56 * MiB), (bf16*)(ws + WS_P0 + 64 * MiB), (bf16*)(ws + WS_P0 + 80 * MiB),
                               (float*)(ws + WS_IG), (float*)(ws + WS_IG + 128 * 1024), 0.08838834764831845f};
              pg8::gemm_phase<pg8::EpiInProj, pg8::StaticOrder, PG8_ALIGN, PG8_SP2>(lds, g, S, E, tid); }
            GRID_BAR(); }
PHASE_REP(3) {
            { FRESH(); MixP P; fill_mixp(P, ap, ws, j);
              for (int u = vcu; u < 768; u += G) {
                if (u < 256) MX1M_UNIT(P, lds, tid, u >> 7, (u >> 5) & 3, u & 31);
                else { const int r = u - 256; MX1R_UNIT(P, (const bf16*)(ws + WS_WGT) + (size_t)j * 16 * 16384, lds, tid, r >> 8, (r >> 5) & 7, r & 31); }
            } }
            GRID_BAR(); }
PHASE_REP(4) {
            { FRESH(); MixP P; fill_mixp(P, ap, ws, j); mx2_mlstm(P, lds, tid, vcu * 512 + tid, G * 512); rgl::mx2_carry(P, (float*)(ws + WS_CARRY), vcu * 512 + tid, G * 512); }
            GRID_BAR(); }
PHASE_REP(5) {
            { FRESH(); MixP P; fill_mixp(P, ap, ws, j);
              for (int u = vcu; u < 512; u += G) {
                if (u < 256) MX3M_UNIT(P, lds, tid, u >> 7, (u >> 5) & 3, u & 31);
                else { const int r = u - 256; rgl::mx3_unit(P, (const float*)(ws + WS_CARRY), tid, r >> 7, (r >> 2) & 31, r & 3); }
            } }
            GRID_BAR(); }
        } else {
PHASE_REP(6) {
            { FRESH(); pg8::Gemm g{(const bf16*)(ws + WS_HN), (const bf16*)(ws + WS_WQKV) + (size_t)j * 6144 * 2048, M, 6144, DM}; pg8::StaticOrder S; S.init(M, 6144, G, bx);
              pg8::EpiBf16Split E{(bf16*)(ws + WS_P0), DM, DM, (size_t)M * DM, 0.08838834764831845f * LOG2E};
              pg8::gemm_phase<pg8::EpiBf16Split, pg8::StaticOrder, PG8_ALIGN, PG8_SP2>(lds, g, S, E, tid); }
            GRID_BAR(); }
PHASE_REP(7) {             { FRESH(); sba::attn_phase((const bf16*)(ws + WS_P0), (const bf16*)(ws + WS_P0) + (size_t)M * DM, (const bf16*)(ws + WS_P0) + (size_t)2 * M * DM, (bf16*)(ws + WS_MIX), lds, tid, vcu, G); }
            GRID_BAR(); }
        }
        { FRESH(); const bf16* Bt = ((layer & 1) == 0) ? (const bf16*)(ws + WS_WABOUT) + (size_t)j * 2048 * 2048 : (const bf16*)(ws + WS_WSBO) + (size_t)j * 2048 * 2048;
          pg8::Gemm g{(const bf16*)(ws + WS_MIX), Bt, M, DM, DM}; pg8::StaticOrder S; S.init(M, DM, G, bx);
          pg8::EpiResid E{(layer == 0) ? ap->in[0] : ap->out, ap->out, (const float*)(ws + WS_MOD) + (size_t)(layer * 2 + 0) * 2 * 6144 + 4096};
          pg8::gemm_phase<pg8::EpiResid, pg8::StaticOrder, PG8_ALIGN, PG8_SP2>(lds, g, S, E, tid); }
        GRID_BAR();
PHASE_REP(1) {
        { FRESH(); norm_phase(ap->out, ap->in[4] + (size_t)(layer * 2 + 1) * DM, (const float*)(ws + WS_MOD) + (size_t)(layer * 2 + 1) * 2 * 6144, (bf16*)(ws + WS_HN), lane, gw, NGW); }
        GRID_BAR(); }
PHASE_REP(8) {
        { FRESH(); pg8::Gemm g{(const bf16*)(ws + WS_HN), (const bf16*)(ws + WS_W13) + (size_t)layer * 2 * FF * 2048, M, 2 * FF, DM}; pg8::StaticOrder S; S.init(M, 2 * FF, G, bx);
          pg8::EpiSwiGLU E{(bf16*)(ws + WS_ACT)};
          pg8::gemm_phase<pg8::EpiSwiGLU, pg8::StaticOrder, PG8_ALIGN, PG8_SP2>(lds, g, S, E, tid); }
        GRID_BAR(); }
        { FRESH(); pg8::Gemm g{(const bf16*)(ws + WS_ACT), (const bf16*)(ws + WS_W2) + (size_t)layer * 2048 * FF, M, DM, FF}; pg8::StaticOrder S; S.init(M, DM, G, bx);
          pg8::EpiResid E{ap->out, ap->out, (const float*)(ws + WS_MOD) + (size_t)(layer * 2 + 1) * 2 * 6144 + 4096};
          pg8::gemm_phase<pg8::EpiResid, pg8::StaticOrder, PG8_ALIGN, PG8_SP2>(lds, g, S, E, tid); }
        GRID_BAR();
    }
    { FRESH(); final_norm_phase(ap->out, ap->in[5], ap->out, lane, gw, NGW); }
}

extern "C" void kernel_launch(void* const* d_in, const int* in_sizes, int n_in, void* d_out, int out_size, void* d_ws, size_t ws_size, hipStream_t stream) {
    static int grid = 0;
    if (grid == 0) {
        if (n_in != 20 || in_sizes[0] != M * DM || out_size != M * DM || ws_size < WS_END) { fprintf(stderr, "kernel_launch: unexpected shapes: n_in %d in0 %d out %d ws %zu (need %zu); nothing launched\n", n_in, n_in > 0 ? in_sizes[0] : -1, out_size, ws_size, (size_t)WS_END); grid = -1; return; }
        int dev = 0, cus = 0, per_cu = 0;
        if (hipGetDevice(&dev) != hipSuccess || hipDeviceGetAttribute(&cus, hipDeviceAttributeMultiprocessorCount, dev) != hipSuccess) { fprintf(stderr, "kernel_launch: device query failed\n"); grid = -1; return; }
        if (hipFuncSetAttribute((const void*)fwd_kernel, hipFuncAttributeMaxDynamicSharedMemorySize, LDS_BYTES) != hipSuccess) { fprintf(stderr, "kernel_launch: hipFuncSetAttribute failed\n"); grid = -1; return; }
        if (hipOccupancyMaxActiveBlocksPerMultiprocessor(&per_cu, (const void*)fwd_kernel, NWAVES * 64, LDS_BYTES) != hipSuccess || per_cu < 1)
            fprintf(stderr, "kernel_launch: note: occupancy query reports %d workgroups per CU\n", per_cu);
        (void)hipGetLastError();
        grid = cus;
    }
    if (grid < 0) return;
    if (hipMemsetAsync((char*)d_ws + WS_CTL, 0, CTL_ZERO_BYTES, stream) != hipSuccess) { fprintf(stderr, "kernel_launch: memset failed\n"); return; }
    Args a{};
    for (int i = 0; i < 20; ++i) a.in[i] = (const float*)d_in[i];
    a.out = (float*)d_out; a.ws = (unsigned char*)d_ws;
    hipLaunchKernelGGL(fwd_kernel, dim3(grid), dim3(NWAVES * 64), LDS_BYTES, stream, a);
    const hipError_t le = hipPeekAtLastError();
    if (le != hipSuccess) fprintf(stderr, "kernel_launch: launch failed: %s\n", hipGetErrorName(le));
}
```

```cpp
#include <hip/hip_runtime.h>
#include <cstdio>
#include <cstdint>

#ifndef CONV_KA_V
#define CONV_KA_V 2
#define CONV_KB_V 2
#endif
constexpr int NWAVES = 8;
constexpr int BATCH = 2, SEQ = 4096, DM = 2048, DEPTH = 4, M = BATCH * SEQ;
constexpr int LRU_W = 1024, NBLK = 8, BW = 128;
constexpr int MLW = 1024, MH = 4, DV = 256, DK = 128, MQK = 512, CH = 128, NCH = SEQ / CH;
constexpr int AB_IN = 5128, AB_IN_PAD = 5376;
constexpr int SBH = 16, SBD = 128;
constexpr int FF = 5632;
constexpr float EPS = 1e-6f;
constexpr float LOG2E = 1.4426950408889634f, LN2 = 0.6931471805599453f;

constexpr size_t MiB = 1u << 20;
constexpr size_t WS_CTL = 0, CTL_ZERO_BYTES = 1 * MiB;
constexpr size_t WS_MOD = 1 * MiB;
constexpr size_t WS_WABIN = 2 * MiB;
constexpr size_t WS_WABOUT = 44 * MiB;
constexpr size_t WS_WQKV = 60 * MiB;
constexpr size_t WS_WSBO = 108 * MiB;
constexpr size_t WS_W13 = 124 * MiB;
constexpr size_t WS_W2 = 300 * MiB;
constexpr size_t WS_HN = 388 * MiB;
constexpr size_t WS_P0 = 420 * MiB;
constexpr size_t WS_IG = 516 * MiB;
constexpr size_t WS_MIX = 517 * MiB;
constexpr size_t WS_ACT = 549 * MiB;
constexpr size_t WS_DC = 637 * MiB;
constexpr size_t WS_CIN = 669 * MiB;
constexpr size_t WS_SMALL = 685 * MiB;
constexpr size_t WS_HLOC = 686 * MiB;
constexpr size_t WS_PCUM = 718 * MiB;
constexpr size_t WS_AGG = 750 * MiB;
constexpr size_t WS_HTMP = 752 * MiB;
constexpr size_t WS_WGT = 784 * MiB;
constexpr size_t WS_CARRY = 785 * MiB;
constexpr size_t WS_END = 786 * MiB;
constexpr int CW_BAR = 4096;

constexpr int BIG_BYTES = 147456;
constexpr int MISC_OFF = BIG_BYTES;
constexpr int SM_OFF = BIG_BYTES + 1024;
constexpr int LDS_BYTES = 163840;

namespace pg8 {
#define PG8_LAS __attribute__((address_space(3)))
typedef unsigned short bf16_t;
typedef short bf16x8 __attribute__((ext_vector_type(8)));
typedef float f32x4 __attribute__((ext_vector_type(4)));
typedef unsigned u32x4 __attribute__((ext_vector_type(4)));
constexpr int BM = 256, BK = 64, HALF = 128, HTB = HALF * BK * 2  , STAGE_BYTES = 8 * HTB, NXCD = 8, WGM = 8;

__host__ __device__ __forceinline__ int lds_byte(int r, int c) { const int st = (r >> 4) * 2 + (c >> 5), rr = r & 15, cc = c & 31, ob = rr * 64 + cc * 2; return st * 1024 + (ob ^ (((ob >> 9) & 1) << 5)); }
__host__ __device__ __forceinline__ void stage_rc(int b, int& R, int& C) { const int st = b / 1024, sb = b % 1024, swz = sb ^ (((sb >> 9) & 1) << 5); R = (st >> 1) * 16 + swz / 64; C = (st & 1) * 32 + (swz % 64) / 2; }
__host__ __device__ __forceinline__ int perm32(int rho) { const int n = rho >> 4, i = rho & 15; return 8 * (i >> 2) + 4 * n + (i & 3); }

struct Unit { int pm, pn; };
struct Gemm { const bf16_t* A; const bf16_t* Bt; int M, N, K; };

struct StaticOrder {
    int nM, nN, nwg, G, c;
    __host__ __device__ void init(int M, int N, int G_, int c_) { nM = M / BM; nN = N / BM; nwg = nM * nN; G = G_; c = c_; }
    __host__ __device__ bool next(int i, Unit& u) const {
        const long L = (long)i * G + c; if (L >= nwg) return false;
        int wgid = (int)L; { const int q = nwg / NXCD, r = nwg % NXCD, xcd = wgid % NXCD, off = wgid / NXCD; wgid = (xcd < r ? xcd * (q + 1) : r * (q + 1) + (xcd - r) * q) + off; }
        const int nig = WGM * nN, gid = wgid / nig, fm = gid * WGM, gsz = (nM - fm) < WGM ? (nM - fm) : WGM;
        u.pm = fm + ((wgid % nig) % gsz); u.pn = (wgid % nig) / gsz; return true;
    }
    __device__ __forceinline__ void a_ready(const Unit&) const {}
    __device__ __forceinline__ void done(const Unit&) const {}
};

__device__ __forceinline__ unsigned cvt_pk_bf16(float lo, float hi) { unsigned r; asm volatile("v_cvt_pk_bf16_f32 %0, %1, %2" : "=v"(r) : "v"(lo), "v"(hi)); return r; }
typedef float f32x2 __attribute__((ext_vector_type(2)));
__device__ __forceinline__ u32x4 pack8(f32x4 v0, f32x4 v1) { u32x4 w; w.x = cvt_pk_bf16(v0[0], v0[1]); w.y = cvt_pk_bf16(v0[2], v0[3]); w.z = cvt_pk_bf16(v1[0], v1[1]); w.w = cvt_pk_bf16(v1[2], v1[3]); return w; }

struct EpiBf16Split {
    static constexpr bool PERM = true, AFTER_DRAIN = false;
    bf16_t* O; int ldc; int split_cols; size_t split_stride; float scale0;
    __device__ __forceinline__ void operator()(const f32x4 (&acc)[2][2][4][2], const Unit& u, int wr, int wc, int fr, int fq) const {
        const int row0 = u.pm * BM + wr * 64 + fr; int colt = u.pn * BM; bf16_t* base = O;
        float sc = 1.f; { const int t = colt / split_cols; base += (size_t)t * split_stride; colt -= t * split_cols; if (t == 0) sc = scale0; }
        const int col0 = colt + wc * 32 + 8 * fq;
#pragma unroll
        for (int ai = 0; ai < 2; ++ai)
#pragma unroll
            for (int m = 0; m < 4; ++m) { bf16_t* rowp = base + (size_t)(row0 + ai * HALF + m * 16) * ldc + col0;
#pragma unroll
                for (int bj = 0; bj < 2; ++bj) { *(u32x4*)(rowp + bj * HALF) = pack8(acc[ai][bj][m][0] * sc, acc[ai][bj][m][1] * sc); } }
    }
};

struct EpiResid {
    static constexpr bool PERM = true, AFTER_DRAIN = false;
    const float* base; float* out; const float* gate0;
    __device__ __forceinline__ void operator()(const f32x4 (&acc)[2][2][4][2], const Unit& u, int wr, int wc, int fr, int fq) const {
        const int row0 = u.pm * BM + wr * 64 + fr, col0 = u.pn * BM + wc * 32 + 8 * fq;
        const float* gp = gate0 + (u.pm >= 16 ? 6144 : 0) + col0;
        f32x4 gv[2][2];
#pragma unroll
        for (int bj = 0; bj < 2; ++bj)
#pragma unroll
            for (int n = 0; n < 2; ++n) gv[bj][n] = *(const f32x4*)(gp + bj * HALF + 4 * n);
#pragma unroll
        for (int ai = 0; ai < 2; ++ai)
#pragma unroll
            for (int m = 0; m < 4; ++m) { const size_t off = (size_t)(row0 + ai * HALF + m * 16) * 2048 + col0;
#pragma unroll
                for (int bj = 0; bj < 2; ++bj)
#pragma unroll
                    for (int n = 0; n < 2; ++n) { const f32x4 b = *(const f32x4*)(base + off + bj * HALF + 4 * n); *(f32x4*)(out + off + bj * HALF + 4 * n) = b + gv[bj][n] * acc[ai][bj][m][n]; }
                if (m & 1) asm volatile("" ::: "memory"); }
    }
};

struct EpiSwiGLU {
    static constexpr bool PERM = true, AFTER_DRAIN = false;
    bf16_t* O;
    static __device__ __forceinline__ f32x4 silu_mul(f32x4 a, f32x4 b) { f32x4 r;
#pragma unroll
        for (int i = 0; i < 4; ++i) { const float e = __builtin_amdgcn_exp2f(-a[i] * 1.4426950408889634f); r[i] = a[i] * __builtin_amdgcn_rcpf(1.f + e) * b[i]; }
        return r; }
    __device__ __forceinline__ void operator()(const f32x4 (&acc)[2][2][4][2], const Unit& u, int wr, int wc, int fr, int fq) const {
        const int row0 = u.pm * BM + wr * 64 + fr, col0 = u.pn * HALF + wc * 32 + 8 * fq;
#pragma unroll
        for (int ai = 0; ai < 2; ++ai)
#pragma unroll
            for (int m = 0; m < 4; ++m) { bf16_t* rowp = O + (size_t)(row0 + ai * HALF + m * 16) * 5632 + col0;
                *(u32x4*)rowp = pack8(silu_mul(acc[ai][0][m][0], acc[ai][1][m][0]), silu_mul(acc[ai][0][m][1], acc[ai][1][m][1])); }
    }
};

struct EpiInProj {
    static constexpr bool PERM = true, AFTER_DRAIN = false;
    float* XA; bf16_t *YA, *Qm, *Km, *Vm, *Om; float *IG, *FG; float kscale;
    __device__ __forceinline__ void operator()(const f32x4 (&acc)[2][2][4][2], const Unit& u, int wr, int wc, int fr, int fq) const {
        const int pn = u.pn, row0 = u.pm * BM + wr * 64 + fr, cl = wc * 32 + 8 * fq;
        if (pn < 4) {
#pragma unroll
            for (int ai = 0; ai < 2; ++ai)
#pragma unroll
                for (int m = 0; m < 4; ++m) { float* rp = XA + (size_t)(row0 + ai * HALF + m * 16) * 1024 + pn * 256 + cl;
#pragma unroll
                    for (int bj = 0; bj < 2; ++bj)
#pragma unroll
                        for (int n = 0; n < 2; ++n) *(f32x4*)(rp + bj * HALF + 4 * n) = acc[ai][bj][m][n]; }
        } else if (pn < 20) {
            bf16_t* base; int ld, colt; float sc = 1.f;
            if (pn < 8) { base = YA; ld = 1024; colt = (pn - 4) * 256; }
            else if (pn < 10) { base = Qm; ld = 512; colt = (pn - 8) * 256; }
            else if (pn < 12) { base = Km; ld = 512; colt = (pn - 10) * 256; sc = kscale; }
            else if (pn < 16) { base = Vm; ld = 1024; colt = (pn - 12) * 256; }
            else { base = Om; ld = 1024; colt = (pn - 16) * 256; }
#pragma unroll
            for (int ai = 0; ai < 2; ++ai)
#pragma unroll
                for (int m = 0; m < 4; ++m) { bf16_t* rowp = base + (size_t)(row0 + ai * HALF + m * 16) * ld + colt + cl;
#pragma unroll
                    for (int bj = 0; bj < 2; ++bj) *(u32x4*)(rowp + bj * HALF) = pack8(acc[ai][bj][m][0] * sc, acc[ai][bj][m][1] * sc); }
        } else {
            if (wc == 0 && fq == 0) {
#pragma unroll
                for (int ai = 0; ai < 2; ++ai)
#pragma unroll
                    for (int m = 0; m < 4; ++m) { const size_t r = (size_t)(row0 + ai * HALF + m * 16); *(f32x4*)(IG + r * 4) = acc[ai][0][m][0]; *(f32x4*)(FG + r * 4) = acc[ai][0][m][1]; }
            }
        }
    }
};

template <class Epi, class Sched, bool ALIGN_EPI = false, bool SP2 = false>
__device__ __forceinline__ void gemm_phase(PG8_LAS unsigned char* lds, const Gemm g, const Sched& S, const Epi& E, int tid_in) {
    const int tid = tid_in, wid = __builtin_amdgcn_readfirstlane(tid >> 6), lane = tid & 63, wr = wid >> 2, wc = wid & 3, fr = lane & 15, fq = lane >> 4;
    const int K = g.K, nt = K / BK;
    unsigned voffA[2], voffB[2];
#pragma unroll
    for (int i = 0; i < 2; ++i) { int R, C; stage_rc(tid * 16 + i * 8192, R, C); const int Rb = Epi::PERM ? ((R & ~31) + perm32(R & 31)) : R;
        voffA[i] = (unsigned)(R * K + C) * 2u; voffB[i] = (unsigned)(Rb * K + C) * 2u; }
    const size_t kstep = (size_t)(BK * 2);
    const size_t hstep = (size_t)HALF * K * 2;
    const size_t tstep = 2 * hstep;
    const unsigned ldsw = (unsigned)wid * 1024u;
    const int aoff = lds_byte(wr * 64 + fr, fq * 8), boff = lds_byte(wc * 32 + fr, fq * 8);
#define PG8_SA(b, h) (((b) * 2 + (h)) * HTB)
#define PG8_SB(b, h) ((4 + (b) * 2 + (h)) * HTB)
#define PG8_STAGE(bufoff, gbase, voff) do { _Pragma("unroll") for (int _i = 0; _i < 2; ++_i) \
        __builtin_amdgcn_global_load_lds((const unsigned*)((const char*)(gbase) + (voff)[_i]), (PG8_LAS unsigned*)(lds + (bufoff) + ldsw + _i * 8192), 16, 0, 0); } while (0)
#define PG8_LDA(dst, b, h) do { _Pragma("unroll") for (int m = 0; m < 4; ++m) _Pragma("unroll") for (int k = 0; k < 2; ++k) dst[m][k] = *(const PG8_LAS bf16x8*)(lds + PG8_SA(b, h) + aoff + m * 2048 + k * 1024); } while (0)
#define PG8_LDB(dst, b, h) do { _Pragma("unroll") for (int n = 0; n < 2; ++n) _Pragma("unroll") for (int k = 0; k < 2; ++k) dst[n][k] = *(const PG8_LAS bf16x8*)(lds + PG8_SB(b, h) + boff + n * 2048 + k * 1024); } while (0)
#define PG8_MMA(ai, bj, At, Bt) do { __builtin_amdgcn_s_setprio(1); _Pragma("unroll") for (int m = 0; m < 4; ++m) _Pragma("unroll") for (int n = 0; n < 2; ++n) _Pragma("unroll") for (int k = 0; k < 2; ++k) \
        acc[ai][bj][m][n] = __builtin_amdgcn_mfma_f32_16x16x32_bf16(Bt[n][k], At[m][k], acc[ai][bj][m][n], 0, 0, 0); __builtin_amdgcn_s_setprio(0); } while (0)
#define PG8_WAIT_V(n) asm volatile("s_waitcnt vmcnt(" #n ")" ::: "memory")
#define PG8_WAIT_L(n) asm volatile("s_waitcnt lgkmcnt(" #n ")" ::: "memory")
#define PG8_BAR __builtin_amdgcn_s_barrier()
#define PG8_SCHED __builtin_amdgcn_sched_barrier(0)
    Unit cur, nxt; int ui = 0;
    if (!S.next(0, cur)) return;
    f32x4 acc[2][2][4][2];
#pragma unroll
    for (int a = 0; a < 2; ++a)
#pragma unroll
        for (int b = 0; b < 2; ++b)
#pragma unroll
            for (int m = 0; m < 4; ++m)
#pragma unroll
                for (int n = 0; n < 2; ++n) acc[a][b][m][n] = (f32x4){0.f, 0.f, 0.f, 0.f};
    bf16x8 At[4][2], B0[2][2], B1[2][2];
    const char* cA = (const char*)g.A + (size_t)cur.pm * tstep; const char* cB = (const char*)g.Bt + (size_t)cur.pn * tstep;
    S.a_ready(cur);
    if constexpr (SP2) {
        PG8_STAGE(PG8_SB(0, 0), cB, voffB); PG8_STAGE(PG8_SB(0, 1), cB + hstep, voffB); PG8_STAGE(PG8_SA(0, 0), cA, voffA); PG8_STAGE(PG8_SA(0, 1), cA + hstep, voffA);
        if (wr == 1) PG8_BAR;
        PG8_WAIT_V(2); PG8_BAR;
        PG8_STAGE(PG8_SB(1, 0), cB + kstep, voffB); PG8_STAGE(PG8_SA(1, 0), cA + kstep, voffA); PG8_STAGE(PG8_SB(1, 1), cB + hstep + kstep, voffB);
        PG8_WAIT_V(6); PG8_BAR;
    } else {
        PG8_STAGE(PG8_SB(0, 0), cB, voffB); PG8_STAGE(PG8_SA(0, 0), cA, voffA); PG8_STAGE(PG8_SB(0, 1), cB + hstep, voffB); PG8_STAGE(PG8_SA(0, 1), cA + hstep, voffA);
        if (wr == 1) PG8_BAR;
        PG8_WAIT_V(4); PG8_BAR;
        PG8_STAGE(PG8_SB(1, 0), cB + kstep, voffB); PG8_STAGE(PG8_SA(1, 0), cA + kstep, voffA); PG8_STAGE(PG8_SB(1, 1), cB + hstep + kstep, voffB);
        PG8_WAIT_V(6); PG8_BAR;
    }
    for (;;) {
        const bool has_next = S.next(ui + 1, nxt);
        const char* nA = has_next ? (const char*)g.A + (size_t)nxt.pm * tstep : cA; const char* nB = has_next ? (const char*)g.Bt + (size_t)nxt.pn * tstep : cB;
        for (int t = 0; t < nt; t += 2) {
            const bool last = (t == nt - 2);
            const char* a1 = cA + (size_t)(t + 1) * kstep;
            const char* a2 = last ? nA : cA + (size_t)(t + 2) * kstep; const char* b2 = last ? nB : cB + (size_t)(t + 2) * kstep;
            const char* a3 = a2 + kstep; const char* b3 = b2 + kstep;
            if (last && has_next) S.a_ready(nxt);
            if constexpr (SP2) {
            PG8_LDB(B0, 0, 0); PG8_LDB(B1, 0, 1); PG8_SCHED; PG8_LDA(At, 0, 0); PG8_STAGE(PG8_SA(1, 1), a1 + hstep, voffA);
            PG8_WAIT_V(8); PG8_WAIT_L(0); PG8_BAR; PG8_MMA(0, 0, At, B0); PG8_MMA(0, 1, At, B1); PG8_BAR; PG8_SCHED;
            PG8_LDA(At, 0, 1); PG8_STAGE(PG8_SB(0, 0), b2, voffB); PG8_STAGE(PG8_SB(0, 1), b2 + hstep, voffB); PG8_STAGE(PG8_SA(0, 0), a2, voffA);
            PG8_WAIT_V(8); PG8_WAIT_L(0); PG8_BAR; PG8_MMA(1, 0, At, B0); PG8_MMA(1, 1, At, B1); PG8_BAR; PG8_SCHED;
            PG8_LDB(B0, 1, 0); PG8_LDB(B1, 1, 1); PG8_SCHED; PG8_LDA(At, 1, 0); PG8_STAGE(PG8_SA(0, 1), a2 + hstep, voffA);
            PG8_WAIT_V(8); PG8_WAIT_L(0); PG8_BAR; PG8_MMA(0, 0, At, B0); PG8_MMA(0, 1, At, B1); PG8_BAR; PG8_SCHED;
            PG8_LDA(At, 1, 1); PG8_STAGE(PG8_SB(1, 0), b3, voffB); PG8_STAGE(PG8_SB(1, 1), b3 + hstep, voffB); PG8_STAGE(PG8_SA(1, 0), a3, voffA);
            PG8_WAIT_V(8); PG8_WAIT_L(0); PG8_BAR; PG8_MMA(1, 0, At, B0); PG8_MMA(1, 1, At, B1); PG8_BAR; PG8_SCHED;
            } else {
            PG8_LDB(B0, 0, 0); PG8_SCHED; PG8_LDA(At, 0, 0); PG8_STAGE(PG8_SA(1, 1), a1 + hstep, voffA);
            PG8_WAIT_L(8); PG8_BAR; PG8_WAIT_L(0); PG8_MMA(0, 0, At, B0); PG8_BAR; PG8_SCHED;
            PG8_LDB(B1, 0, 1); PG8_STAGE(PG8_SB(0, 0), b2, voffB);
            PG8_BAR; PG8_WAIT_L(0); PG8_MMA(0, 1, At, B1); PG8_BAR;
            PG8_LDA(At, 0, 1); PG8_STAGE(PG8_SA(0, 0), a2, voffA);
            PG8_BAR; PG8_WAIT_L(0); PG8_MMA(1, 0, At, B0); PG8_BAR; PG8_SCHED;
            PG8_STAGE(PG8_SB(0, 1), b2 + hstep, voffB);
            PG8_WAIT_V(6); PG8_BAR; PG8_MMA(1, 1, At, B1); PG8_BAR;
            PG8_LDB(B0, 1, 0); PG8_SCHED; PG8_LDA(At, 1, 0); PG8_STAGE(PG8_SA(0, 1), a2 + hstep, voffA);
            PG8_WAIT_L(8); PG8_BAR; PG8_WAIT_L(0); PG8_MMA(0, 0, At, B0); PG8_BAR; PG8_SCHED;
            PG8_LDB(B1, 1, 1); PG8_STAGE(PG8_SB(1, 0), b3, voffB);
            PG8_BAR; PG8_WAIT_L(0); PG8_MMA(0, 1, At, B1); PG8_BAR;
            PG8_LDA(At, 1, 1); PG8_STAGE(PG8_SA(1, 0), a3, voffA);
            PG8_BAR; PG8_WAIT_L(0); PG8_MMA(1, 0, At, B0); PG8_BAR; PG8_SCHED;
            PG8_STAGE(PG8_SB(1, 1), b3 + hstep, voffB);
            PG8_WAIT_V(6); PG8_BAR; PG8_MMA(1, 1, At, B1); PG8_BAR;
            }
        }
        if constexpr (ALIGN_EPI) { if (wr == 0) PG8_BAR; }
        if constexpr (!Epi::AFTER_DRAIN) { E(acc, cur, wr, wc, fr, fq); S.done(cur); }
        if (!has_next) break;
#pragma unroll
        for (int a = 0; a < 2; ++a)
#pragma unroll
            for (int b = 0; b < 2; ++b)
#pragma unroll
                for (int m = 0; m < 4; ++m)
#pragma unroll
                    for (int n = 0; n < 2; ++n) acc[a][b][m][n] = (f32x4){0.f, 0.f, 0.f, 0.f};
        cur = nxt; cA = nA; cB = nB; ++ui;
        if constexpr (ALIGN_EPI) { if (wr == 1) PG8_BAR; }
    }
    PG8_WAIT_V(0);
    if constexpr (!ALIGN_EPI) { if (wr == 0) PG8_BAR; }
    PG8_BAR;
    if constexpr (Epi::AFTER_DRAIN) { E.fused(acc, cur, wr, wc, fr, fq, lds, wid, lane); S.done(cur); }
#undef PG8_SA
#undef PG8_SB
#undef PG8_STAGE
#undef PG8_LDA
#undef PG8_LDB
#undef PG8_MMA
#undef PG8_WAIT_V
#undef PG8_WAIT_L
#undef PG8_BAR
#undef PG8_SCHED
}
}
#ifndef PG8_SP2
#define PG8_SP2 true
#endif
#ifndef PG8_ALIGN
#define PG8_ALIGN true
#endif

#define GAS __attribute__((address_space(1)))
#define LAS __attribute__((address_space(3)))
typedef unsigned short bf16;
typedef unsigned v4u __attribute__((ext_vector_type(4)));
typedef unsigned v2u __attribute__((ext_vector_type(2)));
typedef float f32x4 __attribute__((ext_vector_type(4)));
typedef short bf16x8 __attribute__((ext_vector_type(8)));
typedef GAS unsigned gu32;
#define RLX_AGENT __ATOMIC_RELAXED, __HIP_MEMORY_SCOPE_AGENT
#define LDS_WAIT() asm volatile("s_waitcnt lgkmcnt(0)" ::: "memory")
#define VM_WAIT() asm volatile("s_waitcnt vmcnt(0)" ::: "memory")
__device__ __forceinline__ unsigned pk2(float lo, float hi) { return pg8::cvt_pk_bf16(lo, hi); }
__device__ __forceinline__ bf16 f2bf(float x) { return (bf16)(pg8::cvt_pk_bf16(x, 0.f) & 0xffffu); }
__device__ __forceinline__ float bf2f(bf16 b) { return __uint_as_float((unsigned)b << 16); }
__device__ __forceinline__ float bflo(unsigned p) { return __uint_as_float(p << 16); }
__device__ __forceinline__ float bfhi(unsigned p) { return __uint_as_float(p & 0xffff0000u); }
__device__ __forceinline__ float sigmoidf_(float x) { return 1.f / (1.f + __expf(-x)); }
__device__ __forceinline__ float logsigmoidf_(float x) { return fminf(x, 0.f) - log1pf(__expf(-fabsf(x))); }
__device__ __forceinline__ float gelu_tanh(float y) { const float x = 0.7978845608028654f * (y + 0.044715f * y * y * y); const float t = __builtin_amdgcn_exp2f(2.f * LOG2E * x); return 0.5f * y * (2.f - 2.f * __builtin_amdgcn_rcpf(t + 1.f)); }
template <int X> __device__ __forceinline__ float swz_xor(float v) { return __int_as_float(__builtin_amdgcn_ds_swizzle(__float_as_int(v), (X << 10) | 0x1f)); }
__device__ __forceinline__ float xor32(float v) { const unsigned u = __float_as_uint(v); auto rr = __builtin_amdgcn_permlane32_swap(u, u, false, false); const unsigned a = rr[0], b = rr[1]; return __uint_as_float(a ^ b ^ u); }
__device__ __forceinline__ float wave_sum(float v) { v += swz_xor<1>(v); v += swz_xor<2>(v); v += swz_xor<4>(v); v += swz_xor<8>(v); v += swz_xor<16>(v); v += xor32(v); return v; }
__device__ __forceinline__ float wave_max(float v) { v = fmaxf(v, swz_xor<1>(v)); v = fmaxf(v, swz_xor<2>(v)); v = fmaxf(v, swz_xor<4>(v)); v = fmaxf(v, swz_xor<8>(v)); v = fmaxf(v, swz_xor<16>(v)); v = fmaxf(v, xor32(v)); return v; }
__device__ __forceinline__ float lane_up(float x, int off, int lane) { const int src = (lane >= off) ? lane - off : lane; return __int_as_float(__builtin_amdgcn_ds_bpermute(src << 2, __float_as_int(x))); }
__device__ __forceinline__ int fresh_tid(int wave_s) { int l; asm volatile("v_mbcnt_lo_u32_b32 %0, -1, 0\n\tv_mbcnt_hi_u32_b32 %0, -1, %0" : "=v"(l)); int w = wave_s; asm volatile("" : "+s"(w)); int t = w * 64 + l; asm volatile("" : "+v"(t)); return t; }
#define XB_TMO      128
#define XB_XCNT(j)  (256  + 64 * (j))
#define XB_XSUB(j)  (1280 + 64 * (j))
#define XB_XGEN(j)  (2304 + 64 * (j))
#define XB_TOP      3328
#define XB_TOPGEN   3392
#define XCD_BAR_WORDS 3456
#define XB_SPIN_CAP (1u << 18)

__device__ __forceinline__ unsigned xb_ld(unsigned* p)              { return __hip_atomic_load(p, __ATOMIC_RELAXED, __HIP_MEMORY_SCOPE_AGENT); }
__device__ __forceinline__ unsigned xb_add(unsigned* p, unsigned v) { return __hip_atomic_fetch_add(p, v, __ATOMIC_RELAXED, __HIP_MEMORY_SCOPE_AGENT); }
__device__ __forceinline__ unsigned xb_xcc_id() { return (unsigned)__builtin_amdgcn_s_getreg((3 << 11) | 20) & 0xFu; }
#define XB_SPIN(cond, bar) do { unsigned _sp = 0; while (cond) { __builtin_amdgcn_s_sleep(1); \
    if ((++_sp & 255u) == 0u) { if (xb_ld(&(bar)[XB_TMO])) break; if (_sp > XB_SPIN_CAP) { atomicAdd(&(bar)[XB_TMO], 1u); break; } } } } while (0)

struct XcdBarrier {
    unsigned* bar; unsigned x;
    volatile LAS unsigned* st;
};

__device__ __forceinline__ XcdBarrier xcd_barrier_post(unsigned* bar, volatile LAS unsigned* st) {
    XcdBarrier b; b.bar = bar; b.x = xb_xcc_id(); b.st = st;
    if (threadIdx.x == 0) (void)xb_add(&bar[XB_XCNT(b.x)], 1u);
    return b;
}
__device__ __forceinline__ void xcd_barrier_complete(unsigned* bar, unsigned x, unsigned& nloc, unsigned& nx) {
    const unsigned G = gridDim.x * gridDim.y * gridDim.z;
    unsigned sum, cnt, mine, sp = 0u;
    for (;;) {
        sum = 0u; cnt = 0u; mine = 0u;
#pragma unroll
        for (unsigned j = 0; j < 16; ++j) { const unsigned c = xb_ld(&bar[XB_XCNT(j)]); sum += c; cnt += (c > 0u) ? 1u : 0u; mine = (j == x) ? c : mine; }
        if (sum == G) break;
        __builtin_amdgcn_s_sleep(1);
        if ((++sp & 255u) == 0u) { if (xb_ld(&bar[XB_TMO])) break; if (sp > XB_SPIN_CAP) { atomicAdd(&bar[XB_TMO], 1u); break; } }
    }
    nloc = mine > 0u ? mine : 1u; nx = cnt > 0u ? cnt : 1u;
}

__device__ __forceinline__ void xcd_barrier(const XcdBarrier& b) {
    asm volatile("s_waitcnt vmcnt(0)" ::: "memory");
    __syncthreads();
    if (threadIdx.x == 0) {
        unsigned* bar = b.bar;
        __builtin_amdgcn_s_waitcnt(0);
        unsigned nloc = b.st[0], nx = b.st[1];
        if (nloc == 0u) { xcd_barrier_complete(bar, b.x, nloc, nx); b.st[0] = nloc; b.st[1] = nx; }
        const unsigned old = xb_add(&bar[XB_XSUB(b.x)], 1u);
        const unsigned gen = old / nloc;
        if (old + 1u == (gen + 1u) * nloc) {
            __builtin_amdgcn_fence(__ATOMIC_RELEASE, "agent");
            asm volatile("s_waitcnt vmcnt(0)" ::: "memory");
            const unsigned og = xb_add(&bar[XB_TOP], 1u);
            const unsigned tg = og / nx;
            if (og + 1u == (tg + 1u) * nx) xb_add(&bar[XB_TOPGEN], 1u);
            else XB_SPIN(xb_ld(&bar[XB_TOPGEN]) == tg, bar);
            __builtin_amdgcn_fence(__ATOMIC_ACQUIRE, "agent");
            xb_add(&bar[XB_XGEN(b.x)], 1u);
            asm volatile("s_waitcnt vmcnt(0)" ::: "memory");
        } else {
            XB_SPIN(xb_ld(&bar[XB_XGEN(b.x)]) == gen, bar);
            __builtin_amdgcn_fence(__ATOMIC_ACQUIRE, "agent");
            asm volatile("s_waitcnt vmcnt(0)" ::: "memory");
        }
    }
    __syncthreads();
}


struct Args { const float* in[20]; float* out; unsigned char* ws; };
typedef const __attribute__((address_space(4))) Args* KArgs;

constexpr int TSCR = 17408;
__device__ __forceinline__ void transpose_item(const float* W, int K, int N, bf16* WT, int mode, LAS float* scr, int item, int lane) {
    const int nblk = (N + 63) / 64, kb = item / nblk, nb = item % nblk, k0 = 64 * kb, n0 = 64 * nb;
    const int kr = lane >> 4, nq = lane & 15, nn = n0 + 4 * nq; const bool ok = nn < N;
    const float* src = W + (size_t)(k0 + kr) * N + nn;
    f32x4 v[16];
#pragma unroll
    for (int i = 0; i < 16; ++i) v[i] = ok ? *(const GAS f32x4*)(src + (size_t)(4 * i) * N) : (f32x4){0.f, 0.f, 0.f, 0.f};
#pragma unroll
    for (int i = 0; i < 16; ++i) { LAS float* d = scr + (4 * i + kr) * 65 + 4 * nq; d[0] = v[i].x; d[1] = v[i].y; d[2] = v[i].z; d[3] = v[i].w; }
    LDS_WAIT(); asm volatile("" ::: "memory");
    const int c = lane & 7, nr = lane >> 3;
    int r0 = n0; if (mode) r0 = 256 * (n0 >> 7) + (n0 & 127) + (mode == 2 ? 128 : 0);
#pragma unroll
    for (int j = 0; j < 8; ++j) { const int n = nr + 8 * j; const LAS float* s = scr + (8 * c) * 65 + n;
        v4u o; o.x = pk2(s[0 * 65], s[1 * 65]); o.y = pk2(s[2 * 65], s[3 * 65]); o.z = pk2(s[4 * 65], s[5 * 65]); o.w = pk2(s[6 * 65], s[7 * 65]);
        if (n0 + n < N) *(GAS v4u*)(WT + (size_t)(r0 + n) * K + k0 + 8 * c) = o; }
    LDS_WAIT(); asm volatile("" ::: "memory");
}

constexpr int CI_ABIN = 32 * 81, CI_SQ = 32 * 32, CI_QKV = 32 * 96, CI_W1 = 32 * 88, CI_W2 = 88 * 32, CI_WG = 16 * 4;
constexpr int CONV_EVEN = CI_ABIN + CI_WG + CI_SQ + 2 * CI_W1 + CI_W2, CONV_ODD = CI_QKV + CI_SQ + 2 * CI_W1 + CI_W2;
constexpr int CONV_END0 = CONV_EVEN, CONV_END1 = CONV_END0 + CONV_ODD, CONV_END2 = CONV_END1 + CONV_EVEN, CONV_END3 = CONV_END2 + CONV_ODD, CONV_ITEMS = CONV_END3;
__device__ __forceinline__ void conv_item(KArgs args, LAS float* scr, int it, int lane) {
    unsigned char* ws = args->ws;
    int layer = 0, r = it;
    if (r >= CONV_END2) { layer = 3; r -= CONV_END2; } else if (r >= CONV_END1) { layer = 2; r -= CONV_END1; } else if (r >= CONV_END0) { layer = 1; r -= CONV_END0; }
    const int j = layer >> 1;
    if ((layer & 1) == 0) {
        if (r < CI_ABIN) { transpose_item(args->in[9] + (size_t)j * 2048 * AB_IN, 2048, AB_IN, (bf16*)(ws + WS_WABIN) + (size_t)j * AB_IN_PAD * 2048, 0, scr, r, lane); return; } r -= CI_ABIN;
        if (r < CI_WG) { const int mat = j * 16 + (r >> 2); transpose_item(args->in[13] + (size_t)mat * 16384, 128, 128, (bf16*)(ws + WS_WGT) + (size_t)mat * 16384, 0, scr, r & 3, lane); return; } r -= CI_WG;
        if (r < CI_SQ) { transpose_item(args->in[10] + (size_t)j * 2048 * 2048, 2048, 2048, (bf16*)(ws + WS_WABOUT) + (size_t)j * 2048 * 2048, 0, scr, r, lane); return; } r -= CI_SQ;
    } else {
        if (r < CI_QKV) { transpose_item(args->in[18] + (size_t)j * 2048 * 6144, 2048, 6144, (bf16*)(ws + WS_WQKV) + (size_t)j * 6144 * 2048, 0, scr, r, lane); return; } r -= CI_QKV;
        if (r < CI_SQ) { transpose_item(args->in[19] + (size_t)j * 2048 * 2048, 2048, 2048, (bf16*)(ws + WS_WSBO) + (size_t)j * 2048 * 2048, 0, scr, r, lane); return; } r -= CI_SQ;
    }
    if (r < CI_W1) { transpose_item(args->in[6] + (size_t)layer * 2048 * FF, 2048, FF, (bf16*)(ws + WS_W13) + (size_t)layer * 2 * FF * 2048, 1, scr, r, lane); return; } r -= CI_W1;
    if (r < CI_W1) { transpose_item(args->in[7] + (size_t)layer * 2048 * FF, 2048, FF, (bf16*)(ws + WS_W13) + (size_t)layer * 2 * FF * 2048, 2, scr, r, lane); return; } r -= CI_W1;
    transpose_item(args->in[8] + (size_t)layer * FF * 2048, FF, 2048, (bf16*)(ws + WS_W2) + (size_t)layer * 2048 * FF, 0, scr, r, lane);
}
__device__ __forceinline__ void conv_range(KArgs args, LAS unsigned char* lds, int lane, int wave, int first, int count, int widx, int nw) {
    LAS float* scr = (LAS float*)(lds + wave * TSCR);
    for (int i = widx; i < count; i += nw) conv_item(args, scr, first + i, lane);
}
constexpr int CONV_KA = CONV_KA_V, CONV_KB = CONV_KB_V, CONV_NA = 96 * 8 * CONV_KA, CONV_NB = 128 * 8 * CONV_KB;

__device__ __forceinline__ void p0_prologue(KArgs args, LAS unsigned char* lds, int tid, int lane, int wave, int vcu, int G) {
    unsigned char* ws = args->ws;
    const int bx = blockIdx.x;
    if (bx < 192) {
        LAS float* cs = (LAS float*)lds;
        LAS float* red = (LAS float*)(lds + 16384);
        const float* c = args->in[1];
        for (int i = tid; i < 4096; i += 512) { const float v = c[i]; cs[i] = v / (1.f + __expf(-v)); }
        __syncthreads();
        const int mat = bx / 24, cg = bx % 24;
        const float* Wp = args->in[2] + (size_t)mat * 2048 * 6144 + cg * 256 + lane * 4;
        f32x4 a0 = {0.f, 0.f, 0.f, 0.f}, a1 = {0.f, 0.f, 0.f, 0.f};
        const int kbeg = wave * 256;
#pragma unroll 8
        for (int k = kbeg; k < kbeg + 256; ++k) { const f32x4 w = *(const GAS f32x4*)(Wp + (size_t)k * 6144); const float c0 = cs[k], c1 = cs[2048 + k]; a0 += c0 * w; a1 += c1 * w; }
        *(LAS f32x4*)(red + (wave * 2 + 0) * 256 + lane * 4) = a0; *(LAS f32x4*)(red + (wave * 2 + 1) * 256 + lane * 4) = a1;
        __syncthreads();
        { const int b = tid >> 8, col = tid & 255; float s = args->in[3][mat * 6144 + cg * 256 + col];
#pragma unroll
          for (int w = 0; w < 8; ++w) s += red[(w * 2 + b) * 256 + col];
          ((float*)(ws + WS_MOD))[(mat * 2 + b) * 6144 + cg * 256 + col] = s; }
        __syncthreads();
    }
    conv_range(args, lds, lane, wave, 0, CONV_END0, vcu * NWAVES + wave, G * NWAVES);
}

__device__ __forceinline__ void norm_phase(const float* xin, const float* g, const float* mod  , bf16* HN, int lane, int gw, int NGW) {
    int curb = -1; f32x4 gs[8], sh[8];
    for (int row = gw; row < M; row += NGW) {
        const int b = row >= SEQ ? 1 : 0;
        if (b != curb) { curb = b;
#pragma unroll
            for (int j = 0; j < 8; ++j) { const int col = 4 * lane + 256 * j; const f32x4 gg = *(const GAS f32x4*)(g + col), sc = *(const GAS f32x4*)(mod + b * 6144 + 2048 + col); gs[j] = gg * (1.f + sc); sh[j] = *(const GAS f32x4*)(mod + b * 6144 + col); } }
        const GAS f32x4* xr = (const GAS f32x4*)(xin + (size_t)row * DM) + lane;
        f32x4 v[8]; float ss = 0.f;
#pragma unroll
        for (int j = 0; j < 8; ++j) { v[j] = xr[64 * j]; ss += (v[j].x * v[j].x + v[j].y * v[j].y) + (v[j].z * v[j].z + v[j].w * v[j].w); }
        const float rstd = 1.f / sqrtf(wave_sum(ss) * (1.f / DM) + EPS);
        GAS v2u* o8 = (GAS v2u*)(HN + (size_t)row * DM) + lane;
#pragma unroll
        for (int j = 0; j < 8; ++j) { const f32x4 y = v[j] * rstd * gs[j] + sh[j]; v2u w; w.x = pk2(y.x, y.y); w.y = pk2(y.z, y.w); o8[64 * j] = w; }
    }
}
__device__ __forceinline__ void final_norm_phase(const float* xin, const float* g, float* out, int lane, int gw, int NGW) {
    f32x4 gs[8];
#pragma unroll
    for (int j = 0; j < 8; ++j) gs[j] = *(const GAS f32x4*)(g + 4 * lane + 256 * j);
    for (int row = gw; row < M; row += NGW) {
        const GAS f32x4* xr = (const GAS f32x4*)(xin + (size_t)row * DM) + lane;
        f32x4 v[8]; float ss = 0.f;
#pragma unroll
        for (int j = 0; j < 8; ++j) { v[j] = xr[64 * j]; ss += (v[j].x * v[j].x + v[j].y * v[j].y) + (v[j].z * v[j].z + v[j].w * v[j].w); }
        const float rstd = 1.f / sqrtf(wave_sum(ss) * (1.f / DM) + EPS);
        GAS f32x4* o = (GAS f32x4*)(out + (size_t)row * DM) + lane;
#pragma unroll
        for (int j = 0; j < 8; ++j) o[64 * j] = v[j] * rstd * gs[j];
    }
}

struct MixP {
    const float *XA, *IG, *FG; const bf16 *YA, *Qm, *Km, *Vm, *Om; bf16* MIX;
    const float *conv_w, *conv_b, *gate_w, *gate_b, *lam, *mgb, *mng;
    float *DC, *DN, *NIN, *MLOC, *BLAST, *MIN, *HLOC, *PCUM, *AGGP, *AGGH, *HTMP; bf16* CIN;
};

__device__ __forceinline__ void mx1_rglru_unit(const MixP& P, LAS unsigned char* lds, int tid, int b, int n, int c) {
    LAS float* XC = (LAS float*)lds;
    LAS float* AS = (LAS float*)(lds + 65536);
    const int e = tid & 127, tg = tid >> 7, chn = n * 128 + e;
    const size_t rowbase = (size_t)b * SEQ; const int t0 = c * CH;
    {
        float w[4]; for (int j = 0; j < 4; ++j) w[j] = P.conv_w[j * LRU_W + chn];
        const float cb = P.conv_b[chn];
        for (int i = 0; i < 32; ++i) { const int tt = tg * 32 + i, t = t0 + tt; float acc = cb;
#pragma unroll
            for (int j = 0; j < 4; ++j) { const int ts = t - 3 + j; if (ts >= 0) acc += w[j] * P.XA[(rowbase + ts) * LRU_W + chn]; }
            XC[tt * 128 + e] = acc; }
    }
    __syncthreads();
    float ar[32], ai[32];
    { const float br = P.gate_b[chn], bi = P.gate_b[LRU_W + chn];
#pragma unroll
      for (int i = 0; i < 32; ++i) { ar[i] = br; ai[i] = bi; } }
    { const float* Wr = P.gate_w + ((size_t)(0 * NBLK + n) * 128) * 128 + e; const float* Wi = P.gate_w + ((size_t)(1 * NBLK + n) * 128) * 128 + e;
      for (int d = 0; d < 128; ++d) { const float wr = Wr[d * 128], wi = Wi[d * 128];
#pragma unroll
          for (int i = 0; i < 32; ++i) { const float x = XC[(tg * 32 + i) * 128 + d]; ar[i] += x * wr; ai[i] += x * wi; } } }
    __syncthreads();
    { const float ls = logsigmoidf_(P.lam[chn]);
#pragma unroll
      for (int i = 0; i < 32; ++i) { const int tt = tg * 32 + i; const float r = sigmoidf_(ar[i]), ig = sigmoidf_(ai[i]); const float la = 8.f * r * ls; const float a = __expf(la);
          const float mult = sqrtf(-expm1f(2.f * la)); const float xv = XC[tt * 128 + e]; AS[tt * 128 + e] = a; XC[tt * 128 + e] = mult * (ig * xv); } }
    __syncthreads();
    if (tid < 128) { float h = 0.f, pp = 1.f;
        for (int tt = 0; tt < 128; ++tt) { const float a = AS[tt * 128 + e], u = XC[tt * 128 + e]; h = a * h + u; pp *= a; const size_t o = (rowbase + t0 + tt) * LRU_W + chn; P.HLOC[o] = h; P.PCUM[o] = pp; }
        P.AGGP[(b * NCH + c) * LRU_W + chn] = pp; P.AGGH[(b * NCH + c) * LRU_W + chn] = h; }
    __syncthreads();
}

__device__ __forceinline__ void mx3_rglru_unit(const MixP& P, int tid, int b, int c, int half) {
    const int chn = half * 512 + tid;
    float carry = 0.f;
    for (int c2 = 0; c2 < c; ++c2) carry = P.AGGP[(b * NCH + c2) * LRU_W + chn] * carry + P.AGGH[(b * NCH + c2) * LRU_W + chn];
    for (int tt = 0; tt < CH; ++tt) { const size_t row = (size_t)b * SEQ + c * CH + tt; const float h = P.HLOC[row * LRU_W + chn] + P.PCUM[row * LRU_W + chn] * carry;
        const float y = bf2f(P.YA[row * LRU_W + chn]); P.MIX[row * DM + chn] = f2bf(h * gelu_tanh(y)); }
}

__device__ __forceinline__ void mx1_mlstm_unit(const MixP& P, LAS unsigned char* lds, int tid, int b, int h, int c) {
    LAS bf16* VS = (LAS bf16*)lds;
    LAS float* KS = (LAS float*)(lds + 65536);
    LAS float* sm = (LAS float*)(lds + SM_OFF); LAS float *s_li = sm, *s_lf = sm + 128, *s_bc = sm + 256, *s_g = sm + 384, *s_sc = sm + 768;
    const size_t rowbase = (size_t)b * SEQ + c * CH; const int uidx = (b * MH + h) * NCH + c;
    if (tid < 128) { s_li[tid] = P.IG[(rowbase + tid) * 4 + h] + P.mgb[h]; s_lf[tid] = logsigmoidf_(P.FG[(rowbase + tid) * 4 + h] + P.mgb[MH + h]); }
    __syncthreads();
    if (tid == 0) { float acc = 0.f, G = -INFINITY; for (int s = 0; s < 128; ++s) { acc += s_lf[s]; s_bc[s] = acc; const float g = s_li[s] - acc; s_g[s] = g; G = fmaxf(G, g); } s_sc[0] = G; s_sc[1] = acc; }
    __syncthreads();
    { const float G = s_sc[0]; const int s = tid >> 2, q = tid & 3; const float w = __expf(s_g[s] - G);
      const bf16* vp = P.Vm + (rowbase + s) * MLW + h * DV;
#pragma unroll
      for (int i = 0; i < 8; ++i) { const int ch = q + 4 * i; *(LAS v4u*)(VS + s * 256 + ch * 8) = *(const GAS v4u*)(vp + ch * 8); }
      const bf16* kp = P.Km + (rowbase + s) * MQK + h * DK + q * 32;
#pragma unroll
      for (int i = 0; i < 4; ++i) { const v4u kk = *(const GAS v4u*)(kp + i * 8); LAS float* d = KS + s * 128 + q * 32 + i * 8;
          d[0] = w * bflo(kk.x); d[1] = w * bfhi(kk.x); d[2] = w * bflo(kk.y); d[3] = w * bfhi(kk.y); d[4] = w * bflo(kk.z); d[5] = w * bfhi(kk.z); d[6] = w * bflo(kk.w); d[7] = w * bfhi(kk.w); } }
    __syncthreads();
    { const int d = tid & 127, vg = tid >> 7;
      float* dc = P.DC + ((size_t)uidx * DV + vg * 64) * DK + d;
#pragma unroll 1
      for (int i = 0; i < 64; ++i) { const LAS bf16* vcol = VS + vg * 64 + i; float acc = 0.f;
#pragma unroll 8
          for (int s = 0; s < 128; ++s) acc += KS[s * 128 + d] * bf2f(vcol[s * 256]);
          dc[(size_t)i * DK] = acc; }
      if (tid < 128) { float a = 0.f; for (int s = 0; s < 128; ++s) a += KS[s * 128 + tid]; P.DN[uidx * DK + tid] = a; }
      if (tid == 0) { P.MLOC[uidx] = s_sc[1] + s_sc[0]; P.BLAST[uidx] = s_sc[1]; } }
    __syncthreads();
}

__device__ __forceinline__ void mx2_mlstm(const MixP& P, LAS unsigned char* lds, int tid, int gtid, int NT) {
    LAS float* sm = (LAS float*)(lds + SM_OFF); LAS float *s_dec = sm, *s_scl = sm + 256, *s_min = sm + 512;
    if (tid < 8) { float m = 0.f; for (int k = 0; k < NCH; ++k) { const int u = tid * NCH + k; s_min[u] = m; const float bl = P.BLAST[u], ml = P.MLOC[u]; const float mn = fmaxf(bl + m, ml);
        s_dec[u] = __expf(bl + m - mn); s_scl[u] = __expf(ml - mn); m = mn; } }
    __syncthreads();
    typedef float f32x2v __attribute__((ext_vector_type(2)));
    for (int e2 = gtid; e2 < 8 * DV * DK / 2; e2 += NT) { const int chain = e2 / (DV * DK / 2), idx = (e2 % (DV * DK / 2)) * 2;
        const float* dcp = P.DC + (size_t)chain * NCH * (DV * DK) + idx; bf16* cip = P.CIN + (size_t)chain * NCH * (DV * DK) + idx;
        f32x2v d[NCH];
#pragma unroll
        for (int k = 0; k < NCH; ++k) d[k] = *(const GAS f32x2v*)(dcp + (size_t)k * (DV * DK));
        float c0 = 0.f, c1 = 0.f;
#pragma unroll
        for (int k = 0; k < NCH; ++k) { const int u = chain * NCH + k; *(GAS unsigned*)(cip + (size_t)k * (DV * DK)) = pk2(c0, c1); const float dd = s_dec[u], sc = s_scl[u]; c0 = dd * c0 + sc * d[k].x; c1 = dd * c1 + sc * d[k].y; } }
    if (gtid < 8 * DK) { const int chain = gtid / DK, dd_ = gtid % DK; float nv = 0.f; float dn[NCH];
#pragma unroll
        for (int k = 0; k < NCH; ++k) dn[k] = P.DN[(chain * NCH + k) * DK + dd_];
#pragma unroll
        for (int k = 0; k < NCH; ++k) { const int u = chain * NCH + k; P.NIN[u * DK + dd_] = nv; nv = s_dec[u] * nv + s_scl[u] * dn[k]; } }
    if (gtid < 256) P.MIN[gtid] = s_min[gtid];
    __syncthreads();
}

__device__ __forceinline__ void mx3_mlstm_unit(const MixP& P, LAS unsigned char* lds, int tid, int lane, int wave, int b, int h, int c) {
    constexpr int SS = 129, KSTR = 130;
    LAS float* S = (LAS float*)lds;
    LAS bf16* QS = (LAS bf16*)(lds + 66048);
    LAS bf16* KSb = (LAS bf16*)(lds + 66048 + 32768);
    LAS float* sm = (LAS float*)(lds + SM_OFF); LAS float *s_li = sm, *s_lf = sm + 128, *s_bc = sm + 256, *s_g = sm + 384, *s_M = sm + 512, *s_dn = sm + 640, *s_wi = sm + 768, *s_nin = sm + 896;
    const size_t rowbase = (size_t)b * SEQ + c * CH; const int uidx = (b * MH + h) * NCH + c;
    const float m_in = P.MIN[uidx];
    if (tid < 128) { s_li[tid] = P.IG[(rowbase + tid) * 4 + h] + P.mgb[h]; s_lf[tid] = logsigmoidf_(P.FG[(rowbase + tid) * 4 + h] + P.mgb[MH + h]); s_nin[tid] = P.NIN[uidx * DK + tid]; }
    { const int s = tid >> 2, q = tid & 3;
      const bf16* qp = P.Qm + (rowbase + s) * MQK + h * DK + q * 32; const bf16* kp = P.Km + (rowbase + s) * MQK + h * DK + q * 32;
#pragma unroll
      for (int i = 0; i < 4; ++i) { *(LAS v4u*)(QS + s * 128 + q * 32 + i * 8) = *(const GAS v4u*)(qp + i * 8);
          const v4u kk = *(const GAS v4u*)(kp + i * 8); LAS unsigned* kd = (LAS unsigned*)(KSb + s * KSTR + q * 32 + i * 8); kd[0] = kk.x; kd[1] = kk.y; kd[2] = kk.z; kd[3] = kk.w; } }
    __syncthreads();
    if (tid == 0) { float acc = 0.f, cm = m_in; for (int s = 0; s < 128; ++s) { acc += s_lf[s]; s_bc[s] = acc; const float g = s_li[s] - acc; s_g[s] = g; cm = fmaxf(cm, g); s_M[s] = cm; s_wi[s] = __expf(m_in - cm); } }
    __syncthreads();
    { const int s = tid & 127, tg = tid >> 7;
      const float gs = s_g[s]; const LAS unsigned* krow = (const LAS unsigned*)(KSb + s * KSTR);
#pragma unroll 1
      for (int i = 0; i < 32; ++i) { const int t = tg * 32 + i; float acc = 0.f; const LAS unsigned* qrow = (const LAS unsigned*)(QS + t * 128);
#pragma unroll 8
          for (int d2 = 0; d2 < 64; ++d2) { const unsigned qp = qrow[d2], kp = krow[d2]; acc += bflo(qp) * bflo(kp) + bfhi(qp) * bfhi(kp); }
          S[t * SS + s] = (s <= t) ? acc * __expf(gs - s_M[t]) : 0.f; } }
    __syncthreads();
    if (tid < 128) { const int t = tid; float den = 0.f; for (int s = 0; s < 128; ++s) den += S[t * SS + s];
        float qn = 0.f; for (int d = 0; d < 128; ++d) qn += bf2f(QS[t * 128 + d]) * s_nin[d];
        den += s_wi[t] * qn; const float mt = s_bc[t] + s_M[t]; s_dn[t] = 1.f / fmaxf(fabsf(den), __expf(-mt)); }
    __syncthreads();
    { const int v = tid & 255, tg = tid >> 8;
      const bf16* cp = P.CIN + ((size_t)uidx * DV + v) * DK;
      const bf16* vp = P.Vm + rowbase * MLW + h * DV + v;
      float* ht = P.HTMP + (size_t)uidx * CH * DV;
#pragma unroll 1
      for (int i = 0; i < 64; ++i) { const int t = tg * 64 + i; float acc = 0.f; const LAS unsigned* qrow = (const LAS unsigned*)(QS + t * 128);
#pragma unroll 4
          for (int d2 = 0; d2 < 64; ++d2) { const unsigned qp = qrow[d2]; const unsigned cc = *(const GAS unsigned*)(cp + 2 * d2); acc += bflo(qp) * bflo(cc) + bfhi(qp) * bfhi(cc); }
          acc *= s_wi[t];
          const LAS float* srow = S + t * SS;
#pragma unroll 4
          for (int s = 0; s < 128; ++s) acc += srow[s] * bf2f(*(const GAS bf16*)(vp + (size_t)s * MLW));
          ht[t * DV + v] = acc * s_dn[t]; } }
    __syncthreads();
    const float* HS = P.HTMP + (size_t)uidx * CH * DV;
    for (int i = 0; i < 16; ++i) { const int t = wave * 16 + i; const f32x4 hv = *(const GAS f32x4*)(HS + t * 256 + 4 * lane);
        const float ss = wave_sum((hv.x * hv.x + hv.y * hv.y) + (hv.z * hv.z + hv.w * hv.w)); const float rstd = 1.f / sqrtf(ss * (1.f / DV) + EPS);
        const f32x4 ng = *(const GAS f32x4*)(P.mng + h * DV + 4 * lane); const v2u ob = *(const GAS v2u*)(P.Om + (rowbase + t) * MLW + h * DV + 4 * lane);
        const float o0 = sigmoidf_(bflo(ob.x)), o1 = sigmoidf_(bfhi(ob.x)), o2 = sigmoidf_(bflo(ob.y)), o3 = sigmoidf_(bfhi(ob.y));
        v2u w; w.x = pk2(hv.x * rstd * ng.x * o0, hv.y * rstd * ng.y * o1); w.y = pk2(hv.z * rstd * ng.z * o2, hv.w * rstd * ng.w * o3);
        *(GAS v2u*)(P.MIX + (rowbase + t) * DM + LRU_W + h * DV + 4 * lane) = w; }
    __syncthreads();
}

__device__ __forceinline__ void attn_v1_phase(const bf16* Q, const bf16* K, const bf16* V, bf16* O, LAS unsigned char* lds, int lane, int wave, int gw, int NGW) {
    LAS float* qs = (LAS float*)(lds + wave * 512);
    for (int u = gw; u < BATCH * SBH * SEQ; u += NGW) {
        const int bh = u & 31, t = u >> 5, b = bh >> 4, h = bh & 15;
        const size_t rowbase = (size_t)b * SEQ;
        { const unsigned qp = *(const GAS unsigned*)(Q + (rowbase + t) * DM + h * SBD + 2 * lane); qs[2 * lane] = bflo(qp); qs[2 * lane + 1] = bfhi(qp); }
        LDS_WAIT();
        float o0 = 0.f, o1 = 0.f, carry = 0.f;
        for (int kb = (t - 1) >> 6; kb >= 0 && t > 0; --kb) {
            const int s = kb * 64 + lane; const bool valid = s < t;
            const bf16* kp = K + (rowbase + s) * DM + h * SBD;
            float z = 0.f;
#pragma unroll
            for (int i = 0; i < 16; ++i) { const v4u kk = *(const GAS v4u*)(kp + i * 8); const LAS float* qq = qs + i * 8;
                z += qq[0] * bflo(kk.x) + qq[1] * bfhi(kk.x) + qq[2] * bflo(kk.y) + qq[3] * bfhi(kk.y) + qq[4] * bflo(kk.z) + qq[5] * bfhi(kk.z) + qq[6] * bflo(kk.w) + qq[7] * bfhi(kk.w); }
            const float sp = valid ? (fmaxf(z, 0.f) + __builtin_amdgcn_logf(1.f + __builtin_amdgcn_exp2f(-fabsf(z)))) : 0.f;
            float x = sp;
#pragma unroll
            for (int off = 1; off < 64; off <<= 1) { const float y = __shfl_down(x, off); if (lane + off < 64) x += y; }
            const float R = x + carry; carry += __shfl(x, 0);
            const float A = valid ? __builtin_amdgcn_exp2f(z - R) : 0.f;
            const bf16* vp = V + (rowbase + kb * 64) * DM + h * SBD + 2 * lane;
            for (int l = 0; l < 64; ++l) { const float a = __shfl(A, l); const unsigned pr = *(const GAS unsigned*)(vp + (size_t)l * DM); o0 += a * bflo(pr); o1 += a * bfhi(pr); }
        }
        *(GAS unsigned*)(O + (rowbase + t) * DM + h * SBD + 2 * lane) = pk2(o0, o1);
    }
}

namespace sba {
typedef float f32x16 __attribute__((ext_vector_type(16)));
typedef short v4i16_t __attribute__((ext_vector_type(4)));
typedef float f32x2_t __attribute__((ext_vector_type(2))); typedef __bf16 bf16x2_t __attribute__((ext_vector_type(2)));
__device__ __forceinline__ unsigned cvtpk_s(float lo, float hi) { f32x2_t v = {lo, hi}; bf16x2_t b = __builtin_convertvector(v, bf16x2_t); return __builtin_bit_cast(unsigned, b); }
__device__ __forceinline__ int img_off(int row, int ch) { return 256 * row + 16 * (ch ^ (((row & 3) << 2) | ((row >> 2) & 3))); }
__device__ __forceinline__ v4i16_t vtr(const LAS unsigned char* p) { return __builtin_amdgcn_ds_read_tr16_b64_v4i16((LAS v4i16_t*)p); }

__device__ __forceinline__ void sb_weights(f32x16& p, float& carry, int hi) {
    float w[16];
#pragma unroll
    for (int r = 0; r < 16; ++r) { const float e = __builtin_amdgcn_exp2f(__builtin_fminf(p[r], 100.f)); p[r] = e; w[r] = __builtin_amdgcn_rcpf(1.f + e); }
    float E[4], Od[4];
#pragma unroll
    for (int m = 0; m < 4; ++m) { w[4 * m + 2] *= w[4 * m + 3]; w[4 * m + 1] *= w[4 * m + 2]; w[4 * m] *= w[4 * m + 1];
        const unsigned tv = __float_as_uint(w[4 * m]); auto rr = __builtin_amdgcn_permlane32_swap(tv, tv, false, false); E[m] = __uint_as_float(rr[0]); Od[m] = __uint_as_float(rr[1]); }
    float SP[4]; SP[3] = carry; SP[2] = SP[3] * (E[3] * Od[3]); SP[1] = SP[2] * (E[2] * Od[2]); SP[0] = SP[1] * (E[1] * Od[1]); carry = SP[0] * (E[0] * Od[0]);
#pragma unroll
    for (int m = 0; m < 4; ++m) { const float off = hi ? SP[m] : SP[m] * Od[m];
#pragma unroll
        for (int i = 0; i < 4; ++i) { const int r = 4 * m + i; p[r] = (p[r] * off) * w[r]; } }
}
__device__ __forceinline__ void sb_mask(f32x16& p, int lim  ) {
#pragma unroll
    for (int r = 0; r < 16; ++r) p[r] = ((r & 3) + 8 * (r >> 2) < lim) ? p[r] : -INFINITY;
}

__device__ __forceinline__ void attn_unit(const bf16* Q, const bf16* K, const bf16* V, bf16* O, LAS unsigned char* lds, int tid, int b, int h, int qb) {
    const int lane = tid & 63, wave = __builtin_amdgcn_readfirstlane(tid >> 6), r32 = lane & 31, hi = lane >> 5;
    const size_t rowbase = (size_t)b * SEQ; const int q0 = qb * 256, Qw = q0 + 32 * wave, t = Qw + r32;
    bf16x8 qf[8];
    { const bf16* qp = Q + (rowbase + t) * DM + h * SBD + hi * 8;
#pragma unroll
      for (int d = 0; d < 8; ++d) qf[d] = *(const GAS bf16x8*)(qp + d * 16); }
    f32x16 o[4];
#pragma unroll
    for (int i = 0; i < 4; ++i)
#pragma unroll
        for (int r = 0; r < 16; ++r) o[i][r] = 0.f;
    float carry = 1.f;
    const int NT = 4 * qb + 4;
    const int sr = tid >> 4, sc = tid & 15;
    const GAS unsigned char* kg = (const GAS unsigned char*)(K + rowbase * DM + h * SBD); const GAS unsigned char* vg = (const GAS unsigned char*)(V + rowbase * DM + h * SBD);
    const unsigned goff = (unsigned)(sr * DM + sc * 8) * 2u;
    const int w0 = img_off(sr, sc), w1 = img_off(sr + 32, sc);
    v4u sk0, sk1, sv0, sv1;
#define SB_LOAD(kt) do { const unsigned o_ = goff + (unsigned)(kt) * (64u * DM * 2u); sk0 = *(const GAS v4u*)(kg + o_); sk1 = *(const GAS v4u*)(kg + o_ + 32u * DM * 2u); sv0 = *(const GAS v4u*)(vg + o_); sv1 = *(const GAS v4u*)(vg + o_ + 32u * DM * 2u); } while (0)
#define SB_WRITE(buf) do { LAS unsigned char* kb_ = lds + (buf) * 16384; LAS unsigned char* vb_ = lds + 32768 + (buf) * 16384; *(LAS v4u*)(kb_ + w0) = sk0; *(LAS v4u*)(kb_ + w1) = sk1; *(LAS v4u*)(vb_ + w0) = sv0; *(LAS v4u*)(vb_ + w1) = sv1; } while (0)
    const int krt = ((r32 & 3) << 2) | ((r32 >> 2) & 3);
    const int i16 = lane & 15, q4 = i16 >> 2, p4 = i16 & 3, gb = (lane >> 4) & 1;
    const int vlow0 = ((2 * gb + (p4 >> 1)) ^ hi), vlow1 = vlow0 ^ 2;
    const int vrow0 = 256 * (4 * hi + q4) + 8 * (p4 & 1);
    SB_LOAD(NT - 1); SB_WRITE(0); __syncthreads();
    for (int it = 0; it < NT; ++it) {
        const int kt = NT - 1 - it, buf = it & 1, key0 = kt * 64;
        if (it + 1 < NT) SB_LOAD(kt - 1);
        const bool skip = key0 >= Qw + 31, full = key0 + 63 < Qw;
        if (!skip) {
            const LAS unsigned char* Kb = lds + buf * 16384; const LAS unsigned char* Vb = lds + 32768 + buf * 16384;
            f32x16 p0, p1;
#pragma unroll
            for (int r = 0; r < 16; ++r) { p0[r] = 0.f; p1[r] = 0.f; }
#pragma unroll
            for (int d = 0; d < 8; ++d) { const int off = 256 * r32 + 16 * ((2 * d + hi) ^ krt);
                const bf16x8 k0 = *(const LAS bf16x8*)(Kb + off), k1 = *(const LAS bf16x8*)(Kb + off + 8192);
                p0 = __builtin_amdgcn_mfma_f32_32x32x16_bf16(k0, qf[d], p0, 0, 0, 0); p1 = __builtin_amdgcn_mfma_f32_32x32x16_bf16(k1, qf[d], p1, 0, 0, 0); }
            bf16x8 af[2][2];
#define SB_PACK(P, u) do { _Pragma("unroll") for (int s = 0; s < 2; ++s) { v4u aw; aw.x = cvtpk_s(P[8 * s], P[8 * s + 1]); aw.y = cvtpk_s(P[8 * s + 2], P[8 * s + 3]); aw.z = cvtpk_s(P[8 * s + 4], P[8 * s + 5]); aw.w = cvtpk_s(P[8 * s + 6], P[8 * s + 7]); af[u][s] = __builtin_bit_cast(bf16x8, aw); } } while (0)
            if (!full) { sb_mask(p1, t - key0 - 32 - 4 * hi); sb_mask(p0, t - key0 - 4 * hi); }
            sb_weights(p1, carry, hi); SB_PACK(p1, 1); __builtin_amdgcn_sched_barrier(0); sb_weights(p0, carry, hi); SB_PACK(p0, 0);
#undef SB_PACK
            __builtin_amdgcn_sched_barrier(0);
#pragma unroll
            for (int u = 0; u < 2; ++u)
#pragma unroll
                for (int s = 0; s < 2; ++s) {
#pragma unroll
                    for (int db = 0; db < 4; ++db) {
                        const int c0 = (((db ^ q4) << 2) | vlow0), c1 = (((db ^ q4) << 2) | vlow1);
                        const v4i16_t lo = vtr(Vb + vrow0 + 256 * (32 * u + 16 * s) + 16 * c0), hh = vtr(Vb + vrow0 + 256 * (32 * u + 16 * s + 8) + 16 * c1);
                        const bf16x8 vf = {lo[0], lo[1], lo[2], lo[3], hh[0], hh[1], hh[2], hh[3]};
                        o[db] = __builtin_amdgcn_mfma_f32_32x32x16_bf16(vf, af[u][s], o[db], 0, 0, 0);
                    }
                }
        }
        if (it + 1 < NT) SB_WRITE(buf ^ 1);
        __syncthreads();
    }
#undef SB_LOAD
#undef SB_WRITE
    bf16* op = O + (rowbase + t) * DM + h * SBD + 4 * hi;
#pragma unroll
    for (int db = 0; db < 4; ++db)
#pragma unroll
        for (int g = 0; g < 4; ++g) { v2u w; w.x = cvtpk_s(o[db][4 * g], o[db][4 * g + 1]); w.y = cvtpk_s(o[db][4 * g + 2], o[db][4 * g + 3]); *(GAS v2u*)(op + 32 * db + 8 * g) = w; }
}

__device__ __forceinline__ void attn_phase(const bf16* Q, const bf16* K, const bf16* V, bf16* O, LAS unsigned char* lds, int tid, int vcu, int G) {
    for (int pi = vcu; pi < 256; pi += G) {
        const int bh = pi >> 3, x = pi & 7;
#pragma unroll 1
        for (int uu = 0; uu < 2; ++uu) attn_unit(Q, K, V, O, lds, tid, bh >> 4, bh & 15, uu ? x : 15 - x);
    }
}
}

namespace mls {
using sba::f32x16; using sba::v4i16_t; using sba::cvtpk_s; using sba::img_off; using sba::vtr;
__device__ __forceinline__ float half_sum(float x) { const unsigned u = __float_as_uint(x); auto rr = __builtin_amdgcn_permlane32_swap(u, u, false, false); return __uint_as_float(rr[0]) + __uint_as_float(rr[1]); }

__device__ __forceinline__ void stage_v(const bf16* Vm, size_t rowbase, int h, LAS unsigned char* lds, int tid) {
    const int c32 = tid & 31; const bf16* vp = Vm + rowbase * MLW + h * DV + c32 * 8;
#pragma unroll
    for (int k = 0; k < 8; ++k) { const int row = (tid >> 5) + 16 * k; const v4u x = *(const GAS v4u*)(vp + (size_t)row * MLW); *(LAS v4u*)(lds + (c32 >> 4) * 32768 + img_off(row, c32 & 15)) = x; }
}
__device__ __forceinline__ void gate_scan(const MixP& P, size_t rowbase, int h, int lane, float& bc0, float& bc1, float& g0, float& g1) {
    const float li0 = P.IG[(rowbase + 2 * lane) * 4 + h] + P.mgb[h], li1 = P.IG[(rowbase + 2 * lane + 1) * 4 + h] + P.mgb[h];
    const float lf0 = logsigmoidf_(P.FG[(rowbase + 2 * lane) * 4 + h] + P.mgb[MH + h]), lf1 = logsigmoidf_(P.FG[(rowbase + 2 * lane + 1) * 4 + h] + P.mgb[MH + h]);
    const float ps = lf0 + lf1; float x = ps;
#pragma unroll
    for (int off = 1; off < 64; off <<= 1) { const float y = lane_up(x, off, lane); if (lane >= off) x += y; }
    bc0 = (x - ps) + lf0; bc1 = bc0 + lf1; g0 = li0 - bc0; g1 = li1 - bc1;
}

__device__ __forceinline__ void mx1_unit(const MixP& P, LAS unsigned char* lds, int tid, int b, int h, int c) {
    const int lane = tid & 63, wave = __builtin_amdgcn_readfirstlane(tid >> 6), r32 = lane & 31, hi = lane >> 5;
    LAS float* sm = (LAS float*)(lds + SM_OFF); LAS float *s_w = sm, *s_sc = sm + 128;
    const size_t rowbase = (size_t)b * SEQ + c * CH; const int uidx = (b * MH + h) * NCH + c;
    stage_v(P.Vm, rowbase, h, lds, tid);
    if (wave == 0) { float bc0, bc1, g0, g1; gate_scan(P, rowbase, h, lane, bc0, bc1, g0, g1);
        const float G = wave_max(fmaxf(g0, g1));
        s_w[2 * lane] = __expf(g0 - G); s_w[2 * lane + 1] = __expf(g1 - G);
        const float bl = __int_as_float(__builtin_amdgcn_readlane(__float_as_int(bc1), 63)); if (lane == 0) { s_sc[0] = G; s_sc[1] = bl; } }
    __syncthreads();
    { const int row = tid >> 2, q = tid & 3; const float w = s_w[row]; const bf16* kp = P.Km + (rowbase + row) * MQK + h * DK + q * 32;
#pragma unroll
      for (int i = 0; i < 4; ++i) { const v4u kk = *(const GAS v4u*)(kp + i * 8); v4u o;
          o.x = cvtpk_s(w * bflo(kk.x), w * bfhi(kk.x)); o.y = cvtpk_s(w * bflo(kk.y), w * bfhi(kk.y)); o.z = cvtpk_s(w * bflo(kk.z), w * bfhi(kk.z)); o.w = cvtpk_s(w * bflo(kk.w), w * bfhi(kk.w));
          *(LAS v4u*)(lds + 65536 + img_off(row, 4 * q + i)) = o; } }
    __syncthreads();
    f32x16 acc[4], accn[4];
#pragma unroll
    for (int i = 0; i < 4; ++i)
#pragma unroll
        for (int r = 0; r < 16; ++r) { acc[i][r] = 0.f; accn[i][r] = 0.f; }
    const int i16 = lane & 15, q4 = i16 >> 2, p4 = i16 & 3, gb = (lane >> 4) & 1;
    const int lowb = 2 * gb + (p4 >> 1);
    const int rowb = 256 * (8 * hi + q4) + 8 * (p4 & 1);
    const LAS unsigned char* Vb = lds + (wave >> 2) * 32768; const LAS unsigned char* Kb = lds + 65536;
    const int vdb = wave & 3;
    const bf16x8 ones = {0x3F80, 0x3F80, 0x3F80, 0x3F80, 0x3F80, 0x3F80, 0x3F80, 0x3F80};
#pragma unroll
    for (int ks = 0; ks < 8; ++ks) {
        const int lw0 = lowb ^ (2 * hi), lw1 = lowb ^ (2 * hi + 1);
        const v4i16_t vl = vtr(Vb + rowb + 256 * (16 * ks) + 16 * (((vdb ^ q4) << 2) | lw0)), vh2 = vtr(Vb + rowb + 256 * (16 * ks + 4) + 16 * (((vdb ^ q4) << 2) | lw1));
        const bf16x8 vf = {vl[0], vl[1], vl[2], vl[3], vh2[0], vh2[1], vh2[2], vh2[3]};
#pragma unroll
        for (int db = 0; db < 4; ++db) {
            const v4i16_t kl = vtr(Kb + rowb + 256 * (16 * ks) + 16 * (((db ^ q4) << 2) | lw0)), kh = vtr(Kb + rowb + 256 * (16 * ks + 4) + 16 * (((db ^ q4) << 2) | lw1));
            const bf16x8 kf = {kl[0], kl[1], kl[2], kl[3], kh[0], kh[1], kh[2], kh[3]};
            acc[db] = __builtin_amdgcn_mfma_f32_32x32x16_bf16(vf, kf, acc[db], 0, 0, 0);
            if (wave == 0) accn[db] = __builtin_amdgcn_mfma_f32_32x32x16_bf16(ones, kf, accn[db], 0, 0, 0);
        }
    }
    float* dc = P.DC + ((size_t)uidx * DV + 32 * wave) * DK + r32;
#pragma unroll
    for (int db = 0; db < 4; ++db)
#pragma unroll
        for (int r = 0; r < 16; ++r) dc[(size_t)((r & 3) + 8 * (r >> 2) + 4 * hi) * DK + 32 * db] = acc[db][r];
    if (wave == 0 && hi == 0) {
#pragma unroll
        for (int db = 0; db < 4; ++db) P.DN[uidx * DK + 32 * db + r32] = accn[db][0]; }
    if (tid == 0) { P.MLOC[uidx] = s_sc[1] + s_sc[0]; P.BLAST[uidx] = s_sc[1]; }
    __syncthreads();
}

__device__ __forceinline__ void mx3_unit(const MixP& P, LAS unsigned char* lds, int tid, int b, int h, int c) {
    const int lane = tid & 63, wave = __builtin_amdgcn_readfirstlane(tid >> 6), r32 = lane & 31, hi = lane >> 5;
    const int qb = wave & 3, vh = wave >> 2;
    LAS float* sm = (LAS float*)(lds + SM_OFF); LAS float *s_g2 = sm, *s_M2 = sm + 128, *s_bc = sm + 256, *s_nin = sm + 384, *s_part = sm + 512;
    const size_t rowbase = (size_t)b * SEQ + c * CH; const int uidx = (b * MH + h) * NCH + c;
    const float m_in = P.MIN[uidx];
    stage_v(P.Vm, rowbase, h, lds, tid);
    if (wave == 0) { float bc0, bc1, g0, g1; gate_scan(P, rowbase, h, lane, bc0, bc1, g0, g1);
        float y = fmaxf(g0, g1);
#pragma unroll
        for (int off = 1; off < 64; off <<= 1) { const float z = lane_up(y, off, lane); if (lane >= off) y = fmaxf(y, z); }
        float ex = lane_up(y, 1, lane); if (lane == 0) ex = -INFINITY;
        const float M0 = fmaxf(m_in, fmaxf(ex, g0)), M1 = fmaxf(m_in, y);
        s_g2[2 * lane] = g0 * LOG2E; s_g2[2 * lane + 1] = g1 * LOG2E; s_M2[2 * lane] = M0 * LOG2E; s_M2[2 * lane + 1] = M1 * LOG2E; s_bc[2 * lane] = bc0; s_bc[2 * lane + 1] = bc1; }
    if (wave == 1) { s_nin[lane] = P.NIN[uidx * DK + lane]; s_nin[64 + lane] = P.NIN[uidx * DK + 64 + lane]; }
    const int t = 32 * qb + r32;
    bf16x8 qf[8];
    { const bf16* qp = P.Qm + (rowbase + t) * MQK + h * DK + hi * 8;
#pragma unroll
      for (int d = 0; d < 8; ++d) qf[d] = *(const GAS bf16x8*)(qp + d * 16); }
    __syncthreads();
    const float M2 = s_M2[t], bct = s_bc[t];
    const float wint = __builtin_amdgcn_exp2f(m_in * LOG2E - M2);
    f32x16 acc[4];
#pragma unroll
    for (int i = 0; i < 4; ++i)
#pragma unroll
        for (int r = 0; r < 16; ++r) acc[i][r] = 0.f;
    { const bf16* cp = P.CIN + ((size_t)uidx * DV + 128 * vh + r32) * DK + hi * 8;
#pragma unroll
      for (int vb = 0; vb < 4; ++vb)
#pragma unroll
          for (int d = 0; d < 8; ++d) { const bf16x8 cf = *(const GAS bf16x8*)(cp + (size_t)(32 * vb) * DK + d * 16); acc[vb] = __builtin_amdgcn_mfma_f32_32x32x16_bf16(cf, qf[d], acc[vb], 0, 0, 0); } }
#pragma unroll
    for (int i = 0; i < 4; ++i)
#pragma unroll
        for (int r = 0; r < 16; ++r) acc[i][r] *= wint;
    float qn = 0.f;
#pragma unroll
    for (int d = 0; d < 8; ++d)
#pragma unroll
        for (int j = 0; j < 8; ++j) qn += bf2f((bf16)qf[d][j]) * s_nin[16 * d + 8 * hi + j];
    float den = wint * half_sum(qn), dpart = 0.f;
    const int i16 = lane & 15, q4 = i16 >> 2, p4 = i16 & 3, gb = (lane >> 4) & 1;
    const int vlow0 = ((2 * gb + (p4 >> 1)) ^ hi), vlow1 = vlow0 ^ 2;
    const int vrow0 = 256 * (4 * hi + q4) + 8 * (p4 & 1);
    const LAS unsigned char* Vb = lds + vh * 32768;
    for (int kb = 0; kb <= qb; ++kb) {
        f32x16 p;
#pragma unroll
        for (int r = 0; r < 16; ++r) p[r] = 0.f;
        { const bf16* kp = P.Km + (rowbase + 32 * kb + r32) * MQK + h * DK + hi * 8;
#pragma unroll
          for (int d = 0; d < 8; ++d) { const bf16x8 kf = *(const GAS bf16x8*)(kp + d * 16); p = __builtin_amdgcn_mfma_f32_32x32x16_bf16(kf, qf[d], p, 0, 0, 0); } }
#pragma unroll
        for (int m = 0; m < 4; ++m) { const f32x4 gq = *(const LAS f32x4*)(s_g2 + 32 * kb + 8 * m + 4 * hi);
#pragma unroll
            for (int i = 0; i < 4; ++i) { const int r = 4 * m + i; float w = __builtin_amdgcn_exp2f(gq[i] - M2); if (kb == qb) w = (8 * m + 4 * hi + i <= r32) ? w : 0.f; p[r] *= w; dpart += p[r]; } }
        bf16x8 af[2];
#pragma unroll
        for (int s = 0; s < 2; ++s) { v4u aw; aw.x = cvtpk_s(p[8 * s], p[8 * s + 1]); aw.y = cvtpk_s(p[8 * s + 2], p[8 * s + 3]); aw.z = cvtpk_s(p[8 * s + 4], p[8 * s + 5]); aw.w = cvtpk_s(p[8 * s + 6], p[8 * s + 7]); af[s] = __builtin_bit_cast(bf16x8, aw); }
        const LAS unsigned char* Vk = Vb + 256 * 32 * kb;
#pragma unroll
        for (int s = 0; s < 2; ++s)
#pragma unroll
            for (int vb = 0; vb < 4; ++vb) {
                const int c0 = (((vb ^ q4) << 2) | vlow0), c1 = (((vb ^ q4) << 2) | vlow1);
                const v4i16_t lo = vtr(Vk + vrow0 + 256 * (16 * s) + 16 * c0), hh = vtr(Vk + vrow0 + 256 * (16 * s + 8) + 16 * c1);
                const bf16x8 vf = {lo[0], lo[1], lo[2], lo[3], hh[0], hh[1], hh[2], hh[3]};
                acc[vb] = __builtin_amdgcn_mfma_f32_32x32x16_bf16(vf, af[s], acc[vb], 0, 0, 0);
            }
    }
    den += half_sum(dpart);
    const float mt = bct + M2 * LN2;
    const float scl = 1.f / fmaxf(fabsf(den), __expf(-mt));
    float ss = 0.f;
#pragma unroll
    for (int i = 0; i < 4; ++i)
#pragma unroll
        for (int r = 0; r < 16; ++r) { acc[i][r] *= scl; ss += acc[i][r] * acc[i][r]; }
    ss = half_sum(ss);
    if (hi == 0) s_part[wave * 32 + r32] = ss;
    __syncthreads();
    const float tot = s_part[qb * 32 + r32] + s_part[(4 + qb) * 32 + r32];
    const float rstd = 1.f / sqrtf(tot * (1.f / DV) + EPS);
    { const int vbase = h * DV + 128 * vh + 4 * hi;
      const bf16* op = P.Om + (rowbase + t) * MLW + vbase; bf16* mp = P.MIX + (rowbase + t) * DM + LRU_W + vbase; const float* ng = P.mng + vbase;
#pragma unroll
      for (int vb = 0; vb < 4; ++vb)
#pragma unroll
          for (int g = 0; g < 4; ++g) { const int vo = 32 * vb + 8 * g; const f32x4 n4 = *(const GAS f32x4*)(ng + vo); const v2u ob = *(const GAS v2u*)(op + vo);
              const float o0 = sigmoidf_(bflo(ob.x)), o1 = sigmoidf_(bfhi(ob.x)), o2 = sigmoidf_(bflo(ob.y)), o3 = sigmoidf_(bfhi(ob.y));
              v2u w; w.x = cvtpk_s(acc[vb][4 * g] * rstd * n4.x * o0, acc[vb][4 * g + 1] * rstd * n4.y * o1); w.y = cvtpk_s(acc[vb][4 * g + 2] * rstd * n4.z * o2, acc[vb][4 * g + 3] * rstd * n4.w * o3);
              *(GAS v2u*)(mp + vo) = w; } }
    __syncthreads();
}
}

namespace rgl {
using sba::f32x16; using sba::img_off;
__device__ __forceinline__ float sig_fast(float x) { return __builtin_amdgcn_rcpf(1.f + __builtin_amdgcn_exp2f(-LOG2E * x)); }
__device__ __forceinline__ void swap_pair(float x, float& ev, float& od) { const unsigned u = __float_as_uint(x); auto rr = __builtin_amdgcn_permlane32_swap(u, u, false, false); ev = __uint_as_float(rr[0]); od = __uint_as_float(rr[1]); }

__device__ __forceinline__ void mx1_unit(const MixP& P, const bf16* WGT  , LAS unsigned char* lds, int tid, int b, int n, int c) {
    const int lane = tid & 63, wave = __builtin_amdgcn_readfirstlane(tid >> 6), r32 = lane & 31, hi = lane >> 5;
    LAS float* XC = (LAS float*)lds;
    LAS unsigned char* XB = lds + 65536;
    LAS float* s_agg = (LAS float*)(lds + SM_OFF);
    const size_t rowbase = (size_t)b * SEQ; const int t0 = c * CH;
    {
        const int e = tid & 127, tg = tid >> 7, chn = n * 128 + e;
        const float w0 = P.conv_w[chn], w1 = P.conv_w[LRU_W + chn], w2 = P.conv_w[2 * LRU_W + chn], w3 = P.conv_w[3 * LRU_W + chn], cb = P.conv_b[chn];
        const int ts = t0 + tg * 32; const float* xp = P.XA + (rowbase + ts) * LRU_W + chn;
        float x0 = (ts >= 3) ? xp[-3 * LRU_W] : 0.f, x1 = (ts >= 2) ? xp[-2 * LRU_W] : 0.f, x2 = (ts >= 1) ? xp[-1 * LRU_W] : 0.f;
        LAS unsigned char* xb = XB + 2 * (e & 7);
#pragma unroll 8
        for (int i = 0; i < 32; ++i) { const float x3 = xp[(size_t)i * LRU_W]; const float y = cb + w0 * x0 + w1 * x1 + w2 * x2 + w3 * x3; x0 = x1; x1 = x2; x2 = x3;
            const int tt = tg * 32 + i; XC[tt * 128 + e] = y; *(LAS bf16*)(xb + img_off(tt, e >> 3)) = f2bf(y); }
    }
    __syncthreads();
    const int tb = wave & 3, eh = wave >> 2;
    f32x16 ar[2], ai[2];
#pragma unroll
    for (int i = 0; i < 2; ++i)
#pragma unroll
        for (int r = 0; r < 16; ++r) { ar[i][r] = 0.f; ai[i][r] = 0.f; }
    { const int krt = ((r32 & 3) << 2) | ((r32 >> 2) & 3);
      const bf16* wr = WGT + ((size_t)(0 * NBLK + n) * 128 + 64 * eh + r32) * 128 + hi * 8; const bf16* wi = WGT + ((size_t)(1 * NBLK + n) * 128 + 64 * eh + r32) * 128 + hi * 8;
#pragma unroll
      for (int d = 0; d < 8; ++d) { const bf16x8 xf = *(const LAS bf16x8*)(XB + 256 * (32 * tb + r32) + 16 * ((2 * d + hi) ^ krt));
#pragma unroll
          for (int eb = 0; eb < 2; ++eb) { const bf16x8 fr = *(const GAS bf16x8*)(wr + (size_t)(32 * eb) * 128 + d * 16), fi = *(const GAS bf16x8*)(wi + (size_t)(32 * eb) * 128 + d * 16);
              ar[eb] = __builtin_amdgcn_mfma_f32_32x32x16_bf16(xf, fr, ar[eb], 0, 0, 0); ai[eb] = __builtin_amdgcn_mfma_f32_32x32x16_bf16(xf, fi, ai[eb], 0, 0, 0); } } }
    float BA[2], BH[2];
#pragma unroll
    for (int eb = 0; eb < 2; ++eb) {
        const int e = 64 * eh + 32 * eb + r32, chn = n * 128 + e;
        const float br = P.gate_b[chn], bi = P.gate_b[LRU_W + chn], ls8 = 8.f * LOG2E * logsigmoidf_(P.lam[chn]);
        float qa[4], qh[4];
#pragma unroll
        for (int m = 0; m < 4; ++m) { float A = 1.f, H = 0.f;
#pragma unroll
            for (int i = 0; i < 4; ++i) { const int r = 4 * m + i, tt = 32 * tb + 8 * m + 4 * hi + i;
                const float rg = sig_fast(ar[eb][r] + br), ig = sig_fast(ai[eb][r] + bi); const float a = __builtin_amdgcn_exp2f(rg * ls8); const float mult = __builtin_amdgcn_sqrtf(fmaxf(1.f - a * a, 0.f));
                const float u = mult * (ig * XC[tt * 128 + e]); H = a * H + u; A = A * a; ar[eb][r] = H; ai[eb][r] = A; }
            qa[m] = A; qh[m] = H; }
        float PA = 1.f, PH = 0.f;
#pragma unroll
        for (int m = 0; m < 4; ++m) { float ea, oa, eh_, oh; swap_pair(qa[m], ea, oa); swap_pair(qh[m], eh_, oh);
            const float pa_odd = ea * PA, ph_odd = ea * PH + eh_;
            const float ma = hi ? pa_odd : PA, mh = hi ? ph_odd : PH;
#pragma unroll
            for (int i = 0; i < 4; ++i) { const int r = 4 * m + i; ar[eb][r] += ai[eb][r] * mh; ai[eb][r] *= ma; }
            PA = oa * pa_odd; PH = oa * ph_odd + oh; }
        BA[eb] = PA; BH[eb] = PH;
        if (hi == 0) { s_agg[(tb * 128 + e) * 2] = PA; s_agg[(tb * 128 + e) * 2 + 1] = PH; }
    }
    __syncthreads();
#pragma unroll
    for (int eb = 0; eb < 2; ++eb) {
        const int e = 64 * eh + 32 * eb + r32, chn = n * 128 + e;
        float CA = 1.f, CHh = 0.f;
        for (int t2 = 0; t2 < tb; ++t2) { const float a = s_agg[(t2 * 128 + e) * 2], h = s_agg[(t2 * 128 + e) * 2 + 1]; CHh = a * CHh + h; CA = CA * a; }
#pragma unroll
        for (int r = 0; r < 16; ++r) { const int tt = 32 * tb + (r & 3) + 8 * (r >> 2) + 4 * hi; const size_t o = (rowbase + t0 + tt) * LRU_W + chn;
            P.HLOC[o] = ar[eb][r] + ai[eb][r] * CHh; P.PCUM[o] = ai[eb][r] * CA; }
        if (tb == 3 && hi == 0) { P.AGGP[(b * NCH + c) * LRU_W + chn] = BA[eb] * CA; P.AGGH[(b * NCH + c) * LRU_W + chn] = BA[eb] * CHh + BH[eb]; }
    }
    __syncthreads();
}

__device__ __forceinline__ void mx2_carry(const MixP& P, float* CARRY, int gtid, int NT) {
    const int g2 = NT - 1 - gtid;
    if (g2 < BATCH * LRU_W) { const int b = g2 >> 10, chn = g2 & 1023; float ap[NCH], ah[NCH];
#pragma unroll
        for (int c = 0; c < NCH; ++c) { const int o = (b * NCH + c) * LRU_W + chn; ap[c] = P.AGGP[o]; ah[c] = P.AGGH[o]; }
        float carry = 0.f;
#pragma unroll
        for (int c = 0; c < NCH; ++c) { CARRY[(b * NCH + c) * LRU_W + chn] = carry; carry = ap[c] * carry + ah[c]; } }
}
__device__ __forceinline__ void mx3_unit(const MixP& P, const float* CARRY, int tid, int b, int c, int tq) {
    typedef float f32x2v __attribute__((ext_vector_type(2)));
    const int chn = 2 * tid; const f32x2v cr = *(const GAS f32x2v*)(CARRY + (b * NCH + c) * LRU_W + chn);
    const size_t row0 = (size_t)b * SEQ + c * CH + tq * 32;
#pragma unroll 4
    for (int i = 0; i < 32; ++i) { const size_t row = row0 + i; const f32x2v h = *(const GAS f32x2v*)(P.HLOC + row * LRU_W + chn), p = *(const GAS f32x2v*)(P.PCUM + row * LRU_W + chn);
        const unsigned yy = *(const GAS unsigned*)(P.YA + row * LRU_W + chn);
        *(GAS unsigned*)(P.MIX + row * DM + chn) = pk2((h.x + p.x * cr.x) * gelu_tanh(bflo(yy)), (h.y + p.y * cr.y) * gelu_tanh(bfhi(yy))); }
}
}
#ifndef IDLE_TICKS
#define IDLE_TICKS 3500u
#endif
#ifndef REPMASK
#define REPMASK 0
#endif
#define PHASE_REP(bit) for (int rep_ = 0; rep_ <= ((REPMASK >> (bit)) & 1); ++rep_)
#ifndef MX1R_UNIT
#define MX1R_UNIT rgl::mx1_unit
#endif
#ifndef MX1M_UNIT
#define MX1M_UNIT mls::mx1_unit
#endif
#ifndef MX3M_UNIT
#define MX3M_UNIT mls::mx3_unit
#endif

__device__ __forceinline__ KArgs fresh_args() { KArgs p = (KArgs)__builtin_amdgcn_kernarg_segment_ptr(); asm volatile("" : "+s"(p)); return p; }
__device__ __forceinline__ void fill_mixp(MixP& P, KArgs ap, unsigned char* ws, int j) {
    P.XA = (const float*)(ws + WS_P0); P.YA = (const bf16*)(ws + WS_P0 + 32 * MiB); P.Qm = (const bf16*)(ws + WS_P0 + 48 * MiB); P.Km = (const bf16*)(ws + WS_P0 + 56 * MiB);
    P.Vm = (const bf16*)(ws + WS_P0 + 64 * MiB); P.Om = (const bf16*)(ws + WS_P0 + 80 * MiB); P.IG = (const float*)(ws + WS_IG); P.FG = (const float*)(ws + WS_IG + 128 * 1024); P.MIX = (bf16*)(ws + WS_MIX);
    P.conv_w = ap->in[11] + (size_t)j * 4 * LRU_W; P.conv_b = ap->in[12] + (size_t)j * LRU_W; P.gate_w = ap->in[13] + (size_t)j * 2 * NBLK * BW * BW; P.gate_b = ap->in[14] + (size_t)j * 2 * LRU_W;
    P.lam = ap->in[15] + (size_t)j * LRU_W; P.mgb = ap->in[16] + (size_t)j * 2 * MH; P.mng = ap->in[17] + (size_t)j * MLW;
    P.DC = (float*)(ws + WS_DC); P.CIN = (bf16*)(ws + WS_CIN); P.DN = (float*)(ws + WS_SMALL); P.NIN = (float*)(ws + WS_SMALL + 128 * 1024); P.MLOC = (float*)(ws + WS_SMALL + 256 * 1024);
    P.BLAST = (float*)(ws + WS_SMALL + 257 * 1024); P.MIN = (float*)(ws + WS_SMALL + 258 * 1024); P.HLOC = (float*)(ws + WS_HLOC); P.PCUM = (float*)(ws + WS_PCUM);
    P.AGGP = (float*)(ws + WS_AGG); P.AGGH = (float*)(ws + WS_AGG + 256 * 1024); P.HTMP = (float*)(ws + WS_HTMP);
}
__global__ void __launch_bounds__(NWAVES * 64, 2) fwd_kernel(Args args) {
    extern __shared__ __attribute__((aligned(16))) unsigned char lds_raw[];
    LAS unsigned char* lds = (LAS unsigned char*)lds_raw;
    const int tid0 = threadIdx.x; const int wave_s = __builtin_amdgcn_readfirstlane(tid0 >> 6);
    const int G = gridDim.x, bx = blockIdx.x; const int vcu = (G % 8 == 0) ? (bx % 8) * (G / 8) + bx / 8 : bx;
    const int NGW = G * NWAVES;
#define FRESH() const int tid = fresh_tid(wave_s), lane = tid & 63, wave = __builtin_amdgcn_readfirstlane(tid >> 6), gw = vcu * NWAVES + wave; (void)lane; (void)gw; const KArgs ap = fresh_args(); unsigned char* const ws = ap->ws; (void)ws
    volatile LAS unsigned* MISC = (volatile LAS unsigned*)(lds + MISC_OFF);
    if (tid0 < 64) MISC[tid0] = 0u;
    __syncthreads();
    XcdBarrier bar = xcd_barrier_post((unsigned*)(args.ws + WS_CTL) + CW_BAR, MISC + 8);
#define GRID_BAR() do { XcdBarrier b2_ = bar; asm volatile("" : "+s"(b2_.x)); asm volatile("" : "+s"(b2_.bar)); xcd_barrier(b2_); } while (0)

PHASE_REP(0) {     { FRESH(); p0_prologue(ap, lds, tid, lane, wave, vcu, G); }
    GRID_BAR(); }

    for (int layer = 0; layer < DEPTH; ++layer) {
        const int j = layer >> 1;
PHASE_REP(1) {
        { FRESH(); const int na_ = (G == 256) ? CONV_NA : 0, nb_ = (G == 256) ? CONV_NB : 0;
          if (layer == 1) conv_range(ap, lds, lane, wave, CONV_END0 + na_ + nb_, CONV_END1 - (CONV_END0 + na_ + nb_), gw, NGW);
          if (layer == 2) conv_range(ap, lds, lane, wave, CONV_END1 + nb_, CONV_END2 - (CONV_END1 + nb_), gw, NGW);
          if (layer == 3) conv_range(ap, lds, lane, wave, CONV_END2 + na_ + nb_, CONV_END3 - (CONV_END2 + na_ + nb_), gw, NGW);
          norm_phase((layer == 0) ? ap->in[0] : ap->out, ap->in[4] + (size_t)(layer * 2 + 0) * DM, (const float*)(ws + WS_MOD) + (size_t)(layer * 2 + 0) * 2 * 6144, (bf16*)(ws + WS_HN), lane, gw, NGW); }
        GRID_BAR(); }
        if ((layer & 1) == 0) {
PHASE_REP(2) {
            { FRESH(); pg8::Gemm g{(const bf16*)(ws + WS_HN), (const bf16*)(ws + WS_WABIN) + (size_t)j * AB_IN_PAD * 2048, M, AB_IN_PAD, DM}; pg8::StaticOrder S; S.init(M, AB_IN_PAD, G, bx);
              pg8::EpiInProj E{(float*)(ws + WS_P0), (bf16*)(ws + WS_P0 + 32 * MiB), (bf16*)(ws + WS_P0 + 48 * MiB), (bf16*)(ws + WS_P0 + 56 * MiB), (bf16*)(ws + WS_P0 + 64 * MiB), (bf16*)(ws + WS_P0 + 80 * MiB),
                               (float*)(ws + WS_IG), (float*)(ws + WS_IG + 128 * 1024), 0.08838834764831845f};
              pg8::gemm_phase<pg8::EpiInProj, pg8::StaticOrder, PG8_ALIGN, PG8_SP2>(lds, g, S, E, tid);
              if (G == 256 && bx >= 160) conv_range(ap, lds, lane, wave, (layer == 0 ? CONV_END0 : CONV_END2), CONV_NA, (bx - 160) * NWAVES + wave, 96 * NWAVES); }
            GRID_BAR(); }
PHASE_REP(3) {
            { FRESH(); MixP P; fill_mixp(P, ap, ws, j);
              for (int u = vcu; u < 768; u += G) {
                if (u < 256) MX1M_UNIT(P, lds, tid, u >> 7, (u >> 5) & 3, u & 31);
                else { const int r = u - 256; MX1R_UNIT(P, (const bf16*)(ws + WS_WGT) + (size_t)j * 16 * 16384, lds, tid, r >> 8, (r >> 5) & 7, r & 31); }
            } }
            GRID_BAR(); }
PHASE_REP(4) {
            { FRESH(); MixP P; fill_mixp(P, ap, ws, j); mx2_mlstm(P, lds, tid, vcu * 512 + tid, G * 512); rgl::mx2_carry(P, (float*)(ws + WS_CARRY), vcu * 512 + tid, G * 512); }
            GRID_BAR(); }
PHASE_REP(5) {
            { FRESH(); MixP P; fill_mixp(P, ap, ws, j);
              for (int u = vcu; u < 512; u += G) {
                if (u < 256) MX3M_UNIT(P, lds, tid, u >> 7, (u >> 5) & 3, u & 31);
                else { const int r = u - 256; rgl::mx3_unit(P, (const float*)(ws + WS_CARRY), tid, r >> 7, (r >> 2) & 31, r & 3); }
            } }
            GRID_BAR(); }
        } else {
PHASE_REP(6) {
            { FRESH(); pg8::Gemm g{(const bf16*)(ws + WS_HN), (const bf16*)(ws + WS_WQKV) + (size_t)j * 6144 * 2048, M, 6144, DM}; pg8::StaticOrder S; S.init(M, 6144, G, bx);
              pg8::EpiBf16Split E{(bf16*)(ws + WS_P0), DM, DM, (size_t)M * DM, 0.08838834764831845f * LOG2E};
              pg8::gemm_phase<pg8::EpiBf16Split, pg8::StaticOrder, PG8_ALIGN, PG8_SP2>(lds, g, S, E, tid); }
            GRID_BAR(); }
PHASE_REP(7) {             { FRESH(); sba::attn_phase((const bf16*)(ws + WS_P0), (const bf16*)(ws + WS_P0) + (size_t)M * DM, (const bf16*)(ws + WS_P0) + (size_t)2 * M * DM, (bf16*)(ws + WS_MIX), lds, tid, vcu, G); }
            GRID_BAR(); }
        }
        { FRESH(); const bf16* Bt = ((layer & 1) == 0) ? (const bf16*)(ws + WS_WABOUT) + (size_t)j * 2048 * 2048 : (const bf16*)(ws + WS_WSBO) + (size_t)j * 2048 * 2048;
          pg8::Gemm g{(const bf16*)(ws + WS_MIX), Bt, M, DM, DM}; pg8::StaticOrder S; S.init(M, DM, G, bx);
          pg8::EpiResid E{(layer == 0) ? ap->in[0] : ap->out, ap->out, (const float*)(ws + WS_MOD) + (size_t)(layer * 2 + 0) * 2 * 6144 + 4096};
          pg8::gemm_phase<pg8::EpiResid, pg8::StaticOrder, PG8_ALIGN, PG8_SP2>(lds, g, S, E, tid); }
        GRID_BAR();
PHASE_REP(1) {
        { FRESH(); norm_phase(ap->out, ap->in[4] + (size_t)(layer * 2 + 1) * DM, (const float*)(ws + WS_MOD) + (size_t)(layer * 2 + 1) * 2 * 6144, (bf16*)(ws + WS_HN), lane, gw, NGW); }
        GRID_BAR(); }
PHASE_REP(8) {
        { FRESH(); pg8::Gemm g{(const bf16*)(ws + WS_HN), (const bf16*)(ws + WS_W13) + (size_t)layer * 2 * FF * 2048, M, 2 * FF, DM}; pg8::StaticOrder S; S.init(M, 2 * FF, G, bx);
          pg8::EpiSwiGLU E{(bf16*)(ws + WS_ACT)};
          pg8::gemm_phase<pg8::EpiSwiGLU, pg8::StaticOrder, PG8_ALIGN, PG8_SP2>(lds, g, S, E, tid);
          if (G == 256 && bx >= 128 && layer < 3) conv_range(ap, lds, lane, wave, (layer == 0 ? CONV_END0 + CONV_NA : (layer == 1 ? CONV_END1 : CONV_END2 + CONV_NA)), CONV_NB, (bx - 128) * NWAVES + wave, 128 * NWAVES); }
        GRID_BAR(); }
        { FRESH(); pg8::Gemm g{(const bf16*)(ws + WS_ACT), (const bf16*)(ws + WS_W2) + (size_t)layer * 2048 * FF, M, DM, FF}; pg8::StaticOrder S; S.init(M, DM, G, bx);
          pg8::EpiResid E{ap->out, ap->out, (const float*)(ws + WS_MOD) + (size_t)(layer * 2 + 1) * 2 * 6144 + 4096};
          pg8::gemm_phase<pg8::EpiResid, pg8::StaticOrder, PG8_ALIGN, PG8_SP2>(lds, g, S, E, tid); }
        GRID_BAR();
    }
    { FRESH(); final_norm_phase(ap->out, ap->in[5], ap->out, lane, gw, NGW); }
}

extern "C" void kernel_launch(void* const* d_in, const int* in_sizes, int n_in, void* d_out, int out_size, void* d_ws, size_t ws_size, hipStream_t stream) {
    static int grid = 0;
    if (grid == 0) {
        if (n_in != 20 || in_sizes[0] != M * DM || out_size != M * DM || ws_size < WS_END) { fprintf(stderr, "kernel_launch: unexpected shapes: n_in %d in0 %d out %d ws %zu (need %zu); nothing launched\n", n_in, n_in > 0 ? in_sizes[0] : -1, out_size, ws_size, (size_t)WS_END); grid = -1; return; }
        int dev = 0, cus = 0, per_cu = 0;
        if (hipGetDevice(&dev) != hipSuccess || hipDeviceGetAttribute(&cus, hipDeviceAttributeMultiprocessorCount, dev) != hipSuccess) { fprintf(stderr, "kernel_launch: device query failed\n"); grid = -1; return; }
        if (hipFuncSetAttribute((const void*)fwd_kernel, hipFuncAttributeMaxDynamicSharedMemorySize, LDS_BYTES) != hipSuccess) { fprintf(stderr, "kernel_launch: hipFuncSetAttribute failed\n"); grid = -1; return; }
        if (hipOccupancyMaxActiveBlocksPerMultiprocessor(&per_cu, (const void*)fwd_kernel, NWAVES * 64, LDS_BYTES) != hipSuccess || per_cu < 1)
            fprintf(stderr, "kernel_launch: note: occupancy query reports %d workgroups per CU\n", per_cu);
        (void)hipGetLastError();
        grid = cus;
    }
    if (grid < 0) return;
    if (hipMemsetAsync((char*)d_ws + WS_CTL, 0, CTL_ZERO_BYTES, stream) != hipSuccess) { fprintf(stderr, "kernel_launch: memset failed\n"); return; }
    Args a{};
    for (int i = 0; i < 20; ++i) a.in[i] = (const float*)d_in[i];
    a.out = (float*)d_out; a.ws = (unsigned char*)d_ws;
    hipLaunchKernelGGL(fwd_kernel, dim3(grid), dim3(NWAVES * 64), LDS_BYTES, stream, a);
    const hipError_t le = hipPeekAtLastError();
    if (le != hipSuccess) fprintf(stderr, "kernel_launch: launch failed: %s\n", hipGetErrorName(le));
}
```

```cpp
#define REPMASK 0
#include <hip/hip_runtime.h>
#include <cstdio>
#include <cstdint>

#ifndef CONV_KA_V
#define CONV_KA_V 2
#define CONV_KB_V 2
#endif
constexpr int NWAVES = 8;
constexpr int BATCH = 2, SEQ = 4096, DM = 2048, DEPTH = 4, M = BATCH * SEQ;
constexpr int LRU_W = 1024, NBLK = 8, BW = 128;
constexpr int MLW = 1024, MH = 4, DV = 256, DK = 128, MQK = 512, CH = 128, NCH = SEQ / CH;
constexpr int AB_IN = 5128, AB_IN_PAD = 5376;
constexpr int SBH = 16, SBD = 128;
constexpr int FF = 5632;
constexpr float EPS = 1e-6f;
constexpr float LOG2E = 1.4426950408889634f, LN2 = 0.6931471805599453f;

constexpr size_t MiB = 1u << 20;
constexpr size_t WS_CTL = 0, CTL_ZERO_BYTES = 1 * MiB;
constexpr size_t WS_MOD = 1 * MiB;
constexpr size_t WS_WABIN = 2 * MiB;
constexpr size_t WS_WABOUT = 44 * MiB;
constexpr size_t WS_WQKV = 60 * MiB;
constexpr size_t WS_WSBO = 108 * MiB;
constexpr size_t WS_W13 = 124 * MiB;
constexpr size_t WS_W2 = 300 * MiB;
constexpr size_t WS_HN = 388 * MiB;
constexpr size_t WS_P0 = 420 * MiB;
constexpr size_t WS_IG = 516 * MiB;
constexpr size_t WS_MIX = 517 * MiB;
constexpr size_t WS_ACT = 549 * MiB;
constexpr size_t WS_DC = 637 * MiB;
constexpr size_t WS_CIN = 669 * MiB;
constexpr size_t WS_SMALL = 685 * MiB;
constexpr size_t WS_HLOC = 686 * MiB;
constexpr size_t WS_PCUM = 718 * MiB;
constexpr size_t WS_AGG = 750 * MiB;
constexpr size_t WS_HTMP = 752 * MiB;
constexpr size_t WS_WGT = 784 * MiB;
constexpr size_t WS_CARRY = 785 * MiB;
constexpr size_t WS_END = 786 * MiB;
constexpr int CW_BAR = 4096;

constexpr int BIG_BYTES = 147456;
constexpr int MISC_OFF = BIG_BYTES;
constexpr int SM_OFF = BIG_BYTES + 1024;
constexpr int LDS_BYTES = 163840;

namespace pg8 {
#define PG8_LAS __attribute__((address_space(3)))
typedef unsigned short bf16_t;
typedef short bf16x8 __attribute__((ext_vector_type(8)));
typedef float f32x4 __attribute__((ext_vector_type(4)));
typedef unsigned u32x4 __attribute__((ext_vector_type(4)));
constexpr int BM = 256, BK = 64, HALF = 128, HTB = HALF * BK * 2  , STAGE_BYTES = 8 * HTB, NXCD = 8, WGM = 8;

__host__ __device__ __forceinline__ int lds_byte(int r, int c) { const int st = (r >> 4) * 2 + (c >> 5), rr = r & 15, cc = c & 31, ob = rr * 64 + cc * 2; return st * 1024 + (ob ^ (((ob >> 9) & 1) << 5)); }
__host__ __device__ __forceinline__ void stage_rc(int b, int& R, int& C) { const int st = b / 1024, sb = b % 1024, swz = sb ^ (((sb >> 9) & 1) << 5); R = (st >> 1) * 16 + swz / 64; C = (st & 1) * 32 + (swz % 64) / 2; }
__host__ __device__ __forceinline__ int perm32(int rho) { const int n = rho >> 4, i = rho & 15; return 8 * (i >> 2) + 4 * n + (i & 3); }

struct Unit { int pm, pn; };
struct Gemm { const bf16_t* A; const bf16_t* Bt; int M, N, K; };

struct StaticOrder {
    int nM, nN, nwg, G, c;
    __host__ __device__ void init(int M, int N, int G_, int c_) { nM = M / BM; nN = N / BM; nwg = nM * nN; G = G_; c = c_; }
    __host__ __device__ bool next(int i, Unit& u) const {
        const long L = (long)i * G + c; if (L >= nwg) return false;
        int wgid = (int)L; { const int q = nwg / NXCD, r = nwg % NXCD, xcd = wgid % NXCD, off = wgid / NXCD; wgid = (xcd < r ? xcd * (q + 1) : r * (q + 1) + (xcd - r) * q) + off; }
        const int nig = WGM * nN, gid = wgid / nig, fm = gid * WGM, gsz = (nM - fm) < WGM ? (nM - fm) : WGM;
        u.pm = fm + ((wgid % nig) % gsz); u.pn = (wgid % nig) / gsz; return true;
    }
    __device__ __forceinline__ void a_ready(const Unit&) const {}
    __device__ __forceinline__ void done(const Unit&) const {}
};

__device__ __forceinline__ unsigned cvt_pk_bf16(float lo, float hi) { unsigned r; asm volatile("v_cvt_pk_bf16_f32 %0, %1, %2" : "=v"(r) : "v"(lo), "v"(hi)); return r; }
typedef float f32x2 __attribute__((ext_vector_type(2)));
__device__ __forceinline__ u32x4 pack8(f32x4 v0, f32x4 v1) { u32x4 w; w.x = cvt_pk_bf16(v0[0], v0[1]); w.y = cvt_pk_bf16(v0[2], v0[3]); w.z = cvt_pk_bf16(v1[0], v1[1]); w.w = cvt_pk_bf16(v1[2], v1[3]); return w; }

struct EpiBf16Split {
    static constexpr bool PERM = true, AFTER_DRAIN = false;
    bf16_t* O; int ldc; int split_cols; size_t split_stride; float scale0;
    __device__ __forceinline__ void operator()(const f32x4 (&acc)[2][2][4][2], const Unit& u, int wr, int wc, int fr, int fq) const {
        const int row0 = u.pm * BM + wr * 64 + fr; int colt = u.pn * BM; bf16_t* base = O;
        float sc = 1.f; { const int t = colt / split_cols; base += (size_t)t * split_stride; colt -= t * split_cols; if (t == 0) sc = scale0; }
        const int col0 = colt + wc * 32 + 8 * fq;
#pragma unroll
        for (int ai = 0; ai < 2; ++ai)
#pragma unroll
            for (int m = 0; m < 4; ++m) { bf16_t* rowp = base + (size_t)(row0 + ai * HALF + m * 16) * ldc + col0;
#pragma unroll
                for (int bj = 0; bj < 2; ++bj) { *(u32x4*)(rowp + bj * HALF) = pack8(acc[ai][bj][m][0] * sc, acc[ai][bj][m][1] * sc); } }
    }
};

struct EpiResid {
    static constexpr bool PERM = true, AFTER_DRAIN = false;
    const float* base; float* out; const float* gate0;
    __device__ __forceinline__ void operator()(const f32x4 (&acc)[2][2][4][2], const Unit& u, int wr, int wc, int fr, int fq) const {
        const int row0 = u.pm * BM + wr * 64 + fr, col0 = u.pn * BM + wc * 32 + 8 * fq;
        const float* gp = gate0 + (u.pm >= 16 ? 6144 : 0) + col0;
        f32x4 gv[2][2];
#pragma unroll
        for (int bj = 0; bj < 2; ++bj)
#pragma unroll
            for (int n = 0; n < 2; ++n) gv[bj][n] = *(const f32x4*)(gp + bj * HALF + 4 * n);
#pragma unroll
        for (int ai = 0; ai < 2; ++ai)
#pragma unroll
            for (int m = 0; m < 4; ++m) { const size_t off = (size_t)(row0 + ai * HALF + m * 16) * 2048 + col0;
#pragma unroll
                for (int bj = 0; bj < 2; ++bj)
#pragma unroll
                    for (int n = 0; n < 2; ++n) { const f32x4 b = *(const f32x4*)(base + off + bj * HALF + 4 * n); *(f32x4*)(out + off + bj * HALF + 4 * n) = b + gv[bj][n] * acc[ai][bj][m][n]; }
                if (m & 1) asm volatile("" ::: "memory"); }
    }
};

struct EpiSwiGLU {
    static constexpr bool PERM = true, AFTER_DRAIN = false;
    bf16_t* O;
    static __device__ __forceinline__ f32x4 silu_mul(f32x4 a, f32x4 b) { f32x4 r;
#pragma unroll
        for (int i = 0; i < 4; ++i) { const float e = __builtin_amdgcn_exp2f(-a[i] * 1.4426950408889634f); r[i] = a[i] * __builtin_amdgcn_rcpf(1.f + e) * b[i]; }
        return r; }
    __device__ __forceinline__ void operator()(const f32x4 (&acc)[2][2][4][2], const Unit& u, int wr, int wc, int fr, int fq) const {
        const int row0 = u.pm * BM + wr * 64 + fr, col0 = u.pn * HALF + wc * 32 + 8 * fq;
#pragma unroll
        for (int ai = 0; ai < 2; ++ai)
#pragma unroll
            for (int m = 0; m < 4; ++m) { bf16_t* rowp = O + (size_t)(row0 + ai * HALF + m * 16) * 5632 + col0;
                *(u32x4*)rowp = pack8(silu_mul(acc[ai][0][m][0], acc[ai][1][m][0]), silu_mul(acc[ai][0][m][1], acc[ai][1][m][1])); }
    }
};

struct EpiInProj {
    static constexpr bool PERM = true, AFTER_DRAIN = false;
    float* XA; bf16_t *YA, *Qm, *Km, *Vm, *Om; float *IG, *FG; float kscale;
    __device__ __forceinline__ void operator()(const f32x4 (&acc)[2][2][4][2], const Unit& u, int wr, int wc, int fr, int fq) const {
        const int pn = u.pn, row0 = u.pm * BM + wr * 64 + fr, cl = wc * 32 + 8 * fq;
        if (pn < 4) {
#pragma unroll
            for (int ai = 0; ai < 2; ++ai)
#pragma unroll
                for (int m = 0; m < 4; ++m) { float* rp = XA + (size_t)(row0 + ai * HALF + m * 16) * 1024 + pn * 256 + cl;
#pragma unroll
                    for (int bj = 0; bj < 2; ++bj)
#pragma unroll
                        for (int n = 0; n < 2; ++n) *(f32x4*)(rp + bj * HALF + 4 * n) = acc[ai][bj][m][n]; }
        } else if (pn < 20) {
            bf16_t* base; int ld, colt; float sc = 1.f;
            if (pn < 8) { base = YA; ld = 1024; colt = (pn - 4) * 256; }
            else if (pn < 10) { base = Qm; ld = 512; colt = (pn - 8) * 256; }
            else if (pn < 12) { base = Km; ld = 512; colt = (pn - 10) * 256; sc = kscale; }
            else if (pn < 16) { base = Vm; ld = 1024; colt = (pn - 12) * 256; }
            else { base = Om; ld = 1024; colt = (pn - 16) * 256; }
#pragma unroll
            for (int ai = 0; ai < 2; ++ai)
#pragma unroll
                for (int m = 0; m < 4; ++m) { bf16_t* rowp = base + (size_t)(row0 + ai * HALF + m * 16) * ld + colt + cl;
#pragma unroll
                    for (int bj = 0; bj < 2; ++bj) *(u32x4*)(rowp + bj * HALF) = pack8(acc[ai][bj][m][0] * sc, acc[ai][bj][m][1] * sc); }
        } else {
            if (wc == 0 && fq == 0) {
#pragma unroll
                for (int ai = 0; ai < 2; ++ai)
#pragma unroll
                    for (int m = 0; m < 4; ++m) { const size_t r = (size_t)(row0 + ai * HALF + m * 16); *(f32x4*)(IG + r * 4) = acc[ai][0][m][0]; *(f32x4*)(FG + r * 4) = acc[ai][0][m][1]; }
            }
        }
    }
};

template <class Epi, class Sched, bool ALIGN_EPI = false, bool SP2 = false>
__device__ __forceinline__ void gemm_phase(PG8_LAS unsigned char* lds, const Gemm g, const Sched& S, const Epi& E, int tid_in) {
    const int tid = tid_in, wid = __builtin_amdgcn_readfirstlane(tid >> 6), lane = tid & 63, wr = wid >> 2, wc = wid & 3, fr = lane & 15, fq = lane >> 4;
    const int K = g.K, nt = K / BK;
    unsigned voffA[2], voffB[2];
#pragma unroll
    for (int i = 0; i < 2; ++i) { int R, C; stage_rc(tid * 16 + i * 8192, R, C); const int Rb = Epi::PERM ? ((R & ~31) + perm32(R & 31)) : R;
        voffA[i] = (unsigned)(R * K + C) * 2u; voffB[i] = (unsigned)(Rb * K + C) * 2u; }
    const size_t kstep = (size_t)(BK * 2);
    const size_t hstep = (size_t)HALF * K * 2;
    const size_t tstep = 2 * hstep;
    const unsigned ldsw = (unsigned)wid * 1024u;
    const int aoff = lds_byte(wr * 64 + fr, fq * 8), boff = lds_byte(wc * 32 + fr, fq * 8);
#define PG8_SA(b, h) (((b) * 2 + (h)) * HTB)
#define PG8_SB(b, h) ((4 + (b) * 2 + (h)) * HTB)
#define PG8_STAGE(bufoff, gbase, voff) do { _Pragma("unroll") for (int _i = 0; _i < 2; ++_i) \
        __builtin_amdgcn_global_load_lds((const unsigned*)((const char*)(gbase) + (voff)[_i]), (PG8_LAS unsigned*)(lds + (bufoff) + ldsw + _i * 8192), 16, 0, 0); } while (0)
#define PG8_LDA(dst, b, h) do { _Pragma("unroll") for (int m = 0; m < 4; ++m) _Pragma("unroll") for (int k = 0; k < 2; ++k) dst[m][k] = *(const PG8_LAS bf16x8*)(lds + PG8_SA(b, h) + aoff + m * 2048 + k * 1024); } while (0)
#define PG8_LDB(dst, b, h) do { _Pragma("unroll") for (int n = 0; n < 2; ++n) _Pragma("unroll") for (int k = 0; k < 2; ++k) dst[n][k] = *(const PG8_LAS bf16x8*)(lds + PG8_SB(b, h) + boff + n * 2048 + k * 1024); } while (0)
#define PG8_MMA(ai, bj, At, Bt) do { __builtin_amdgcn_s_setprio(1); _Pragma("unroll") for (int m = 0; m < 4; ++m) _Pragma("unroll") for (int n = 0; n < 2; ++n) _Pragma("unroll") for (int k = 0; k < 2; ++k) \
        acc[ai][bj][m][n] = __builtin_amdgcn_mfma_f32_16x16x32_bf16(Bt[n][k], At[m][k], acc[ai][bj][m][n], 0, 0, 0); __builtin_amdgcn_s_setprio(0); } while (0)
#define PG8_WAIT_V(n) asm volatile("s_waitcnt vmcnt(" #n ")" ::: "memory")
#define PG8_WAIT_L(n) asm volatile("s_waitcnt lgkmcnt(" #n ")" ::: "memory")
#define PG8_BAR __builtin_amdgcn_s_barrier()
#define PG8_SCHED __builtin_amdgcn_sched_barrier(0)
    Unit cur, nxt; int ui = 0;
    if (!S.next(0, cur)) return;
    f32x4 acc[2][2][4][2];
#pragma unroll
    for (int a = 0; a < 2; ++a)
#pragma unroll
        for (int b = 0; b < 2; ++b)
#pragma unroll
            for (int m = 0; m < 4; ++m)
#pragma unroll
                for (int n = 0; n < 2; ++n) acc[a][b][m][n] = (f32x4){0.f, 0.f, 0.f, 0.f};
    bf16x8 At[4][2], B0[2][2], B1[2][2];
    const char* cA = (const char*)g.A + (size_t)cur.pm * tstep; const char* cB = (const char*)g.Bt + (size_t)cur.pn * tstep;
    S.a_ready(cur);
    if constexpr (SP2) {
        PG8_STAGE(PG8_SB(0, 0), cB, voffB); PG8_STAGE(PG8_SB(0, 1), cB + hstep, voffB); PG8_STAGE(PG8_SA(0, 0), cA, voffA); PG8_STAGE(PG8_SA(0, 1), cA + hstep, voffA);
        if (wr == 1) PG8_BAR;
        PG8_WAIT_V(2); PG8_BAR;
        PG8_STAGE(PG8_SB(1, 0), cB + kstep, voffB); PG8_STAGE(PG8_SA(1, 0), cA + kstep, voffA); PG8_STAGE(PG8_SB(1, 1), cB + hstep + kstep, voffB);
        PG8_WAIT_V(6); PG8_BAR;
    } else {
        PG8_STAGE(PG8_SB(0, 0), cB, voffB); PG8_STAGE(PG8_SA(0, 0), cA, voffA); PG8_STAGE(PG8_SB(0, 1), cB + hstep, voffB); PG8_STAGE(PG8_SA(0, 1), cA + hstep, voffA);
        if (wr == 1) PG8_BAR;
        PG8_WAIT_V(4); PG8_BAR;
        PG8_STAGE(PG8_SB(1, 0), cB + kstep, voffB); PG8_STAGE(PG8_SA(1, 0), cA + kstep, voffA); PG8_STAGE(PG8_SB(1, 1), cB + hstep + kstep, voffB);
        PG8_WAIT_V(6); PG8_BAR;
    }
    for (;;) {
        const bool has_next = S.next(ui + 1, nxt);
        const char* nA = has_next ? (const char*)g.A + (size_t)nxt.pm * tstep : cA; const char* nB = has_next ? (const char*)g.Bt + (size_t)nxt.pn * tstep : cB;
        for (int t = 0; t < nt; t += 2) {
            const bool last = (t == nt - 2);
            const char* a1 = cA + (size_t)(t + 1) * kstep;
            const char* a2 = last ? nA : cA + (size_t)(t + 2) * kstep; const char* b2 = last ? nB : cB + (size_t)(t + 2) * kstep;
            const char* a3 = a2 + kstep; const char* b3 = b2 + kstep;
            if (last && has_next) S.a_ready(nxt);
            if constexpr (SP2) {
            PG8_LDB(B0, 0, 0); PG8_LDB(B1, 0, 1); PG8_SCHED; PG8_LDA(At, 0, 0); PG8_STAGE(PG8_SA(1, 1), a1 + hstep, voffA);
            PG8_WAIT_V(8); PG8_WAIT_L(0); PG8_BAR; PG8_MMA(0, 0, At, B0); PG8_MMA(0, 1, At, B1); PG8_BAR; PG8_SCHED;
            PG8_LDA(At, 0, 1); PG8_STAGE(PG8_SB(0, 0), b2, voffB); PG8_STAGE(PG8_SB(0, 1), b2 + hstep, voffB); PG8_STAGE(PG8_SA(0, 0), a2, voffA);
            PG8_WAIT_V(8); PG8_WAIT_L(0); PG8_BAR; PG8_MMA(1, 0, At, B0); PG8_MMA(1, 1, At, B1); PG8_BAR; PG8_SCHED;
            PG8_LDB(B0, 1, 0); PG8_LDB(B1, 1, 1); PG8_SCHED; PG8_LDA(At, 1, 0); PG8_STAGE(PG8_SA(0, 1), a2 + hstep, voffA);
            PG8_WAIT_V(8); PG8_WAIT_L(0); PG8_BAR; PG8_MMA(0, 0, At, B0); PG8_MMA(0, 1, At, B1); PG8_BAR; PG8_SCHED;
            PG8_LDA(At, 1, 1); PG8_STAGE(PG8_SB(1, 0), b3, voffB); PG8_STAGE(PG8_SB(1, 1), b3 + hstep, voffB); PG8_STAGE(PG8_SA(1, 0), a3, voffA);
            PG8_WAIT_V(8); PG8_WAIT_L(0); PG8_BAR; PG8_MMA(1, 0, At, B0); PG8_MMA(1, 1, At, B1); PG8_BAR; PG8_SCHED;
            } else {
            PG8_LDB(B0, 0, 0); PG8_SCHED; PG8_LDA(At, 0, 0); PG8_STAGE(PG8_SA(1, 1), a1 + hstep, voffA);
            PG8_WAIT_L(8); PG8_BAR; PG8_WAIT_L(0); PG8_MMA(0, 0, At, B0); PG8_BAR; PG8_SCHED;
            PG8_LDB(B1, 0, 1); PG8_STAGE(PG8_SB(0, 0), b2, voffB);
            PG8_BAR; PG8_WAIT_L(0); PG8_MMA(0, 1, At, B1); PG8_BAR;
            PG8_LDA(At, 0, 1); PG8_STAGE(PG8_SA(0, 0), a2, voffA);
            PG8_BAR; PG8_WAIT_L(0); PG8_MMA(1, 0, At, B0); PG8_BAR; PG8_SCHED;
            PG8_STAGE(PG8_SB(0, 1), b2 + hstep, voffB);
            PG8_WAIT_V(6); PG8_BAR; PG8_MMA(1, 1, At, B1); PG8_BAR;
            PG8_LDB(B0, 1, 0); PG8_SCHED; PG8_LDA(At, 1, 0); PG8_STAGE(PG8_SA(0, 1), a2 + hstep, voffA);
            PG8_WAIT_L(8); PG8_BAR; PG8_WAIT_L(0); PG8_MMA(0, 0, At, B0); PG8_BAR; PG8_SCHED;
            PG8_LDB(B1, 1, 1); PG8_STAGE(PG8_SB(1, 0), b3, voffB);
            PG8_BAR; PG8_WAIT_L(0); PG8_MMA(0, 1, At, B1); PG8_BAR;
            PG8_LDA(At, 1, 1); PG8_STAGE(PG8_SA(1, 0), a3, voffA);
            PG8_BAR; PG8_WAIT_L(0); PG8_MMA(1, 0, At, B0); PG8_BAR; PG8_SCHED;
            PG8_STAGE(PG8_SB(1, 1), b3 + hstep, voffB);
            PG8_WAIT_V(6); PG8_BAR; PG8_MMA(1, 1, At, B1); PG8_BAR;
            }
        }
        if constexpr (ALIGN_EPI) { if (wr == 0) PG8_BAR; }
        if constexpr (!Epi::AFTER_DRAIN) { E(acc, cur, wr, wc, fr, fq); S.done(cur); }
        if (!has_next) break;
#pragma unroll
        for (int a = 0; a < 2; ++a)
#pragma unroll
            for (int b = 0; b < 2; ++b)
#pragma unroll
                for (int m = 0; m < 4; ++m)
#pragma unroll
                    for (int n = 0; n < 2; ++n) acc[a][b][m][n] = (f32x4){0.f, 0.f, 0.f, 0.f};
        cur = nxt; cA = nA; cB = nB; ++ui;
        if constexpr (ALIGN_EPI) { if (wr == 1) PG8_BAR; }
    }
    PG8_WAIT_V(0);
    if constexpr (!ALIGN_EPI) { if (wr == 0) PG8_BAR; }
    PG8_BAR;
    if constexpr (Epi::AFTER_DRAIN) { E.fused(acc, cur, wr, wc, fr, fq, lds, wid, lane); S.done(cur); }
#undef PG8_SA
#undef PG8_SB
#undef PG8_STAGE
#undef PG8_LDA
#undef PG8_LDB
#undef PG8_MMA
#undef PG8_WAIT_V
#undef PG8_WAIT_L
#undef PG8_BAR
#undef PG8_SCHED
}
}
#ifndef PG8_SP2
#define PG8_SP2 true
#endif
#ifndef PG8_ALIGN
#define PG8_ALIGN true
#endif

#define GAS __attribute__((address_space(1)))
#define LAS __attribute__((address_space(3)))
typedef unsigned short bf16;
typedef unsigned v4u __attribute__((ext_vector_type(4)));
typedef unsigned v2u __attribute__((ext_vector_type(2)));
typedef float f32x4 __attribute__((ext_vector_type(4)));
typedef short bf16x8 __attribute__((ext_vector_type(8)));
typedef GAS unsigned gu32;
#define RLX_AGENT __ATOMIC_RELAXED, __HIP_MEMORY_SCOPE_AGENT
#define LDS_WAIT() asm volatile("s_waitcnt lgkmcnt(0)" ::: "memory")
#define VM_WAIT() asm volatile("s_waitcnt vmcnt(0)" ::: "memory")
__device__ __forceinline__ unsigned pk2(float lo, float hi) { return pg8::cvt_pk_bf16(lo, hi); }
__device__ __forceinline__ bf16 f2bf(float x) { return (bf16)(pg8::cvt_pk_bf16(x, 0.f) & 0xffffu); }
__device__ __forceinline__ float bf2f(bf16 b) { return __uint_as_float((unsigned)b << 16); }
__device__ __forceinline__ float bflo(unsigned p) { return __uint_as_float(p << 16); }
__device__ __forceinline__ float bfhi(unsigned p) { return __uint_as_float(p & 0xffff0000u); }
__device__ __forceinline__ float sigmoidf_(float x) { return 1.f / (1.f + __expf(-x)); }
__device__ __forceinline__ float logsigmoidf_(float x) { return fminf(x, 0.f) - log1pf(__expf(-fabsf(x))); }
__device__ __forceinline__ float gelu_tanh(float y) { const float x = 0.7978845608028654f * (y + 0.044715f * y * y * y); const float t = __builtin_amdgcn_exp2f(2.f * LOG2E * x); return 0.5f * y * (2.f - 2.f * __builtin_amdgcn_rcpf(t + 1.f)); }
template <int X> __device__ __forceinline__ float swz_xor(float v) { return __int_as_float(__builtin_amdgcn_ds_swizzle(__float_as_int(v), (X << 10) | 0x1f)); }
__device__ __forceinline__ float xor32(float v) { const unsigned u = __float_as_uint(v); auto rr = __builtin_amdgcn_permlane32_swap(u, u, false, false); const unsigned a = rr[0], b = rr[1]; return __uint_as_float(a ^ b ^ u); }
__device__ __forceinline__ float wave_sum(float v) { v += swz_xor<1>(v); v += swz_xor<2>(v); v += swz_xor<4>(v); v += swz_xor<8>(v); v += swz_xor<16>(v); v += xor32(v); return v; }
__device__ __forceinline__ float wave_max(float v) { v = fmaxf(v, swz_xor<1>(v)); v = fmaxf(v, swz_xor<2>(v)); v = fmaxf(v, swz_xor<4>(v)); v = fmaxf(v, swz_xor<8>(v)); v = fmaxf(v, swz_xor<16>(v)); v = fmaxf(v, xor32(v)); return v; }
__device__ __forceinline__ float lane_up(float x, int off, int lane) { const int src = (lane >= off) ? lane - off : lane; return __int_as_float(__builtin_amdgcn_ds_bpermute(src << 2, __float_as_int(x))); }
__device__ __forceinline__ int fresh_tid(int wave_s) { int l; asm volatile("v_mbcnt_lo_u32_b32 %0, -1, 0\n\tv_mbcnt_hi_u32_b32 %0, -1, %0" : "=v"(l)); int w = wave_s; asm volatile("" : "+s"(w)); int t = w * 64 + l; asm volatile("" : "+v"(t)); return t; }
#define XB_TMO      128
#define XB_XCNT(j)  (256  + 64 * (j))
#define XB_XSUB(j)  (1280 + 64 * (j))
#define XB_XGEN(j)  (2304 + 64 * (j))
#define XB_TOP      3328
#define XB_TOPGEN   3392
#define XCD_BAR_WORDS 3456
#define XB_SPIN_CAP (1u << 18)

__device__ __forceinline__ unsigned xb_ld(unsigned* p)              { return __hip_atomic_load(p, __ATOMIC_RELAXED, __HIP_MEMORY_SCOPE_AGENT); }
__device__ __forceinline__ unsigned xb_add(unsigned* p, unsigned v) { return __hip_atomic_fetch_add(p, v, __ATOMIC_RELAXED, __HIP_MEMORY_SCOPE_AGENT); }
__device__ __forceinline__ unsigned xb_xcc_id() { return (unsigned)__builtin_amdgcn_s_getreg((3 << 11) | 20) & 0xFu; }
#define XB_SPIN(cond, bar) do { unsigned _sp = 0; while (cond) { __builtin_amdgcn_s_sleep(1); \
    if ((++_sp & 255u) == 0u) { if (xb_ld(&(bar)[XB_TMO])) break; if (_sp > XB_SPIN_CAP) { atomicAdd(&(bar)[XB_TMO], 1u); break; } } } } while (0)

struct XcdBarrier {
    unsigned* bar; unsigned x;
    volatile LAS unsigned* st;
};

__device__ __forceinline__ XcdBarrier xcd_barrier_post(unsigned* bar, volatile LAS unsigned* st) {
    XcdBarrier b; b.bar = bar; b.x = xb_xcc_id(); b.st = st;
    if (threadIdx.x == 0) (void)xb_add(&bar[XB_XCNT(b.x)], 1u);
    return b;
}
__device__ __forceinline__ void xcd_barrier_complete(unsigned* bar, unsigned x, unsigned& nloc, unsigned& nx) {
    const unsigned G = gridDim.x * gridDim.y * gridDim.z;
    unsigned sum, cnt, mine, sp = 0u;
    for (;;) {
        sum = 0u; cnt = 0u; mine = 0u;
#pragma unroll
        for (unsigned j = 0; j < 16; ++j) { const unsigned c = xb_ld(&bar[XB_XCNT(j)]); sum += c; cnt += (c > 0u) ? 1u : 0u; mine = (j == x) ? c : mine; }
        if (sum == G) break;
        __builtin_amdgcn_s_sleep(1);
        if ((++sp & 255u) == 0u) { if (xb_ld(&bar[XB_TMO])) break; if (sp > XB_SPIN_CAP) { atomicAdd(&bar[XB_TMO], 1u); break; } }
    }
    nloc = mine > 0u ? mine : 1u; nx = cnt > 0u ? cnt : 1u;
}

__device__ __forceinline__ void xcd_barrier(const XcdBarrier& b) {
    asm volatile("s_waitcnt vmcnt(0)" ::: "memory");
    __syncthreads();
    if (threadIdx.x == 0) {
        unsigned* bar = b.bar;
        __builtin_amdgcn_s_waitcnt(0);
        unsigned nloc = b.st[0], nx = b.st[1];
        if (nloc == 0u) { xcd_barrier_complete(bar, b.x, nloc, nx); b.st[0] = nloc; b.st[1] = nx; }
        const unsigned old = xb_add(&bar[XB_XSUB(b.x)], 1u);
        const unsigned gen = old / nloc;
        if (old + 1u == (gen + 1u) * nloc) {
            __builtin_amdgcn_fence(__ATOMIC_RELEASE, "agent");
            asm volatile("s_waitcnt vmcnt(0)" ::: "memory");
            const unsigned og = xb_add(&bar[XB_TOP], 1u);
            const unsigned tg = og / nx;
            if (og + 1u == (tg + 1u) * nx) xb_add(&bar[XB_TOPGEN], 1u);
            else XB_SPIN(xb_ld(&bar[XB_TOPGEN]) == tg, bar);
            __builtin_amdgcn_fence(__ATOMIC_ACQUIRE, "agent");
            xb_add(&bar[XB_XGEN(b.x)], 1u);
            asm volatile("s_waitcnt vmcnt(0)" ::: "memory");
        } else {
            XB_SPIN(xb_ld(&bar[XB_XGEN(b.x)]) == gen, bar);
            __builtin_amdgcn_fence(__ATOMIC_ACQUIRE, "agent");
            asm volatile("s_waitcnt vmcnt(0)" ::: "memory");
        }
    }
    __syncthreads();
}


struct Args { const float* in[20]; float* out; unsigned char* ws; };
typedef const __attribute__((address_space(4))) Args* KArgs;

constexpr int TSCR = 17408;
__device__ __forceinline__ void transpose_item(const float* W, int K, int N, bf16* WT, int mode, LAS float* scr, int item, int lane) {
    const int nblk = (N + 63) / 64, kb = item / nblk, nb = item % nblk, k0 = 64 * kb, n0 = 64 * nb;
    const int kr = lane >> 4, nq = lane & 15, nn = n0 + 4 * nq; const bool ok = nn < N;
    const float* src = W + (size_t)(k0 + kr) * N + nn;
    f32x4 v[16];
#pragma unroll
    for (int i = 0; i < 16; ++i) v[i] = ok ? *(const GAS f32x4*)(src + (size_t)(4 * i) * N) : (f32x4){0.f, 0.f, 0.f, 0.f};
#pragma unroll
    for (int i = 0; i < 16; ++i) { LAS float* d = scr + (4 * i + kr) * 65 + 4 * nq; d[0] = v[i].x; d[1] = v[i].y; d[2] = v[i].z; d[3] = v[i].w; }
    LDS_WAIT(); asm volatile("" ::: "memory");
    const int c = lane & 7, nr = lane >> 3;
    int r0 = n0; if (mode) r0 = 256 * (n0 >> 7) + (n0 & 127) + (mode == 2 ? 128 : 0);
#pragma unroll
    for (int j = 0; j < 8; ++j) { const int n = nr + 8 * j; const LAS float* s = scr + (8 * c) * 65 + n;
        v4u o; o.x = pk2(s[0 * 65], s[1 * 65]); o.y = pk2(s[2 * 65], s[3 * 65]); o.z = pk2(s[4 * 65], s[5 * 65]); o.w = pk2(s[6 * 65], s[7 * 65]);
        if (n0 + n < N) *(GAS v4u*)(WT + (size_t)(r0 + n) * K + k0 + 8 * c) = o; }
    LDS_WAIT(); asm volatile("" ::: "memory");
}

constexpr int CI_ABIN = 32 * 81, CI_SQ = 32 * 32, CI_QKV = 32 * 96, CI_W1 = 32 * 88, CI_W2 = 88 * 32, CI_WG = 16 * 4;
constexpr int CONV_EVEN = CI_ABIN + CI_WG + CI_SQ + 2 * CI_W1 + CI_W2, CONV_ODD = CI_QKV + CI_SQ + 2 * CI_W1 + CI_W2;
constexpr int CONV_END0 = CONV_EVEN, CONV_END1 = CONV_END0 + CONV_ODD, CONV_END2 = CONV_END1 + CONV_EVEN, CONV_END3 = CONV_END2 + CONV_ODD, CONV_ITEMS = CONV_END3;
__device__ __forceinline__ void conv_item(KArgs args, LAS float* scr, int it, int lane) {
    unsigned char* ws = args->ws;
    int layer = 0, r = it;
    if (r >= CONV_END2) { layer = 3; r -= CONV_END2; } else if (r >= CONV_END1) { layer = 2; r -= CONV_END1; } else if (r >= CONV_END0) { layer = 1; r -= CONV_END0; }
    const int j = layer >> 1;
    if ((layer & 1) == 0) {
        if (r < CI_ABIN) { transpose_item(args->in[9] + (size_t)j * 2048 * AB_IN, 2048, AB_IN, (bf16*)(ws + WS_WABIN) + (size_t)j * AB_IN_PAD * 2048, 0, scr, r, lane); return; } r -= CI_ABIN;
        if (r < CI_WG) { const int mat = j * 16 + (r >> 2); transpose_item(args->in[13] + (size_t)mat * 16384, 128, 128, (bf16*)(ws + WS_WGT) + (size_t)mat * 16384, 0, scr, r & 3, lane); return; } r -= CI_WG;
        if (r < CI_SQ) { transpose_item(args->in[10] + (size_t)j * 2048 * 2048, 2048, 2048, (bf16*)(ws + WS_WABOUT) + (size_t)j * 2048 * 2048, 0, scr, r, lane); return; } r -= CI_SQ;
    } else {
        if (r < CI_QKV) { transpose_item(args->in[18] + (size_t)j * 2048 * 6144, 2048, 6144, (bf16*)(ws + WS_WQKV) + (size_t)j * 6144 * 2048, 0, scr, r, lane); return; } r -= CI_QKV;
        if (r < CI_SQ) { transpose_item(args->in[19] + (size_t)j * 2048 * 2048, 2048, 2048, (bf16*)(ws + WS_WSBO) + (size_t)j * 2048 * 2048, 0, scr, r, lane); return; } r -= CI_SQ;
    }
    if (r < CI_W1) { transpose_item(args->in[6] + (size_t)layer * 2048 * FF, 2048, FF, (bf16*)(ws + WS_W13) + (size_t)layer * 2 * FF * 2048, 1, scr, r, lane); return; } r -= CI_W1;
    if (r < CI_W1) { transpose_item(args->in[7] + (size_t)layer * 2048 * FF, 2048, FF, (bf16*)(ws + WS_W13) + (size_t)layer * 2 * FF * 2048, 2, scr, r, lane); return; } r -= CI_W1;
    transpose_item(args->in[8] + (size_t)layer * FF * 2048, FF, 2048, (bf16*)(ws + WS_W2) + (size_t)layer * 2048 * FF, 0, scr, r, lane);
}
__device__ __forceinline__ void conv_range(KArgs args, LAS unsigned char* lds, int lane, int wave, int first, int count, int widx, int nw) {
    LAS float* scr = (LAS float*)(lds + wave * TSCR);
    for (int i = widx; i < count; i += nw) conv_item(args, scr, first + i, lane);
}
constexpr int CONV_KA = CONV_KA_V, CONV_KB = CONV_KB_V, CONV_NA = 96 * 8 * CONV_KA, CONV_NB = 128 * 8 * CONV_KB;

__device__ __forceinline__ void p0_prologue(KArgs args, LAS unsigned char* lds, int tid, int lane, int wave, int vcu, int G) {
    unsigned char* ws = args->ws;
    const int bx = blockIdx.x;
    if (bx < 192) {
        LAS float* cs = (LAS float*)lds;
        LAS float* red = (LAS float*)(lds + 16384);
        const float* c = args->in[1];
        for (int i = tid; i < 4096; i += 512) { const float v = c[i]; cs[i] = v / (1.f + __expf(-v)); }
        __syncthreads();
        const int mat = bx / 24, cg = bx % 24;
        const float* Wp = args->in[2] + (size_t)mat * 2048 * 6144 + cg * 256 + lane * 4;
        f32x4 a0 = {0.f, 0.f, 0.f, 0.f}, a1 = {0.f, 0.f, 0.f, 0.f};
        const int kbeg = wave * 256;
#pragma unroll 8
        for (int k = kbeg; k < kbeg + 256; ++k) { const f32x4 w = *(const GAS f32x4*)(Wp + (size_t)k * 6144); const float c0 = cs[k], c1 = cs[2048 + k]; a0 += c0 * w; a1 += c1 * w; }
        *(LAS f32x4*)(red + (wave * 2 + 0) * 256 + lane * 4) = a0; *(LAS f32x4*)(red + (wave * 2 + 1) * 256 + lane * 4) = a1;
        __syncthreads();
        { const int b = tid >> 8, col = tid & 255; float s = args->in[3][mat * 6144 + cg * 256 + col];
#pragma unroll
          for (int w = 0; w < 8; ++w) s += red[(w * 2 + b) * 256 + col];
          ((float*)(ws + WS_MOD))[(mat * 2 + b) * 6144 + cg * 256 + col] = s; }
        __syncthreads();
    }
    conv_range(args, lds, lane, wave, 0, CONV_END0, vcu * NWAVES + wave, G * NWAVES);
}

__device__ __forceinline__ void norm_phase(const float* xin, const float* g, const float* mod  , bf16* HN, int lane, int gw, int NGW) {
    int curb = -1; f32x4 gs[8], sh[8];
    for (int row = gw; row < M; row += NGW) {
        const int b = row >= SEQ ? 1 : 0;
        if (b != curb) { curb = b;
#pragma unroll
            for (int j = 0; j < 8; ++j) { const int col = 4 * lane + 256 * j; const f32x4 gg = *(const GAS f32x4*)(g + col), sc = *(const GAS f32x4*)(mod + b * 6144 + 2048 + col); gs[j] = gg * (1.f + sc); sh[j] = *(const GAS f32x4*)(mod + b * 6144 + col); } }
        const GAS f32x4* xr = (const GAS f32x4*)(xin + (size_t)row * DM) + lane;
        f32x4 v[8]; float ss = 0.f;
#pragma unroll
        for (int j = 0; j < 8; ++j) { v[j] = xr[64 * j]; ss += (v[j].x * v[j].x + v[j].y * v[j].y) + (v[j].z * v[j].z + v[j].w * v[j].w); }
        const float rstd = 1.f / sqrtf(wave_sum(ss) * (1.f / DM) + EPS);
        GAS v2u* o8 = (GAS v2u*)(HN + (size_t)row * DM) + lane;
#pragma unroll
        for (int j = 0; j < 8; ++j) { const f32x4 y = v[j] * rstd * gs[j] + sh[j]; v2u w; w.x = pk2(y.x, y.y); w.y = pk2(y.z, y.w); o8[64 * j] = w; }
    }
}
__device__ __forceinline__ void final_norm_phase(const float* xin, const float* g, float* out, int lane, int gw, int NGW) {
    f32x4 gs[8];
#pragma unroll
    for (int j = 0; j < 8; ++j) gs[j] = *(const GAS f32x4*)(g + 4 * lane + 256 * j);
    for (int row = gw; row < M; row += NGW) {
        const GAS f32x4* xr = (const GAS f32x4*)(xin + (size_t)row * DM) + lane;
        f32x4 v[8]; float ss = 0.f;
#pragma unroll
        for (int j = 0; j < 8; ++j) { v[j] = xr[64 * j]; ss += (v[j].x * v[j].x + v[j].y * v[j].y) + (v[j].z * v[j].z + v[j].w * v[j].w); }
        const float rstd = 1.f / sqrtf(wave_sum(ss) * (1.f / DM) + EPS);
        GAS f32x4* o = (GAS f32x4*)(out + (size_t)row * DM) + lane;
#pragma unroll
        for (int j = 0; j < 8; ++j) o[64 * j] = v[j] * rstd * gs[j];
    }
}

struct MixP {
    const float *XA, *IG, *FG; const bf16 *YA, *Qm, *Km, *Vm, *Om; bf16* MIX;
    const float *conv_w, *conv_b, *gate_w, *gate_b, *lam, *mgb, *mng;
    float *DC, *DN, *NIN, *MLOC, *BLAST, *MIN, *HLOC, *PCUM, *AGGP, *AGGH, *HTMP; bf16* CIN;
};

__device__ __forceinline__ void mx1_rglru_unit(const MixP& P, LAS unsigned char* lds, int tid, int b, int n, int c) {
    LAS float* XC = (LAS float*)lds;
    LAS float* AS = (LAS float*)(lds + 65536);
    const int e = tid & 127, tg = tid >> 7, chn = n * 128 + e;
    const size_t rowbase = (size_t)b * SEQ; const int t0 = c * CH;
    {
        float w[4]; for (int j = 0; j < 4; ++j) w[j] = P.conv_w[j * LRU_W + chn];
        const float cb = P.conv_b[chn];
        for (int i = 0; i < 32; ++i) { const int tt = tg * 32 + i, t = t0 + tt; float acc = cb;
#pragma unroll
            for (int j = 0; j < 4; ++j) { const int ts = t - 3 + j; if (ts >= 0) acc += w[j] * P.XA[(rowbase + ts) * LRU_W + chn]; }
            XC[tt * 128 + e] = acc; }
    }
    __syncthreads();
    float ar[32], ai[32];
    { const float br = P.gate_b[chn], bi = P.gate_b[LRU_W + chn];
#pragma unroll
      for (int i = 0; i < 32; ++i) { ar[i] = br; ai[i] = bi; } }
    { const float* Wr = P.gate_w + ((size_t)(0 * NBLK + n) * 128) * 128 + e; const float* Wi = P.gate_w + ((size_t)(1 * NBLK + n) * 128) * 128 + e;
      for (int d = 0; d < 128; ++d) { const float wr = Wr[d * 128], wi = Wi[d * 128];
#pragma unroll
          for (int i = 0; i < 32; ++i) { const float x = XC[(tg * 32 + i) * 128 + d]; ar[i] += x * wr; ai[i] += x * wi; } } }
    __syncthreads();
    { const float ls = logsigmoidf_(P.lam[chn]);
#pragma unroll
      for (int i = 0; i < 32; ++i) { const int tt = tg * 32 + i; const float r = sigmoidf_(ar[i]), ig = sigmoidf_(ai[i]); const float la = 8.f * r * ls; const float a = __expf(la);
          const float mult = sqrtf(-expm1f(2.f * la)); const float xv = XC[tt * 128 + e]; AS[tt * 128 + e] = a; XC[tt * 128 + e] = mult * (ig * xv); } }
    __syncthreads();
    if (tid < 128) { float h = 0.f, pp = 1.f;
        for (int tt = 0; tt < 128; ++tt) { const float a = AS[tt * 128 + e], u = XC[tt * 128 + e]; h = a * h + u; pp *= a; const size_t o = (rowbase + t0 + tt) * LRU_W + chn; P.HLOC[o] = h; P.PCUM[o] = pp; }
        P.AGGP[(b * NCH + c) * LRU_W + chn] = pp; P.AGGH[(b * NCH + c) * LRU_W + chn] = h; }
    __syncthreads();
}

__device__ __forceinline__ void mx3_rglru_unit(const MixP& P, int tid, int b, int c, int half) {
    const int chn = half * 512 + tid;
    float carry = 0.f;
    for (int c2 = 0; c2 < c; ++c2) carry = P.AGGP[(b * NCH + c2) * LRU_W + chn] * carry + P.AGGH[(b * NCH + c2) * LRU_W + chn];
    for (int tt = 0; tt < CH; ++tt) { const size_t row = (size_t)b * SEQ + c * CH + tt; const float h = P.HLOC[row * LRU_W + chn] + P.PCUM[row * LRU_W + chn] * carry;
        const float y = bf2f(P.YA[row * LRU_W + chn]); P.MIX[row * DM + chn] = f2bf(h * gelu_tanh(y)); }
}

__device__ __forceinline__ void mx1_mlstm_unit(const MixP& P, LAS unsigned char* lds, int tid, int b, int h, int c) {
    LAS bf16* VS = (LAS bf16*)lds;
    LAS float* KS = (LAS float*)(lds + 65536);
    LAS float* sm = (LAS float*)(lds + SM_OFF); LAS float *s_li = sm, *s_lf = sm + 128, *s_bc = sm + 256, *s_g = sm + 384, *s_sc = sm + 768;
    const size_t rowbase = (size_t)b * SEQ + c * CH; const int uidx = (b * MH + h) * NCH + c;
    if (tid < 128) { s_li[tid] = P.IG[(rowbase + tid) * 4 + h] + P.mgb[h]; s_lf[tid] = logsigmoidf_(P.FG[(rowbase + tid) * 4 + h] + P.mgb[MH + h]); }
    __syncthreads();
    if (tid == 0) { float acc = 0.f, G = -INFINITY; for (int s = 0; s < 128; ++s) { acc += s_lf[s]; s_bc[s] = acc; const float g = s_li[s] - acc; s_g[s] = g; G = fmaxf(G, g); } s_sc[0] = G; s_sc[1] = acc; }
    __syncthreads();
    { const float G = s_sc[0]; const int s = tid >> 2, q = tid & 3; const float w = __expf(s_g[s] - G);
      const bf16* vp = P.Vm + (rowbase + s) * MLW + h * DV;
#pragma unroll
      for (int i = 0; i < 8; ++i) { const int ch = q + 4 * i; *(LAS v4u*)(VS + s * 256 + ch * 8) = *(const GAS v4u*)(vp + ch * 8); }
      const bf16* kp = P.Km + (rowbase + s) * MQK + h * DK + q * 32;
#pragma unroll
      for (int i = 0; i < 4; ++i) { const v4u kk = *(const GAS v4u*)(kp + i * 8); LAS float* d = KS + s * 128 + q * 32 + i * 8;
          d[0] = w * bflo(kk.x); d[1] = w * bfhi(kk.x); d[2] = w * bflo(kk.y); d[3] = w * bfhi(kk.y); d[4] = w * bflo(kk.z); d[5] = w * bfhi(kk.z); d[6] = w * bflo(kk.w); d[7] = w * bfhi(kk.w); } }
    __syncthreads();
    { const int d = tid & 127, vg = tid >> 7;
      float* dc = P.DC + ((size_t)uidx * DV + vg * 64) * DK + d;
#pragma unroll 1
      for (int i = 0; i < 64; ++i) { const LAS bf16* vcol = VS + vg * 64 + i; float acc = 0.f;
#pragma unroll 8
          for (int s = 0; s < 128; ++s) acc += KS[s * 128 + d] * bf2f(vcol[s * 256]);
          dc[(size_t)i * DK] = acc; }
      if (tid < 128) { float a = 0.f; for (int s = 0; s < 128; ++s) a += KS[s * 128 + tid]; P.DN[uidx * DK + tid] = a; }
      if (tid == 0) { P.MLOC[uidx] = s_sc[1] + s_sc[0]; P.BLAST[uidx] = s_sc[1]; } }
    __syncthreads();
}

__device__ __forceinline__ void mx2_mlstm(const MixP& P, LAS unsigned char* lds, int tid, int gtid, int NT) {
    LAS float* sm = (LAS float*)(lds + SM_OFF); LAS float *s_dec = sm, *s_scl = sm + 256, *s_min = sm + 512;
    if (tid < 8) { float m = 0.f; for (int k = 0; k < NCH; ++k) { const int u = tid * NCH + k; s_min[u] = m; const float bl = P.BLAST[u], ml = P.MLOC[u]; const float mn = fmaxf(bl + m, ml);
        s_dec[u] = __expf(bl + m - mn); s_scl[u] = __expf(ml - mn); m = mn; } }
    __syncthreads();
    typedef float f32x2v __attribute__((ext_vector_type(2)));
    for (int e2 = gtid; e2 < 8 * DV * DK / 2; e2 += NT) { const int chain = e2 / (DV * DK / 2), idx = (e2 % (DV * DK / 2)) * 2;
        const float* dcp = P.DC + (size_t)chain * NCH * (DV * DK) + idx; bf16* cip = P.CIN + (size_t)chain * NCH * (DV * DK) + idx;
        f32x2v d[NCH];
#pragma unroll
        for (int k = 0; k < NCH; ++k) d[k] = *(const GAS f32x2v*)(dcp + (size_t)k * (DV * DK));
        float c0 = 0.f, c1 = 0.f;
#pragma unroll
        for (int k = 0; k < NCH; ++k) { const int u = chain * NCH + k; *(GAS unsigned*)(cip + (size_t)k * (DV * DK)) = pk2(c0, c1); const float dd = s_dec[u], sc = s_scl[u]; c0 = dd * c0 + sc * d[k].x; c1 = dd * c1 + sc * d[k].y; } }
    if (gtid < 8 * DK) { const int chain = gtid / DK, dd_ = gtid % DK; float nv = 0.f; float dn[NCH];
#pragma unroll
        for (int k = 0; k < NCH; ++k) dn[k] = P.DN[(chain * NCH + k) * DK + dd_];
#pragma unroll
        for (int k = 0; k < NCH; ++k) { const int u = chain * NCH + k; P.NIN[u * DK + dd_] = nv; nv = s_dec[u] * nv + s_scl[u] * dn[k]; } }
    if (gtid < 256) P.MIN[gtid] = s_min[gtid];
    __syncthreads();
}

__device__ __forceinline__ void mx3_mlstm_unit(const MixP& P, LAS unsigned char* lds, int tid, int lane, int wave, int b, int h, int c) {
    constexpr int SS = 129, KSTR = 130;
    LAS float* S = (LAS float*)lds;
    LAS bf16* QS = (LAS bf16*)(lds + 66048);
    LAS bf16* KSb = (LAS bf16*)(lds + 66048 + 32768);
    LAS float* sm = (LAS float*)(lds + SM_OFF); LAS float *s_li = sm, *s_lf = sm + 128, *s_bc = sm + 256, *s_g = sm + 384, *s_M = sm + 512, *s_dn = sm + 640, *s_wi = sm + 768, *s_nin = sm + 896;
    const size_t rowbase = (size_t)b * SEQ + c * CH; const int uidx = (b * MH + h) * NCH + c;
    const float m_in = P.MIN[uidx];
    if (tid < 128) { s_li[tid] = P.IG[(rowbase + tid) * 4 + h] + P.mgb[h]; s_lf[tid] = logsigmoidf_(P.FG[(rowbase + tid) * 4 + h] + P.mgb[MH + h]); s_nin[tid] = P.NIN[uidx * DK + tid]; }
    { const int s = tid >> 2, q = tid & 3;
      const bf16* qp = P.Qm + (rowbase + s) * MQK + h * DK + q * 32; const bf16* kp = P.Km + (rowbase + s) * MQK + h * DK + q * 32;
#pragma unroll
      for (int i = 0; i < 4; ++i) { *(LAS v4u*)(QS + s * 128 + q * 32 + i * 8) = *(const GAS v4u*)(qp + i * 8);
          const v4u kk = *(const GAS v4u*)(kp + i * 8); LAS unsigned* kd = (LAS unsigned*)(KSb + s * KSTR + q * 32 + i * 8); kd[0] = kk.x; kd[1] = kk.y; kd[2] = kk.z; kd[3] = kk.w; } }
    __syncthreads();
    if (tid == 0) { float acc = 0.f, cm = m_in; for (int s = 0; s < 128; ++s) { acc += s_lf[s]; s_bc[s] = acc; const float g = s_li[s] - acc; s_g[s] = g; cm = fmaxf(cm, g); s_M[s] = cm; s_wi[s] = __expf(m_in - cm); } }
    __syncthreads();
    { const int s = tid & 127, tg = tid >> 7;
      const float gs = s_g[s]; const LAS unsigned* krow = (const LAS unsigned*)(KSb + s * KSTR);
#pragma unroll 1
      for (int i = 0; i < 32; ++i) { const int t = tg * 32 + i; float acc = 0.f; const LAS unsigned* qrow = (const LAS unsigned*)(QS + t * 128);
#pragma unroll 8
          for (int d2 = 0; d2 < 64; ++d2) { const unsigned qp = qrow[d2], kp = krow[d2]; acc += bflo(qp) * bflo(kp) + bfhi(qp) * bfhi(kp); }
          S[t * SS + s] = (s <= t) ? acc * __expf(gs - s_M[t]) : 0.f; } }
    __syncthreads();
    if (tid < 128) { const int t = tid; float den = 0.f; for (int s = 0; s < 128; ++s) den += S[t * SS + s];
        float qn = 0.f; for (int d = 0; d < 128; ++d) qn += bf2f(QS[t * 128 + d]) * s_nin[d];
        den += s_wi[t] * qn; const float mt = s_bc[t] + s_M[t]; s_dn[t] = 1.f / fmaxf(fabsf(den), __expf(-mt)); }
    __syncthreads();
    { const int v = tid & 255, tg = tid >> 8;
      const bf16* cp = P.CIN + ((size_t)uidx * DV + v) * DK;
      const bf16* vp = P.Vm + rowbase * MLW + h * DV + v;
      float* ht = P.HTMP + (size_t)uidx * CH * DV;
#pragma unroll 1
      for (int i = 0; i < 64; ++i) { const int t = tg * 64 + i; float acc = 0.f; const LAS unsigned* qrow = (const LAS unsigned*)(QS + t * 128);
#pragma unroll 4
          for (int d2 = 0; d2 < 64; ++d2) { const unsigned qp = qrow[d2]; const unsigned cc = *(const GAS unsigned*)(cp + 2 * d2); acc += bflo(qp) * bflo(cc) + bfhi(qp) * bfhi(cc); }
          acc *= s_wi[t];
          const LAS float* srow = S + t * SS;
#pragma unroll 4
          for (int s = 0; s < 128; ++s) acc += srow[s] * bf2f(*(const GAS bf16*)(vp + (size_t)s * MLW));
          ht[t * DV + v] = acc * s_dn[t]; } }
    __syncthreads();
    const float* HS = P.HTMP + (size_t)uidx * CH * DV;
    for (int i = 0; i < 16; ++i) { const int t = wave * 16 + i; const f32x4 hv = *(const GAS f32x4*)(HS + t * 256 + 4 * lane);
        const float ss = wave_sum((hv.x * hv.x + hv.y * hv.y) + (hv.z * hv.z + hv.w * hv.w)); const float rstd = 1.f / sqrtf(ss * (1.f / DV) + EPS);
        const f32x4 ng = *(const GAS f32x4*)(P.mng + h * DV + 4 * lane); const v2u ob = *(const GAS v2u*)(P.Om + (rowbase + t) * MLW + h * DV + 4 * lane);
        const float o0 = sigmoidf_(bflo(ob.x)), o1 = sigmoidf_(bfhi(ob.x)), o2 = sigmoidf_(bflo(ob.y)), o3 = sigmoidf_(bfhi(ob.y));
        v2u w; w.x = pk2(hv.x * rstd * ng.x * o0, hv.y * rstd * ng.y * o1); w.y = pk2(hv.z * rstd * ng.z * o2, hv.w * rstd * ng.w * o3);
        *(GAS v2u*)(P.MIX + (rowbase + t) * DM + LRU_W + h * DV + 4 * lane) = w; }
    __syncthreads();
}

__device__ __forceinline__ void attn_v1_phase(const bf16* Q, const bf16* K, const bf16* V, bf16* O, LAS unsigned char* lds, int lane, int wave, int gw, int NGW) {
    LAS float* qs = (LAS float*)(lds + wave * 512);
    for (int u = gw; u < BATCH * SBH * SEQ; u += NGW) {
        const int bh = u & 31, t = u >> 5, b = bh >> 4, h = bh & 15;
        const size_t rowbase = (size_t)b * SEQ;
        { const unsigned qp = *(const GAS unsigned*)(Q + (rowbase + t) * DM + h * SBD + 2 * lane); qs[2 * lane] = bflo(qp); qs[2 * lane + 1] = bfhi(qp); }
        LDS_WAIT();
        float o0 = 0.f, o1 = 0.f, carry = 0.f;
        for (int kb = (t - 1) >> 6; kb >= 0 && t > 0; --kb) {
            const int s = kb * 64 + lane; const bool valid = s < t;
            const bf16* kp = K + (rowbase + s) * DM + h * SBD;
            float z = 0.f;
#pragma unroll
            for (int i = 0; i < 16; ++i) { const v4u kk = *(const GAS v4u*)(kp + i * 8); const LAS float* qq = qs + i * 8;
                z += qq[0] * bflo(kk.x) + qq[1] * bfhi(kk.x) + qq[2] * bflo(kk.y) + qq[3] * bfhi(kk.y) + qq[4] * bflo(kk.z) + qq[5] * bfhi(kk.z) + qq[6] * bflo(kk.w) + qq[7] * bfhi(kk.w); }
            const float sp = valid ? (fmaxf(z, 0.f) + __builtin_amdgcn_logf(1.f + __builtin_amdgcn_exp2f(-fabsf(z)))) : 0.f;
            float x = sp;
#pragma unroll
            for (int off = 1; off < 64; off <<= 1) { const float y = __shfl_down(x, off); if (lane + off < 64) x += y; }
            const float R = x + carry; carry += __shfl(x, 0);
            const float A = valid ? __builtin_amdgcn_exp2f(z - R) : 0.f;
            const bf16* vp = V + (rowbase + kb * 64) * DM + h * SBD + 2 * lane;
            for (int l = 0; l < 64; ++l) { const float a = __shfl(A, l); const unsigned pr = *(const GAS unsigned*)(vp + (size_t)l * DM); o0 += a * bflo(pr); o1 += a * bfhi(pr); }
        }
        *(GAS unsigned*)(O + (rowbase + t) * DM + h * SBD + 2 * lane) = pk2(o0, o1);
    }
}

namespace sba {
typedef float f32x16 __attribute__((ext_vector_type(16)));
typedef short v4i16_t __attribute__((ext_vector_type(4)));
typedef float f32x2_t __attribute__((ext_vector_type(2))); typedef __bf16 bf16x2_t __attribute__((ext_vector_type(2)));
__device__ __forceinline__ unsigned cvtpk_s(float lo, float hi) { f32x2_t v = {lo, hi}; bf16x2_t b = __builtin_convertvector(v, bf16x2_t); return __builtin_bit_cast(unsigned, b); }
__device__ __forceinline__ int img_off(int row, int ch) { return 256 * row + 16 * (ch ^ (((row & 3) << 2) | ((row >> 2) & 3))); }
__device__ __forceinline__ v4i16_t vtr(const LAS unsigned char* p) { return __builtin_amdgcn_ds_read_tr16_b64_v4i16((LAS v4i16_t*)p); }

__device__ __forceinline__ void sb_weights(f32x16& p, float& carry, int hi) {
    float w[16];
#pragma unroll
    for (int r = 0; r < 16; ++r) { float zc; asm("v_min_f32_e32 %0, 0x42c80000, %1" : "=v"(zc) : "v"(p[r])); const float e = __builtin_amdgcn_exp2f(zc); p[r] = e; w[r] = __builtin_amdgcn_rcpf(1.f + e); }
    float E[4], Od[4];
#pragma unroll
    for (int m = 0; m < 4; ++m) { w[4 * m + 2] *= w[4 * m + 3]; w[4 * m + 1] *= w[4 * m + 2]; w[4 * m] *= w[4 * m + 1];
        const unsigned tv = __float_as_uint(w[4 * m]); auto rr = __builtin_amdgcn_permlane32_swap(tv, tv, false, false); E[m] = __uint_as_float(rr[0]); Od[m] = __uint_as_float(rr[1]); }
    float SP[4]; SP[3] = carry; SP[2] = SP[3] * (E[3] * Od[3]); SP[1] = SP[2] * (E[2] * Od[2]); SP[0] = SP[1] * (E[1] * Od[1]); carry = SP[0] * (E[0] * Od[0]);
#pragma unroll
    for (int m = 0; m < 4; ++m) { const float off = hi ? SP[m] : SP[m] * Od[m];
#pragma unroll
        for (int i = 0; i < 4; ++i) { const int r = 4 * m + i; p[r] = (p[r] * off) * w[r]; } }
}
__device__ __forceinline__ void sb_mask(f32x16& p, int lim  ) {
#pragma unroll
    for (int r = 0; r < 16; ++r) p[r] = ((r & 3) + 8 * (r >> 2) < lim) ? p[r] : -INFINITY;
}

__device__ __forceinline__ void attn_unit(const bf16* Q, const bf16* K, const bf16* V, bf16* O, LAS unsigned char* lds, int tid, int b, int h, int qb) {
    const int lane = tid & 63, wave = __builtin_amdgcn_readfirstlane(tid >> 6), r32 = lane & 31, hi = lane >> 5;
    const size_t rowbase = (size_t)b * SEQ; const int q0 = qb * 256, Qw = q0 + 32 * wave, t = Qw + r32;
    bf16x8 qf[8];
    { const bf16* qp = Q + (rowbase + t) * DM + h * SBD + hi * 8;
#pragma unroll
      for (int d = 0; d < 8; ++d) qf[d] = *(const GAS bf16x8*)(qp + d * 16); }
    f32x16 o[4];
#pragma unroll
    for (int i = 0; i < 4; ++i)
#pragma unroll
        for (int r = 0; r < 16; ++r) o[i][r] = 0.f;
    float carry = 1.f;
    const int NT = 4 * qb + 4;
    const int sr = tid >> 4, sc = tid & 15;
    const GAS unsigned char* kg = (const GAS unsigned char*)(K + rowbase * DM + h * SBD); const GAS unsigned char* vg = (const GAS unsigned char*)(V + rowbase * DM + h * SBD);
    const unsigned goff = (unsigned)(sr * DM + sc * 8) * 2u;
    const int w0 = img_off(sr, sc), w1 = img_off(sr + 32, sc);
    v4u sk0, sk1, sv0, sv1;
#define SB_LOAD(kt) do { const unsigned o_ = goff + (unsigned)(kt) * (64u * DM * 2u); sk0 = *(const GAS v4u*)(kg + o_); sk1 = *(const GAS v4u*)(kg + o_ + 32u * DM * 2u); sv0 = *(const GAS v4u*)(vg + o_); sv1 = *(const GAS v4u*)(vg + o_ + 32u * DM * 2u); } while (0)
#define SB_WRITE(buf) do { LAS unsigned char* kb_ = lds + (buf) * 16384; LAS unsigned char* vb_ = lds + 32768 + (buf) * 16384; *(LAS v4u*)(kb_ + w0) = sk0; *(LAS v4u*)(kb_ + w1) = sk1; *(LAS v4u*)(vb_ + w0) = sv0; *(LAS v4u*)(vb_ + w1) = sv1; } while (0)
    const int krt = ((r32 & 3) << 2) | ((r32 >> 2) & 3);
    const int i16 = lane & 15, q4 = i16 >> 2, p4 = i16 & 3, gb = (lane >> 4) & 1;
    const int vlow0 = ((2 * gb + (p4 >> 1)) ^ hi), vlow1 = vlow0 ^ 2;
    const int vrow0 = 256 * (4 * hi + q4) + 8 * (p4 & 1);
    const bool lag = wave >= 4;
    bf16x8 af[2][2]; bool have = false; int pvb = 0, vb = 0;
#define SB_AV(VBUF) do { const LAS unsigned char* Vb_ = lds + 32768 + (VBUF) * 16384; __builtin_amdgcn_s_setprio(1); \
        _Pragma("unroll") for (int u = 0; u < 2; ++u) _Pragma("unroll") for (int s = 0; s < 2; ++s) _Pragma("unroll") for (int db = 0; db < 4; ++db) { \
            const int c0 = (((db ^ q4) << 2) | vlow0), c1 = (((db ^ q4) << 2) | vlow1); \
            const v4i16_t lo = vtr(Vb_ + vrow0 + 256 * (32 * u + 16 * s) + 16 * c0), hh = vtr(Vb_ + vrow0 + 256 * (32 * u + 16 * s + 8) + 16 * c1); \
            const bf16x8 vf = {lo[0], lo[1], lo[2], lo[3], hh[0], hh[1], hh[2], hh[3]}; \
            o[db] = __builtin_amdgcn_mfma_f32_32x32x16_bf16(vf, af[u][s], o[db], 0, 0, 0); } __builtin_amdgcn_s_setprio(0); } while (0)
#define SB_WRITE3(kbuf, vbuf) do { LAS unsigned char* kb_ = lds + (kbuf) * 16384; LAS unsigned char* vb_ = lds + 32768 + (vbuf) * 16384; *(LAS v4u*)(kb_ + w0) = sk0; *(LAS v4u*)(kb_ + w1) = sk1; *(LAS v4u*)(vb_ + w0) = sv0; *(LAS v4u*)(vb_ + w1) = sv1; } while (0)
#define SB_LOADS(S, kt) do { const unsigned o_ = goff + (unsigned)(kt) * (64u * DM * 2u); S##k0 = *(const GAS v4u*)(kg + o_); S##k1 = *(const GAS v4u*)(kg + o_ + 32u * DM * 2u); S##v0 = *(const GAS v4u*)(vg + o_); S##v1 = *(const GAS v4u*)(vg + o_ + 32u * DM * 2u); } while (0)
#define SB_WRITES(S, kbuf, vbuf) do { LAS unsigned char* kb_ = lds + (kbuf) * 16384; LAS unsigned char* vb_ = lds + 32768 + (vbuf) * 16384; *(LAS v4u*)(kb_ + w0) = S##k0; *(LAS v4u*)(kb_ + w1) = S##k1; *(LAS v4u*)(vb_ + w0) = S##v0; *(LAS v4u*)(vb_ + w1) = S##v1; } while (0)
#define SB_PACK(P, u) do { _Pragma("unroll") for (int s = 0; s < 2; ++s) { v4u aw; aw.x = cvtpk_s(P[8 * s], P[8 * s + 1]); aw.y = cvtpk_s(P[8 * s + 2], P[8 * s + 3]); aw.z = cvtpk_s(P[8 * s + 4], P[8 * s + 5]); aw.w = cvtpk_s(P[8 * s + 6], P[8 * s + 7]); af[u][s] = __builtin_bit_cast(bf16x8, aw); } } while (0)
#define SB_STEP(S, it) do { \
        const int kt = NT - 1 - (it), buf = (it) & 1, key0 = kt * 64; \
        const bool skip = key0 >= Qw + 31, full = key0 + 63 < Qw; \
        if (lag && have) { SB_AV(pvb); __builtin_amdgcn_sched_barrier(0); } \
        have = false; \
        if (!skip) { \
            const LAS unsigned char* Kb = lds + buf * 16384; \
            f32x16 p0, p1; \
            _Pragma("unroll") for (int r = 0; r < 16; ++r) { p0[r] = 0.f; p1[r] = 0.f; } __builtin_amdgcn_s_setprio(1); \
            _Pragma("unroll") for (int d = 0; d < 8; ++d) { const int off = 256 * r32 + 16 * ((2 * d + hi) ^ krt); \
                const bf16x8 k0 = *(const LAS bf16x8*)(Kb + off), k1 = *(const LAS bf16x8*)(Kb + off + 8192); \
                p0 = __builtin_amdgcn_mfma_f32_32x32x16_bf16(k0, qf[d], p0, 0, 0, 0); p1 = __builtin_amdgcn_mfma_f32_32x32x16_bf16(k1, qf[d], p1, 0, 0, 0); } __builtin_amdgcn_s_setprio(0); \
            if (!full) { sb_mask(p1, t - key0 - 32 - 4 * hi); sb_mask(p0, t - key0 - 4 * hi); } \
            sb_weights(p1, carry, hi); SB_PACK(p1, 1); __builtin_amdgcn_sched_barrier(0); sb_weights(p0, carry, hi); SB_PACK(p0, 0); \
            __builtin_amdgcn_sched_barrier(0); \
            have = true; \
            if (!lag) { SB_AV(vb); have = false; } \
        } \
        pvb = vb; vb = (vb == 2) ? 0 : vb + 1; \
        if ((it) + 1 < NT) SB_WRITES(S, buf ^ 1, vb); \
        if ((it) + 3 < NT) SB_LOADS(S, kt - 3); \
        __syncthreads(); } while (0)
    v4u sAk0, sAk1, sAv0, sAv1, sBk0, sBk1, sBv0, sBv1;
    SB_LOADS(sA, NT - 1); SB_WRITES(sA, 0, 0); SB_LOADS(sA, NT - 2); SB_LOADS(sB, NT - 3); __syncthreads();
    for (int it = 0; it < NT; it += 2) { SB_STEP(sA, it); SB_STEP(sB, it + 1); }
#undef SB_STEP
#undef SB_PACK
#undef SB_LOADS
#undef SB_WRITES
    if (lag && have) SB_AV(pvb);
    __syncthreads();
#undef SB_AV
#undef SB_WRITE3
#undef SB_LOAD
#undef SB_WRITE
    bf16* op = O + (rowbase + t) * DM + h * SBD + 4 * hi;
#pragma unroll
    for (int db = 0; db < 4; ++db)
#pragma unroll
        for (int g = 0; g < 4; ++g) { v2u w; w.x = cvtpk_s(o[db][4 * g], o[db][4 * g + 1]); w.y = cvtpk_s(o[db][4 * g + 2], o[db][4 * g + 3]); *(GAS v2u*)(op + 32 * db + 8 * g) = w; }
}

__device__ __forceinline__ void attn_phase(const bf16* Q, const bf16* K, const bf16* V, bf16* O, LAS unsigned char* lds, int tid, int vcu, int G) {
    for (int pi = vcu; pi < 256; pi += G) {
        const int bh = pi >> 3, x = pi & 7;
#pragma unroll 1
        for (int uu = 0; uu < 2; ++uu) attn_unit(Q, K, V, O, lds, tid, bh >> 4, bh & 15, uu ? x : 15 - x);
    }
}
}

namespace mls {
using sba::f32x16; using sba::v4i16_t; using sba::cvtpk_s; using sba::img_off; using sba::vtr;
__device__ __forceinline__ float half_sum(float x) { const unsigned u = __float_as_uint(x); auto rr = __builtin_amdgcn_permlane32_swap(u, u, false, false); return __uint_as_float(rr[0]) + __uint_as_float(rr[1]); }

__device__ __forceinline__ void stage_v(const bf16* Vm, size_t rowbase, int h, LAS unsigned char* lds, int tid) {
    const int c32 = tid & 31; const bf16* vp = Vm + rowbase * MLW + h * DV + c32 * 8;
#pragma unroll
    for (int k = 0; k < 8; ++k) { const int row = (tid >> 5) + 16 * k; const v4u x = *(const GAS v4u*)(vp + (size_t)row * MLW); *(LAS v4u*)(lds + (c32 >> 4) * 32768 + img_off(row, c32 & 15)) = x; }
}
__device__ __forceinline__ void gate_scan(const MixP& P, size_t rowbase, int h, int lane, float& bc0, float& bc1, float& g0, float& g1) {
    const float li0 = P.IG[(rowbase + 2 * lane) * 4 + h] + P.mgb[h], li1 = P.IG[(rowbase + 2 * lane + 1) * 4 + h] + P.mgb[h];
    const float lf0 = logsigmoidf_(P.FG[(rowbase + 2 * lane) * 4 + h] + P.mgb[MH + h]), lf1 = logsigmoidf_(P.FG[(rowbase + 2 * lane + 1) * 4 + h] + P.mgb[MH + h]);
    const float ps = lf0 + lf1; float x = ps;
#pragma unroll
    for (int off = 1; off < 64; off <<= 1) { const float y = lane_up(x, off, lane); if (lane >= off) x += y; }
    bc0 = (x - ps) + lf0; bc1 = bc0 + lf1; g0 = li0 - bc0; g1 = li1 - bc1;
}

__device__ __forceinline__ void mx1_unit(const MixP& P, LAS unsigned char* lds, int tid, int b, int h, int c) {
    const int lane = tid & 63, wave = __builtin_amdgcn_readfirstlane(tid >> 6), r32 = lane & 31, hi = lane >> 5;
    LAS float* sm = (LAS float*)(lds + SM_OFF); LAS float *s_w = sm, *s_sc = sm + 128;
    const size_t rowbase = (size_t)b * SEQ + c * CH; const int uidx = (b * MH + h) * NCH + c;
    stage_v(P.Vm, rowbase, h, lds, tid);
    if (wave == 0) { float bc0, bc1, g0, g1; gate_scan(P, rowbase, h, lane, bc0, bc1, g0, g1);
        const float G = wave_max(fmaxf(g0, g1));
        s_w[2 * lane] = __expf(g0 - G); s_w[2 * lane + 1] = __expf(g1 - G);
        const float bl = __int_as_float(__builtin_amdgcn_readlane(__float_as_int(bc1), 63)); if (lane == 0) { s_sc[0] = G; s_sc[1] = bl; } }
    __syncthreads();
    { const int row = tid >> 2, q = tid & 3; const float w = s_w[row]; const bf16* kp = P.Km + (rowbase + row) * MQK + h * DK + q * 32;
#pragma unroll
      for (int i = 0; i < 4; ++i) { const v4u kk = *(const GAS v4u*)(kp + i * 8); v4u o;
          o.x = cvtpk_s(w * bflo(kk.x), w * bfhi(kk.x)); o.y = cvtpk_s(w * bflo(kk.y), w * bfhi(kk.y)); o.z = cvtpk_s(w * bflo(kk.z), w * bfhi(kk.z)); o.w = cvtpk_s(w * bflo(kk.w), w * bfhi(kk.w));
          *(LAS v4u*)(lds + 65536 + img_off(row, 4 * q + i)) = o; } }
    __syncthreads();
    f32x16 acc[4], accn[4];
#pragma unroll
    for (int i = 0; i < 4; ++i)
#pragma unroll
        for (int r = 0; r < 16; ++r) { acc[i][r] = 0.f; accn[i][r] = 0.f; }
    const int i16 = lane & 15, q4 = i16 >> 2, p4 = i16 & 3, gb = (lane >> 4) & 1;
    const int lowb = 2 * gb + (p4 >> 1);
    const int rowb = 256 * (8 * hi + q4) + 8 * (p4 & 1);
    const LAS unsigned char* Vb = lds + (wave >> 2) * 32768; const LAS unsigned char* Kb = lds + 65536;
    const int vdb = wave & 3;
    const bf16x8 ones = {0x3F80, 0x3F80, 0x3F80, 0x3F80, 0x3F80, 0x3F80, 0x3F80, 0x3F80};
#pragma unroll
    for (int ks = 0; ks < 8; ++ks) {
        const int lw0 = lowb ^ (2 * hi), lw1 = lowb ^ (2 * hi + 1);
        const v4i16_t vl = vtr(Vb + rowb + 256 * (16 * ks) + 16 * (((vdb ^ q4) << 2) | lw0)), vh2 = vtr(Vb + rowb + 256 * (16 * ks + 4) + 16 * (((vdb ^ q4) << 2) | lw1));
        const bf16x8 vf = {vl[0], vl[1], vl[2], vl[3], vh2[0], vh2[1], vh2[2], vh2[3]};
#pragma unroll
        for (int db = 0; db < 4; ++db) {
            const v4i16_t kl = vtr(Kb + rowb + 256 * (16 * ks) + 16 * (((db ^ q4) << 2) | lw0)), kh = vtr(Kb + rowb + 256 * (16 * ks + 4) + 16 * (((db ^ q4) << 2) | lw1));
            const bf16x8 kf = {kl[0], kl[1], kl[2], kl[3], kh[0], kh[1], kh[2], kh[3]};
            acc[db] = __builtin_amdgcn_mfma_f32_32x32x16_bf16(vf, kf, acc[db], 0, 0, 0);
            if (wave == 0) accn[db] = __builtin_amdgcn_mfma_f32_32x32x16_bf16(ones, kf, accn[db], 0, 0, 0);
        }
    }
    float* dc = P.DC + ((size_t)uidx * DV + 32 * wave) * DK + r32;
#pragma unroll
    for (int db = 0; db < 4; ++db)
#pragma unroll
        for (int r = 0; r < 16; ++r) dc[(size_t)((r & 3) + 8 * (r >> 2) + 4 * hi) * DK + 32 * db] = acc[db][r];
    if (wave == 0 && hi == 0) {
#pragma unroll
        for (int db = 0; db < 4; ++db) P.DN[uidx * DK + 32 * db + r32] = accn[db][0]; }
    if (tid == 0) { P.MLOC[uidx] = s_sc[1] + s_sc[0]; P.BLAST[uidx] = s_sc[1]; }
    __syncthreads();
}

__device__ __forceinline__ void mx3_unit(const MixP& P, LAS unsigned char* lds, int tid, int b, int h, int c) {
    const int lane = tid & 63, wave = __builtin_amdgcn_readfirstlane(tid >> 6), r32 = lane & 31, hi = lane >> 5;
    const int qb = wave & 3, vh = wave >> 2;
    LAS float* sm = (LAS float*)(lds + SM_OFF); LAS float *s_g2 = sm, *s_M2 = sm + 128, *s_bc = sm + 256, *s_nin = sm + 384, *s_part = sm + 512;
    const size_t rowbase = (size_t)b * SEQ + c * CH; const int uidx = (b * MH + h) * NCH + c;
    const float m_in = P.MIN[uidx];
    stage_v(P.Vm, rowbase, h, lds, tid);
    if (wave == 0) { float bc0, bc1, g0, g1; gate_scan(P, rowbase, h, lane, bc0, bc1, g0, g1);
        float y = fmaxf(g0, g1);
#pragma unroll
        for (int off = 1; off < 64; off <<= 1) { const float z = lane_up(y, off, lane); if (lane >= off) y = fmaxf(y, z); }
        float ex = lane_up(y, 1, lane); if (lane == 0) ex = -INFINITY;
        const float M0 = fmaxf(m_in, fmaxf(ex, g0)), M1 = fmaxf(m_in, y);
        s_g2[2 * lane] = g0 * LOG2E; s_g2[2 * lane + 1] = g1 * LOG2E; s_M2[2 * lane] = M0 * LOG2E; s_M2[2 * lane + 1] = M1 * LOG2E; s_bc[2 * lane] = bc0; s_bc[2 * lane + 1] = bc1; }
    if (wave == 1) { s_nin[lane] = P.NIN[uidx * DK + lane]; s_nin[64 + lane] = P.NIN[uidx * DK + 64 + lane]; }
    const int t = 32 * qb + r32;
    bf16x8 qf[8];
    { const bf16* qp = P.Qm + (rowbase + t) * MQK + h * DK + hi * 8;
#pragma unroll
      for (int d = 0; d < 8; ++d) qf[d] = *(const GAS bf16x8*)(qp + d * 16); }
    __syncthreads();
    const float M2 = s_M2[t], bct = s_bc[t];
    const float wint = __builtin_amdgcn_exp2f(m_in * LOG2E - M2);
    f32x16 acc[4];
#pragma unroll
    for (int i = 0; i < 4; ++i)
#pragma unroll
        for (int r = 0; r < 16; ++r) acc[i][r] = 0.f;
    { const bf16* cp = P.CIN + ((size_t)uidx * DV + 128 * vh + r32) * DK + hi * 8;
#pragma unroll
      for (int vb = 0; vb < 4; ++vb)
#pragma unroll
          for (int d = 0; d < 8; ++d) { const bf16x8 cf = *(const GAS bf16x8*)(cp + (size_t)(32 * vb) * DK + d * 16); acc[vb] = __builtin_amdgcn_mfma_f32_32x32x16_bf16(cf, qf[d], acc[vb], 0, 0, 0); } }
#pragma unroll
    for (int i = 0; i < 4; ++i)
#pragma unroll
        for (int r = 0; r < 16; ++r) acc[i][r] *= wint;
    float qn = 0.f;
#pragma unroll
    for (int d = 0; d < 8; ++d)
#pragma unroll
        for (int j = 0; j < 8; ++j) qn += bf2f((bf16)qf[d][j]) * s_nin[16 * d + 8 * hi + j];
    float den = wint * half_sum(qn), dpart = 0.f;
    const int i16 = lane & 15, q4 = i16 >> 2, p4 = i16 & 3, gb = (lane >> 4) & 1;
    const int vlow0 = ((2 * gb + (p4 >> 1)) ^ hi), vlow1 = vlow0 ^ 2;
    const int vrow0 = 256 * (4 * hi + q4) + 8 * (p4 & 1);
    const LAS unsigned char* Vb = lds + vh * 32768;
    for (int kb = 0; kb <= qb; ++kb) {
        f32x16 p;
#pragma unroll
        for (int r = 0; r < 16; ++r) p[r] = 0.f;
        { const bf16* kp = P.Km + (rowbase + 32 * kb + r32) * MQK + h * DK + hi * 8;
#pragma unroll
          for (int d = 0; d < 8; ++d) { const bf16x8 kf = *(const GAS bf16x8*)(kp + d * 16); p = __builtin_amdgcn_mfma_f32_32x32x16_bf16(kf, qf[d], p, 0, 0, 0); } }
#pragma unroll
        for (int m = 0; m < 4; ++m) { const f32x4 gq = *(const LAS f32x4*)(s_g2 + 32 * kb + 8 * m + 4 * hi);
#pragma unroll
            for (int i = 0; i < 4; ++i) { const int r = 4 * m + i; float w = __builtin_amdgcn_exp2f(gq[i] - M2); if (kb == qb) w = (8 * m + 4 * hi + i <= r32) ? w : 0.f; p[r] *= w; dpart += p[r]; } }
        bf16x8 af[2];
#pragma unroll
        for (int s = 0; s < 2; ++s) { v4u aw; aw.x = cvtpk_s(p[8 * s], p[8 * s + 1]); aw.y = cvtpk_s(p[8 * s + 2], p[8 * s + 3]); aw.z = cvtpk_s(p[8 * s + 4], p[8 * s + 5]); aw.w = cvtpk_s(p[8 * s + 6], p[8 * s + 7]); af[s] = __builtin_bit_cast(bf16x8, aw); }
        const LAS unsigned char* Vk = Vb + 256 * 32 * kb;
#pragma unroll
        for (int s = 0; s < 2; ++s)
#pragma unroll
            for (int vb = 0; vb < 4; ++vb) {
                const int c0 = (((vb ^ q4) << 2) | vlow0), c1 = (((vb ^ q4) << 2) | vlow1);
                const v4i16_t lo = vtr(Vk + vrow0 + 256 * (16 * s) + 16 * c0), hh = vtr(Vk + vrow0 + 256 * (16 * s + 8) + 16 * c1);
                const bf16x8 vf = {lo[0], lo[1], lo[2], lo[3], hh[0], hh[1], hh[2], hh[3]};
                acc[vb] = __builtin_amdgcn_mfma_f32_32x32x16_bf16(vf, af[s], acc[vb], 0, 0, 0);
            }
    }
    den += half_sum(dpart);
    const float mt = bct + M2 * LN2;
    const float scl = 1.f / fmaxf(fabsf(den), __expf(-mt));
    float ss = 0.f;
#pragma unroll
    for (int i = 0; i < 4; ++i)
#pragma unroll
        for (int r = 0; r < 16; ++r) { acc[i][r] *= scl; ss += acc[i][r] * acc[i][r]; }
    ss = half_sum(ss);
    if (hi == 0) s_part[wave * 32 + r32] = ss;
    __syncthreads();
    const float tot = s_part[qb * 32 + r32] + s_part[(4 + qb) * 32 + r32];
    const float rstd = 1.f / sqrtf(tot * (1.f / DV) + EPS);
    { const int vbase = h * DV + 128 * vh + 4 * hi;
      const bf16* op = P.Om + (rowbase + t) * MLW + vbase; bf16* mp = P.MIX + (rowbase + t) * DM + LRU_W + vbase; const float* ng = P.mng + vbase;
#pragma unroll
      for (int vb = 0; vb < 4; ++vb)
#pragma unroll
          for (int g = 0; g < 4; ++g) { const int vo = 32 * vb + 8 * g; const f32x4 n4 = *(const GAS f32x4*)(ng + vo); const v2u ob = *(const GAS v2u*)(op + vo);
              const float o0 = sigmoidf_(bflo(ob.x)), o1 = sigmoidf_(bfhi(ob.x)), o2 = sigmoidf_(bflo(ob.y)), o3 = sigmoidf_(bfhi(ob.y));
              v2u w; w.x = cvtpk_s(acc[vb][4 * g] * rstd * n4.x * o0, acc[vb][4 * g + 1] * rstd * n4.y * o1); w.y = cvtpk_s(acc[vb][4 * g + 2] * rstd * n4.z * o2, acc[vb][4 * g + 3] * rstd * n4.w * o3);
              *(GAS v2u*)(mp + vo) = w; } }
    __syncthreads();
}
}

namespace rgl {
using sba::f32x16; using sba::img_off;
__device__ __forceinline__ float sig_fast(float x) { return __builtin_amdgcn_rcpf(1.f + __builtin_amdgcn_exp2f(-LOG2E * x)); }
__device__ __forceinline__ void swap_pair(float x, float& ev, float& od) { const unsigned u = __float_as_uint(x); auto rr = __builtin_amdgcn_permlane32_swap(u, u, false, false); ev = __uint_as_float(rr[0]); od = __uint_as_float(rr[1]); }

__device__ __forceinline__ void mx1_unit(const MixP& P, const bf16* WGT  , LAS unsigned char* lds, int tid, int b, int n, int c) {
    const int lane = tid & 63, wave = __builtin_amdgcn_readfirstlane(tid >> 6), r32 = lane & 31, hi = lane >> 5;
    LAS float* XC = (LAS float*)lds;
    LAS unsigned char* XB = lds + 65536;
    LAS float* s_agg = (LAS float*)(lds + SM_OFF);
    const size_t rowbase = (size_t)b * SEQ; const int t0 = c * CH;
    {
        const int e = tid & 127, tg = tid >> 7, chn = n * 128 + e;
        const float w0 = P.conv_w[chn], w1 = P.conv_w[LRU_W + chn], w2 = P.conv_w[2 * LRU_W + chn], w3 = P.conv_w[3 * LRU_W + chn], cb = P.conv_b[chn];
        const int ts = t0 + tg * 32; const float* xp = P.XA + (rowbase + ts) * LRU_W + chn;
        float x0 = (ts >= 3) ? xp[-3 * LRU_W] : 0.f, x1 = (ts >= 2) ? xp[-2 * LRU_W] : 0.f, x2 = (ts >= 1) ? xp[-1 * LRU_W] : 0.f;
        LAS unsigned char* xb = XB + 2 * (e & 7);
#pragma unroll 8
        for (int i = 0; i < 32; ++i) { const float x3 = xp[(size_t)i * LRU_W]; const float y = cb + w0 * x0 + w1 * x1 + w2 * x2 + w3 * x3; x0 = x1; x1 = x2; x2 = x3;
            const int tt = tg * 32 + i; XC[tt * 128 + e] = y; *(LAS bf16*)(xb + img_off(tt, e >> 3)) = f2bf(y); }
    }
    __syncthreads();
    const int tb = wave & 3, eh = wave >> 2;
    f32x16 ar[2], ai[2];
#pragma unroll
    for (int i = 0; i < 2; ++i)
#pragma unroll
        for (int r = 0; r < 16; ++r) { ar[i][r] = 0.f; ai[i][r] = 0.f; }
    { const int krt = ((r32 & 3) << 2) | ((r32 >> 2) & 3);
      const bf16* wr = WGT + ((size_t)(0 * NBLK + n) * 128 + 64 * eh + r32) * 128 + hi * 8; const bf16* wi = WGT + ((size_t)(1 * NBLK + n) * 128 + 64 * eh + r32) * 128 + hi * 8;
#pragma unroll
      for (int d = 0; d < 8; ++d) { const bf16x8 xf = *(const LAS bf16x8*)(XB + 256 * (32 * tb + r32) + 16 * ((2 * d + hi) ^ krt));
#pragma unroll
          for (int eb = 0; eb < 2; ++eb) { const bf16x8 fr = *(const GAS bf16x8*)(wr + (size_t)(32 * eb) * 128 + d * 16), fi = *(const GAS bf16x8*)(wi + (size_t)(32 * eb) * 128 + d * 16);
              ar[eb] = __builtin_amdgcn_mfma_f32_32x32x16_bf16(xf, fr, ar[eb], 0, 0, 0); ai[eb] = __builtin_amdgcn_mfma_f32_32x32x16_bf16(xf, fi, ai[eb], 0, 0, 0); } } }
    float BA[2], BH[2];
#pragma unroll
    for (int eb = 0; eb < 2; ++eb) {
        const int e = 64 * eh + 32 * eb + r32, chn = n * 128 + e;
        const float br = P.gate_b[chn], bi = P.gate_b[LRU_W + chn], ls8 = 8.f * LOG2E * logsigmoidf_(P.lam[chn]);
        float qa[4], qh[4];
#pragma unroll
        for (int m = 0; m < 4; ++m) { float A = 1.f, H = 0.f;
#pragma unroll
            for (int i = 0; i < 4; ++i) { const int r = 4 * m + i, tt = 32 * tb + 8 * m + 4 * hi + i;
                const float rg = sig_fast(ar[eb][r] + br), ig = sig_fast(ai[eb][r] + bi); const float a = __builtin_amdgcn_exp2f(rg * ls8); const float mult = __builtin_amdgcn_sqrtf(fmaxf(1.f - a * a, 0.f));
                const float u = mult * (ig * XC[tt * 128 + e]); H = a * H + u; A = A * a; ar[eb][r] = H; ai[eb][r] = A; }
            qa[m] = A; qh[m] = H; }
        float PA = 1.f, PH = 0.f;
#pragma unroll
        for (int m = 0; m < 4; ++m) { float ea, oa, eh_, oh; swap_pair(qa[m], ea, oa); swap_pair(qh[m], eh_, oh);
            const float pa_odd = ea * PA, ph_odd = ea * PH + eh_;
            const float ma = hi ? pa_odd : PA, mh = hi ? ph_odd : PH;
#pragma unroll
            for (int i = 0; i < 4; ++i) { const int r = 4 * m + i; ar[eb][r] += ai[eb][r] * mh; ai[eb][r] *= ma; }
            PA = oa * pa_odd; PH = oa * ph_odd + oh; }
        BA[eb] = PA; BH[eb] = PH;
        if (hi == 0) { s_agg[(tb * 128 + e) * 2] = PA; s_agg[(tb * 128 + e) * 2 + 1] = PH; }
    }
    __syncthreads();
#pragma unroll
    for (int eb = 0; eb < 2; ++eb) {
        const int e = 64 * eh + 32 * eb + r32, chn = n * 128 + e;
        float CA = 1.f, CHh = 0.f;
        for (int t2 = 0; t2 < tb; ++t2) { const float a = s_agg[(t2 * 128 + e) * 2], h = s_agg[(t2 * 128 + e) * 2 + 1]; CHh = a * CHh + h; CA = CA * a; }
#pragma unroll
        for (int r = 0; r < 16; ++r) { const int tt = 32 * tb + (r & 3) + 8 * (r >> 2) + 4 * hi; const size_t o = (rowbase + t0 + tt) * LRU_W + chn;
            P.HLOC[o] = ar[eb][r] + ai[eb][r] * CHh; P.PCUM[o] = ai[eb][r] * CA; }
        if (tb == 3 && hi == 0) { P.AGGP[(b * NCH + c) * LRU_W + chn] = BA[eb] * CA; P.AGGH[(b * NCH + c) * LRU_W + chn] = BA[eb] * CHh + BH[eb]; }
    }
    __syncthreads();
}

__device__ __forceinline__ void mx2_carry(const MixP& P, float* CARRY, int gtid, int NT) {
    const int g2 = NT - 1 - gtid;
    if (g2 < BATCH * LRU_W) { const int b = g2 >> 10, chn = g2 & 1023; float ap[NCH], ah[NCH];
#pragma unroll
        for (int c = 0; c < NCH; ++c) { const int o = (b * NCH + c) * LRU_W + chn; ap[c] = P.AGGP[o]; ah[c] = P.AGGH[o]; }
        float carry = 0.f;
#pragma unroll
        for (int c = 0; c < NCH; ++c) { CARRY[(b * NCH + c) * LRU_W + chn] = carry; carry = ap[c] * carry + ah[c]; } }
}
__device__ __forceinline__ void mx3_unit(const MixP& P, const float* CARRY, int tid, int b, int c, int tq) {
    typedef float f32x2v __attribute__((ext_vector_type(2)));
    const int chn = 2 * tid; const f32x2v cr = *(const GAS f32x2v*)(CARRY + (b * NCH + c) * LRU_W + chn);
    const size_t row0 = (size_t)b * SEQ + c * CH + tq * 32;
#pragma unroll 4
    for (int i = 0; i < 32; ++i) { const size_t row = row0 + i; const f32x2v h = *(const GAS f32x2v*)(P.HLOC + row * LRU_W + chn), p = *(const GAS f32x2v*)(P.PCUM + row * LRU_W + chn);
        const unsigned yy = *(const GAS unsigned*)(P.YA + row * LRU_W + chn);
        *(GAS unsigned*)(P.MIX + row * DM + chn) = pk2((h.x + p.x * cr.x) * gelu_tanh(bflo(yy)), (h.y + p.y * cr.y) * gelu_tanh(bfhi(yy))); }
}
}
#ifndef IDLE_TICKS
#define IDLE_TICKS 3500u
#endif
#ifndef REPMASK
#define REPMASK 0
#endif
#define PHASE_REP(bit) for (int rep_ = 0; rep_ <= ((REPMASK >> (bit)) & 1); ++rep_)
#ifndef MX1R_UNIT
#define MX1R_UNIT rgl::mx1_unit
#endif
#ifndef MX1M_UNIT
#define MX1M_UNIT mls::mx1_unit
#endif
#ifndef MX3M_UNIT
#define MX3M_UNIT mls::mx3_unit
#endif

__device__ __forceinline__ KArgs fresh_args() { KArgs p = (KArgs)__builtin_amdgcn_kernarg_segment_ptr(); asm volatile("" : "+s"(p)); return p; }
__device__ __forceinline__ void fill_mixp(MixP& P, KArgs ap, unsigned char* ws, int j) {
    P.XA = (const float*)(ws + WS_P0); P.YA = (const bf16*)(ws + WS_P0 + 32 * MiB); P.Qm = (const bf16*)(ws + WS_P0 + 48 * MiB); P.Km = (const bf16*)(ws + WS_P0 + 56 * MiB);
    P.Vm = (const bf16*)(ws + WS_P0 + 64 * MiB); P.Om = (const bf16*)(ws + WS_P0 + 80 * MiB); P.IG = (const float*)(ws + WS_IG); P.FG = (const float*)(ws + WS_IG + 128 * 1024); P.MIX = (bf16*)(ws + WS_MIX);
    P.conv_w = ap->in[11] + (size_t)j * 4 * LRU_W; P.conv_b = ap->in[12] + (size_t)j * LRU_W; P.gate_w = ap->in[13] + (size_t)j * 2 * NBLK * BW * BW; P.gate_b = ap->in[14] + (size_t)j * 2 * LRU_W;
    P.lam = ap->in[15] + (size_t)j * LRU_W; P.mgb = ap->in[16] + (size_t)j * 2 * MH; P.mng = ap->in[17] + (size_t)j * MLW;
    P.DC = (float*)(ws + WS_DC); P.CIN = (bf16*)(ws + WS_CIN); P.DN = (float*)(ws + WS_SMALL); P.NIN = (float*)(ws + WS_SMALL + 128 * 1024); P.MLOC = (float*)(ws + WS_SMALL + 256 * 1024);
    P.BLAST = (float*)(ws + WS_SMALL + 257 * 1024); P.MIN = (float*)(ws + WS_SMALL + 258 * 1024); P.HLOC = (float*)(ws + WS_HLOC); P.PCUM = (float*)(ws + WS_PCUM);
    P.AGGP = (float*)(ws + WS_AGG); P.AGGH = (float*)(ws + WS_AGG + 256 * 1024); P.HTMP = (float*)(ws + WS_HTMP);
}
__global__ void __launch_bounds__(NWAVES * 64, 2) fwd_kernel(Args args) {
    extern __shared__ __attribute__((aligned(16))) unsigned char lds_raw[];
    LAS unsigned char* lds = (LAS unsigned char*)lds_raw;
    const int tid0 = threadIdx.x; const int wave_s = __builtin_amdgcn_readfirstlane(tid0 >> 6);
    const int G = gridDim.x, bx = blockIdx.x; const int vcu = (G % 8 == 0) ? (bx % 8) * (G / 8) + bx / 8 : bx;
    const int NGW = G * NWAVES;
#define FRESH() const int tid = fresh_tid(wave_s), lane = tid & 63, wave = __builtin_amdgcn_readfirstlane(tid >> 6), gw = vcu * NWAVES + wave; (void)lane; (void)gw; const KArgs ap = fresh_args(); unsigned char* const ws = ap->ws; (void)ws
    volatile LAS unsigned* MISC = (volatile LAS unsigned*)(lds + MISC_OFF);
    if (tid0 < 64) MISC[tid0] = 0u;
    __syncthreads();
    XcdBarrier bar = xcd_barrier_post((unsigned*)(args.ws + WS_CTL) + CW_BAR, MISC + 8);
#define GRID_BAR() do { XcdBarrier b2_ = bar; asm volatile("" : "+s"(b2_.x)); asm volatile("" : "+s"(b2_.bar)); xcd_barrier(b2_); } while (0)

PHASE_REP(0) {     { FRESH(); p0_prologue(ap, lds, tid, lane, wave, vcu, G); }
    GRID_BAR(); }

    for (int layer = 0; layer < DEPTH; ++layer) {
        const int j = layer >> 1;
PHASE_REP(1) {
        { FRESH(); const int na_ = (G == 256) ? CONV_NA : 0, nb_ = (G == 256) ? CONV_NB : 0;
          if (layer == 1) conv_range(ap, lds, lane, wave, CONV_END0 + na_ + nb_, CONV_END1 - (CONV_END0 + na_ + nb_), gw, NGW);
          if (layer == 2) conv_range(ap, lds, lane, wave, CONV_END1 + nb_, CONV_END2 - (CONV_END1 + nb_), gw, NGW);
          if (layer == 3) conv_range(ap, lds, lane, wave, CONV_END2 + na_ + nb_, CONV_END3 - (CONV_END2 + na_ + nb_), gw, NGW);
          norm_phase((layer == 0) ? ap->in[0] : ap->out, ap->in[4] + (size_t)(layer * 2 + 0) * DM, (const float*)(ws + WS_MOD) + (size_t)(layer * 2 + 0) * 2 * 6144, (bf16*)(ws + WS_HN), lane, gw, NGW); }
        GRID_BAR(); }
        if ((layer & 1) == 0) {
PHASE_REP(2) {
            { FRESH(); pg8::Gemm g{(const bf16*)(ws + WS_HN), (const bf16*)(ws + WS_WABIN) + (size_t)j * AB_IN_PAD * 2048, M, AB_IN_PAD, DM}; pg8::StaticOrder S; S.init(M, AB_IN_PAD, G, bx);
              pg8::EpiInProj E{(float*)(ws + WS_P0), (bf16*)(ws + WS_P0 + 32 * MiB), (bf16*)(ws + WS_P0 + 48 * MiB), (bf16*)(ws + WS_P0 + 56 * MiB), (bf16*)(ws + WS_P0 + 64 * MiB), (bf16*)(ws + WS_P0 + 80 * MiB),
                               (float*)(ws + WS_IG), (float*)(ws + WS_IG + 128 * 1024), 0.08838834764831845f};
              pg8::gemm_phase<pg8::EpiInProj, pg8::StaticOrder, PG8_ALIGN, PG8_SP2>(lds, g, S, E, tid);
              if (G == 256 && bx >= 160) conv_range(ap, lds, lane, wave, (layer == 0 ? CONV_END0 : CONV_END2), CONV_NA, (bx - 160) * NWAVES + wave, 96 * NWAVES); }
            GRID_BAR(); }
PHASE_REP(3) {
            { FRESH(); MixP P; fill_mixp(P, ap, ws, j);
              for (int u = vcu; u < 768; u += G) {
                if (u < 256) MX1M_UNIT(P, lds, tid, u >> 7, (u >> 5) & 3, u & 31);
                else { const int r = u - 256; MX1R_UNIT(P, (const bf16*)(ws + WS_WGT) + (size_t)j * 16 * 16384, lds, tid, r >> 8, (r >> 5) & 7, r & 31); }
            } }
            GRID_BAR(); }
PHASE_REP(4) {
            { FRESH(); MixP P; fill_mixp(P, ap, ws, j); mx2_mlstm(P, lds, tid, vcu * 512 + tid, G * 512); rgl::mx2_carry(P, (float*)(ws + WS_CARRY), vcu * 512 + tid, G * 512); }
            GRID_BAR(); }
PHASE_REP(5) {
            { FRESH(); MixP P; fill_mixp(P, ap, ws, j);
              for (int u = vcu; u < 512; u += G) {
                if (u < 256) MX3M_UNIT(P, lds, tid, u >> 7, (u >> 5) & 3, u & 31);
                else { const int r = u - 256; rgl::mx3_unit(P, (const float*)(ws + WS_CARRY), tid, r >> 7, (r >> 2) & 31, r & 3); }
            } }
            GRID_BAR(); }
        } else {
PHASE_REP(6) {
            { FRESH(); pg8::Gemm g{(const bf16*)(ws + WS_HN), (const bf16*)(ws + WS_WQKV) + (size_t)j * 6144 * 2048, M, 6144, DM}; pg8::StaticOrder S; S.init(M, 6144, G, bx);
              pg8::EpiBf16Split E{(bf16*)(ws + WS_P0), DM, DM, (size_t)M * DM, 0.08838834764831845f * LOG2E};
              pg8::gemm_phase<pg8::EpiBf16Split, pg8::StaticOrder, PG8_ALIGN, PG8_SP2>(lds, g, S, E, tid); }
            GRID_BAR(); }
PHASE_REP(7) {             { FRESH(); sba::attn_phase((const bf16*)(ws + WS_P0), (const bf16*)(ws + WS_P0) + (size_t)M * DM, (const bf16*)(ws + WS_P0) + (size_t)2 * M * DM, (bf16*)(ws + WS_MIX), lds, tid, vcu, G); }
            GRID_BAR(); }
        }
        { FRESH(); const bf16* Bt = ((layer & 1) == 0) ? (const bf16*)(ws + WS_WABOUT) + (size_t)j * 2048 * 2048 : (const bf16*)(ws + WS_WSBO) + (size_t)j * 2048 * 2048;
          pg8::Gemm g{(const bf16*)(ws + WS_MIX), Bt, M, DM, DM}; pg8::StaticOrder S; S.init(M, DM, G, bx);
          pg8::EpiResid E{(layer == 0) ? ap->in[0] : ap->out, ap->out, (const float*)(ws + WS_MOD) + (size_t)(layer * 2 + 0) * 2 * 6144 + 4096};
          pg8::gemm_phase<pg8::EpiResid, pg8::StaticOrder, PG8_ALIGN, PG8_SP2>(lds, g, S, E, tid); }
        GRID_BAR();
PHASE_REP(1) {
        { FRESH(); norm_phase(ap->out, ap->in[4] + (size_t)(layer * 2 + 1) * DM, (const float*)(ws + WS_MOD) + (size_t)(layer * 2 + 1) * 2 * 6144, (bf16*)(ws + WS_HN), lane, gw, NGW); }
        GRID_BAR(); }
PHASE_REP(8) {
        { FRESH(); pg8::Gemm g{(const bf16*)(ws + WS_HN), (const bf16*)(ws + WS_W13) + (size_t)layer * 2 * FF * 2048, M, 2 * FF, DM}; pg8::StaticOrder S; S.init(M, 2 * FF, G, bx);
          pg8::EpiSwiGLU E{(bf16*)(ws + WS_ACT)};
          pg8::gemm_phase<pg8::EpiSwiGLU, pg8::StaticOrder, PG8_ALIGN, PG8_SP2>(lds, g, S, E, tid);
          if (G == 256 && bx >= 128 && layer < 3) conv_range(ap, lds, lane, wave, (layer == 0 ? CONV_END0 + CONV_NA : (layer == 1 ? CONV_END1 : CONV_END2 + CONV_NA)), CONV_NB, (bx - 128) * NWAVES + wave, 128 * NWAVES); }
        GRID_BAR(); }
        { FRESH(); pg8::Gemm g{(const bf16*)(ws + WS_ACT), (const bf16*)(ws + WS_W2) + (size_t)layer * 2048 * FF, M, DM, FF}; pg8::StaticOrder S; S.init(M, DM, G, bx);
          pg8::EpiResid E{ap->out, ap->out, (const float*)(ws + WS_MOD) + (size_t)(layer * 2 + 1) * 2 * 6144 + 4096};
          pg8::gemm_phase<pg8::EpiResid, pg8::StaticOrder, PG8_ALIGN, PG8_SP2>(lds, g, S, E, tid); }
        GRID_BAR();
    }
    { FRESH(); final_norm_phase(ap->out, ap->in[5], ap->out, lane, gw, NGW); }
}

extern "C" void kernel_launch(void* const* d_in, const int* in_sizes, int n_in, void* d_out, int out_size, void* d_ws, size_t ws_size, hipStream_t stream) {
    static int grid = 0;
    if (grid == 0) {
        if (n_in != 20 || in_sizes[0] != M * DM || out_size != M * DM || ws_size < WS_END) { fprintf(stderr, "kernel_launch: unexpected shapes: n_in %d in0 %d out %d ws %zu (need %zu); nothing launched\n", n_in, n_in > 0 ? in_sizes[0] : -1, out_size, ws_size, (size_t)WS_END); grid = -1; return; }
        int dev = 0, cus = 0, per_cu = 0;
        if (hipGetDevice(&dev) != hipSuccess || hipDeviceGetAttribute(&cus, hipDeviceAttributeMultiprocessorCount, dev) != hipSuccess) { fprintf(stderr, "kernel_launch: device query failed\n"); grid = -1; return; }
        if (hipFuncSetAttribute((const void*)fwd_kernel, hipFuncAttributeMaxDynamicSharedMemorySize, LDS_BYTES) != hipSuccess) { fprintf(stderr, "kernel_launch: hipFuncSetAttribute failed\n"); grid = -1; return; }
        if (hipOccupancyMaxActiveBlocksPerMultiprocessor(&per_cu, (const void*)fwd_kernel, NWAVES * 64, LDS_BYTES) != hipSuccess || per_cu < 1)
            fprintf(stderr, "kernel_launch: note: occupancy query reports %d workgroups per CU\n", per_cu);
        (void)hipGetLastError();
        grid = cus;
    }
    if (grid < 0) return;
    if (hipMemsetAsync((char*)d_ws + WS_CTL, 0, CTL_ZERO_BYTES, stream) != hipSuccess) { fprintf(stderr, "kernel_launch: memset failed\n"); return; }
    Args a{};
    for (int i = 0; i < 20; ++i) a.in[i] = (const float*)d_in[i];
    a.out = (float*)d_out; a.ws = (unsigned char*)d_ws;
    hipLaunchKernelGGL(fwd_kernel, dim3(grid), dim3(NWAVES * 64), LDS_BYTES, stream, a);
    const hipError_t le = hipPeekAtLastError();
    if (le != hipSuccess) fprintf(stderr, "kernel_launch: launch failed: %s\n", hipGetErrorName(le));
}
```

```cpp
#define REPMASK 0
#include <hip/hip_runtime.h>
#include <cstdio>
#include <cstdint>

#ifndef CONV_KA_V
#define CONV_KA_V 2
#define CONV_KB_V 2
#endif
constexpr int NWAVES = 8;
constexpr int BATCH = 2, SEQ = 4096, DM = 2048, DEPTH = 4, M = BATCH * SEQ;
constexpr int LRU_W = 1024, NBLK = 8, BW = 128;
constexpr int MLW = 1024, MH = 4, DV = 256, DK = 128, MQK = 512, CH = 128, NCH = SEQ / CH;
constexpr int AB_IN = 5128, AB_IN_PAD = 5376;
constexpr int SBH = 16, SBD = 128;
constexpr int FF = 5632;
constexpr float EPS = 1e-6f;
constexpr float LOG2E = 1.4426950408889634f, LN2 = 0.6931471805599453f;

constexpr size_t MiB = 1u << 20;
constexpr size_t WS_CTL = 0, CTL_ZERO_BYTES = 1 * MiB;
constexpr size_t WS_MOD = 1 * MiB;
constexpr size_t WS_WABIN = 2 * MiB;
constexpr size_t WS_WABOUT = 44 * MiB;
constexpr size_t WS_WQKV = 60 * MiB;
constexpr size_t WS_WSBO = 108 * MiB;
constexpr size_t WS_W13 = 124 * MiB;
constexpr size_t WS_W2 = 300 * MiB;
constexpr size_t WS_HN = 388 * MiB;
constexpr size_t WS_P0 = 420 * MiB;
constexpr size_t WS_IG = 516 * MiB;
constexpr size_t WS_MIX = 517 * MiB;
constexpr size_t WS_ACT = 549 * MiB;
constexpr size_t WS_DC = 637 * MiB;
constexpr size_t WS_CIN = 669 * MiB;
constexpr size_t WS_SMALL = 685 * MiB;
constexpr size_t WS_HLOC = 686 * MiB;
constexpr size_t WS_PCUM = 718 * MiB;
constexpr size_t WS_AGG = 750 * MiB;
constexpr size_t WS_HTMP = 752 * MiB;
constexpr size_t WS_WGT = 784 * MiB;
constexpr size_t WS_CARRY = 785 * MiB;
constexpr size_t WS_X2 = 786 * MiB;
constexpr size_t WS_END = 850 * MiB;
constexpr int CW_BAR = 4096;

constexpr int BIG_BYTES = 147456;
constexpr int MISC_OFF = BIG_BYTES;
constexpr int SM_OFF = BIG_BYTES + 1024;
constexpr int LDS_BYTES = 163840;

namespace pg8 {
#define PG8_LAS __attribute__((address_space(3)))
typedef unsigned short bf16_t;
typedef short bf16x8 __attribute__((ext_vector_type(8)));
typedef float f32x4 __attribute__((ext_vector_type(4)));
typedef unsigned u32x4 __attribute__((ext_vector_type(4)));
constexpr int BM = 256, BK = 64, HALF = 128, HTB = HALF * BK * 2  , STAGE_BYTES = 8 * HTB, NXCD = 8, WGM = 8;

__host__ __device__ __forceinline__ int lds_byte(int r, int c) { const int st = (r >> 4) * 2 + (c >> 5), rr = r & 15, cc = c & 31, ob = rr * 64 + cc * 2; return st * 1024 + (ob ^ (((ob >> 9) & 1) << 5)); }
__host__ __device__ __forceinline__ void stage_rc(int b, int& R, int& C) { const int st = b / 1024, sb = b % 1024, swz = sb ^ (((sb >> 9) & 1) << 5); R = (st >> 1) * 16 + swz / 64; C = (st & 1) * 32 + (swz % 64) / 2; }
__host__ __device__ __forceinline__ int perm32(int rho) { const int n = rho >> 4, i = rho & 15; return 8 * (i >> 2) + 4 * n + (i & 3); }

struct Unit { int pm, pn; };
struct Gemm { const bf16_t* A; const bf16_t* Bt; int M, N, K; };

struct StaticOrder {
    int nM, nN, nwg, G, c;
    __host__ __device__ void init(int M, int N, int G_, int c_) { nM = M / BM; nN = N / BM; nwg = nM * nN; G = G_; c = c_; }
    __host__ __device__ bool next(int i, Unit& u) const {
        const long L = (long)i * G + c; if (L >= nwg) return false;
        int wgid = (int)L; { const int q = nwg / NXCD, r = nwg % NXCD, xcd = wgid % NXCD, off = wgid / NXCD; wgid = (xcd < r ? xcd * (q + 1) : r * (q + 1) + (xcd - r) * q) + off; }
        const int nig = WGM * nN, gid = wgid / nig, fm = gid * WGM, gsz = (nM - fm) < WGM ? (nM - fm) : WGM;
        u.pm = fm + ((wgid % nig) % gsz); u.pn = (wgid % nig) / gsz; return true;
    }
    __device__ __forceinline__ void a_ready(const Unit&) const {}
    __device__ __forceinline__ void done(const Unit&) const {}
};

__device__ __forceinline__ unsigned cvt_pk_bf16(float lo, float hi) { unsigned r; asm volatile("v_cvt_pk_bf16_f32 %0, %1, %2" : "=v"(r) : "v"(lo), "v"(hi)); return r; }
typedef float f32x2 __attribute__((ext_vector_type(2)));
__device__ __forceinline__ u32x4 pack8(f32x4 v0, f32x4 v1) { u32x4 w; w.x = cvt_pk_bf16(v0[0], v0[1]); w.y = cvt_pk_bf16(v0[2], v0[3]); w.z = cvt_pk_bf16(v1[0], v1[1]); w.w = cvt_pk_bf16(v1[2], v1[3]); return w; }

struct EpiBf16Split {
    static constexpr bool PERM = true, AFTER_DRAIN = false;
    bf16_t* O; int ldc; int split_cols; size_t split_stride; float scale0;
    __device__ __forceinline__ void operator()(const f32x4 (&acc)[2][2][4][2], const Unit& u, int wr, int wc, int fr, int fq) const {
        const int row0 = u.pm * BM + wr * 64 + fr; int colt = u.pn * BM; bf16_t* base = O;
        float sc = 1.f; { const int t = colt / split_cols; base += (size_t)t * split_stride; colt -= t * split_cols; if (t == 0) sc = scale0; }
        const int col0 = colt + wc * 32 + 8 * fq;
#pragma unroll
        for (int ai = 0; ai < 2; ++ai)
#pragma unroll
            for (int m = 0; m < 4; ++m) { bf16_t* rowp = base + (size_t)(row0 + ai * HALF + m * 16) * ldc + col0;
#pragma unroll
                for (int bj = 0; bj < 2; ++bj) { *(u32x4*)(rowp + bj * HALF) = pack8(acc[ai][bj][m][0] * sc, acc[ai][bj][m][1] * sc); } }
    }
};

struct EpiResid {
    static constexpr bool PERM = true, AFTER_DRAIN = false;
    const float* basef; const bf16_t* baseh; bf16_t* out; const float* gate0;
    __device__ __forceinline__ void operator()(const f32x4 (&acc)[2][2][4][2], const Unit& u, int wr, int wc, int fr, int fq) const {
        const int row0 = u.pm * BM + wr * 64 + fr, col0 = u.pn * BM + wc * 32 + 8 * fq;
        const float* gp = gate0 + (u.pm >= 16 ? 6144 : 0) + col0;
        f32x4 gv[2][2];
#pragma unroll
        for (int bj = 0; bj < 2; ++bj)
#pragma unroll
            for (int n = 0; n < 2; ++n) gv[bj][n] = *(const f32x4*)(gp + bj * HALF + 4 * n);
        if (basef) {
#pragma unroll
            for (int ai = 0; ai < 2; ++ai)
#pragma unroll
                for (int m = 0; m < 4; ++m) { const size_t off = (size_t)(row0 + ai * HALF + m * 16) * 2048 + col0;
#pragma unroll
                    for (int bj = 0; bj < 2; ++bj) { const f32x4 b0 = *(const f32x4*)(basef + off + bj * HALF), b1 = *(const f32x4*)(basef + off + bj * HALF + 4);
                        *(u32x4*)(out + off + bj * HALF) = pack8(b0 + gv[bj][0] * acc[ai][bj][m][0], b1 + gv[bj][1] * acc[ai][bj][m][1]); }
                    if (m & 1) asm volatile("" ::: "memory"); }
        } else {
#pragma unroll
            for (int ai = 0; ai < 2; ++ai) { u32x4 bv[4][2];
#pragma unroll
                for (int m = 0; m < 4; ++m)
#pragma unroll
                    for (int bj = 0; bj < 2; ++bj) bv[m][bj] = *(const u32x4*)(baseh + (size_t)(row0 + ai * HALF + m * 16) * 2048 + col0 + bj * HALF);
#pragma unroll
                for (int m = 0; m < 4; ++m) { const size_t off = (size_t)(row0 + ai * HALF + m * 16) * 2048 + col0;
#pragma unroll
                    for (int bj = 0; bj < 2; ++bj) { const u32x4 b = bv[m][bj];
                        const f32x4 b0 = {__uint_as_float(b.x << 16), __uint_as_float(b.x & 0xffff0000u), __uint_as_float(b.y << 16), __uint_as_float(b.y & 0xffff0000u)};
                        const f32x4 b1 = {__uint_as_float(b.z << 16), __uint_as_float(b.z & 0xffff0000u), __uint_as_float(b.w << 16), __uint_as_float(b.w & 0xffff0000u)};
                        *(u32x4*)(out + off + bj * HALF) = pack8(b0 + gv[bj][0] * acc[ai][bj][m][0], b1 + gv[bj][1] * acc[ai][bj][m][1]); } }
                asm volatile("" ::: "memory"); }
        }
    }
};

struct EpiSwiGLU {
    static constexpr bool PERM = true, AFTER_DRAIN = false;
    bf16_t* O;
    static __device__ __forceinline__ f32x4 silu_mul(f32x4 a, f32x4 b) { f32x4 r;
#pragma unroll
        for (int i = 0; i < 4; ++i) { const float e = __builtin_amdgcn_exp2f(-a[i] * 1.4426950408889634f); r[i] = a[i] * __builtin_amdgcn_rcpf(1.f + e) * b[i]; }
        return r; }
    __device__ __forceinline__ void operator()(const f32x4 (&acc)[2][2][4][2], const Unit& u, int wr, int wc, int fr, int fq) const {
        const int row0 = u.pm * BM + wr * 64 + fr, col0 = u.pn * HALF + wc * 32 + 8 * fq;
#pragma unroll
        for (int ai = 0; ai < 2; ++ai)
#pragma unroll
            for (int m = 0; m < 4; ++m) { bf16_t* rowp = O + (size_t)(row0 + ai * HALF + m * 16) * 5632 + col0;
                *(u32x4*)rowp = pack8(silu_mul(acc[ai][0][m][0], acc[ai][1][m][0]), silu_mul(acc[ai][0][m][1], acc[ai][1][m][1])); }
    }
};

struct EpiInProj {
    static constexpr bool PERM = true, AFTER_DRAIN = false;
    float* XA; bf16_t *YA, *Qm, *Km, *Vm, *Om; float *IG, *FG; float kscale;
    __device__ __forceinline__ void operator()(const f32x4 (&acc)[2][2][4][2], const Unit& u, int wr, int wc, int fr, int fq) const {
        const int pn = u.pn, row0 = u.pm * BM + wr * 64 + fr, cl = wc * 32 + 8 * fq;
        if (pn < 4) {
#pragma unroll
            for (int ai = 0; ai < 2; ++ai)
#pragma unroll
                for (int m = 0; m < 4; ++m) { float* rp = XA + (size_t)(row0 + ai * HALF + m * 16) * 1024 + pn * 256 + cl;
#pragma unroll
                    for (int bj = 0; bj < 2; ++bj)
#pragma unroll
                        for (int n = 0; n < 2; ++n) *(f32x4*)(rp + bj * HALF + 4 * n) = acc[ai][bj][m][n]; }
        } else if (pn < 20) {
            bf16_t* base; int ld, colt; float sc = 1.f;
            if (pn < 8) { base = YA; ld = 1024; colt = (pn - 4) * 256; }
            else if (pn < 10) { base = Qm; ld = 512; colt = (pn - 8) * 256; }
            else if (pn < 12) { base = Km; ld = 512; colt = (pn - 10) * 256; sc = kscale; }
            else if (pn < 16) { base = Vm; ld = 1024; colt = (pn - 12) * 256; }
            else { base = Om; ld = 1024; colt = (pn - 16) * 256; }
#pragma unroll
            for (int ai = 0; ai < 2; ++ai)
#pragma unroll
                for (int m = 0; m < 4; ++m) { bf16_t* rowp = base + (size_t)(row0 + ai * HALF + m * 16) * ld + colt + cl;
#pragma unroll
                    for (int bj = 0; bj < 2; ++bj) *(u32x4*)(rowp + bj * HALF) = pack8(acc[ai][bj][m][0] * sc, acc[ai][bj][m][1] * sc); }
        } else {
            if (wc == 0 && fq == 0) {
#pragma unroll
                for (int ai = 0; ai < 2; ++ai)
#pragma unroll
                    for (int m = 0; m < 4; ++m) { const size_t r = (size_t)(row0 + ai * HALF + m * 16); *(f32x4*)(IG + r * 4) = acc[ai][0][m][0]; *(f32x4*)(FG + r * 4) = acc[ai][0][m][1]; }
            }
        }
    }
};

template <class Epi, class Sched, bool ALIGN_EPI = false, bool SP2 = false>
__device__ __forceinline__ void gemm_phase(PG8_LAS unsigned char* lds, const Gemm g, const Sched& S, const Epi& E, int tid_in) {
    const int tid = tid_in, wid = __builtin_amdgcn_readfirstlane(tid >> 6), lane = tid & 63, wr = wid >> 2, wc = wid & 3, fr = lane & 15, fq = lane >> 4;
    const int K = g.K, nt = K / BK;
    unsigned voffA[2], voffB[2];
#pragma unroll
    for (int i = 0; i < 2; ++i) { int R, C; stage_rc(tid * 16 + i * 8192, R, C); const int Rb = Epi::PERM ? ((R & ~31) + perm32(R & 31)) : R;
        voffA[i] = (unsigned)(R * K + C) * 2u; voffB[i] = (unsigned)(Rb * K + C) * 2u; }
    const size_t kstep = (size_t)(BK * 2);
    const size_t hstep = (size_t)HALF * K * 2;
    const size_t tstep = 2 * hstep;
    const unsigned ldsw = (unsigned)wid * 1024u;
    const int aoff = lds_byte(wr * 64 + fr, fq * 8), boff = lds_byte(wc * 32 + fr, fq * 8);
#define PG8_SA(b, h) (((b) * 2 + (h)) * HTB)
#define PG8_SB(b, h) ((4 + (b) * 2 + (h)) * HTB)
#define PG8_STAGE(bufoff, gbase, voff) do { _Pragma("unroll") for (int _i = 0; _i < 2; ++_i) \
        __builtin_amdgcn_global_load_lds((const unsigned*)((const char*)(gbase) + (voff)[_i]), (PG8_LAS unsigned*)(lds + (bufoff) + ldsw + _i * 8192), 16, 0, 0); } while (0)
#define PG8_LDA(dst, b, h) do { _Pragma("unroll") for (int m = 0; m < 4; ++m) _Pragma("unroll") for (int k = 0; k < 2; ++k) dst[m][k] = *(const PG8_LAS bf16x8*)(lds + PG8_SA(b, h) + aoff + m * 2048 + k * 1024); } while (0)
#define PG8_LDB(dst, b, h) do { _Pragma("unroll") for (int n = 0; n < 2; ++n) _Pragma("unroll") for (int k = 0; k < 2; ++k) dst[n][k] = *(const PG8_LAS bf16x8*)(lds + PG8_SB(b, h) + boff + n * 2048 + k * 1024); } while (0)
#define PG8_MMA(ai, bj, At, Bt) do { __builtin_amdgcn_s_setprio(1); _Pragma("unroll") for (int m = 0; m < 4; ++m) _Pragma("unroll") for (int n = 0; n < 2; ++n) _Pragma("unroll") for (int k = 0; k < 2; ++k) \
        acc[ai][bj][m][n] = __builtin_amdgcn_mfma_f32_16x16x32_bf16(Bt[n][k], At[m][k], acc[ai][bj][m][n], 0, 0, 0); __builtin_amdgcn_s_setprio(0); } while (0)
#define PG8_WAIT_V(n) asm volatile("s_waitcnt vmcnt(" #n ")" ::: "memory")
#define PG8_WAIT_L(n) asm volatile("s_waitcnt lgkmcnt(" #n ")" ::: "memory")
#define PG8_BAR __builtin_amdgcn_s_barrier()
#define PG8_SCHED __builtin_amdgcn_sched_barrier(0)
    Unit cur, nxt; int ui = 0;
    if (!S.next(0, cur)) return;
    f32x4 acc[2][2][4][2];
#pragma unroll
    for (int a = 0; a < 2; ++a)
#pragma unroll
        for (int b = 0; b < 2; ++b)
#pragma unroll
            for (int m = 0; m < 4; ++m)
#pragma unroll
                for (int n = 0; n < 2; ++n) acc[a][b][m][n] = (f32x4){0.f, 0.f, 0.f, 0.f};
    bf16x8 At[4][2], B0[2][2], B1[2][2];
    const char* cA = (const char*)g.A + (size_t)cur.pm * tstep; const char* cB = (const char*)g.Bt + (size_t)cur.pn * tstep;
    S.a_ready(cur);
    if constexpr (SP2) {
        PG8_STAGE(PG8_SB(0, 0), cB, voffB); PG8_STAGE(PG8_SB(0, 1), cB + hstep, voffB); PG8_STAGE(PG8_SA(0, 0), cA, voffA); PG8_STAGE(PG8_SA(0, 1), cA + hstep, voffA);
        if (wr == 1) PG8_BAR;
        PG8_WAIT_V(2); PG8_BAR;
        PG8_STAGE(PG8_SB(1, 0), cB + kstep, voffB); PG8_STAGE(PG8_SA(1, 0), cA + kstep, voffA); PG8_STAGE(PG8_SB(1, 1), cB + hstep + kstep, voffB);
        PG8_WAIT_V(6); PG8_BAR;
    } else {
        PG8_STAGE(PG8_SB(0, 0), cB, voffB); PG8_STAGE(PG8_SA(0, 0), cA, voffA); PG8_STAGE(PG8_SB(0, 1), cB + hstep, voffB); PG8_STAGE(PG8_SA(0, 1), cA + hstep, voffA);
        if (wr == 1) PG8_BAR;
        PG8_WAIT_V(4); PG8_BAR;
        PG8_STAGE(PG8_SB(1, 0), cB + kstep, voffB); PG8_STAGE(PG8_SA(1, 0), cA + kstep, voffA); PG8_STAGE(PG8_SB(1, 1), cB + hstep + kstep, voffB);
        PG8_WAIT_V(6); PG8_BAR;
    }
    for (;;) {
        const bool has_next = S.next(ui + 1, nxt);
        const char* nA = has_next ? (const char*)g.A + (size_t)nxt.pm * tstep : cA; const char* nB = has_next ? (const char*)g.Bt + (size_t)nxt.pn * tstep : cB;
        for (int t = 0; t < nt; t += 2) {
            const bool last = (t == nt - 2);
            const char* a1 = cA + (size_t)(t + 1) * kstep;
            const char* a2 = last ? nA : cA + (size_t)(t + 2) * kstep; const char* b2 = last ? nB : cB + (size_t)(t + 2) * kstep;
            const char* a3 = a2 + kstep; const char* b3 = b2 + kstep;
            if (last && has_next) S.a_ready(nxt);
            if constexpr (SP2) {
            PG8_LDB(B0, 0, 0); PG8_LDB(B1, 0, 1); PG8_SCHED; PG8_LDA(At, 0, 0); PG8_STAGE(PG8_SA(1, 1), a1 + hstep, voffA);
            PG8_WAIT_V(8); PG8_WAIT_L(0); PG8_BAR; PG8_MMA(0, 0, At, B0); PG8_MMA(0, 1, At, B1); PG8_BAR; PG8_SCHED;
            PG8_LDA(At, 0, 1); PG8_STAGE(PG8_SB(0, 0), b2, voffB); PG8_STAGE(PG8_SB(0, 1), b2 + hstep, voffB); PG8_STAGE(PG8_SA(0, 0), a2, voffA);
            PG8_WAIT_V(8); PG8_WAIT_L(0); PG8_BAR; PG8_MMA(1, 0, At, B0); PG8_MMA(1, 1, At, B1); PG8_BAR; PG8_SCHED;
            PG8_LDB(B0, 1, 0); PG8_LDB(B1, 1, 1); PG8_SCHED; PG8_LDA(At, 1, 0); PG8_STAGE(PG8_SA(0, 1), a2 + hstep, voffA);
            PG8_WAIT_V(8); PG8_WAIT_L(0); PG8_BAR; PG8_MMA(0, 0, At, B0); PG8_MMA(0, 1, At, B1); PG8_BAR; PG8_SCHED;
            PG8_LDA(At, 1, 1); PG8_STAGE(PG8_SB(1, 0), b3, voffB); PG8_STAGE(PG8_SB(1, 1), b3 + hstep, voffB); PG8_STAGE(PG8_SA(1, 0), a3, voffA);
            PG8_WAIT_V(8); PG8_WAIT_L(0); PG8_BAR; PG8_MMA(1, 0, At, B0); PG8_MMA(1, 1, At, B1); PG8_BAR; PG8_SCHED;
            } else {
            PG8_LDB(B0, 0, 0); PG8_SCHED; PG8_LDA(At, 0, 0); PG8_STAGE(PG8_SA(1, 1), a1 + hstep, voffA);
            PG8_WAIT_L(8); PG8_BAR; PG8_WAIT_L(0); PG8_MMA(0, 0, At, B0); PG8_BAR; PG8_SCHED;
            PG8_LDB(B1, 0, 1); PG8_STAGE(PG8_SB(0, 0), b2, voffB);
            PG8_BAR; PG8_WAIT_L(0); PG8_MMA(0, 1, At, B1); PG8_BAR;
            PG8_LDA(At, 0, 1); PG8_STAGE(PG8_SA(0, 0), a2, voffA);
            PG8_BAR; PG8_WAIT_L(0); PG8_MMA(1, 0, At, B0); PG8_BAR; PG8_SCHED;
            PG8_STAGE(PG8_SB(0, 1), b2 + hstep, voffB);
            PG8_WAIT_V(6); PG8_BAR; PG8_MMA(1, 1, At, B1); PG8_BAR;
            PG8_LDB(B0, 1, 0); PG8_SCHED; PG8_LDA(At, 1, 0); PG8_STAGE(PG8_SA(0, 1), a2 + hstep, voffA);
            PG8_WAIT_L(8); PG8_BAR; PG8_WAIT_L(0); PG8_MMA(0, 0, At, B0); PG8_BAR; PG8_SCHED;
            PG8_LDB(B1, 1, 1); PG8_STAGE(PG8_SB(1, 0), b3, voffB);
            PG8_BAR; PG8_WAIT_L(0); PG8_MMA(0, 1, At, B1); PG8_BAR;
            PG8_LDA(At, 1, 1); PG8_STAGE(PG8_SA(1, 0), a3, voffA);
            PG8_BAR; PG8_WAIT_L(0); PG8_MMA(1, 0, At, B0); PG8_BAR; PG8_SCHED;
            PG8_STAGE(PG8_SB(1, 1), b3 + hstep, voffB);
            PG8_WAIT_V(6); PG8_BAR; PG8_MMA(1, 1, At, B1); PG8_BAR;
            }
        }
        if constexpr (ALIGN_EPI) { if (wr == 0) PG8_BAR; }
        if constexpr (!Epi::AFTER_DRAIN) { E(acc, cur, wr, wc, fr, fq); S.done(cur); }
        if (!has_next) break;
#pragma unroll
        for (int a = 0; a < 2; ++a)
#pragma unroll
            for (int b = 0; b < 2; ++b)
#pragma unroll
                for (int m = 0; m < 4; ++m)
#pragma unroll
                    for (int n = 0; n < 2; ++n) acc[a][b][m][n] = (f32x4){0.f, 0.f, 0.f, 0.f};
        cur = nxt; cA = nA; cB = nB; ++ui;
        if constexpr (ALIGN_EPI) { if (wr == 1) PG8_BAR; }
    }
    PG8_WAIT_V(0);
    if constexpr (!ALIGN_EPI) { if (wr == 0) PG8_BAR; }
    PG8_BAR;
    if constexpr (Epi::AFTER_DRAIN) { E.fused(acc, cur, wr, wc, fr, fq, lds, wid, lane); S.done(cur); }
#undef PG8_SA
#undef PG8_SB
#undef PG8_STAGE
#undef PG8_LDA
#undef PG8_LDB
#undef PG8_MMA
#undef PG8_WAIT_V
#undef PG8_WAIT_L
#undef PG8_BAR
#undef PG8_SCHED
}
}
#ifndef PG8_SP2
#define PG8_SP2 true
#endif
#ifndef PG8_ALIGN
#define PG8_ALIGN true
#endif

#define GAS __attribute__((address_space(1)))
#define LAS __attribute__((address_space(3)))
typedef unsigned short bf16;
typedef unsigned v4u __attribute__((ext_vector_type(4)));
typedef unsigned v2u __attribute__((ext_vector_type(2)));
typedef float f32x4 __attribute__((ext_vector_type(4)));
typedef short bf16x8 __attribute__((ext_vector_type(8)));
typedef GAS unsigned gu32;
#define RLX_AGENT __ATOMIC_RELAXED, __HIP_MEMORY_SCOPE_AGENT
#define LDS_WAIT() asm volatile("s_waitcnt lgkmcnt(0)" ::: "memory")
#define VM_WAIT() asm volatile("s_waitcnt vmcnt(0)" ::: "memory")
__device__ __forceinline__ unsigned pk2(float lo, float hi) { return pg8::cvt_pk_bf16(lo, hi); }
__device__ __forceinline__ bf16 f2bf(float x) { return (bf16)(pg8::cvt_pk_bf16(x, 0.f) & 0xffffu); }
__device__ __forceinline__ float bf2f(bf16 b) { return __uint_as_float((unsigned)b << 16); }
__device__ __forceinline__ float bflo(unsigned p) { return __uint_as_float(p << 16); }
__device__ __forceinline__ float bfhi(unsigned p) { return __uint_as_float(p & 0xffff0000u); }
__device__ __forceinline__ float sigmoidf_(float x) { return 1.f / (1.f + __expf(-x)); }
__device__ __forceinline__ float logsigmoidf_(float x) { return fminf(x, 0.f) - log1pf(__expf(-fabsf(x))); }
__device__ __forceinline__ float gelu_tanh(float y) { const float x = 0.7978845608028654f * (y + 0.044715f * y * y * y); const float t = __builtin_amdgcn_exp2f(2.f * LOG2E * x); return 0.5f * y * (2.f - 2.f * __builtin_amdgcn_rcpf(t + 1.f)); }
template <int X> __device__ __forceinline__ float swz_xor(float v) { return __int_as_float(__builtin_amdgcn_ds_swizzle(__float_as_int(v), (X << 10) | 0x1f)); }
__device__ __forceinline__ float xor32(float v) { const unsigned u = __float_as_uint(v); auto rr = __builtin_amdgcn_permlane32_swap(u, u, false, false); const unsigned a = rr[0], b = rr[1]; return __uint_as_float(a ^ b ^ u); }
__device__ __forceinline__ float wave_sum(float v) { v += swz_xor<1>(v); v += swz_xor<2>(v); v += swz_xor<4>(v); v += swz_xor<8>(v); v += swz_xor<16>(v); v += xor32(v); return v; }
__device__ __forceinline__ float wave_max(float v) { v = fmaxf(v, swz_xor<1>(v)); v = fmaxf(v, swz_xor<2>(v)); v = fmaxf(v, swz_xor<4>(v)); v = fmaxf(v, swz_xor<8>(v)); v = fmaxf(v, swz_xor<16>(v)); v = fmaxf(v, xor32(v)); return v; }
__device__ __forceinline__ float lane_up(float x, int off, int lane) { const int src = (lane >= off) ? lane - off : lane; return __int_as_float(__builtin_amdgcn_ds_bpermute(src << 2, __float_as_int(x))); }
__device__ __forceinline__ int fresh_tid(int wave_s) { int l; asm volatile("v_mbcnt_lo_u32_b32 %0, -1, 0\n\tv_mbcnt_hi_u32_b32 %0, -1, %0" : "=v"(l)); int w = wave_s; asm volatile("" : "+s"(w)); int t = w * 64 + l; asm volatile("" : "+v"(t)); return t; }
#define XB_TMO      128
#define XB_XCNT(j)  (256  + 64 * (j))
#define XB_XSUB(j)  (1280 + 64 * (j))
#define XB_XGEN(j)  (2304 + 64 * (j))
#define XB_TOP      3328
#define XB_TOPGEN   3392
#define XCD_BAR_WORDS 3456
#define XB_SPIN_CAP (1u << 18)

__device__ __forceinline__ unsigned xb_ld(unsigned* p)              { return __hip_atomic_load(p, __ATOMIC_RELAXED, __HIP_MEMORY_SCOPE_AGENT); }
__device__ __forceinline__ unsigned xb_add(unsigned* p, unsigned v) { return __hip_atomic_fetch_add(p, v, __ATOMIC_RELAXED, __HIP_MEMORY_SCOPE_AGENT); }
__device__ __forceinline__ unsigned xb_xcc_id() { return (unsigned)__builtin_amdgcn_s_getreg((3 << 11) | 20) & 0xFu; }
#define XB_SPIN(cond, bar) do { unsigned _sp = 0; while (cond) { __builtin_amdgcn_s_sleep(1); \
    if ((++_sp & 255u) == 0u) { if (xb_ld(&(bar)[XB_TMO])) break; if (_sp > XB_SPIN_CAP) { atomicAdd(&(bar)[XB_TMO], 1u); break; } } } } while (0)

struct XcdBarrier {
    unsigned* bar; unsigned x;
    volatile LAS unsigned* st;
};

__device__ __forceinline__ XcdBarrier xcd_barrier_post(unsigned* bar, volatile LAS unsigned* st) {
    XcdBarrier b; b.bar = bar; b.x = xb_xcc_id(); b.st = st;
    if (threadIdx.x == 0) (void)xb_add(&bar[XB_XCNT(b.x)], 1u);
    return b;
}
__device__ __forceinline__ void xcd_barrier_complete(unsigned* bar, unsigned x, unsigned& nloc, unsigned& nx) {
    const unsigned G = gridDim.x * gridDim.y * gridDim.z;
    unsigned sum, cnt, mine, sp = 0u;
    for (;;) {
        sum = 0u; cnt = 0u; mine = 0u;
#pragma unroll
        for (unsigned j = 0; j < 16; ++j) { const unsigned c = xb_ld(&bar[XB_XCNT(j)]); sum += c; cnt += (c > 0u) ? 1u : 0u; mine = (j == x) ? c : mine; }
        if (sum == G) break;
        __builtin_amdgcn_s_sleep(1);
        if ((++sp & 255u) == 0u) { if (xb_ld(&bar[XB_TMO])) break; if (sp > XB_SPIN_CAP) { atomicAdd(&bar[XB_TMO], 1u); break; } }
    }
    nloc = mine > 0u ? mine : 1u; nx = cnt > 0u ? cnt : 1u;
}

__device__ __forceinline__ void xcd_barrier(const XcdBarrier& b) {
    asm volatile("s_waitcnt vmcnt(0)" ::: "memory");
    __syncthreads();
    if (threadIdx.x == 0) {
        unsigned* bar = b.bar;
        __builtin_amdgcn_s_waitcnt(0);
        unsigned nloc = b.st[0], nx = b.st[1];
        if (nloc == 0u) { xcd_barrier_complete(bar, b.x, nloc, nx); b.st[0] = nloc; b.st[1] = nx; }
        const unsigned old = xb_add(&bar[XB_XSUB(b.x)], 1u);
        const unsigned gen = old / nloc;
        if (old + 1u == (gen + 1u) * nloc) {
            __builtin_amdgcn_fence(__ATOMIC_RELEASE, "agent");
            asm volatile("s_waitcnt vmcnt(0)" ::: "memory");
            const unsigned og = xb_add(&bar[XB_TOP], 1u);
            const unsigned tg = og / nx;
            if (og + 1u == (tg + 1u) * nx) xb_add(&bar[XB_TOPGEN], 1u);
            else XB_SPIN(xb_ld(&bar[XB_TOPGEN]) == tg, bar);
            __builtin_amdgcn_fence(__ATOMIC_ACQUIRE, "agent");
            xb_add(&bar[XB_XGEN(b.x)], 1u);
            asm volatile("s_waitcnt vmcnt(0)" ::: "memory");
        } else {
            XB_SPIN(xb_ld(&bar[XB_XGEN(b.x)]) == gen, bar);
            __builtin_amdgcn_fence(__ATOMIC_ACQUIRE, "agent");
            asm volatile("s_waitcnt vmcnt(0)" ::: "memory");
        }
    }
    __syncthreads();
}


struct Args { const float* in[20]; float* out; unsigned char* ws; };
typedef const __attribute__((address_space(4))) Args* KArgs;

constexpr int TSCR = 17408;
__device__ __forceinline__ void transpose_item(const float* W, int K, int N, bf16* WT, int mode, LAS float* scr, int item, int lane) {
    const int nblk = (N + 63) / 64, kb = item / nblk, nb = item % nblk, k0 = 64 * kb, n0 = 64 * nb;
    const int kr = lane >> 4, nq = lane & 15, nn = n0 + 4 * nq; const bool ok = nn < N;
    const float* src = W + (size_t)(k0 + kr) * N + nn;
    f32x4 v[16];
#pragma unroll
    for (int i = 0; i < 16; ++i) v[i] = ok ? *(const GAS f32x4*)(src + (size_t)(4 * i) * N) : (f32x4){0.f, 0.f, 0.f, 0.f};
#pragma unroll
    for (int i = 0; i < 16; ++i) { LAS float* d = scr + (4 * i + kr) * 65 + 4 * nq; d[0] = v[i].x; d[1] = v[i].y; d[2] = v[i].z; d[3] = v[i].w; }
    LDS_WAIT(); asm volatile("" ::: "memory");
    const int c = lane & 7, nr = lane >> 3;
    int r0 = n0; if (mode) r0 = 256 * (n0 >> 7) + (n0 & 127) + (mode == 2 ? 128 : 0);
#pragma unroll
    for (int j = 0; j < 8; ++j) { const int n = nr + 8 * j; const LAS float* s = scr + (8 * c) * 65 + n;
        v4u o; o.x = pk2(s[0 * 65], s[1 * 65]); o.y = pk2(s[2 * 65], s[3 * 65]); o.z = pk2(s[4 * 65], s[5 * 65]); o.w = pk2(s[6 * 65], s[7 * 65]);
        if (n0 + n < N) *(GAS v4u*)(WT + (size_t)(r0 + n) * K + k0 + 8 * c) = o; }
    LDS_WAIT(); asm volatile("" ::: "memory");
}

constexpr int CI_ABIN = 32 * 81, CI_SQ = 32 * 32, CI_QKV = 32 * 96, CI_W1 = 32 * 88, CI_W2 = 88 * 32, CI_WG = 16 * 4;
constexpr int CONV_EVEN = CI_ABIN + CI_WG + CI_SQ + 2 * CI_W1 + CI_W2, CONV_ODD = CI_QKV + CI_SQ + 2 * CI_W1 + CI_W2;
constexpr int CONV_END0 = CONV_EVEN, CONV_END1 = CONV_END0 + CONV_ODD, CONV_END2 = CONV_END1 + CONV_EVEN, CONV_END3 = CONV_END2 + CONV_ODD, CONV_ITEMS = CONV_END3;
__device__ __forceinline__ void conv_item(KArgs args, LAS float* scr, int it, int lane) {
    unsigned char* ws = args->ws;
    int layer = 0, r = it;
    if (r >= CONV_END2) { layer = 3; r -= CONV_END2; } else if (r >= CONV_END1) { layer = 2; r -= CONV_END1; } else if (r >= CONV_END0) { layer = 1; r -= CONV_END0; }
    const int j = layer >> 1;
    if ((layer & 1) == 0) {
        if (r < CI_ABIN) { transpose_item(args->in[9] + (size_t)j * 2048 * AB_IN, 2048, AB_IN, (bf16*)(ws + WS_WABIN) + (size_t)j * AB_IN_PAD * 2048, 0, scr, r, lane); return; } r -= CI_ABIN;
        if (r < CI_WG) { const int mat = j * 16 + (r >> 2); transpose_item(args->in[13] + (size_t)mat * 16384, 128, 128, (bf16*)(ws + WS_WGT) + (size_t)mat * 16384, 0, scr, r & 3, lane); return; } r -= CI_WG;
        if (r < CI_SQ) { transpose_item(args->in[10] + (size_t)j * 2048 * 2048, 2048, 2048, (bf16*)(ws + WS_WABOUT) + (size_t)j * 2048 * 2048, 0, scr, r, lane); return; } r -= CI_SQ;
    } else {
        if (r < CI_QKV) { transpose_item(args->in[18] + (size_t)j * 2048 * 6144, 2048, 6144, (bf16*)(ws + WS_WQKV) + (size_t)j * 6144 * 2048, 0, scr, r, lane); return; } r -= CI_QKV;
        if (r < CI_SQ) { transpose_item(args->in[19] + (size_t)j * 2048 * 2048, 2048, 2048, (bf16*)(ws + WS_WSBO) + (size_t)j * 2048 * 2048, 0, scr, r, lane); return; } r -= CI_SQ;
    }
    if (r < CI_W1) { transpose_item(args->in[6] + (size_t)layer * 2048 * FF, 2048, FF, (bf16*)(ws + WS_W13) + (size_t)layer * 2 * FF * 2048, 1, scr, r, lane); return; } r -= CI_W1;
    if (r < CI_W1) { transpose_item(args->in[7] + (size_t)layer * 2048 * FF, 2048, FF, (bf16*)(ws + WS_W13) + (size_t)layer * 2 * FF * 2048, 2, scr, r, lane); return; } r -= CI_W1;
    transpose_item(args->in[8] + (size_t)layer * FF * 2048, FF, 2048, (bf16*)(ws + WS_W2) + (size_t)layer * 2048 * FF, 0, scr, r, lane);
}
__device__ __forceinline__ void conv_range(KArgs args, LAS unsigned char* lds, int lane, int wave, int first, int count, int widx, int nw) {
    LAS float* scr = (LAS float*)(lds + wave * TSCR);
    for (int i = widx; i < count; i += nw) conv_item(args, scr, first + i, lane);
}
constexpr int CONV_KA = CONV_KA_V, CONV_KB = CONV_KB_V, CONV_NA = 96 * 8 * CONV_KA, CONV_NB = 128 * 8 * CONV_KB;

__device__ __forceinline__ void p0_prologue(KArgs args, LAS unsigned char* lds, int tid, int lane, int wave, int vcu, int G) {
    unsigned char* ws = args->ws;
    const int bx = blockIdx.x;
    if (bx < 192) {
        LAS float* cs = (LAS float*)lds;
        LAS float* red = (LAS float*)(lds + 16384);
        const float* c = args->in[1];
        for (int i = tid; i < 4096; i += 512) { const float v = c[i]; cs[i] = v / (1.f + __expf(-v)); }
        __syncthreads();
        const int mat = bx / 24, cg = bx % 24;
        const float* Wp = args->in[2] + (size_t)mat * 2048 * 6144 + cg * 256 + lane * 4;
        f32x4 a0 = {0.f, 0.f, 0.f, 0.f}, a1 = {0.f, 0.f, 0.f, 0.f};
        const int kbeg = wave * 256;
#pragma unroll 8
        for (int k = kbeg; k < kbeg + 256; ++k) { const f32x4 w = *(const GAS f32x4*)(Wp + (size_t)k * 6144); const float c0 = cs[k], c1 = cs[2048 + k]; a0 += c0 * w; a1 += c1 * w; }
        *(LAS f32x4*)(red + (wave * 2 + 0) * 256 + lane * 4) = a0; *(LAS f32x4*)(red + (wave * 2 + 1) * 256 + lane * 4) = a1;
        __syncthreads();
        { const int b = tid >> 8, col = tid & 255; float s = args->in[3][mat * 6144 + cg * 256 + col];
#pragma unroll
          for (int w = 0; w < 8; ++w) s += red[(w * 2 + b) * 256 + col];
          ((float*)(ws + WS_MOD))[(mat * 2 + b) * 6144 + cg * 256 + col] = s; }
        __syncthreads();
    }
    conv_range(args, lds, lane, wave, 0, CONV_END0, vcu * NWAVES + wave, G * NWAVES);
}

__device__ __forceinline__ void norm_phase(const float* xf, const bf16* xh, const float* g, const float* mod  , bf16* HN, int lane, int gw, int NGW) {
    int curb = -1; f32x4 gs[8], sh[8];
    for (int row = gw; row < M; row += NGW) {
        const int b = row >= SEQ ? 1 : 0;
        if (b != curb) { curb = b;
#pragma unroll
            for (int j = 0; j < 8; ++j) { const int col = 4 * lane + 256 * j; const f32x4 gg = *(const GAS f32x4*)(g + col), sc = *(const GAS f32x4*)(mod + b * 6144 + 2048 + col); gs[j] = gg * (1.f + sc); sh[j] = *(const GAS f32x4*)(mod + b * 6144 + col); } }
        f32x4 v[8]; float ss = 0.f;
        if (xf) { const GAS f32x4* xr = (const GAS f32x4*)(xf + (size_t)row * DM) + lane;
#pragma unroll
            for (int j = 0; j < 8; ++j) v[j] = xr[64 * j]; }
        else { const GAS v2u* xr = (const GAS v2u*)(xh + (size_t)row * DM) + lane;
#pragma unroll
            for (int j = 0; j < 8; ++j) { const v2u w = xr[64 * j]; v[j] = (f32x4){bflo(w.x), bfhi(w.x), bflo(w.y), bfhi(w.y)}; } }
#pragma unroll
        for (int j = 0; j < 8; ++j) ss += (v[j].x * v[j].x + v[j].y * v[j].y) + (v[j].z * v[j].z + v[j].w * v[j].w);
        const float rstd = 1.f / sqrtf(wave_sum(ss) * (1.f / DM) + EPS);
        GAS v2u* o8 = (GAS v2u*)(HN + (size_t)row * DM) + lane;
#pragma unroll
        for (int j = 0; j < 8; ++j) { const f32x4 y = v[j] * rstd * gs[j] + sh[j]; v2u w; w.x = pk2(y.x, y.y); w.y = pk2(y.z, y.w); o8[64 * j] = w; }
    }
}
__device__ __forceinline__ void final_norm_phase(const bf16* xh, const float* g, float* out, int lane, int gw, int NGW) {
    f32x4 gs[8];
#pragma unroll
    for (int j = 0; j < 8; ++j) gs[j] = *(const GAS f32x4*)(g + 4 * lane + 256 * j);
    for (int row = gw; row < M; row += NGW) {
        const GAS v2u* xr = (const GAS v2u*)(xh + (size_t)row * DM) + lane;
        f32x4 v[8]; float ss = 0.f;
#pragma unroll
        for (int j = 0; j < 8; ++j) { const v2u w = xr[64 * j]; v[j] = (f32x4){bflo(w.x), bfhi(w.x), bflo(w.y), bfhi(w.y)}; ss += (v[j].x * v[j].x + v[j].y * v[j].y) + (v[j].z * v[j].z + v[j].w * v[j].w); }
        const float rstd = 1.f / sqrtf(wave_sum(ss) * (1.f / DM) + EPS);
        GAS f32x4* o = (GAS f32x4*)(out + (size_t)row * DM) + lane;
#pragma unroll
        for (int j = 0; j < 8; ++j) o[64 * j] = v[j] * rstd * gs[j];
    }
}

struct MixP {
    const float *XA, *IG, *FG; const bf16 *YA, *Qm, *Km, *Vm, *Om; bf16* MIX;
    const float *conv_w, *conv_b, *gate_w, *gate_b, *lam, *mgb, *mng;
    float *DC, *DN, *NIN, *MLOC, *BLAST, *MIN, *HLOC, *PCUM, *AGGP, *AGGH, *HTMP; bf16* CIN;
};

__device__ __forceinline__ void mx1_rglru_unit(const MixP& P, LAS unsigned char* lds, int tid, int b, int n, int c) {
    LAS float* XC = (LAS float*)lds;
    LAS float* AS = (LAS float*)(lds + 65536);
    const int e = tid & 127, tg = tid >> 7, chn = n * 128 + e;
    const size_t rowbase = (size_t)b * SEQ; const int t0 = c * CH;
    {
        float w[4]; for (int j = 0; j < 4; ++j) w[j] = P.conv_w[j * LRU_W + chn];
        const float cb = P.conv_b[chn];
        for (int i = 0; i < 32; ++i) { const int tt = tg * 32 + i, t = t0 + tt; float acc = cb;
#pragma unroll
            for (int j = 0; j < 4; ++j) { const int ts = t - 3 + j; if (ts >= 0) acc += w[j] * P.XA[(rowbase + ts) * LRU_W + chn]; }
            XC[tt * 128 + e] = acc; }
    }
    __syncthreads();
    float ar[32], ai[32];
    { const float br = P.gate_b[chn], bi = P.gate_b[LRU_W + chn];
#pragma unroll
      for (int i = 0; i < 32; ++i) { ar[i] = br; ai[i] = bi; } }
    { const float* Wr = P.gate_w + ((size_t)(0 * NBLK + n) * 128) * 128 + e; const float* Wi = P.gate_w + ((size_t)(1 * NBLK + n) * 128) * 128 + e;
      for (int d = 0; d < 128; ++d) { const float wr = Wr[d * 128], wi = Wi[d * 128];
#pragma unroll
          for (int i = 0; i < 32; ++i) { const float x = XC[(tg * 32 + i) * 128 + d]; ar[i] += x * wr; ai[i] += x * wi; } } }
    __syncthreads();
    { const float ls = logsigmoidf_(P.lam[chn]);
#pragma unroll
      for (int i = 0; i < 32; ++i) { const int tt = tg * 32 + i; const float r = sigmoidf_(ar[i]), ig = sigmoidf_(ai[i]); const float la = 8.f * r * ls; const float a = __expf(la);
          const float mult = sqrtf(-expm1f(2.f * la)); const float xv = XC[tt * 128 + e]; AS[tt * 128 + e] = a; XC[tt * 128 + e] = mult * (ig * xv); } }
    __syncthreads();
    if (tid < 128) { float h = 0.f, pp = 1.f;
        for (int tt = 0; tt < 128; ++tt) { const float a = AS[tt * 128 + e], u = XC[tt * 128 + e]; h = a * h + u; pp *= a; const size_t o = (rowbase + t0 + tt) * LRU_W + chn; P.HLOC[o] = h; P.PCUM[o] = pp; }
        P.AGGP[(b * NCH + c) * LRU_W + chn] = pp; P.AGGH[(b * NCH + c) * LRU_W + chn] = h; }
    __syncthreads();
}

__device__ __forceinline__ void mx3_rglru_unit(const MixP& P, int tid, int b, int c, int half) {
    const int chn = half * 512 + tid;
    float carry = 0.f;
    for (int c2 = 0; c2 < c; ++c2) carry = P.AGGP[(b * NCH + c2) * LRU_W + chn] * carry + P.AGGH[(b * NCH + c2) * LRU_W + chn];
    for (int tt = 0; tt < CH; ++tt) { const size_t row = (size_t)b * SEQ + c * CH + tt; const float h = P.HLOC[row * LRU_W + chn] + P.PCUM[row * LRU_W + chn] * carry;
        const float y = bf2f(P.YA[row * LRU_W + chn]); P.MIX[row * DM + chn] = f2bf(h * gelu_tanh(y)); }
}

__device__ __forceinline__ void mx1_mlstm_unit(const MixP& P, LAS unsigned char* lds, int tid, int b, int h, int c) {
    LAS bf16* VS = (LAS bf16*)lds;
    LAS float* KS = (LAS float*)(lds + 65536);
    LAS float* sm = (LAS float*)(lds + SM_OFF); LAS float *s_li = sm, *s_lf = sm + 128, *s_bc = sm + 256, *s_g = sm + 384, *s_sc = sm + 768;
    const size_t rowbase = (size_t)b * SEQ + c * CH; const int uidx = (b * MH + h) * NCH + c;
    if (tid < 128) { s_li[tid] = P.IG[(rowbase + tid) * 4 + h] + P.mgb[h]; s_lf[tid] = logsigmoidf_(P.FG[(rowbase + tid) * 4 + h] + P.mgb[MH + h]); }
    __syncthreads();
    if (tid == 0) { float acc = 0.f, G = -INFINITY; for (int s = 0; s < 128; ++s) { acc += s_lf[s]; s_bc[s] = acc; const float g = s_li[s] - acc; s_g[s] = g; G = fmaxf(G, g); } s_sc[0] = G; s_sc[1] = acc; }
    __syncthreads();
    { const float G = s_sc[0]; const int s = tid >> 2, q = tid & 3; const float w = __expf(s_g[s] - G);
      const bf16* vp = P.Vm + (rowbase + s) * MLW + h * DV;
#pragma unroll
      for (int i = 0; i < 8; ++i) { const int ch = q + 4 * i; *(LAS v4u*)(VS + s * 256 + ch * 8) = *(const GAS v4u*)(vp + ch * 8); }
      const bf16* kp = P.Km + (rowbase + s) * MQK + h * DK + q * 32;
#pragma unroll
      for (int i = 0; i < 4; ++i) { const v4u kk = *(const GAS v4u*)(kp + i * 8); LAS float* d = KS + s * 128 + q * 32 + i * 8;
          d[0] = w * bflo(kk.x); d[1] = w * bfhi(kk.x); d[2] = w * bflo(kk.y); d[3] = w * bfhi(kk.y); d[4] = w * bflo(kk.z); d[5] = w * bfhi(kk.z); d[6] = w * bflo(kk.w); d[7] = w * bfhi(kk.w); } }
    __syncthreads();
    { const int d = tid & 127, vg = tid >> 7;
      float* dc = P.DC + ((size_t)uidx * DV + vg * 64) * DK + d;
#pragma unroll 1
      for (int i = 0; i < 64; ++i) { const LAS bf16* vcol = VS + vg * 64 + i; float acc = 0.f;
#pragma unroll 8
          for (int s = 0; s < 128; ++s) acc += KS[s * 128 + d] * bf2f(vcol[s * 256]);
          dc[(size_t)i * DK] = acc; }
      if (tid < 128) { float a = 0.f; for (int s = 0; s < 128; ++s) a += KS[s * 128 + tid]; P.DN[uidx * DK + tid] = a; }
      if (tid == 0) { P.MLOC[uidx] = s_sc[1] + s_sc[0]; P.BLAST[uidx] = s_sc[1]; } }
    __syncthreads();
}

__device__ __forceinline__ void mx2_mlstm(const MixP& P, LAS unsigned char* lds, int tid, int gtid, int NT) {
    LAS float* sm = (LAS float*)(lds + SM_OFF); LAS float *s_dec = sm, *s_scl = sm + 256, *s_min = sm + 512;
    if (tid < 8) { float m = 0.f; for (int k = 0; k < NCH; ++k) { const int u = tid * NCH + k; s_min[u] = m; const float bl = P.BLAST[u], ml = P.MLOC[u]; const float mn = fmaxf(bl + m, ml);
        s_dec[u] = __expf(bl + m - mn); s_scl[u] = __expf(ml - mn); m = mn; } }
    __syncthreads();
    typedef float f32x2v __attribute__((ext_vector_type(2)));
    for (int e2 = gtid; e2 < 8 * DV * DK / 2; e2 += NT) { const int chain = e2 / (DV * DK / 2), idx = (e2 % (DV * DK / 2)) * 2;
        const float* dcp = P.DC + (size_t)chain * NCH * (DV * DK) + idx; bf16* cip = P.CIN + (size_t)chain * NCH * (DV * DK) + idx;
        f32x2v d[NCH];
#pragma unroll
        for (int k = 0; k < NCH; ++k) d[k] = *(const GAS f32x2v*)(dcp + (size_t)k * (DV * DK));
        float c0 = 0.f, c1 = 0.f;
#pragma unroll
        for (int k = 0; k < NCH; ++k) { const int u = chain * NCH + k; *(GAS unsigned*)(cip + (size_t)k * (DV * DK)) = pk2(c0, c1); const float dd = s_dec[u], sc = s_scl[u]; c0 = dd * c0 + sc * d[k].x; c1 = dd * c1 + sc * d[k].y; } }
    if (gtid < 8 * DK) { const int chain = gtid / DK, dd_ = gtid % DK; float nv = 0.f; float dn[NCH];
#pragma unroll
        for (int k = 0; k < NCH; ++k) dn[k] = P.DN[(chain * NCH + k) * DK + dd_];
#pragma unroll
        for (int k = 0; k < NCH; ++k) { const int u = chain * NCH + k; P.NIN[u * DK + dd_] = nv; nv = s_dec[u] * nv + s_scl[u] * dn[k]; } }
    if (gtid < 256) P.MIN[gtid] = s_min[gtid];
    __syncthreads();
}

__device__ __forceinline__ void mx3_mlstm_unit(const MixP& P, LAS unsigned char* lds, int tid, int lane, int wave, int b, int h, int c) {
    constexpr int SS = 129, KSTR = 130;
    LAS float* S = (LAS float*)lds;
    LAS bf16* QS = (LAS bf16*)(lds + 66048);
    LAS bf16* KSb = (LAS bf16*)(lds + 66048 + 32768);
    LAS float* sm = (LAS float*)(lds + SM_OFF); LAS float *s_li = sm, *s_lf = sm + 128, *s_bc = sm + 256, *s_g = sm + 384, *s_M = sm + 512, *s_dn = sm + 640, *s_wi = sm + 768, *s_nin = sm + 896;
    const size_t rowbase = (size_t)b * SEQ + c * CH; const int uidx = (b * MH + h) * NCH + c;
    const float m_in = P.MIN[uidx];
    if (tid < 128) { s_li[tid] = P.IG[(rowbase + tid) * 4 + h] + P.mgb[h]; s_lf[tid] = logsigmoidf_(P.FG[(rowbase + tid) * 4 + h] + P.mgb[MH + h]); s_nin[tid] = P.NIN[uidx * DK + tid]; }
    { const int s = tid >> 2, q = tid & 3;
      const bf16* qp = P.Qm + (rowbase + s) * MQK + h * DK + q * 32; const bf16* kp = P.Km + (rowbase + s) * MQK + h * DK + q * 32;
#pragma unroll
      for (int i = 0; i < 4; ++i) { *(LAS v4u*)(QS + s * 128 + q * 32 + i * 8) = *(const GAS v4u*)(qp + i * 8);
          const v4u kk = *(const GAS v4u*)(kp + i * 8); LAS unsigned* kd = (LAS unsigned*)(KSb + s * KSTR + q * 32 + i * 8); kd[0] = kk.x; kd[1] = kk.y; kd[2] = kk.z; kd[3] = kk.w; } }
    __syncthreads();
    if (tid == 0) { float acc = 0.f, cm = m_in; for (int s = 0; s < 128; ++s) { acc += s_lf[s]; s_bc[s] = acc; const float g = s_li[s] - acc; s_g[s] = g; cm = fmaxf(cm, g); s_M[s] = cm; s_wi[s] = __expf(m_in - cm); } }
    __syncthreads();
    { const int s = tid & 127, tg = tid >> 7;
      const float gs = s_g[s]; const LAS unsigned* krow = (const LAS unsigned*)(KSb + s * KSTR);
#pragma unroll 1
      for (int i = 0; i < 32; ++i) { const int t = tg * 32 + i; float acc = 0.f; const LAS unsigned* qrow = (const LAS unsigned*)(QS + t * 128);
#pragma unroll 8
          for (int d2 = 0; d2 < 64; ++d2) { const unsigned qp = qrow[d2], kp = krow[d2]; acc += bflo(qp) * bflo(kp) + bfhi(qp) * bfhi(kp); }
          S[t * SS + s] = (s <= t) ? acc * __expf(gs - s_M[t]) : 0.f; } }
    __syncthreads();
    if (tid < 128) { const int t = tid; float den = 0.f; for (int s = 0; s < 128; ++s) den += S[t * SS + s];
        float qn = 0.f; for (int d = 0; d < 128; ++d) qn += bf2f(QS[t * 128 + d]) * s_nin[d];
        den += s_wi[t] * qn; const float mt = s_bc[t] + s_M[t]; s_dn[t] = 1.f / fmaxf(fabsf(den), __expf(-mt)); }
    __syncthreads();
    { const int v = tid & 255, tg = tid >> 8;
      const bf16* cp = P.CIN + ((size_t)uidx * DV + v) * DK;
      const bf16* vp = P.Vm + rowbase * MLW + h * DV + v;
      float* ht = P.HTMP + (size_t)uidx * CH * DV;
#pragma unroll 1
      for (int i = 0; i < 64; ++i) { const int t = tg * 64 + i; float acc = 0.f; const LAS unsigned* qrow = (const LAS unsigned*)(QS + t * 128);
#pragma unroll 4
          for (int d2 = 0; d2 < 64; ++d2) { const unsigned qp = qrow[d2]; const unsigned cc = *(const GAS unsigned*)(cp + 2 * d2); acc += bflo(qp) * bflo(cc) + bfhi(qp) * bfhi(cc); }
          acc *= s_wi[t];
          const LAS float* srow = S + t * SS;
#pragma unroll 4
          for (int s = 0; s < 128; ++s) acc += srow[s] * bf2f(*(const GAS bf16*)(vp + (size_t)s * MLW));
          ht[t * DV + v] = acc * s_dn[t]; } }
    __syncthreads();
    const float* HS = P.HTMP + (size_t)uidx * CH * DV;
    for (int i = 0; i < 16; ++i) { const int t = wave * 16 + i; const f32x4 hv = *(const GAS f32x4*)(HS + t * 256 + 4 * lane);
        const float ss = wave_sum((hv.x * hv.x + hv.y * hv.y) + (hv.z * hv.z + hv.w * hv.w)); const float rstd = 1.f / sqrtf(ss * (1.f / DV) + EPS);
        const f32x4 ng = *(const GAS f32x4*)(P.mng + h * DV + 4 * lane); const v2u ob = *(const GAS v2u*)(P.Om + (rowbase + t) * MLW + h * DV + 4 * lane);
        const float o0 = sigmoidf_(bflo(ob.x)), o1 = sigmoidf_(bfhi(ob.x)), o2 = sigmoidf_(bflo(ob.y)), o3 = sigmoidf_(bfhi(ob.y));
        v2u w; w.x = pk2(hv.x * rstd * ng.x * o0, hv.y * rstd * ng.y * o1); w.y = pk2(hv.z * rstd * ng.z * o2, hv.w * rstd * ng.w * o3);
        *(GAS v2u*)(P.MIX + (rowbase + t) * DM + LRU_W + h * DV + 4 * lane) = w; }
    __syncthreads();
}

__device__ __forceinline__ void attn_v1_phase(const bf16* Q, const bf16* K, const bf16* V, bf16* O, LAS unsigned char* lds, int lane, int wave, int gw, int NGW) {
    LAS float* qs = (LAS float*)(lds + wave * 512);
    for (int u = gw; u < BATCH * SBH * SEQ; u += NGW) {
        const int bh = u & 31, t = u >> 5, b = bh >> 4, h = bh & 15;
        const size_t rowbase = (size_t)b * SEQ;
        { const unsigned qp = *(const GAS unsigned*)(Q + (rowbase + t) * DM + h * SBD + 2 * lane); qs[2 * lane] = bflo(qp); qs[2 * lane + 1] = bfhi(qp); }
        LDS_WAIT();
        float o0 = 0.f, o1 = 0.f, carry = 0.f;
        for (int kb = (t - 1) >> 6; kb >= 0 && t > 0; --kb) {
            const int s = kb * 64 + lane; const bool valid = s < t;
            const bf16* kp = K + (rowbase + s) * DM + h * SBD;
            float z = 0.f;
#pragma unroll
            for (int i = 0; i < 16; ++i) { const v4u kk = *(const GAS v4u*)(kp + i * 8); const LAS float* qq = qs + i * 8;
                z += qq[0] * bflo(kk.x) + qq[1] * bfhi(kk.x) + qq[2] * bflo(kk.y) + qq[3] * bfhi(kk.y) + qq[4] * bflo(kk.z) + qq[5] * bfhi(kk.z) + qq[6] * bflo(kk.w) + qq[7] * bfhi(kk.w); }
            const float sp = valid ? (fmaxf(z, 0.f) + __builtin_amdgcn_logf(1.f + __builtin_amdgcn_exp2f(-fabsf(z)))) : 0.f;
            float x = sp;
#pragma unroll
            for (int off = 1; off < 64; off <<= 1) { const float y = __shfl_down(x, off); if (lane + off < 64) x += y; }
            const float R = x + carry; carry += __shfl(x, 0);
            const float A = valid ? __builtin_amdgcn_exp2f(z - R) : 0.f;
            const bf16* vp = V + (rowbase + kb * 64) * DM + h * SBD + 2 * lane;
            for (int l = 0; l < 64; ++l) { const float a = __shfl(A, l); const unsigned pr = *(const GAS unsigned*)(vp + (size_t)l * DM); o0 += a * bflo(pr); o1 += a * bfhi(pr); }
        }
        *(GAS unsigned*)(O + (rowbase + t) * DM + h * SBD + 2 * lane) = pk2(o0, o1);
    }
}

namespace sba {
typedef float f32x16 __attribute__((ext_vector_type(16)));
typedef short v4i16_t __attribute__((ext_vector_type(4)));
typedef float f32x2_t __attribute__((ext_vector_type(2))); typedef __bf16 bf16x2_t __attribute__((ext_vector_type(2)));
__device__ __forceinline__ unsigned cvtpk_s(float lo, float hi) { f32x2_t v = {lo, hi}; bf16x2_t b = __builtin_convertvector(v, bf16x2_t); return __builtin_bit_cast(unsigned, b); }
__device__ __forceinline__ int img_off(int row, int ch) { return 256 * row + 16 * (ch ^ (((row & 3) << 2) | ((row >> 2) & 3))); }
__device__ __forceinline__ v4i16_t vtr(const LAS unsigned char* p) { return __builtin_amdgcn_ds_read_tr16_b64_v4i16((LAS v4i16_t*)p); }

__device__ __forceinline__ void sb_weights(f32x16& p, float& carry, int hi) {
    float w[16];
#pragma unroll
    for (int r = 0; r < 16; ++r) { float zc; asm("v_min_f32_e32 %0, 0x42c80000, %1" : "=v"(zc) : "v"(p[r])); const float e = __builtin_amdgcn_exp2f(zc); p[r] = e; w[r] = __builtin_amdgcn_rcpf(1.f + e); }
    float E[4], Od[4];
#pragma unroll
    for (int m = 0; m < 4; ++m) { w[4 * m + 2] *= w[4 * m + 3]; w[4 * m + 1] *= w[4 * m + 2]; w[4 * m] *= w[4 * m + 1];
        const unsigned tv = __float_as_uint(w[4 * m]); auto rr = __builtin_amdgcn_permlane32_swap(tv, tv, false, false); E[m] = __uint_as_float(rr[0]); Od[m] = __uint_as_float(rr[1]); }
    float SP[4]; SP[3] = carry; SP[2] = SP[3] * (E[3] * Od[3]); SP[1] = SP[2] * (E[2] * Od[2]); SP[0] = SP[1] * (E[1] * Od[1]); carry = SP[0] * (E[0] * Od[0]);
#pragma unroll
    for (int m = 0; m < 4; ++m) { const float off = hi ? SP[m] : SP[m] * Od[m];
#pragma unroll
        for (int i = 0; i < 4; ++i) { const int r = 4 * m + i; p[r] = (p[r] * off) * w[r]; } }
}
__device__ __forceinline__ void sb_mask(f32x16& p, int lim  ) {
#pragma unroll
    for (int r = 0; r < 16; ++r) p[r] = ((r & 3) + 8 * (r >> 2) < lim) ? p[r] : -INFINITY;
}

__device__ __forceinline__ void attn_unit(const bf16* Q, const bf16* K, const bf16* V, bf16* O, LAS unsigned char* lds, int tid, int b, int h, int qb) {
    const int lane = tid & 63, wave = __builtin_amdgcn_readfirstlane(tid >> 6), r32 = lane & 31, hi = lane >> 5;
    const size_t rowbase = (size_t)b * SEQ; const int q0 = qb * 256, Qw = q0 + 32 * wave, t = Qw + r32;
    bf16x8 qf[8];
    { const bf16* qp = Q + (rowbase + t) * DM + h * SBD + hi * 8;
#pragma unroll
      for (int d = 0; d < 8; ++d) qf[d] = *(const GAS bf16x8*)(qp + d * 16); }
    f32x16 o[4];
#pragma unroll
    for (int i = 0; i < 4; ++i)
#pragma unroll
        for (int r = 0; r < 16; ++r) o[i][r] = 0.f;
    float carry = 1.f;
    const int NT = 4 * qb + 4;
    const int sr = tid >> 4, sc = tid & 15;
    const GAS unsigned char* kg = (const GAS unsigned char*)(K + rowbase * DM + h * SBD); const GAS unsigned char* vg = (const GAS unsigned char*)(V + rowbase * DM + h * SBD);
    const unsigned goff = (unsigned)(sr * DM + sc * 8) * 2u;
    const int w0 = img_off(sr, sc), w1 = img_off(sr + 32, sc);
    v4u sk0, sk1, sv0, sv1;
#define SB_LOAD(kt) do { const unsigned o_ = goff + (unsigned)(kt) * (64u * DM * 2u); sk0 = *(const GAS v4u*)(kg + o_); sk1 = *(const GAS v4u*)(kg + o_ + 32u * DM * 2u); sv0 = *(const GAS v4u*)(vg + o_); sv1 = *(const GAS v4u*)(vg + o_ + 32u * DM * 2u); } while (0)
#define SB_WRITE(buf) do { LAS unsigned char* kb_ = lds + (buf) * 16384; LAS unsigned char* vb_ = lds + 32768 + (buf) * 16384; *(LAS v4u*)(kb_ + w0) = sk0; *(LAS v4u*)(kb_ + w1) = sk1; *(LAS v4u*)(vb_ + w0) = sv0; *(LAS v4u*)(vb_ + w1) = sv1; } while (0)
    const int krt = ((r32 & 3) << 2) | ((r32 >> 2) & 3);
    const int i16 = lane & 15, q4 = i16 >> 2, p4 = i16 & 3, gb = (lane >> 4) & 1;
    const int vlow0 = ((2 * gb + (p4 >> 1)) ^ hi), vlow1 = vlow0 ^ 2;
    const int vrow0 = 256 * (4 * hi + q4) + 8 * (p4 & 1);
    const bool lag = wave >= 4;
    bf16x8 af[2][2]; bool have = false; int pvb = 0, vb = 0;
#define SB_AV(VBUF) do { const LAS unsigned char* Vb_ = lds + 32768 + (VBUF) * 16384; __builtin_amdgcn_s_setprio(1); \
        _Pragma("unroll") for (int u = 0; u < 2; ++u) _Pragma("unroll") for (int s = 0; s < 2; ++s) _Pragma("unroll") for (int db = 0; db < 4; ++db) { \
            const int c0 = (((db ^ q4) << 2) | vlow0), c1 = (((db ^ q4) << 2) | vlow1); \
            const v4i16_t lo = vtr(Vb_ + vrow0 + 256 * (32 * u + 16 * s) + 16 * c0), hh = vtr(Vb_ + vrow0 + 256 * (32 * u + 16 * s + 8) + 16 * c1); \
            const bf16x8 vf = {lo[0], lo[1], lo[2], lo[3], hh[0], hh[1], hh[2], hh[3]}; \
            o[db] = __builtin_amdgcn_mfma_f32_32x32x16_bf16(vf, af[u][s], o[db], 0, 0, 0); } __builtin_amdgcn_s_setprio(0); } while (0)
#define SB_WRITE3(kbuf, vbuf) do { LAS unsigned char* kb_ = lds + (kbuf) * 16384; LAS unsigned char* vb_ = lds + 32768 + (vbuf) * 16384; *(LAS v4u*)(kb_ + w0) = sk0; *(LAS v4u*)(kb_ + w1) = sk1; *(LAS v4u*)(vb_ + w0) = sv0; *(LAS v4u*)(vb_ + w1) = sv1; } while (0)
#define SB_LOADS(S, kt) do { const unsigned o_ = goff + (unsigned)(kt) * (64u * DM * 2u); S##k0 = *(const GAS v4u*)(kg + o_); S##k1 = *(const GAS v4u*)(kg + o_ + 32u * DM * 2u); S##v0 = *(const GAS v4u*)(vg + o_); S##v1 = *(const GAS v4u*)(vg + o_ + 32u * DM * 2u); } while (0)
#define SB_WRITES(S, kbuf, vbuf) do { LAS unsigned char* kb_ = lds + (kbuf) * 16384; LAS unsigned char* vb_ = lds + 32768 + (vbuf) * 16384; *(LAS v4u*)(kb_ + w0) = S##k0; *(LAS v4u*)(kb_ + w1) = S##k1; *(LAS v4u*)(vb_ + w0) = S##v0; *(LAS v4u*)(vb_ + w1) = S##v1; } while (0)
#define SB_PACK(P, u) do { _Pragma("unroll") for (int s = 0; s < 2; ++s) { v4u aw; aw.x = cvtpk_s(P[8 * s], P[8 * s + 1]); aw.y = cvtpk_s(P[8 * s + 2], P[8 * s + 3]); aw.z = cvtpk_s(P[8 * s + 4], P[8 * s + 5]); aw.w = cvtpk_s(P[8 * s + 6], P[8 * s + 7]); af[u][s] = __builtin_bit_cast(bf16x8, aw); } } while (0)
#define SB_STEP(S, it) do { \
        const int kt = NT - 1 - (it), buf = (it) & 1, key0 = kt * 64; \
        const bool skip = key0 >= Qw + 31, full = key0 + 63 < Qw; \
        if (lag && have) { SB_AV(pvb); __builtin_amdgcn_sched_barrier(0); } \
        have = false; \
        if (!skip) { \
            const LAS unsigned char* Kb = lds + buf * 16384; \
            f32x16 p0, p1; \
            _Pragma("unroll") for (int r = 0; r < 16; ++r) { p0[r] = 0.f; p1[r] = 0.f; } __builtin_amdgcn_s_setprio(1); \
            _Pragma("unroll") for (int d = 0; d < 8; ++d) { const int off = 256 * r32 + 16 * ((2 * d + hi) ^ krt); \
                const bf16x8 k0 = *(const LAS bf16x8*)(Kb + off), k1 = *(const LAS bf16x8*)(Kb + off + 8192); \
                p0 = __builtin_amdgcn_mfma_f32_32x32x16_bf16(k0, qf[d], p0, 0, 0, 0); p1 = __builtin_amdgcn_mfma_f32_32x32x16_bf16(k1, qf[d], p1, 0, 0, 0); } __builtin_amdgcn_s_setprio(0); \
            if (!full) { sb_mask(p1, t - key0 - 32 - 4 * hi); sb_mask(p0, t - key0 - 4 * hi); } \
            sb_weights(p1, carry, hi); SB_PACK(p1, 1); __builtin_amdgcn_sched_barrier(0); sb_weights(p0, carry, hi); SB_PACK(p0, 0); \
            __builtin_amdgcn_sched_barrier(0); \
            have = true; \
            if (!lag) { SB_AV(vb); have = false; } \
        } \
        pvb = vb; vb = (vb == 2) ? 0 : vb + 1; \
        if ((it) + 1 < NT) SB_WRITES(S, buf ^ 1, vb); \
        if ((it) + 3 < NT) SB_LOADS(S, kt - 3); \
        __syncthreads(); } while (0)
    v4u sAk0, sAk1, sAv0, sAv1, sBk0, sBk1, sBv0, sBv1;
    SB_LOADS(sA, NT - 1); SB_WRITES(sA, 0, 0); SB_LOADS(sA, NT - 2); SB_LOADS(sB, NT - 3); __syncthreads();
    for (int it = 0; it < NT; it += 2) { SB_STEP(sA, it); SB_STEP(sB, it + 1); }
#undef SB_STEP
#undef SB_PACK
#undef SB_LOADS
#undef SB_WRITES
    if (lag && have) SB_AV(pvb);
    __syncthreads();
#undef SB_AV
#undef SB_WRITE3
#undef SB_LOAD
#undef SB_WRITE
    bf16* op = O + (rowbase + t) * DM + h * SBD + 4 * hi;
#pragma unroll
    for (int db = 0; db < 4; ++db)
#pragma unroll
        for (int g = 0; g < 4; ++g) { v2u w; w.x = cvtpk_s(o[db][4 * g], o[db][4 * g + 1]); w.y = cvtpk_s(o[db][4 * g + 2], o[db][4 * g + 3]); *(GAS v2u*)(op + 32 * db + 8 * g) = w; }
}

__device__ __forceinline__ void attn_phase(const bf16* Q, const bf16* K, const bf16* V, bf16* O, LAS unsigned char* lds, int tid, int vcu, int G) {
    for (int pi = vcu; pi < 256; pi += G) {
        const int bh = pi >> 3, x = pi & 7;
#pragma unroll 1
        for (int uu = 0; uu < 2; ++uu) attn_unit(Q, K, V, O, lds, tid, bh >> 4, bh & 15, uu ? x : 15 - x);
    }
}
}

namespace mls {
using sba::f32x16; using sba::v4i16_t; using sba::cvtpk_s; using sba::img_off; using sba::vtr;
__device__ __forceinline__ float half_sum(float x) { const unsigned u = __float_as_uint(x); auto rr = __builtin_amdgcn_permlane32_swap(u, u, false, false); return __uint_as_float(rr[0]) + __uint_as_float(rr[1]); }

__device__ __forceinline__ void stage_v(const bf16* Vm, size_t rowbase, int h, LAS unsigned char* lds, int tid) {
    const int c32 = tid & 31; const bf16* vp = Vm + rowbase * MLW + h * DV + c32 * 8;
#pragma unroll
    for (int k = 0; k < 8; ++k) { const int row = (tid >> 5) + 16 * k; const v4u x = *(const GAS v4u*)(vp + (size_t)row * MLW); *(LAS v4u*)(lds + (c32 >> 4) * 32768 + img_off(row, c32 & 15)) = x; }
}
__device__ __forceinline__ void gate_scan(const MixP& P, size_t rowbase, int h, int lane, float& bc0, float& bc1, float& g0, float& g1) {
    const float li0 = P.IG[(rowbase + 2 * lane) * 4 + h] + P.mgb[h], li1 = P.IG[(rowbase + 2 * lane + 1) * 4 + h] + P.mgb[h];
    const float lf0 = logsigmoidf_(P.FG[(rowbase + 2 * lane) * 4 + h] + P.mgb[MH + h]), lf1 = logsigmoidf_(P.FG[(rowbase + 2 * lane + 1) * 4 + h] + P.mgb[MH + h]);
    const float ps = lf0 + lf1; float x = ps;
#pragma unroll
    for (int off = 1; off < 64; off <<= 1) { const float y = lane_up(x, off, lane); if (lane >= off) x += y; }
    bc0 = (x - ps) + lf0; bc1 = bc0 + lf1; g0 = li0 - bc0; g1 = li1 - bc1;
}

__device__ __forceinline__ void mx1_unit(const MixP& P, LAS unsigned char* lds, int tid, int b, int h, int c) {
    const int lane = tid & 63, wave = __builtin_amdgcn_readfirstlane(tid >> 6), r32 = lane & 31, hi = lane >> 5;
    LAS float* sm = (LAS float*)(lds + SM_OFF); LAS float *s_w = sm, *s_sc = sm + 128;
    const size_t rowbase = (size_t)b * SEQ + c * CH; const int uidx = (b * MH + h) * NCH + c;
    stage_v(P.Vm, rowbase, h, lds, tid);
    if (wave == 0) { float bc0, bc1, g0, g1; gate_scan(P, rowbase, h, lane, bc0, bc1, g0, g1);
        const float G = wave_max(fmaxf(g0, g1));
        s_w[2 * lane] = __expf(g0 - G); s_w[2 * lane + 1] = __expf(g1 - G);
        const float bl = __int_as_float(__builtin_amdgcn_readlane(__float_as_int(bc1), 63)); if (lane == 0) { s_sc[0] = G; s_sc[1] = bl; } }
    __syncthreads();
    { const int row = tid >> 2, q = tid & 3; const float w = s_w[row]; const bf16* kp = P.Km + (rowbase + row) * MQK + h * DK + q * 32;
#pragma unroll
      for (int i = 0; i < 4; ++i) { const v4u kk = *(const GAS v4u*)(kp + i * 8); v4u o;
          o.x = cvtpk_s(w * bflo(kk.x), w * bfhi(kk.x)); o.y = cvtpk_s(w * bflo(kk.y), w * bfhi(kk.y)); o.z = cvtpk_s(w * bflo(kk.z), w * bfhi(kk.z)); o.w = cvtpk_s(w * bflo(kk.w), w * bfhi(kk.w));
          *(LAS v4u*)(lds + 65536 + img_off(row, 4 * q + i)) = o; } }
    __syncthreads();
    f32x16 acc[4], accn[4];
#pragma unroll
    for (int i = 0; i < 4; ++i)
#pragma unroll
        for (int r = 0; r < 16; ++r) { acc[i][r] = 0.f; accn[i][r] = 0.f; }
    const int i16 = lane & 15, q4 = i16 >> 2, p4 = i16 & 3, gb = (lane >> 4) & 1;
    const int lowb = 2 * gb + (p4 >> 1);
    const int rowb = 256 * (8 * hi + q4) + 8 * (p4 & 1);
    const LAS unsigned char* Vb = lds + (wave >> 2) * 32768; const LAS unsigned char* Kb = lds + 65536;
    const int vdb = wave & 3;
    const bf16x8 ones = {0x3F80, 0x3F80, 0x3F80, 0x3F80, 0x3F80, 0x3F80, 0x3F80, 0x3F80};
#pragma unroll
    for (int ks = 0; ks < 8; ++ks) {
        const int lw0 = lowb ^ (2 * hi), lw1 = lowb ^ (2 * hi + 1);
        const v4i16_t vl = vtr(Vb + rowb + 256 * (16 * ks) + 16 * (((vdb ^ q4) << 2) | lw0)), vh2 = vtr(Vb + rowb + 256 * (16 * ks + 4) + 16 * (((vdb ^ q4) << 2) | lw1));
        const bf16x8 vf = {vl[0], vl[1], vl[2], vl[3], vh2[0], vh2[1], vh2[2], vh2[3]};
#pragma unroll
        for (int db = 0; db < 4; ++db) {
            const v4i16_t kl = vtr(Kb + rowb + 256 * (16 * ks) + 16 * (((db ^ q4) << 2) | lw0)), kh = vtr(Kb + rowb + 256 * (16 * ks + 4) + 16 * (((db ^ q4) << 2) | lw1));
            const bf16x8 kf = {kl[0], kl[1], kl[2], kl[3], kh[0], kh[1], kh[2], kh[3]};
            acc[db] = __builtin_amdgcn_mfma_f32_32x32x16_bf16(vf, kf, acc[db], 0, 0, 0);
            if (wave == 0) accn[db] = __builtin_amdgcn_mfma_f32_32x32x16_bf16(ones, kf, accn[db], 0, 0, 0);
        }
    }
    float* dc = P.DC + ((size_t)uidx * DV + 32 * wave) * DK + r32;
#pragma unroll
    for (int db = 0; db < 4; ++db)
#pragma unroll
        for (int r = 0; r < 16; ++r) dc[(size_t)((r & 3) + 8 * (r >> 2) + 4 * hi) * DK + 32 * db] = acc[db][r];
    if (wave == 0 && hi == 0) {
#pragma unroll
        for (int db = 0; db < 4; ++db) P.DN[uidx * DK + 32 * db + r32] = accn[db][0]; }
    if (tid == 0) { P.MLOC[uidx] = s_sc[1] + s_sc[0]; P.BLAST[uidx] = s_sc[1]; }
    __syncthreads();
}

__device__ __forceinline__ void mx3_unit(const MixP& P, LAS unsigned char* lds, int tid, int b, int h, int c) {
    const int lane = tid & 63, wave = __builtin_amdgcn_readfirstlane(tid >> 6), r32 = lane & 31, hi = lane >> 5;
    const int qb = wave & 3, vh = wave >> 2;
    LAS float* sm = (LAS float*)(lds + SM_OFF); LAS float *s_g2 = sm, *s_M2 = sm + 128, *s_bc = sm + 256, *s_nin = sm + 384, *s_part = sm + 512;
    const size_t rowbase = (size_t)b * SEQ + c * CH; const int uidx = (b * MH + h) * NCH + c;
    const float m_in = P.MIN[uidx];
    stage_v(P.Vm, rowbase, h, lds, tid);
    if (wave == 0) { float bc0, bc1, g0, g1; gate_scan(P, rowbase, h, lane, bc0, bc1, g0, g1);
        float y = fmaxf(g0, g1);
#pragma unroll
        for (int off = 1; off < 64; off <<= 1) { const float z = lane_up(y, off, lane); if (lane >= off) y = fmaxf(y, z); }
        float ex = lane_up(y, 1, lane); if (lane == 0) ex = -INFINITY;
        const float M0 = fmaxf(m_in, fmaxf(ex, g0)), M1 = fmaxf(m_in, y);
        s_g2[2 * lane] = g0 * LOG2E; s_g2[2 * lane + 1] = g1 * LOG2E; s_M2[2 * lane] = M0 * LOG2E; s_M2[2 * lane + 1] = M1 * LOG2E; s_bc[2 * lane] = bc0; s_bc[2 * lane + 1] = bc1; }
    if (wave == 1) { s_nin[lane] = P.NIN[uidx * DK + lane]; s_nin[64 + lane] = P.NIN[uidx * DK + 64 + lane]; }
    const int t = 32 * qb + r32;
    bf16x8 qf[8];
    { const bf16* qp = P.Qm + (rowbase + t) * MQK + h * DK + hi * 8;
#pragma unroll
      for (int d = 0; d < 8; ++d) qf[d] = *(const GAS bf16x8*)(qp + d * 16); }
    __syncthreads();
    const float M2 = s_M2[t], bct = s_bc[t];
    const float wint = __builtin_amdgcn_exp2f(m_in * LOG2E - M2);
    f32x16 acc[4];
#pragma unroll
    for (int i = 0; i < 4; ++i)
#pragma unroll
        for (int r = 0; r < 16; ++r) acc[i][r] = 0.f;
    { const bf16* cp = P.CIN + ((size_t)uidx * DV + 128 * vh + r32) * DK + hi * 8;
#pragma unroll
      for (int vb = 0; vb < 4; ++vb)
#pragma unroll
          for (int d = 0; d < 8; ++d) { const bf16x8 cf = *(const GAS bf16x8*)(cp + (size_t)(32 * vb) * DK + d * 16); acc[vb] = __builtin_amdgcn_mfma_f32_32x32x16_bf16(cf, qf[d], acc[vb], 0, 0, 0); } }
#pragma unroll
    for (int i = 0; i < 4; ++i)
#pragma unroll
        for (int r = 0; r < 16; ++r) acc[i][r] *= wint;
    float qn = 0.f;
#pragma unroll
    for (int d = 0; d < 8; ++d)
#pragma unroll
        for (int j = 0; j < 8; ++j) qn += bf2f((bf16)qf[d][j]) * s_nin[16 * d + 8 * hi + j];
    float den = wint * half_sum(qn), dpart = 0.f;
    const int i16 = lane & 15, q4 = i16 >> 2, p4 = i16 & 3, gb = (lane >> 4) & 1;
    const int vlow0 = ((2 * gb + (p4 >> 1)) ^ hi), vlow1 = vlow0 ^ 2;
    const int vrow0 = 256 * (4 * hi + q4) + 8 * (p4 & 1);
    const LAS unsigned char* Vb = lds + vh * 32768;
    for (int kb = 0; kb <= qb; ++kb) {
        f32x16 p;
#pragma unroll
        for (int r = 0; r < 16; ++r) p[r] = 0.f;
        { const bf16* kp = P.Km + (rowbase + 32 * kb + r32) * MQK + h * DK + hi * 8;
#pragma unroll
          for (int d = 0; d < 8; ++d) { const bf16x8 kf = *(const GAS bf16x8*)(kp + d * 16); p = __builtin_amdgcn_mfma_f32_32x32x16_bf16(kf, qf[d], p, 0, 0, 0); } }
#pragma unroll
        for (int m = 0; m < 4; ++m) { const f32x4 gq = *(const LAS f32x4*)(s_g2 + 32 * kb + 8 * m + 4 * hi);
#pragma unroll
            for (int i = 0; i < 4; ++i) { const int r = 4 * m + i; float w = __builtin_amdgcn_exp2f(gq[i] - M2); if (kb == qb) w = (8 * m + 4 * hi + i <= r32) ? w : 0.f; p[r] *= w; dpart += p[r]; } }
        bf16x8 af[2];
#pragma unroll
        for (int s = 0; s < 2; ++s) { v4u aw; aw.x = cvtpk_s(p[8 * s], p[8 * s + 1]); aw.y = cvtpk_s(p[8 * s + 2], p[8 * s + 3]); aw.z = cvtpk_s(p[8 * s + 4], p[8 * s + 5]); aw.w = cvtpk_s(p[8 * s + 6], p[8 * s + 7]); af[s] = __builtin_bit_cast(bf16x8, aw); }
        const LAS unsigned char* Vk = Vb + 256 * 32 * kb;
#pragma unroll
        for (int s = 0; s < 2; ++s)
#pragma unroll
            for (int vb = 0; vb < 4; ++vb) {
                const int c0 = (((vb ^ q4) << 2) | vlow0), c1 = (((vb ^ q4) << 2) | vlow1);
                const v4i16_t lo = vtr(Vk + vrow0 + 256 * (16 * s) + 16 * c0), hh = vtr(Vk + vrow0 + 256 * (16 * s + 8) + 16 * c1);
                const bf16x8 vf = {lo[0], lo[1], lo[2], lo[3], hh[0], hh[1], hh[2], hh[3]};
                acc[vb] = __builtin_amdgcn_mfma_f32_32x32x16_bf16(vf, af[s], acc[vb], 0, 0, 0);
            }
    }
    den += half_sum(dpart);
    const float mt = bct + M2 * LN2;
    const float scl = 1.f / fmaxf(fabsf(den), __expf(-mt));
    float ss = 0.f;
#pragma unroll
    for (int i = 0; i < 4; ++i)
#pragma unroll
        for (int r = 0; r < 16; ++r) { acc[i][r] *= scl; ss += acc[i][r] * acc[i][r]; }
    ss = half_sum(ss);
    if (hi == 0) s_part[wave * 32 + r32] = ss;
    __syncthreads();
    const float tot = s_part[qb * 32 + r32] + s_part[(4 + qb) * 32 + r32];
    const float rstd = 1.f / sqrtf(tot * (1.f / DV) + EPS);
    { const int vbase = h * DV + 128 * vh + 4 * hi;
      const bf16* op = P.Om + (rowbase + t) * MLW + vbase; bf16* mp = P.MIX + (rowbase + t) * DM + LRU_W + vbase; const float* ng = P.mng + vbase;
#pragma unroll
      for (int vb = 0; vb < 4; ++vb)
#pragma unroll
          for (int g = 0; g < 4; ++g) { const int vo = 32 * vb + 8 * g; const f32x4 n4 = *(const GAS f32x4*)(ng + vo); const v2u ob = *(const GAS v2u*)(op + vo);
              const float o0 = sigmoidf_(bflo(ob.x)), o1 = sigmoidf_(bfhi(ob.x)), o2 = sigmoidf_(bflo(ob.y)), o3 = sigmoidf_(bfhi(ob.y));
              v2u w; w.x = cvtpk_s(acc[vb][4 * g] * rstd * n4.x * o0, acc[vb][4 * g + 1] * rstd * n4.y * o1); w.y = cvtpk_s(acc[vb][4 * g + 2] * rstd * n4.z * o2, acc[vb][4 * g + 3] * rstd * n4.w * o3);
              *(GAS v2u*)(mp + vo) = w; } }
    __syncthreads();
}
}

namespace rgl {
using sba::f32x16; using sba::img_off;
__device__ __forceinline__ float sig_fast(float x) { return __builtin_amdgcn_rcpf(1.f + __builtin_amdgcn_exp2f(-LOG2E * x)); }
__device__ __forceinline__ void swap_pair(float x, float& ev, float& od) { const unsigned u = __float_as_uint(x); auto rr = __builtin_amdgcn_permlane32_swap(u, u, false, false); ev = __uint_as_float(rr[0]); od = __uint_as_float(rr[1]); }

__device__ __forceinline__ void mx1_unit(const MixP& P, const bf16* WGT  , LAS unsigned char* lds, int tid, int b, int n, int c) {
    const int lane = tid & 63, wave = __builtin_amdgcn_readfirstlane(tid >> 6), r32 = lane & 31, hi = lane >> 5;
    LAS float* XC = (LAS float*)lds;
    LAS unsigned char* XB = lds + 65536;
    LAS float* s_agg = (LAS float*)(lds + SM_OFF);
    const size_t rowbase = (size_t)b * SEQ; const int t0 = c * CH;
    {
        const int e = tid & 127, tg = tid >> 7, chn = n * 128 + e;
        const float w0 = P.conv_w[chn], w1 = P.conv_w[LRU_W + chn], w2 = P.conv_w[2 * LRU_W + chn], w3 = P.conv_w[3 * LRU_W + chn], cb = P.conv_b[chn];
        const int ts = t0 + tg * 32; const float* xp = P.XA + (rowbase + ts) * LRU_W + chn;
        float x0 = (ts >= 3) ? xp[-3 * LRU_W] : 0.f, x1 = (ts >= 2) ? xp[-2 * LRU_W] : 0.f, x2 = (ts >= 1) ? xp[-1 * LRU_W] : 0.f;
        LAS unsigned char* xb = XB + 2 * (e & 7);
#pragma unroll 8
        for (int i = 0; i < 32; ++i) { const float x3 = xp[(size_t)i * LRU_W]; const float y = cb + w0 * x0 + w1 * x1 + w2 * x2 + w3 * x3; x0 = x1; x1 = x2; x2 = x3;
            const int tt = tg * 32 + i; XC[tt * 128 + e] = y; *(LAS bf16*)(xb + img_off(tt, e >> 3)) = f2bf(y); }
    }
    __syncthreads();
    const int tb = wave & 3, eh = wave >> 2;
    f32x16 ar[2], ai[2];
#pragma unroll
    for (int i = 0; i < 2; ++i)
#pragma unroll
        for (int r = 0; r < 16; ++r) { ar[i][r] = 0.f; ai[i][r] = 0.f; }
    { const int krt = ((r32 & 3) << 2) | ((r32 >> 2) & 3);
      const bf16* wr = WGT + ((size_t)(0 * NBLK + n) * 128 + 64 * eh + r32) * 128 + hi * 8; const bf16* wi = WGT + ((size_t)(1 * NBLK + n) * 128 + 64 * eh + r32) * 128 + hi * 8;
#pragma unroll
      for (int d = 0; d < 8; ++d) { const bf16x8 xf = *(const LAS bf16x8*)(XB + 256 * (32 * tb + r32) + 16 * ((2 * d + hi) ^ krt));
#pragma unroll
          for (int eb = 0; eb < 2; ++eb) { const bf16x8 fr = *(const GAS bf16x8*)(wr + (size_t)(32 * eb) * 128 + d * 16), fi = *(const GAS bf16x8*)(wi + (size_t)(32 * eb) * 128 + d * 16);
              ar[eb] = __builtin_amdgcn_mfma_f32_32x32x16_bf16(xf, fr, ar[eb], 0, 0, 0); ai[eb] = __builtin_amdgcn_mfma_f32_32x32x16_bf16(xf, fi, ai[eb], 0, 0, 0); } } }
    float BA[2], BH[2];
#pragma unroll
    for (int eb = 0; eb < 2; ++eb) {
        const int e = 64 * eh + 32 * eb + r32, chn = n * 128 + e;
        const float br = P.gate_b[chn], bi = P.gate_b[LRU_W + chn], ls8 = 8.f * LOG2E * logsigmoidf_(P.lam[chn]);
        float qa[4], qh[4];
#pragma unroll
        for (int m = 0; m < 4; ++m) { float A = 1.f, H = 0.f;
#pragma unroll
            for (int i = 0; i < 4; ++i) { const int r = 4 * m + i, tt = 32 * tb + 8 * m + 4 * hi + i;
                const float rg = sig_fast(ar[eb][r] + br), ig = sig_fast(ai[eb][r] + bi); const float a = __builtin_amdgcn_exp2f(rg * ls8); const float mult = __builtin_amdgcn_sqrtf(fmaxf(1.f - a * a, 0.f));
                const float u = mult * (ig * XC[tt * 128 + e]); H = a * H + u; A = A * a; ar[eb][r] = H; ai[eb][r] = A; }
            qa[m] = A; qh[m] = H; }
        float PA = 1.f, PH = 0.f;
#pragma unroll
        for (int m = 0; m < 4; ++m) { float ea, oa, eh_, oh; swap_pair(qa[m], ea, oa); swap_pair(qh[m], eh_, oh);
            const float pa_odd = ea * PA, ph_odd = ea * PH + eh_;
            const float ma = hi ? pa_odd : PA, mh = hi ? ph_odd : PH;
#pragma unroll
            for (int i = 0; i < 4; ++i) { const int r = 4 * m + i; ar[eb][r] += ai[eb][r] * mh; ai[eb][r] *= ma; }
            PA = oa * pa_odd; PH = oa * ph_odd + oh; }
        BA[eb] = PA; BH[eb] = PH;
        if (hi == 0) { s_agg[(tb * 128 + e) * 2] = PA; s_agg[(tb * 128 + e) * 2 + 1] = PH; }
    }
    __syncthreads();
#pragma unroll
    for (int eb = 0; eb < 2; ++eb) {
        const int e = 64 * eh + 32 * eb + r32, chn = n * 128 + e;
        float CA = 1.f, CHh = 0.f;
        for (int t2 = 0; t2 < tb; ++t2) { const float a = s_agg[(t2 * 128 + e) * 2], h = s_agg[(t2 * 128 + e) * 2 + 1]; CHh = a * CHh + h; CA = CA * a; }
#pragma unroll
        for (int r = 0; r < 16; ++r) { const int tt = 32 * tb + (r & 3) + 8 * (r >> 2) + 4 * hi; const size_t o = (rowbase + t0 + tt) * LRU_W + chn;
            P.HLOC[o] = ar[eb][r] + ai[eb][r] * CHh; P.PCUM[o] = ai[eb][r] * CA; }
        if (tb == 3 && hi == 0) { P.AGGP[(b * NCH + c) * LRU_W + chn] = BA[eb] * CA; P.AGGH[(b * NCH + c) * LRU_W + chn] = BA[eb] * CHh + BH[eb]; }
    }
    __syncthreads();
}

__device__ __forceinline__ void mx2_carry(const MixP& P, float* CARRY, int gtid, int NT) {
    const int g2 = NT - 1 - gtid;
    if (g2 < BATCH * LRU_W) { const int b = g2 >> 10, chn = g2 & 1023; float ap[NCH], ah[NCH];
#pragma unroll
        for (int c = 0; c < NCH; ++c) { const int o = (b * NCH + c) * LRU_W + chn; ap[c] = P.AGGP[o]; ah[c] = P.AGGH[o]; }
        float carry = 0.f;
#pragma unroll
        for (int c = 0; c < NCH; ++c) { CARRY[(b * NCH + c) * LRU_W + chn] = carry; carry = ap[c] * carry + ah[c]; } }
}
__device__ __forceinline__ void mx3_unit(const MixP& P, const float* CARRY, int tid, int b, int c, int tq) {
    typedef float f32x2v __attribute__((ext_vector_type(2)));
    const int chn = 2 * tid; const f32x2v cr = *(const GAS f32x2v*)(CARRY + (b * NCH + c) * LRU_W + chn);
    const size_t row0 = (size_t)b * SEQ + c * CH + tq * 32;
#pragma unroll 4
    for (int i = 0; i < 32; ++i) { const size_t row = row0 + i; const f32x2v h = *(const GAS f32x2v*)(P.HLOC + row * LRU_W + chn), p = *(const GAS f32x2v*)(P.PCUM + row * LRU_W + chn);
        const unsigned yy = *(const GAS unsigned*)(P.YA + row * LRU_W + chn);
        *(GAS unsigned*)(P.MIX + row * DM + chn) = pk2((h.x + p.x * cr.x) * gelu_tanh(bflo(yy)), (h.y + p.y * cr.y) * gelu_tanh(bfhi(yy))); }
}
}
#ifndef IDLE_TICKS
#define IDLE_TICKS 3500u
#endif
#ifndef REPMASK
#define REPMASK 0
#endif
#define PHASE_REP(bit) for (int rep_ = 0; rep_ <= ((REPMASK >> (bit)) & 1); ++rep_)
#ifndef MX1R_UNIT
#define MX1R_UNIT rgl::mx1_unit
#endif
#ifndef MX1M_UNIT
#define MX1M_UNIT mls::mx1_unit
#endif
#ifndef MX3M_UNIT
#define MX3M_UNIT mls::mx3_unit
#endif

__device__ __forceinline__ KArgs fresh_args() { KArgs p = (KArgs)__builtin_amdgcn_kernarg_segment_ptr(); asm volatile("" : "+s"(p)); return p; }
__device__ __forceinline__ void fill_mixp(MixP& P, KArgs ap, unsigned char* ws, int j) {
    P.XA = (const float*)(ws + WS_P0); P.YA = (const bf16*)(ws + WS_P0 + 32 * MiB); P.Qm = (const bf16*)(ws + WS_P0 + 48 * MiB); P.Km = (const bf16*)(ws + WS_P0 + 56 * MiB);
    P.Vm = (const bf16*)(ws + WS_P0 + 64 * MiB); P.Om = (const bf16*)(ws + WS_P0 + 80 * MiB); P.IG = (const float*)(ws + WS_IG); P.FG = (const float*)(ws + WS_IG + 128 * 1024); P.MIX = (bf16*)(ws + WS_MIX);
    P.conv_w = ap->in[11] + (size_t)j * 4 * LRU_W; P.conv_b = ap->in[12] + (size_t)j * LRU_W; P.gate_w = ap->in[13] + (size_t)j * 2 * NBLK * BW * BW; P.gate_b = ap->in[14] + (size_t)j * 2 * LRU_W;
    P.lam = ap->in[15] + (size_t)j * LRU_W; P.mgb = ap->in[16] + (size_t)j * 2 * MH; P.mng = ap->in[17] + (size_t)j * MLW;
    P.DC = (float*)(ws + WS_DC); P.CIN = (bf16*)(ws + WS_CIN); P.DN = (float*)(ws + WS_SMALL); P.NIN = (float*)(ws + WS_SMALL + 128 * 1024); P.MLOC = (float*)(ws + WS_SMALL + 256 * 1024);
    P.BLAST = (float*)(ws + WS_SMALL + 257 * 1024); P.MIN = (float*)(ws + WS_SMALL + 258 * 1024); P.HLOC = (float*)(ws + WS_HLOC); P.PCUM = (float*)(ws + WS_PCUM);
    P.AGGP = (float*)(ws + WS_AGG); P.AGGH = (float*)(ws + WS_AGG + 256 * 1024); P.HTMP = (float*)(ws + WS_HTMP);
}
__global__ void __launch_bounds__(NWAVES * 64, 2) fwd_kernel(Args args) {
    extern __shared__ __attribute__((aligned(16))) unsigned char lds_raw[];
    LAS unsigned char* lds = (LAS unsigned char*)lds_raw;
    const int tid0 = threadIdx.x; const int wave_s = __builtin_amdgcn_readfirstlane(tid0 >> 6);
    const int G = gridDim.x, bx = blockIdx.x; const int vcu = (G % 8 == 0) ? (bx % 8) * (G / 8) + bx / 8 : bx;
    const int NGW = G * NWAVES;
#define FRESH() const int tid = fresh_tid(wave_s), lane = tid & 63, wave = __builtin_amdgcn_readfirstlane(tid >> 6), gw = vcu * NWAVES + wave; (void)lane; (void)gw; const KArgs ap = fresh_args(); unsigned char* const ws = ap->ws; (void)ws
    volatile LAS unsigned* MISC = (volatile LAS unsigned*)(lds + MISC_OFF);
    if (tid0 < 64) MISC[tid0] = 0u;
    __syncthreads();
    XcdBarrier bar = xcd_barrier_post((unsigned*)(args.ws + WS_CTL) + CW_BAR, MISC + 8);
#define GRID_BAR() do { XcdBarrier b2_ = bar; asm volatile("" : "+s"(b2_.x)); asm volatile("" : "+s"(b2_.bar)); xcd_barrier(b2_); } while (0)

PHASE_REP(0) {     { FRESH(); p0_prologue(ap, lds, tid, lane, wave, vcu, G); }
    GRID_BAR(); }

    for (int layer = 0; layer < DEPTH; ++layer) {
        const int j = layer >> 1;
PHASE_REP(1) {
        { FRESH(); const int na_ = (G == 256) ? CONV_NA : 0, nb_ = (G == 256) ? CONV_NB : 0;
          if (layer == 1) conv_range(ap, lds, lane, wave, CONV_END0 + na_ + nb_, CONV_END1 - (CONV_END0 + na_ + nb_), gw, NGW);
          if (layer == 2) conv_range(ap, lds, lane, wave, CONV_END1 + nb_, CONV_END2 - (CONV_END1 + nb_), gw, NGW);
          if (layer == 3) conv_range(ap, lds, lane, wave, CONV_END2 + na_ + nb_, CONV_END3 - (CONV_END2 + na_ + nb_), gw, NGW);
          norm_phase((layer == 0) ? ap->in[0] : (const float*)nullptr, (const bf16*)(ws + WS_X2), ap->in[4] + (size_t)(layer * 2 + 0) * DM, (const float*)(ws + WS_MOD) + (size_t)(layer * 2 + 0) * 2 * 6144, (bf16*)(ws + WS_HN), lane, gw, NGW); }
        GRID_BAR(); }
        if ((layer & 1) == 0) {
PHASE_REP(2) {
            { FRESH(); pg8::Gemm g{(const bf16*)(ws + WS_HN), (const bf16*)(ws + WS_WABIN) + (size_t)j * AB_IN_PAD * 2048, M, AB_IN_PAD, DM}; pg8::StaticOrder S; S.init(M, AB_IN_PAD, G, bx);
              pg8::EpiInProj E{(float*)(ws + WS_P0), (bf16*)(ws + WS_P0 + 32 * MiB), (bf16*)(ws + WS_P0 + 48 * MiB), (bf16*)(ws + WS_P0 + 56 * MiB), (bf16*)(ws + WS_P0 + 64 * MiB), (bf16*)(ws + WS_P0 + 80 * MiB),
                               (float*)(ws + WS_IG), (float*)(ws + WS_IG + 128 * 1024), 0.08838834764831845f};
              pg8::gemm_phase<pg8::EpiInProj, pg8::StaticOrder, PG8_ALIGN, PG8_SP2>(lds, g, S, E, tid);
              if (G == 256 && bx >= 160) conv_range(ap, lds, lane, wave, (layer == 0 ? CONV_END0 : CONV_END2), CONV_NA, (bx - 160) * NWAVES + wave, 96 * NWAVES); }
            GRID_BAR(); }
PHASE_REP(3) {
            { FRESH(); MixP P; fill_mixp(P, ap, ws, j);
              for (int u = vcu; u < 768; u += G) {
                if (u < 256) MX1M_UNIT(P, lds, tid, u >> 7, (u >> 5) & 3, u & 31);
                else { const int r = u - 256; MX1R_UNIT(P, (const bf16*)(ws + WS_WGT) + (size_t)j * 16 * 16384, lds, tid, r >> 8, (r >> 5) & 7, r & 31); }
            } }
            GRID_BAR(); }
PHASE_REP(4) {
            { FRESH(); MixP P; fill_mixp(P, ap, ws, j); mx2_mlstm(P, lds, tid, vcu * 512 + tid, G * 512); rgl::mx2_carry(P, (float*)(ws + WS_CARRY), vcu * 512 + tid, G * 512); }
            GRID_BAR(); }
PHASE_REP(5) {
            { FRESH(); MixP P; fill_mixp(P, ap, ws, j);
              for (int u = vcu; u < 512; u += G) {
                if (u < 256) MX3M_UNIT(P, lds, tid, u >> 7, (u >> 5) & 3, u & 31);
                else { const int r = u - 256; rgl::mx3_unit(P, (const float*)(ws + WS_CARRY), tid, r >> 7, (r >> 2) & 31, r & 3); }
            } }
            GRID_BAR(); }
        } else {
PHASE_REP(6) {
            { FRESH(); pg8::Gemm g{(const bf16*)(ws + WS_HN), (const bf16*)(ws + WS_WQKV) + (size_t)j * 6144 * 2048, M, 6144, DM}; pg8::StaticOrder S; S.init(M, 6144, G, bx);
              pg8::EpiBf16Split E{(bf16*)(ws + WS_P0), DM, DM, (size_t)M * DM, 0.08838834764831845f * LOG2E};
              pg8::gemm_phase<pg8::EpiBf16Split, pg8::StaticOrder, PG8_ALIGN, PG8_SP2>(lds, g, S, E, tid); }
            GRID_BAR(); }
PHASE_REP(7) {             { FRESH(); sba::attn_phase((const bf16*)(ws + WS_P0), (const bf16*)(ws + WS_P0) + (size_t)M * DM, (const bf16*)(ws + WS_P0) + (size_t)2 * M * DM, (bf16*)(ws + WS_MIX), lds, tid, vcu, G); }
            GRID_BAR(); }
        }
        { FRESH(); const bf16* Bt = ((layer & 1) == 0) ? (const bf16*)(ws + WS_WABOUT) + (size_t)j * 2048 * 2048 : (const bf16*)(ws + WS_WSBO) + (size_t)j * 2048 * 2048;
          pg8::Gemm g{(const bf16*)(ws + WS_MIX), Bt, M, DM, DM}; pg8::StaticOrder S; S.init(M, DM, G, bx);
          pg8::EpiResid E{(layer == 0) ? ap->in[0] : (const float*)nullptr, (const bf16*)(ws + WS_X2), (bf16*)(ws + WS_X2), (const float*)(ws + WS_MOD) + (size_t)(layer * 2 + 0) * 2 * 6144 + 4096};
          pg8::gemm_phase<pg8::EpiResid, pg8::StaticOrder, PG8_ALIGN, PG8_SP2>(lds, g, S, E, tid); }
        GRID_BAR();
PHASE_REP(1) {
        { FRESH(); norm_phase((const float*)nullptr, (const bf16*)(ws + WS_X2), ap->in[4] + (size_t)(layer * 2 + 1) * DM, (const float*)(ws + WS_MOD) + (size_t)(layer * 2 + 1) * 2 * 6144, (bf16*)(ws + WS_HN), lane, gw, NGW); }
        GRID_BAR(); }
PHASE_REP(8) {
        { FRESH(); pg8::Gemm g{(const bf16*)(ws + WS_HN), (const bf16*)(ws + WS_W13) + (size_t)layer * 2 * FF * 2048, M, 2 * FF, DM}; pg8::StaticOrder S; S.init(M, 2 * FF, G, bx);
          pg8::EpiSwiGLU E{(bf16*)(ws + WS_ACT)};
          pg8::gemm_phase<pg8::EpiSwiGLU, pg8::StaticOrder, PG8_ALIGN, PG8_SP2>(lds, g, S, E, tid);
          if (G == 256 && bx >= 128 && layer < 3) conv_range(ap, lds, lane, wave, (layer == 0 ? CONV_END0 + CONV_NA : (layer == 1 ? CONV_END1 : CONV_END2 + CONV_NA)), CONV_NB, (bx - 128) * NWAVES + wave, 128 * NWAVES); }
        GRID_BAR(); }
        { FRESH(); pg8::Gemm g{(const bf16*)(ws + WS_ACT), (const bf16*)(ws + WS_W2) + (size_t)layer * 2048 * FF, M, DM, FF}; pg8::StaticOrder S; S.init(M, DM, G, bx);
          pg8::EpiResid E{(const float*)nullptr, (const bf16*)(ws + WS_X2), (bf16*)(ws + WS_X2), (const float*)(ws + WS_MOD) + (size_t)(layer * 2 + 1) * 2 * 6144 + 4096};
          pg8::gemm_phase<pg8::EpiResid, pg8::StaticOrder, PG8_ALIGN, PG8_SP2>(lds, g, S, E, tid); }
        GRID_BAR();
    }
    { FRESH(); final_norm_phase((const bf16*)(ws + WS_X2), ap->in[5], ap->out, lane, gw, NGW); }
}

extern "C" void kernel_launch(void* const* d_in, const int* in_sizes, int n_in, void* d_out, int out_size, void* d_ws, size_t ws_size, hipStream_t stream) {
    static int grid = 0;
    if (grid == 0) {
        if (n_in != 20 || in_sizes[0] != M * DM || out_size != M * DM || ws_size < WS_END) { fprintf(stderr, "kernel_launch: unexpected shapes: n_in %d in0 %d out %d ws %zu (need %zu); nothing launched\n", n_in, n_in > 0 ? in_sizes[0] : -1, out_size, ws_size, (size_t)WS_END); grid = -1; return; }
        int dev = 0, cus = 0, per_cu = 0;
        if (hipGetDevice(&dev) != hipSuccess || hipDeviceGetAttribute(&cus, hipDeviceAttributeMultiprocessorCount, dev) != hipSuccess) { fprintf(stderr, "kernel_launch: device query failed\n"); grid = -1; return; }
        if (hipFuncSetAttribute((const void*)fwd_kernel, hipFuncAttributeMaxDynamicSharedMemorySize, LDS_BYTES) != hipSuccess) { fprintf(stderr, "kernel_launch: hipFuncSetAttribute failed\n"); grid = -1; return; }
        if (hipOccupancyMaxActiveBlocksPerMultiprocessor(&per_cu, (const void*)fwd_kernel, NWAVES * 64, LDS_BYTES) != hipSuccess || per_cu < 1)
            fprintf(stderr, "kernel_launch: note: occupancy query reports %d workgroups per CU\n", per_cu);
        (void)hipGetLastError();
        grid = cus;
    }
    if (grid < 0) return;
    if (hipMemsetAsync((char*)d_ws + WS_CTL, 0, CTL_ZERO_BYTES, stream) != hipSuccess) { fprintf(stderr, "kernel_launch: memset failed\n"); return; }
    Args a{};
    for (int i = 0; i < 20; ++i) a.in[i] = (const float*)d_in[i];
    a.out = (float*)d_out; a.ws = (unsigned char*)d_ws;
    hipLaunchKernelGGL(fwd_kernel, dim3(grid), dim3(NWAVES * 64), LDS_BYTES, stream, a);
    const hipError_t le = hipPeekAtLastError();
    if (le != hipSuccess) fprintf(stderr, "kernel_launch: launch failed: %s\n", hipGetErrorName(le));
}
```
